# Optimizing an MI355X kernel written in HIP

```python
import jax, jax.numpy as jnp
from jax import lax
import numpy as np

D_MODEL = 1024
BATCH = 8
SEQ = 4096
DEPTH = 4

GRID_W = 64
CTX_LEN = 256
EPS = 1e-6

CHUNK = 128
A_GROUPS = 4
A_GROUP_DIM = 128
A_WIDTH = A_GROUPS * A_GROUP_DIM
HEAD_DIM = 64
B_Q_HEADS = 8
B_KV_HEADS = 2
B_GQA = B_Q_HEADS // B_KV_HEADS
B_WIDTH = B_Q_HEADS * HEAD_DIM
KV_WIDTH = B_KV_HEADS * HEAD_DIM
WINDOW = 128
BLOCK = 128
ROPE_THETA = 10000.0
AB_SIZES = (A_WIDTH, A_WIDTH, A_WIDTH, B_WIDTH, KV_WIDTH, KV_WIDTH, B_WIDTH)
AB_IN = 3 * A_WIDTH + 2 * B_WIDTH + 2 * KV_WIDTH
AB_MIX = A_WIDTH + B_WIDTH
AB_K_OFF = 3 * A_WIDTH + B_WIDTH

C_WIDTH = D_MODEL
C_HEADS = 4
C_BLOCK = C_WIDTH // C_HEADS
CONV_W = 4
CONV_LEFT = 2
LRU_C = 8.0

N_EVEN = (DEPTH + 1) // 2
N_ODD = DEPTH // 2

kernel_name = "hybrid_gmlp_swa_rglru_prefix_dit"


def _split(p, sizes):
    outs, off = [], 0
    for s in sizes:
        outs.append(p[..., off:off + s])
        off += s
    return outs


def rmsnorm(x, g):
    xf = x.astype(jnp.float32)
    y = xf * lax.rsqrt(jnp.mean(xf * xf, axis=-1, keepdims=True) + EPS)
    return (y * g).astype(x.dtype)


def group_layernorm(v, g, b):
    vf = v.astype(jnp.float32)
    mu = jnp.mean(vf, axis=-1, keepdims=True)
    var = jnp.mean(jnp.square(vf - mu), axis=-1, keepdims=True)
    return ((vf - mu) * lax.rsqrt(var + EPS) * g + b).astype(v.dtype)


def axial_rope(L):
    rows = L // GRID_W
    r, col = jnp.meshgrid(jnp.arange(rows), jnp.arange(GRID_W), indexing="ij")
    r = r.reshape(-1).astype(jnp.float32)
    col = col.reshape(-1).astype(jnp.float32)
    n_freq = HEAD_DIM // 4
    inv_freq = ROPE_THETA ** (-jnp.arange(n_freq, dtype=jnp.float32) / n_freq)
    ang = jnp.concatenate([r[:, None] * inv_freq, col[:, None] * inv_freq], axis=-1)
    return jnp.cos(ang), jnp.sin(ang)


def apply_rope(x, cos, sin):
    half = HEAD_DIM // 2
    x1, x2 = x[..., :half], x[..., half:]
    c, s = cos[None, :, None, :], sin[None, :, None, :]
    return jnp.concatenate([x1 * c - x2 * s, x2 * c + x1 * s], axis=-1).astype(x.dtype)


def chunk_gmlp(u, v, ln_g, ln_b, w_s, b_s):
    bsz, L, _ = u.shape
    n = L // CHUNK
    v = group_layernorm(v.reshape(bsz, L, A_GROUPS, A_GROUP_DIM),
                        ln_g.reshape(A_GROUPS, A_GROUP_DIM), ln_b.reshape(A_GROUPS, A_GROUP_DIM))
    v = v.reshape(bsz, n, CHUNK, A_GROUPS, A_GROUP_DIM)
    sv = jnp.einsum("gpq,bnqgd->bnpgd", w_s, v) + b_s.T[None, None, :, :, None]
    return u * sv.reshape(bsz, L, A_WIDTH)


def _sink_logits(sink, bsz, nq):
    s = sink.reshape(B_KV_HEADS, B_GQA).astype(jnp.float32)[None, :, :, None, None]
    return jnp.broadcast_to(s, (bsz, B_KV_HEADS, B_GQA, nq, 1))


def window_attention(q, k, v, k_c, v_c, sink):
    bsz, L, _, _ = q.shape
    Lc = k_c.shape[1]
    n = L // BLOCK
    q = q.reshape(bsz, L, B_KV_HEADS, B_GQA, HEAD_DIM) * (HEAD_DIM ** -0.5)
    pad = ((0, 0), (BLOCK, BLOCK), (0, 0), (0, 0))
    k_pad = jnp.pad(k, pad)
    v_pad = jnp.pad(v, pad)
    s_sink = _sink_logits(sink, bsz, BLOCK)

    def block(j):
        start = j * BLOCK
        qb = lax.dynamic_slice_in_dim(q, start, BLOCK, axis=1)
        kb = lax.dynamic_slice_in_dim(k_pad, start, 3 * BLOCK, axis=1)
        vb = lax.dynamic_slice_in_dim(v_pad, start, 3 * BLOCK, axis=1)
        s_loc = jnp.einsum("bqkgd,bskd->bkgqs", qb, kb).astype(jnp.float32)
        qpos = start + jnp.arange(BLOCK)
        kpos = start - BLOCK + jnp.arange(3 * BLOCK)
        valid = (jnp.abs(qpos[:, None] - kpos[None, :]) <= WINDOW) & (kpos[None, :] >= 0) & (kpos[None, :] < L)
        s_loc = jnp.where(valid, s_loc, -1e30)
        s_ctx = jnp.einsum("bqkgd,bskd->bkgqs", qb, k_c).astype(jnp.float32)
        p = jax.nn.softmax(jnp.concatenate([s_sink, s_ctx, s_loc], axis=-1), axis=-1)
        p_ctx = p[..., 1:1 + Lc].astype(v.dtype)
        p_loc = p[..., 1 + Lc:].astype(v.dtype)
        return (jnp.einsum("bkgqs,bskd->bqkgd", p_ctx, v_c)
                + jnp.einsum("bkgqs,bskd->bqkgd", p_loc, vb))

    out = lax.map(block, jnp.arange(n))
    return out.transpose(1, 0, 2, 3, 4, 5).reshape(bsz, L, B_WIDTH)


def context_attention(q_c, k_c, v_c, sink):
    bsz, Lc, _, _ = q_c.shape
    q_c = q_c.reshape(bsz, Lc, B_KV_HEADS, B_GQA, HEAD_DIM) * (HEAD_DIM ** -0.5)
    s = jnp.einsum("bqkgd,bskd->bkgqs", q_c, k_c).astype(jnp.float32)
    p = jax.nn.softmax(jnp.concatenate([_sink_logits(sink, bsz, Lc), s], axis=-1), axis=-1)
    out = jnp.einsum("bkgqs,bskd->bqkgd", p[..., 1:].astype(v_c.dtype), v_c)
    return out.reshape(bsz, Lc, B_WIDTH)


def even_mixer(h, hc, w_in, ln_g, ln_b, w_s, b_s, sink, w_out, cos, sin, need_ctx):
    bsz, L, _ = h.shape
    Lc = hc.shape[1]
    u, v, ga, q, k, vv, gb = _split(h @ w_in, AB_SIZES)
    ya = chunk_gmlp(jax.nn.gelu(u), jax.nn.gelu(v), ln_g, ln_b, w_s, b_s) * jax.nn.silu(ga)
    if need_ctx:
        uc, vc, gac, qc, kc, vvc, gbc = _split(hc @ w_in, AB_SIZES)
    else:
        kc, vvc = _split(hc @ w_in[:, AB_K_OFF:AB_K_OFF + 2 * KV_WIDTH], (KV_WIDTH, KV_WIDTH))
    kc = kc.reshape(bsz, Lc, B_KV_HEADS, HEAD_DIM)
    vvc = vvc.reshape(bsz, Lc, B_KV_HEADS, HEAD_DIM)
    q = apply_rope(q.reshape(bsz, L, B_Q_HEADS, HEAD_DIM), cos, sin)
    k = apply_rope(k.reshape(bsz, L, B_KV_HEADS, HEAD_DIM), cos, sin)
    vv = vv.reshape(bsz, L, B_KV_HEADS, HEAD_DIM)
    yb = window_attention(q, k, vv, kc, vvc, sink) * jax.nn.silu(gb)
    y = jnp.concatenate([ya, yb], axis=-1) @ w_out
    if not need_ctx:
        return y, None
    yac = chunk_gmlp(jax.nn.gelu(uc), jax.nn.gelu(vc), ln_g, ln_b, w_s, b_s) * jax.nn.silu(gac)
    ybc = context_attention(qc.reshape(bsz, Lc, B_Q_HEADS, HEAD_DIM), kc, vvc, sink) * jax.nn.silu(gbc)
    yc = jnp.concatenate([yac, ybc], axis=-1) @ w_out
    return y, yc


def depthwise_conv(z, w, b):
    ch = z.shape[-1]
    out = lax.conv_general_dilated(z, w[:, None, :], window_strides=(1,),
                                   padding=[(CONV_LEFT, CONV_W - 1 - CONV_LEFT)],
                                   dimension_numbers=("NWC", "WIO", "NWC"),
                                   feature_group_count=ch)
    return out + b


def rglru_coeffs(z, w_a, b_a, w_i, b_i, lam):
    bsz, L, _ = z.shape
    zb = z.reshape(bsz, L, C_HEADS, C_BLOCK)
    r = jax.nn.sigmoid((jnp.einsum("blhi,hij->blhj", zb, w_a).reshape(bsz, L, C_WIDTH) + b_a).astype(jnp.float32))
    ig = jax.nn.sigmoid((jnp.einsum("blhi,hij->blhj", zb, w_i).reshape(bsz, L, C_WIDTH) + b_i).astype(jnp.float32))
    log_a = -LRU_C * r * jax.nn.softplus(-lam.astype(jnp.float32))
    a = jnp.exp(log_a)
    bx = jnp.sqrt(-jnp.expm1(2.0 * log_a)) * (ig * z.astype(jnp.float32))
    return a, bx


def linear_scan(a, b, h0, reverse):
    if reverse:
        a, b = jnp.flip(a, axis=1), jnp.flip(b, axis=1)

    def combine(e1, e2):
        a1, b1 = e1
        a2, b2 = e2
        return a1 * a2, a2 * b1 + b2

    a_cum, b_cum = lax.associative_scan(combine, (a, b), axis=1)
    h = a_cum * h0[:, None, :] + b_cum
    if reverse:
        h = jnp.flip(h, axis=1)
    return h


def odd_mixer(h, hc, w_in, conv_w, conv_b, w_a, b_a, w_i, b_i, lam, w_out, need_ctx):
    bsz = h.shape[0]
    xr, g = _split(h @ w_in, (C_WIDTH, C_WIDTH))
    if need_ctx:
        xr_c, g_c = _split(hc @ w_in, (C_WIDTH, C_WIDTH))
    else:
        xr_c = hc @ w_in[:, :C_WIDTH]
    z = depthwise_conv(xr, conv_w, conv_b)
    z_c = depthwise_conv(xr_c, conv_w, conv_b)
    h_lat = None
    h_ctx = None
    for d, reverse in ((0, False), (1, True)):
        a_c, b_c = rglru_coeffs(z_c, w_a[d], b_a[d], w_i[d], b_i[d], lam[d])
        s_c = linear_scan(a_c, b_c, jnp.zeros((bsz, C_WIDTH), jnp.float32), reverse)
        h0 = s_c[:, 0] if reverse else s_c[:, -1]
        a_l, b_l = rglru_coeffs(z, w_a[d], b_a[d], w_i[d], b_i[d], lam[d])
        s_l = linear_scan(a_l, b_l, h0, reverse)
        h_lat = s_l if h_lat is None else h_lat + s_l
        if need_ctx:
            h_ctx = s_c if h_ctx is None else h_ctx + s_c
    y = (h_lat.astype(h.dtype) * jax.nn.silu(g)) @ w_out
    if not need_ctx:
        return y, None
    yc = (h_ctx.astype(hc.dtype) * jax.nn.silu(g_c)) @ w_out
    return y, yc


def setup_inputs(seed: int = 0) -> dict:
    key = jax.random.key(seed)
    ks = jax.random.split(key, 32)
    n = jax.random.normal
    f32 = jnp.float32
    d = D_MODEL
    u_lam = jax.random.uniform(ks[22], (N_ODD, 2, C_WIDTH), f32, minval=0.9, maxval=0.999)
    a0 = u_lam ** (1.0 / LRU_C)
    return {
        "x": n(ks[0], (BATCH, SEQ, d), f32),
        "c": n(ks[1], (BATCH, d), f32),
        "ctx": n(ks[2], (BATCH, CTX_LEN, d), f32),
        "c_ctx": n(ks[3], (d,), f32),
        "norm_g": 1.0 + 0.02 * n(ks[4], (DEPTH, d), f32),
        "w_mod": n(ks[5], (DEPTH, d, 3 * d), f32) * (0.5 * d ** -0.5),
        "b_mod": 0.02 * n(ks[6], (DEPTH, 3 * d), f32),
        "ab_w_in": n(ks[7], (N_EVEN, d, AB_IN), f32) * d ** -0.5,
        "a_ln_g": 1.0 + 0.02 * n(ks[8], (N_EVEN, A_WIDTH), f32),
        "a_ln_b": 0.02 * n(ks[9], (N_EVEN, A_WIDTH), f32),
        "a_w_s": n(ks[10], (N_EVEN, A_GROUPS, CHUNK, CHUNK), f32) * CHUNK ** -0.5,
        "a_b_s": 1.0 + 0.02 * n(ks[11], (N_EVEN, A_GROUPS, CHUNK), f32),
        "b_sink": 0.5 * n(ks[12], (N_EVEN, B_Q_HEADS), f32),
        "ab_w_out": n(ks[13], (N_EVEN, AB_MIX, d), f32) * AB_MIX ** -0.5,
        "c_w_in": n(ks[14], (N_ODD, d, 2 * C_WIDTH), f32) * d ** -0.5,
        "c_conv_w": n(ks[15], (N_ODD, CONV_W, C_WIDTH), f32) * CONV_W ** -0.5,
        "c_conv_b": 0.02 * n(ks[16], (N_ODD, C_WIDTH), f32),
        "c_w_a": n(ks[17], (N_ODD, 2, C_HEADS, C_BLOCK, C_BLOCK), f32) * C_BLOCK ** -0.5,
        "c_b_a": 0.02 * n(ks[18], (N_ODD, 2, C_WIDTH), f32),
        "c_w_i": n(ks[19], (N_ODD, 2, C_HEADS, C_BLOCK, C_BLOCK), f32) * C_BLOCK ** -0.5,
        "c_b_i": 0.02 * n(ks[20], (N_ODD, 2, C_WIDTH), f32),
        "c_lam": jnp.log(a0) - jnp.log1p(-a0),
        "c_w_out": n(ks[21], (N_ODD, C_WIDTH, d), f32) * C_WIDTH ** -0.5,
        "final_g": 1.0 + 0.02 * n(ks[23], (d,), f32),
    }


def reference(x, c, ctx, c_ctx, norm_g, w_mod, b_mod, ab_w_in, a_ln_g, a_ln_b, a_w_s, a_b_s, b_sink,
              ab_w_out, c_w_in, c_conv_w, c_conv_b, c_w_a, c_b_a, c_w_i, c_b_i, c_lam, c_w_out, final_g):
    L = x.shape[1]
    cos, sin = axial_rope(L)
    silu_c = jax.nn.silu(c)
    silu_cc = jax.nn.silu(c_ctx)
    xc = ctx
    for layer in range(DEPTH):
        need_ctx = layer < DEPTH - 1
        shift, scale, gate = jnp.split((silu_c @ w_mod[layer] + b_mod[layer])[:, None, :], 3, axis=-1)
        shift_c, scale_c, gate_c = jnp.split(silu_cc @ w_mod[layer] + b_mod[layer], 3, axis=-1)
        h = rmsnorm(x, norm_g[layer]) * (1.0 + scale) + shift
        hc = rmsnorm(xc, norm_g[layer]) * (1.0 + scale_c) + shift_c
        i = layer // 2
        if layer % 2 == 0:
            y, yc = even_mixer(h, hc, ab_w_in[i], a_ln_g[i], a_ln_b[i], a_w_s[i], a_b_s[i], b_sink[i],
                               ab_w_out[i], cos, sin, need_ctx)
        else:
            y, yc = odd_mixer(h, hc, c_w_in[i], c_conv_w[i], c_conv_b[i], c_w_a[i], c_b_a[i], c_w_i[i],
                              c_b_i[i], c_lam[i], c_w_out[i], need_ctx)
        x = x + gate * y
        if need_ctx:
            xc = xc + gate_c * yc
    return rmsnorm(x, final_g)
```

```cpp
#include <hip/hip_runtime.h>
#include <hip/hip_cooperative_groups.h>
#include <stdint.h>
#include <stdio.h>
namespace cg = cooperative_groups;

#ifndef COOP
#define COOP 1
#endif

typedef unsigned short bf16_t;
typedef __attribute__((ext_vector_type(8))) short bf16x8;
typedef __attribute__((ext_vector_type(16))) float f32x16;
typedef __attribute__((ext_vector_type(4))) unsigned int u32x4;
typedef __attribute__((ext_vector_type(2))) unsigned int u32x2;

constexpr int DM = 1024;
constexpr int NBATCH = 8;
constexpr int SEQL = 4096;
constexpr int LCTX = 256;
constexpr int NL = NBATCH * SEQL;
constexpr int NC = NBATCH * LCTX;
constexpr int NR = NL + NC;
constexpr int SMEM_BYTES = 72 * 1024;
constexpr int NTHREADS = 256;

struct Params {
  const float *x, *c, *ctx, *c_ctx, *norm_g, *w_mod, *b_mod, *ab_w_in, *a_ln_g, *a_ln_b, *a_w_s, *a_b_s,
      *b_sink, *ab_w_out, *c_w_in, *c_conv_w, *c_conv_b, *c_w_a, *c_b_a, *c_w_i, *c_b_i, *c_lam, *c_w_out,
      *final_g;
  float* out;
  float* xbuf;
  float* mods;
  bf16_t* hbuf;
  bf16_t* ebuf;
  bf16_t *wt_in_e, *wt_out_e, *wt_in_o, *wt_out_o, *wga, *wgi;
};

__device__ __forceinline__ bf16_t f2bf(float f) {
  uint32_t u = __float_as_uint(f);
  u += 0x7fffu + ((u >> 16) & 1u);
  return (bf16_t)(u >> 16);
}
__device__ __forceinline__ float bf2f(bf16_t b) { return __uint_as_float(((uint32_t)b) << 16); }
__device__ __forceinline__ uint32_t pack2(float a, float b) {
  return (uint32_t)f2bf(a) | ((uint32_t)f2bf(b) << 16);
}
__device__ __forceinline__ float lo_bf(uint32_t u) { return __uint_as_float(u << 16); }
__device__ __forceinline__ float hi_bf(uint32_t u) { return __uint_as_float(u & 0xffff0000u); }
__device__ __forceinline__ float silu_f(float x) { return x / (1.f + __expf(-x)); }
__device__ __forceinline__ float sigmoid_f(float x) { return 1.f / (1.f + __expf(-x)); }
__device__ __forceinline__ float gelu_f(float x) {
  float y = 0.7978845608028654f * (x + 0.044715f * x * x * x);
  float t = 1.f - 2.f / (1.f + __expf(2.f * y));
  return 0.5f * x * (1.f + t);
}
__device__ __forceinline__ f32x16 zero16() {
  f32x16 z;
#pragma unroll
  for (int i = 0; i < 16; ++i) z[i] = 0.f;
  return z;
}
__device__ __forceinline__ float wave_sum(float v) {
#pragma unroll
  for (int o = 32; o > 0; o >>= 1) v += __shfl_xor(v, o);
  return v;
}

__device__ __forceinline__ int otid() {
  int t = threadIdx.x;
  asm volatile("" : "+v"(t));
  return t;
}

struct EvenBufs {
  bf16_t *ug, *vg, *gas, *qb, *gbs, *kb, *vtl, *vtc;
};
__device__ __forceinline__ EvenBufs even_bufs(const Params& p) {
  EvenBufs e;
  e.ug = p.ebuf;
  e.vg = e.ug + (size_t)NR * 512;
  e.gas = e.vg + (size_t)NR * 512;
  e.qb = e.gas + (size_t)NR * 512;
  e.gbs = e.qb + (size_t)NR * 512;
  e.kb = e.gbs + (size_t)NR * 512;
  e.vtl = e.kb + (size_t)NR * 128;
  e.vtc = e.vtl + (size_t)NBATCH * 128 * SEQL;
  return e;
}
struct OddBufs {
  bf16_t *xr, *sg, *sb;
};
__device__ __forceinline__ OddBufs odd_bufs(const Params& p) {
  OddBufs o;
  o.xr = p.ebuf;
  o.sg = o.xr + (size_t)NR * 1024;
  o.sb = o.sg + (size_t)NR * 1024;
  return o;
}

__device__ void transpose_item(const Params& p, int item, char* smem) {
  float* tile = (float*)smem;
  const float* src;
  bf16_t* dst;
  int K, N, local;
  if (item < 1408) { src = p.ab_w_in; dst = p.wt_in_e; K = 1024; N = 2816; local = item; }
  else if (item < 1920) { src = p.ab_w_out; dst = p.wt_out_e; K = 1024; N = 1024; local = item - 1408; }
  else if (item < 2944) { src = p.c_w_in; dst = p.wt_in_o; K = 1024; N = 2048; local = item - 1920; }
  else if (item < 3456) { src = p.c_w_out; dst = p.wt_out_o; K = 1024; N = 1024; local = item - 2944; }
  else if (item < 3712) { src = p.c_w_a; dst = p.wga; K = 256; N = 256; local = item - 3456; }
  else { src = p.c_w_i; dst = p.wgi; K = 256; N = 256; local = item - 3712; }
  const int ntn = N / 64;
  const int tpb = (K / 64) * ntn;
  const int bi = local / tpb;
  const int rem = local % tpb;
  const int k0 = (rem / ntn) * 64, n0 = (rem % ntn) * 64;
  src += (size_t)bi * K * N;
  dst += (size_t)bi * K * N;
  const int tid = otid();
  __syncthreads();
#pragma unroll
  for (int i = 0; i < 16; ++i) {
    int rr = i * 4 + (tid >> 6), cc = tid & 63;
    tile[rr * 65 + cc] = src[(size_t)(k0 + rr) * N + n0 + cc];
  }
  __syncthreads();
#pragma unroll
  for (int i = 0; i < 16; ++i) {
    int n = i * 4 + (tid >> 6), k = tid & 63;
    dst[(size_t)(n0 + n) * K + k0 + k] = f2bf(tile[k * 65 + n]);
  }
}

__device__ void mods_item(const Params& p, int item, char* smem) {
  float* sc = (float*)smem;
  float* red = sc + 9 * 1024;
  const int tid = otid();
  const int l = item / 96, n0 = (item % 96) * 32;
  __syncthreads();
  for (int i = tid; i < 9 * 1024; i += NTHREADS) {
    int j = i >> 10, k = i & 1023;
    float v = (j < 8) ? p.c[j * 1024 + k] : p.c_ctx[k];
    sc[i] = silu_f(v);
  }
  __syncthreads();
  const int col = tid & 31, kg = tid >> 5;
  float acc[9];
#pragma unroll
  for (int j = 0; j < 9; ++j) acc[j] = 0.f;
  const float* w = p.w_mod + ((size_t)l * 1024 + kg * 128) * 3072 + n0 + col;
#pragma unroll 8
  for (int k = 0; k < 128; ++k) {
    float wv = w[(size_t)k * 3072];
#pragma unroll
    for (int j = 0; j < 9; ++j) acc[j] += sc[j * 1024 + kg * 128 + k] * wv;
  }
#pragma unroll
  for (int j = 0; j < 9; ++j) red[(kg * 9 + j) * 32 + col] = acc[j];
  __syncthreads();
  for (int i = tid; i < 9 * 32; i += NTHREADS) {
    int j = i >> 5, cc = i & 31;
    float s = 0.f;
#pragma unroll
    for (int g = 0; g < 8; ++g) s += red[(g * 9 + j) * 32 + cc];
    p.mods[((size_t)l * 9 + j) * 3072 + n0 + cc] = s + p.b_mod[l * 3072 + n0 + cc];
  }
}

__device__ void phase0(const Params& p, char* smem) {
  const int total = 3968 + 384;
  for (int item = blockIdx.x; item < total; item += gridDim.x) {
    if (item < 384) mods_item(p, item, smem);
    else transpose_item(p, item - 384, smem);
  }
}

__device__ void phase_prep(const Params& p, int layer) {
  const int tid = otid();
  const int lane = tid & 63;
  const int gw = blockIdx.x * 4 + (tid >> 6);
  const int nw = gridDim.x * 4;
  const float* ng = p.norm_g + layer * 1024;
  for (int R = gw; R < NR; R += nw) {
    const float* src;
    if (layer == 0) src = (R < NL) ? p.x + (size_t)R * 1024 : p.ctx + (size_t)(R - NL) * 1024;
    else src = p.xbuf + (size_t)R * 1024;
    const int bidx = (R < NL) ? (R >> 12) : 8;
    const float* md = p.mods + ((size_t)layer * 9 + bidx) * 3072;
    float4 v[4];
#pragma unroll
    for (int i = 0; i < 4; ++i) v[i] = ((const float4*)src)[lane + 64 * i];
    float ss = 0.f;
#pragma unroll
    for (int i = 0; i < 4; ++i) ss += v[i].x * v[i].x + v[i].y * v[i].y + v[i].z * v[i].z + v[i].w * v[i].w;
    ss = wave_sum(ss);
    const float rstd = rsqrtf(ss * (1.f / 1024.f) + 1e-6f);
#pragma unroll
    for (int i = 0; i < 4; ++i) {
      const int k4 = lane + 64 * i;
      float4 g = ((const float4*)ng)[k4];
      float4 sh = ((const float4*)md)[k4];
      float4 sc = ((const float4*)(md + 1024))[k4];
      float h0 = v[i].x * rstd * g.x * (1.f + sc.x) + sh.x;
      float h1 = v[i].y * rstd * g.y * (1.f + sc.y) + sh.y;
      float h2 = v[i].z * rstd * g.z * (1.f + sc.z) + sh.z;
      float h3 = v[i].w * rstd * g.w * (1.f + sc.w) + sh.w;
      u32x2 pk;
      pk.x = pack2(h0, h1);
      pk.y = pack2(h2, h3);
      *(u32x2*)(p.hbuf + (size_t)R * 1024 + k4 * 4) = pk;
      if (layer == 0) ((float4*)(p.xbuf + (size_t)R * 1024))[k4] = v[i];
    }
  }
}

__device__ void phase_final(const Params& p) {
  const int tid = otid();
  const int lane = tid & 63;
  const int gw = blockIdx.x * 4 + (tid >> 6);
  const int nw = gridDim.x * 4;
  for (int R = gw; R < NL; R += nw) {
    const float* src = p.xbuf + (size_t)R * 1024;
    float4 v[4];
#pragma unroll
    for (int i = 0; i < 4; ++i) v[i] = ((const float4*)src)[lane + 64 * i];
    float ss = 0.f;
#pragma unroll
    for (int i = 0; i < 4; ++i) ss += v[i].x * v[i].x + v[i].y * v[i].y + v[i].z * v[i].z + v[i].w * v[i].w;
    ss = wave_sum(ss);
    const float rstd = rsqrtf(ss * (1.f / 1024.f) + 1e-6f);
#pragma unroll
    for (int i = 0; i < 4; ++i) {
      const int k4 = lane + 64 * i;
      float4 g = ((const float4*)p.final_g)[k4];
      float4 o;
      o.x = v[i].x * rstd * g.x;
      o.y = v[i].y * rstd * g.y;
      o.z = v[i].z * rstd * g.z;
      o.w = v[i].w * rstd * g.w;
      ((float4*)(p.out + (size_t)R * 1024))[k4] = o;
    }
  }
}

constexpr int GS = 72;

__device__ __forceinline__ u32x4 add_bf16x8(u32x4 a, u32x4 b) {
  u32x4 r;
  r.x = pack2(lo_bf(a.x) + lo_bf(b.x), hi_bf(a.x) + hi_bf(b.x));
  r.y = pack2(lo_bf(a.y) + lo_bf(b.y), hi_bf(a.y) + hi_bf(b.y));
  r.z = pack2(lo_bf(a.z) + lo_bf(b.z), hi_bf(a.z) + hi_bf(b.z));
  r.w = pack2(lo_bf(a.w) + lo_bf(b.w), hi_bf(a.w) + hi_bf(b.w));
  return r;
}

template <int AMODE, class Epi>
__device__ void gemm_phase(const bf16_t* __restrict__ A0, const bf16_t* __restrict__ A1,
                           const bf16_t* __restrict__ Bt, int Mtiles, int Ntiles, char* smem, Epi epi) {
  bf16_t* As = (bf16_t*)smem;
  bf16_t* Bs = As + 128 * GS;
  const int tid = otid(), lane = tid & 63, w = tid >> 6;
  const int wm = w >> 1, wn = w & 1;
  const int r = lane & 31, h = lane >> 5;
  const int lrow = tid >> 3, kc = tid & 7;
  const int total = Mtiles * Ntiles;
  for (int tile = blockIdx.x; tile < total; tile += gridDim.x) {
    const int mt = tile / Ntiles, nt = tile % Ntiles;
    const int m0 = mt * 128, n0 = nt * 128;
    const size_t aoff = (size_t)(m0 + lrow) * 1024 + kc * 8;
    const bf16_t* bp = Bt + (size_t)(n0 + lrow) * 1024 + kc * 8;
    u32x4 ra[4], ra1[4], rb[4];
#pragma unroll
    for (int i = 0; i < 4; ++i) {
      ra[i] = *(const u32x4*)(A0 + aoff + (size_t)i * 32 * 1024);
      if (AMODE == 1) ra1[i] = *(const u32x4*)(A1 + aoff + (size_t)i * 32 * 1024);
      rb[i] = *(const u32x4*)(bp + (size_t)i * 32 * 1024);
    }
    f32x16 acc[2][2];
#pragma unroll
    for (int mi = 0; mi < 2; ++mi)
#pragma unroll
      for (int ni = 0; ni < 2; ++ni) acc[mi][ni] = zero16();
    for (int kt = 0; kt < 16; ++kt) {
      __syncthreads();
#pragma unroll
      for (int i = 0; i < 4; ++i) {
        u32x4 av = ra[i];
        if (AMODE == 1) av = add_bf16x8(av, ra1[i]);
        *(u32x4*)(As + (lrow + 32 * i) * GS + kc * 8) = av;
        *(u32x4*)(Bs + (lrow + 32 * i) * GS + kc * 8) = rb[i];
      }
      __syncthreads();
      if (kt < 15) {
        const int k0 = (kt + 1) * 64;
#pragma unroll
        for (int i = 0; i < 4; ++i) {
          ra[i] = *(const u32x4*)(A0 + aoff + (size_t)i * 32 * 1024 + k0);
          if (AMODE == 1) ra1[i] = *(const u32x4*)(A1 + aoff + (size_t)i * 32 * 1024 + k0);
          rb[i] = *(const u32x4*)(bp + (size_t)i * 32 * 1024 + k0);
        }
      }
      const bf16_t* Aw = As + (wm * 64 + r) * GS + h * 8;
      const bf16_t* Bw = Bs + (wn * 64 + r) * GS + h * 8;
#pragma unroll
      for (int ks = 0; ks < 4; ++ks) {
        bf16x8 a0 = *(const bf16x8*)(Aw + ks * 16);
        bf16x8 a1 = *(const bf16x8*)(Aw + 32 * GS + ks * 16);
        bf16x8 b0 = *(const bf16x8*)(Bw + ks * 16);
        bf16x8 b1 = *(const bf16x8*)(Bw + 32 * GS + ks * 16);
        acc[0][0] = __builtin_amdgcn_mfma_f32_32x32x16_bf16(a0, b0, acc[0][0], 0, 0, 0);
        acc[0][1] = __builtin_amdgcn_mfma_f32_32x32x16_bf16(a0, b1, acc[0][1], 0, 0, 0);
        acc[1][0] = __builtin_amdgcn_mfma_f32_32x32x16_bf16(a1, b0, acc[1][0], 0, 0, 0);
        acc[1][1] = __builtin_amdgcn_mfma_f32_32x32x16_bf16(a1, b1, acc[1][1], 0, 0, 0);
      }
    }
    epi(acc, m0 + wm * 64, n0 + wn * 64, lane);
  }
}


struct EpiEvenIn {
  EvenBufs e;
  __device__ void operator()(f32x16 (&acc)[2][2], int rb, int cb, int lane) const {
    const int r = lane & 31, h = lane >> 5;
    if (cb < 1536 || cb >= 2304) {
      bf16_t* dst;
      int c0;
      int mode;
      if (cb < 512) { dst = e.ug; c0 = cb; mode = 0; }
      else if (cb < 1024) { dst = e.vg; c0 = cb - 512; mode = 0; }
      else if (cb < 1536) { dst = e.gas; c0 = cb - 1024; mode = 1; }
      else { dst = e.gbs; c0 = cb - 2304; mode = 1; }
#pragma unroll
      for (int mi = 0; mi < 2; ++mi)
#pragma unroll
        for (int ni = 0; ni < 2; ++ni)
#pragma unroll
          for (int reg = 0; reg < 16; ++reg) {
            const int row = rb + mi * 32 + (reg & 3) + 8 * (reg >> 2) + 4 * h;
            const int col = c0 + ni * 32 + r;
            float v = acc[mi][ni][reg];
            v = (mode == 0) ? gelu_f(v) : silu_f(v);
            dst[(size_t)row * 512 + col] = f2bf(v);
          }
    } else if (cb < 2176) {
      const bool isq = cb < 2048;
      bf16_t* dst = isq ? e.qb : e.kb;
      const int c0 = isq ? (cb - 1536) : (cb - 2048);
      const int ld = isq ? 512 : 128;
      const float scale = isq ? 0.125f : 1.f;
      const bool latent = rb < NL;
      const float inv_freq = exp2f(-(float)(r & 15) * 0.8304820237218406f);
#pragma unroll
      for (int mi = 0; mi < 2; ++mi)
#pragma unroll
        for (int reg = 0; reg < 16; ++reg) {
          const int row = rb + mi * 32 + (reg & 3) + 8 * (reg >> 2) + 4 * h;
          float x1 = acc[mi][0][reg], x2 = acc[mi][1][reg];
          float o1 = x1, o2 = x2;
          if (latent) {
            const int t = row & (SEQL - 1);
            const float pos = (float)((r < 16) ? (t >> 6) : (t & 63));
            const float ang = pos * inv_freq;
            const float cs = __cosf(ang), sn = __sinf(ang);
            o1 = x1 * cs - x2 * sn;
            o2 = x2 * cs + x1 * sn;
          }
          dst[(size_t)row * ld + c0 + r] = f2bf(o1 * scale);
          dst[(size_t)row * ld + c0 + 32 + r] = f2bf(o2 * scale);
        }
    } else {
      const int kvh = (cb - 2176) >> 6;
      const bool latent = rb < NL;
#pragma unroll
      for (int mi = 0; mi < 2; ++mi)
#pragma unroll
        for (int ni = 0; ni < 2; ++ni)
#pragma unroll
          for (int q4 = 0; q4 < 4; ++q4) {
            const int row = rb + mi * 32 + 8 * q4 + 4 * h;
            const int d = ni * 32 + r;
            u32x2 pk;
            pk.x = pack2(acc[mi][ni][q4 * 4 + 0], acc[mi][ni][q4 * 4 + 1]);
            pk.y = pack2(acc[mi][ni][q4 * 4 + 2], acc[mi][ni][q4 * 4 + 3]);
            if (latent) {
              const int b = row >> 12, t = row & (SEQL - 1);
              *(u32x2*)(e.vtl + ((size_t)((b * 2 + kvh) * 64 + d)) * SEQL + t) = pk;
            } else {
              const int rr = row - NL;
              const int b = rr >> 8, t = rr & (LCTX - 1);
              *(u32x2*)(e.vtc + ((size_t)((b * 2 + kvh) * 64 + d)) * LCTX + t) = pk;
            }
          }
    }
  }
};

struct EpiOddIn {
  OddBufs o;
  __device__ void operator()(f32x16 (&acc)[2][2], int rb, int cb, int lane) const {
    const int r = lane & 31, h = lane >> 5;
    const bool isg = cb >= 1024;
    bf16_t* dst = isg ? o.sg : o.xr;
    const int c0 = isg ? cb - 1024 : cb;
#pragma unroll
    for (int mi = 0; mi < 2; ++mi)
#pragma unroll
      for (int ni = 0; ni < 2; ++ni)
#pragma unroll
        for (int reg = 0; reg < 16; ++reg) {
          const int row = rb + mi * 32 + (reg & 3) + 8 * (reg >> 2) + 4 * h;
          const int col = c0 + ni * 32 + r;
          float v = acc[mi][ni][reg];
          if (isg) v = silu_f(v);
          dst[(size_t)row * 1024 + col] = f2bf(v);
        }
  }
};

struct EpiOut {
  float* xbuf;
  const float* mods_l;
  __device__ void operator()(f32x16 (&acc)[2][2], int rb, int cb, int lane) const {
    const int r = lane & 31, h = lane >> 5;
    const int bidx = (rb < NL) ? (rb >> 12) : 8;
    const float* gate = mods_l + (size_t)bidx * 3072 + 2048;
#pragma unroll
    for (int ni = 0; ni < 2; ++ni) {
      const int col = cb + ni * 32 + r;
      const float gv = gate[col];
#pragma unroll
      for (int mi = 0; mi < 2; ++mi)
#pragma unroll
        for (int reg = 0; reg < 16; ++reg) {
          const int row = rb + mi * 32 + (reg & 3) + 8 * (reg >> 2) + 4 * h;
          float* px = xbuf + (size_t)row * 1024 + col;
          *px = *px + gv * acc[mi][ni][reg];
        }
    }
  }
};

constexpr int AS = 72;

__device__ void attn_item(const Params& p, const EvenBufs& e, int item, char* smem, int ei) {
  bf16_t* Ks = (bf16_t*)smem;
  bf16_t* Vs = Ks + 64 * AS;
  const int tid = otid(), lane = tid & 63, w = tid >> 6;
  const int r = lane & 31, h = lane >> 5;
  int b, hq, start, R0;
  bool isctx;
  if (item < 2048) {
    b = item >> 8;
    hq = (item >> 5) & 7;
    const int qblk = item & 31;
    start = qblk * 128;
    R0 = b * SEQL + start;
    isctx = false;
  } else {
    const int it = item - 2048;
    b = it >> 4;
    hq = (it >> 1) & 7;
    start = (it & 1) * 128;
    R0 = NL + b * LCTX + start;
    isctx = true;
  }
  const int kvh = hq >> 2;
  const int qrow = R0 + w * 32 + r;
  bf16x8 qf[4];
#pragma unroll
  for (int s = 0; s < 4; ++s) qf[s] = *(const bf16x8*)(e.qb + (size_t)qrow * 512 + hq * 64 + s * 16 + h * 8);
  float m = p.b_sink[ei * 8 + hq], l = 1.f;
  f32x16 o[2];
  o[0] = zero16();
  o[1] = zero16();
  const int nblk = isctx ? 4 : 10;
  for (int kb = 0; kb < nblk; ++kb) {
    int krow0, kpos0 = 0, vstride;
    const bf16_t* vt;
    bool local = false;
    if (kb < 4) {
      krow0 = NL + b * LCTX + kb * 64;
      vt = e.vtc + (size_t)((b * 2 + kvh) * 64) * LCTX + kb * 64;
      vstride = LCTX;
    } else {
      kpos0 = start - 128 + (kb - 4) * 64;
      if (kpos0 < 0 || kpos0 >= SEQL) continue;
      krow0 = b * SEQL + kpos0;
      vt = e.vtl + (size_t)((b * 2 + kvh) * 64) * SEQL + kpos0;
      vstride = SEQL;
      local = true;
    }
    __syncthreads();
#pragma unroll
    for (int i = 0; i < 2; ++i) {
      const int c = tid + 256 * i;
      const int rr = c >> 3, cc = c & 7;
      *(u32x4*)(Ks + rr * AS + cc * 8) = *(const u32x4*)(e.kb + (size_t)(krow0 + rr) * 128 + kvh * 64 + cc * 8);
      *(u32x4*)(Vs + rr * AS + cc * 8) = *(const u32x4*)(vt + (size_t)rr * vstride + cc * 8);
    }
    __syncthreads();
    f32x16 s[2];
#pragma unroll
    for (int kt = 0; kt < 2; ++kt) {
      s[kt] = zero16();
#pragma unroll
      for (int ks = 0; ks < 4; ++ks) {
        bf16x8 a = *(const bf16x8*)(Ks + (kt * 32 + r) * AS + ks * 16 + h * 8);
        s[kt] = __builtin_amdgcn_mfma_f32_32x32x16_bf16(a, qf[ks], s[kt], 0, 0, 0);
      }
    }
    if (local) {
      const int qpos = start + w * 32 + r;
#pragma unroll
      for (int kt = 0; kt < 2; ++kt)
#pragma unroll
        for (int reg = 0; reg < 16; ++reg) {
          const int kpos = kpos0 + kt * 32 + (reg & 3) + 8 * (reg >> 2) + 4 * h;
          const int diff = qpos - kpos;
          if (diff > 128 || diff < -128) s[kt][reg] = -1e30f;
        }
    }
    float mx = m;
#pragma unroll
    for (int kt = 0; kt < 2; ++kt)
#pragma unroll
      for (int reg = 0; reg < 16; ++reg) mx = fmaxf(mx, s[kt][reg]);
    mx = fmaxf(mx, __shfl_xor(mx, 32));
    const float alpha = __expf(m - mx);
    m = mx;
    float rs = 0.f;
#pragma unroll
    for (int kt = 0; kt < 2; ++kt)
#pragma unroll
      for (int reg = 0; reg < 16; ++reg) {
        const float pv = __expf(s[kt][reg] - mx);
        rs += pv;
        s[kt][reg] = pv;
      }
    rs += __shfl_xor(rs, 32);
    l = l * alpha + rs;
#pragma unroll
    for (int dt = 0; dt < 2; ++dt)
#pragma unroll
      for (int reg = 0; reg < 16; ++reg) o[dt][reg] *= alpha;
#pragma unroll
    for (int kt = 0; kt < 2; ++kt)
#pragma unroll
      for (int sp = 0; sp < 2; ++sp) {
        union { bf16x8 v; uint32_t u[4]; } pf;
#pragma unroll
        for (int j = 0; j < 4; ++j) pf.u[j] = pack2(s[kt][8 * sp + 2 * j], s[kt][8 * sp + 2 * j + 1]);
#pragma unroll
        for (int dt = 0; dt < 2; ++dt) {
          const bf16_t* vp = Vs + (dt * 32 + r) * AS + kt * 32 + sp * 16 + 4 * h;
          union { bf16x8 v; u32x2 u[2]; } af;
          af.u[0] = *(const u32x2*)(vp);
          af.u[1] = *(const u32x2*)(vp + 8);
          o[dt] = __builtin_amdgcn_mfma_f32_32x32x16_bf16(af.v, pf.v, o[dt], 0, 0, 0);
        }
      }
  }
  const float inv = 1.f / l;
  bf16_t* ymix = p.hbuf;
#pragma unroll
  for (int dt = 0; dt < 2; ++dt)
#pragma unroll
    for (int q4 = 0; q4 < 4; ++q4) {
      const int d0 = dt * 32 + 8 * q4 + 4 * h;
      const u32x2 g = *(const u32x2*)(e.gbs + (size_t)qrow * 512 + hq * 64 + d0);
      u32x2 pk;
      pk.x = pack2(o[dt][q4 * 4 + 0] * inv * lo_bf(g.x), o[dt][q4 * 4 + 1] * inv * hi_bf(g.x));
      pk.y = pack2(o[dt][q4 * 4 + 2] * inv * lo_bf(g.y), o[dt][q4 * 4 + 3] * inv * hi_bf(g.y));
      *(u32x2*)(ymix + (size_t)qrow * 1024 + 512 + hq * 64 + d0) = pk;
    }
}

constexpr int MS = 136;

__device__ void gmlp_item(const Params& p, const EvenBufs& e, int item, char* smem, int ei) {
  bf16_t* Ws = (bf16_t*)smem;
  bf16_t* VT = Ws + 128 * MS;
  const int tid = otid(), lane = tid & 63, w = tid >> 6;
  const int r = lane & 31, h = lane >> 5;
  const int wm = w >> 1, wn = w & 1;
  const int rt = item >> 2, g = item & 3;
  const int R0 = rt * 128;
  __syncthreads();
  {
    const float4* wsrc = (const float4*)(p.a_w_s + (size_t)(ei * 4 + g) * 128 * 128);
#pragma unroll
    for (int i = 0; i < 16; ++i) {
      const int idx = tid + 256 * i;
      const int pp = idx >> 5, q4 = idx & 31;
      float4 v = wsrc[idx];
      u32x2 pk;
      pk.x = pack2(v.x, v.y);
      pk.y = pack2(v.z, v.w);
      *(u32x2*)(Ws + pp * MS + q4 * 4) = pk;
    }
  }
#pragma unroll 1
  for (int hp = 0; hp < 2; ++hp) {
    const int q = hp * 64 + (tid >> 2), qt = tid & 3;
    const bf16_t* vsrc = e.vg + (size_t)(R0 + q) * 512 + g * 128 + qt * 32;
    float xv[32];
#pragma unroll
    for (int i = 0; i < 4; ++i) {
      u32x4 u = *(const u32x4*)(vsrc + i * 8);
      xv[i * 8 + 0] = lo_bf(u.x); xv[i * 8 + 1] = hi_bf(u.x);
      xv[i * 8 + 2] = lo_bf(u.y); xv[i * 8 + 3] = hi_bf(u.y);
      xv[i * 8 + 4] = lo_bf(u.z); xv[i * 8 + 5] = hi_bf(u.z);
      xv[i * 8 + 6] = lo_bf(u.w); xv[i * 8 + 7] = hi_bf(u.w);
    }
    float sm = 0.f;
#pragma unroll
    for (int j = 0; j < 32; ++j) sm += xv[j];
    sm += __shfl_xor(sm, 1);
    sm += __shfl_xor(sm, 2);
    const float mean = sm * (1.f / 128.f);
    float sq = 0.f;
#pragma unroll
    for (int j = 0; j < 32; ++j) { float dlt = xv[j] - mean; sq += dlt * dlt; }
    sq += __shfl_xor(sq, 1);
    sq += __shfl_xor(sq, 2);
    const float rstd = rsqrtf(sq * (1.f / 128.f) + 1e-6f);
    const float* lg = p.a_ln_g + ei * 512 + g * 128 + qt * 32;
    const float* lb = p.a_ln_b + ei * 512 + g * 128 + qt * 32;
#pragma unroll
    for (int j = 0; j < 32; ++j) {
      const float val = (xv[j] - mean) * rstd * lg[j] + lb[j];
      VT[(qt * 32 + j) * MS + q] = f2bf(val);
    }
  }
  __syncthreads();
  f32x16 acc[2][2];
#pragma unroll
  for (int mi = 0; mi < 2; ++mi)
#pragma unroll
    for (int ni = 0; ni < 2; ++ni) acc[mi][ni] = zero16();
  const bf16_t* Aw = Ws + (wm * 64 + r) * MS + h * 8;
  const bf16_t* Bw = VT + (wn * 64 + r) * MS + h * 8;
#pragma unroll
  for (int ks = 0; ks < 8; ++ks) {
    bf16x8 a0 = *(const bf16x8*)(Aw + ks * 16);
    bf16x8 a1 = *(const bf16x8*)(Aw + 32 * MS + ks * 16);
    bf16x8 b0 = *(const bf16x8*)(Bw + ks * 16);
    bf16x8 b1 = *(const bf16x8*)(Bw + 32 * MS + ks * 16);
    acc[0][0] = __builtin_amdgcn_mfma_f32_32x32x16_bf16(a0, b0, acc[0][0], 0, 0, 0);
    acc[0][1] = __builtin_amdgcn_mfma_f32_32x32x16_bf16(a0, b1, acc[0][1], 0, 0, 0);
    acc[1][0] = __builtin_amdgcn_mfma_f32_32x32x16_bf16(a1, b0, acc[1][0], 0, 0, 0);
    acc[1][1] = __builtin_amdgcn_mfma_f32_32x32x16_bf16(a1, b1, acc[1][1], 0, 0, 0);
  }
  bf16_t* ymix = p.hbuf;
  const float* bs = p.a_b_s + (ei * 4 + g) * 128;
#pragma unroll
  for (int mi = 0; mi < 2; ++mi)
#pragma unroll
    for (int reg = 0; reg < 16; ++reg) {
      const int prow = wm * 64 + mi * 32 + (reg & 3) + 8 * (reg >> 2) + 4 * h;
      const float bsv = bs[prow];
      const size_t row = (size_t)(R0 + prow);
#pragma unroll
      for (int ni = 0; ni < 2; ++ni) {
        const int col = g * 128 + wn * 64 + ni * 32 + r;
        const float sv = acc[mi][ni][reg] + bsv;
        const float y = bf2f(e.ug[row * 512 + col]) * sv * bf2f(e.gas[row * 512 + col]);
        ymix[row * 1024 + col] = f2bf(y);
      }
    }
}

__device__ void phase_even_mix(const Params& p, char* smem, int ei) {
  const EvenBufs e = even_bufs(p);
  const int n_attn = 2048 + 128, n_gmlp = 1088;
  for (int item = blockIdx.x; item < n_attn + n_gmlp; item += gridDim.x) {
    if (item < n_attn) attn_item(p, e, item, smem, ei);
    else gmlp_item(p, e, item - n_attn, smem, ei);
  }
}

constexpr int ZS = 264;

__device__ void rglru_item(const Params& p, const OddBufs& ob, int item, char* smem, int oi, bool need_ctx) {
  bf16_t* Zs = (bf16_t*)smem;
  bf16_t* Bs = Zs + 64 * ZS;
  float* segA = (float*)(Bs + 64 * ZS);
  float* segB = segA + 256;
  float* carry = segB + 256;
  float* La = (float*)Zs;
  float* Gz = La + 2048;
  const int tid = otid(), lane = tid & 63, w = tid >> 6;
  const int r = lane & 31, h = lane >> 5;
  const int wm = w >> 1, wn = w & 1;
  const int b = item >> 6, dir = (item >> 5) & 1, cs = item & 31;
  const int hd = cs >> 3, j0 = (cs & 7) * 32, c0 = cs * 32;
  bf16_t* sout = dir ? ob.sb : p.hbuf;
  __syncthreads();
  {
    const size_t mo = ((size_t)((oi * 2 + dir) * 4 + hd)) * 65536 + (size_t)j0 * 256;
    const bf16_t* wa = p.wga + mo;
    const bf16_t* wi = p.wgi + mo;
#pragma unroll
    for (int i = 0; i < 8; ++i) {
      const int c = tid + 256 * i;
      const int n = c >> 5, kc = c & 31;
      const bf16_t* src = (n < 32) ? (wa + n * 256 + kc * 8) : (wi + (n - 32) * 256 + kc * 8);
      *(u32x4*)(Bs + n * ZS + kc * 8) = *(const u32x4*)src;
    }
    if (tid < 32) carry[tid] = 0.f;
  }
  const int cc = tid & 31, seg8 = tid >> 5;
  const int chb = hd * 256 + cc * 8;
  float cw[4][8], cbias[8];
#pragma unroll
  for (int j = 0; j < 4; ++j)
#pragma unroll
    for (int e2 = 0; e2 < 8; ++e2) cw[j][e2] = p.c_conv_w[((size_t)oi * 4 + j) * 1024 + chb + e2];
#pragma unroll
  for (int e2 = 0; e2 < 8; ++e2) cbias[e2] = p.c_conv_b[oi * 1024 + chb + e2];
  const int gch = (oi * 2 + dir) * 1024 + c0 + r;
  const float gbias = wn ? p.c_b_i[gch] : p.c_b_a[gch];
  const float spl = log1pf(__expf(-p.c_lam[gch]));
  const int sc_c = tid & 31, sc_sg = tid >> 5;

  for (int step = 0; step < 68; ++step) {
    int Rs, Ls, ti;
    bool wr;
    if (step < 4) { Rs = NL + b * LCTX; Ls = LCTX; ti = dir ? 3 - step : step; wr = need_ctx; }
    else { Rs = b * SEQL; Ls = SEQL; ti = dir ? 63 - (step - 4) : (step - 4); wr = true; }
    const int t0 = ti * 64;
    __syncthreads();
#pragma unroll 1
    for (int hp = 0; hp < 2; ++hp) {
      float xw[7][8];
      const int rbase = seg8 * 8 + hp * 4;
#pragma unroll
      for (int jj = 0; jj < 7; ++jj) {
        const int t = t0 + rbase - 2 + jj;
        u32x4 u = (u32x4){0u, 0u, 0u, 0u};
        if (t >= 0 && t < Ls) u = *(const u32x4*)(ob.xr + (size_t)(Rs + t) * 1024 + chb);
        xw[jj][0] = lo_bf(u.x); xw[jj][1] = hi_bf(u.x);
        xw[jj][2] = lo_bf(u.y); xw[jj][3] = hi_bf(u.y);
        xw[jj][4] = lo_bf(u.z); xw[jj][5] = hi_bf(u.z);
        xw[jj][6] = lo_bf(u.w); xw[jj][7] = hi_bf(u.w);
      }
#pragma unroll
      for (int i = 0; i < 4; ++i) {
        float z[8];
#pragma unroll
        for (int e2 = 0; e2 < 8; ++e2) {
          float a = cbias[e2];
#pragma unroll
          for (int j = 0; j < 4; ++j) a += cw[j][e2] * xw[i + j][e2];
          z[e2] = a;
        }
        u32x4 pk;
        pk.x = pack2(z[0], z[1]); pk.y = pack2(z[2], z[3]);
        pk.z = pack2(z[4], z[5]); pk.w = pack2(z[6], z[7]);
        *(u32x4*)(Zs + (rbase + i) * ZS + cc * 8) = pk;
      }
    }
    __syncthreads();
    f32x16 acc = zero16();
    {
      const bf16_t* Aw = Zs + (wm * 32 + r) * ZS + h * 8;
      const bf16_t* Bw = Bs + (wn * 32 + r) * ZS + h * 8;
#pragma unroll
      for (int ks = 0; ks < 16; ++ks) {
        bf16x8 a = *(const bf16x8*)(Aw + ks * 16);
        bf16x8 bb = *(const bf16x8*)(Bw + ks * 16);
        acc = __builtin_amdgcn_mfma_f32_32x32x16_bf16(a, bb, acc, 0, 0, 0);
      }
    }
    float vals[16];
#pragma unroll
    for (int reg = 0; reg < 16; ++reg) {
      const int row = wm * 32 + (reg & 3) + 8 * (reg >> 2) + 4 * h;
      const float sgm = sigmoid_f(acc[reg] + gbias);
      if (wn == 0) vals[reg] = -8.f * sgm * spl;
      else vals[reg] = sgm * bf2f(Zs[row * ZS + j0 + r]);
    }
    __syncthreads();
    {
      float* dstb = wn ? Gz : La;
#pragma unroll
      for (int reg = 0; reg < 16; ++reg) {
        const int row = wm * 32 + (reg & 3) + 8 * (reg >> 2) + 4 * h;
        dstb[row * 32 + r] = vals[reg];
      }
    }
    __syncthreads();
    float av[8], bv[8];
    {
      float A = 1.f, Bv = 0.f;
#pragma unroll
      for (int i = 0; i < 8; ++i) {
        const int pidx = sc_sg * 8 + i;
        const int row = dir ? 63 - pidx : pidx;
        const float la = La[row * 32 + sc_c];
        const float a = __expf(la);
        const float mult = sqrtf(-expm1f(2.f * la));
        const float bx = mult * Gz[row * 32 + sc_c];
        av[i] = a;
        bv[i] = bx;
        Bv = a * Bv + bx;
        A *= a;
      }
      segA[sc_sg * 32 + sc_c] = A;
      segB[sc_sg * 32 + sc_c] = Bv;
    }
    __syncthreads();
    {
      float hh = carry[(step & 1) * 32 + sc_c];
      for (int s2 = 0; s2 < sc_sg; ++s2) hh = segA[s2 * 32 + sc_c] * hh + segB[s2 * 32 + sc_c];
#pragma unroll
      for (int i = 0; i < 8; ++i) {
        const int pidx = sc_sg * 8 + i;
        const int row = dir ? 63 - pidx : pidx;
        hh = av[i] * hh + bv[i];
        if (wr) {
          const size_t off = (size_t)(Rs + t0 + row) * 1024 + c0 + sc_c;
          sout[off] = f2bf(hh * bf2f(ob.sg[off]));
        }
      }
      if (sc_sg == 7) carry[((step + 1) & 1) * 32 + sc_c] = hh;
    }
  }
}

__device__ void phase_rglru(const Params& p, char* smem, int oi, bool need_ctx) {
  const OddBufs ob = odd_bufs(p);
  for (int item = blockIdx.x; item < 512; item += gridDim.x) rglru_item(p, ob, item, smem, oi, need_ctx);
}

#define LAUNDER(f) q.f = p.f + z
__device__ __forceinline__ void launder(Params& q, const Params& p) {
  long z;
  asm volatile("s_mov_b64 %0, 0" : "=s"(z));
  LAUNDER(x); LAUNDER(c); LAUNDER(ctx); LAUNDER(c_ctx); LAUNDER(norm_g); LAUNDER(w_mod); LAUNDER(b_mod);
  LAUNDER(ab_w_in); LAUNDER(a_ln_g); LAUNDER(a_ln_b); LAUNDER(a_w_s); LAUNDER(a_b_s); LAUNDER(b_sink);
  LAUNDER(ab_w_out); LAUNDER(c_w_in); LAUNDER(c_conv_w); LAUNDER(c_conv_b); LAUNDER(c_w_a); LAUNDER(c_b_a);
  LAUNDER(c_w_i); LAUNDER(c_b_i); LAUNDER(c_lam); LAUNDER(c_w_out); LAUNDER(final_g); LAUNDER(out);
  LAUNDER(xbuf); LAUNDER(mods); LAUNDER(hbuf); LAUNDER(ebuf); LAUNDER(wt_in_e); LAUNDER(wt_out_e);
  LAUNDER(wt_in_o); LAUNDER(wt_out_o); LAUNDER(wga); LAUNDER(wgi);
}

constexpr int NPHASES = 18;

__device__ void run_phase(const Params& p0, int ph, char* smem) {
  if (ph == 0) { Params p; launder(p, p0); phase0(p, smem); return; }
  if (ph == 17) { Params p; launder(p, p0); phase_final(p); return; }
  const int layer = (ph - 1) >> 2, sub = (ph - 1) & 3;
  const int idx = layer >> 1;
  const bool even = (layer & 1) == 0;
  const bool need_ctx = layer < 3;
  if (sub == 0) { Params p; launder(p, p0); phase_prep(p, layer); return; }
  if (even) {
    if (sub == 1) {
      Params p; launder(p, p0);
      EpiEvenIn epi; epi.e = even_bufs(p);
      gemm_phase<0>(p.hbuf, nullptr, p.wt_in_e + (size_t)idx * 2816 * 1024, NR / 128, 22, smem, epi);
    } else if (sub == 2) {
      Params p; launder(p, p0);
      phase_even_mix(p, smem, idx);
    } else {
      Params p; launder(p, p0);
      EpiOut epi; epi.xbuf = p.xbuf; epi.mods_l = p.mods + (size_t)layer * 9 * 3072;
      gemm_phase<0>(p.hbuf, nullptr, p.wt_out_e + (size_t)idx * 1024 * 1024, NR / 128, 8, smem, epi);
    }
  } else {
    if (sub == 1) {
      Params p; launder(p, p0);
      EpiOddIn epi; epi.o = odd_bufs(p);
      gemm_phase<0>(p.hbuf, nullptr, p.wt_in_o + (size_t)idx * 2048 * 1024, NR / 128, 16, smem, epi);
    } else if (sub == 2) {
      Params p; launder(p, p0);
      phase_rglru(p, smem, idx, need_ctx);
    } else {
      Params p; launder(p, p0);
      EpiOut epi; epi.xbuf = p.xbuf; epi.mods_l = p.mods + (size_t)layer * 9 * 3072;
      const OddBufs ob = odd_bufs(p);
      gemm_phase<1>(p.hbuf, ob.sb, p.wt_out_o + (size_t)idx * 1024 * 1024, (need_ctx ? NR : NL) / 128, 8, smem, epi);
    }
  }
}

__global__ void __launch_bounds__(NTHREADS, 2) mega_kernel(Params p, int ph_lo, int ph_hi) {
  __shared__ __attribute__((aligned(16))) char smem[SMEM_BYTES];
  for (int ph = ph_lo; ph < ph_hi; ++ph) {
    run_phase(p, ph, smem);
    if (ph + 1 < ph_hi) cg::this_grid().sync();
  }
}

extern "C" void kernel_launch(void* const* d_in, const int* in_sizes, int n_in, void* d_out, int out_size,
                              void* d_ws, size_t ws_size, hipStream_t stream) {
  static int grid_blocks = 0;
  if (!grid_blocks) {
    int dev = 0, cus = 0, per_cu = 0;
    hipGetDevice(&dev);
    hipDeviceGetAttribute(&cus, hipDeviceAttributeMultiprocessorCount, dev);
    hipOccupancyMaxActiveBlocksPerMultiprocessor(&per_cu, mega_kernel, NTHREADS, 0);
    if (per_cu < 1) per_cu = 1;
    if (per_cu > 2) per_cu = 2;
    grid_blocks = cus * per_cu;
  }
  Params p{};
  const float** fp = (const float**)&p;
  for (int i = 0; i < 24; ++i) fp[i] = (const float*)d_in[i];
  p.out = (float*)d_out;
  char* ws = (char*)d_ws;
  size_t off = 0;
  auto take = [&](size_t bytes) { char* q = ws + off; off += (bytes + 255) & ~(size_t)255; return q; };
  p.xbuf = (float*)take((size_t)NR * 1024 * 4);
  p.mods = (float*)take((size_t)4 * 9 * 3072 * 4);
  p.hbuf = (bf16_t*)take((size_t)NR * 1024 * 2);
  p.ebuf = (bf16_t*)take((size_t)NR * 3072 * 2);
  p.wt_in_e = (bf16_t*)take((size_t)2 * 2816 * 1024 * 2);
  p.wt_out_e = (bf16_t*)take((size_t)2 * 1024 * 1024 * 2);
  p.wt_in_o = (bf16_t*)take((size_t)2 * 2048 * 1024 * 2);
  p.wt_out_o = (bf16_t*)take((size_t)2 * 1024 * 1024 * 2);
  p.wga = (bf16_t*)take((size_t)16 * 65536 * 2);
  p.wgi = (bf16_t*)take((size_t)16 * 65536 * 2);
  if (off > ws_size) fprintf(stderr, "workspace too small: need %zu have %zu\n", off, ws_size);
#if COOP
  int lo = 0, hi = NPHASES;
  void* args[] = {&p, &lo, &hi};
  hipError_t e = hipLaunchCooperativeKernel((void*)mega_kernel, dim3(grid_blocks), dim3(NTHREADS), args, 0, stream);
  if (e != hipSuccess) fprintf(stderr, "cooperative launch failed: %s (grid %d)\n", hipGetErrorString(e), grid_blocks);
#else
  for (int ph = 0; ph < NPHASES; ++ph) mega_kernel<<<grid_blocks, NTHREADS, 0, stream>>>(p, ph, ph + 1);
#endif
}
```

```cpp
#include <hip/hip_runtime.h>
#include <hip/hip_cooperative_groups.h>
#include <stdint.h>
#include <stdio.h>
namespace cg = cooperative_groups;

#ifndef COOP
#define COOP 1
#endif

typedef unsigned short bf16_t;
typedef __attribute__((ext_vector_type(8))) short bf16x8;
typedef __attribute__((ext_vector_type(16))) float f32x16;
typedef __attribute__((ext_vector_type(4))) unsigned int u32x4;
typedef __attribute__((ext_vector_type(2))) unsigned int u32x2;

constexpr int DM = 1024;
constexpr int NBATCH = 8;
constexpr int SEQL = 4096;
constexpr int LCTX = 256;
constexpr int NL = NBATCH * SEQL;
constexpr int NC = NBATCH * LCTX;
constexpr int NR = NL + NC;
constexpr int SMEM_BYTES = 72 * 1024;
constexpr int NTHREADS = 256;

struct Params {
  const float *x, *c, *ctx, *c_ctx, *norm_g, *w_mod, *b_mod, *ab_w_in, *a_ln_g, *a_ln_b, *a_w_s, *a_b_s,
      *b_sink, *ab_w_out, *c_w_in, *c_conv_w, *c_conv_b, *c_w_a, *c_b_a, *c_w_i, *c_b_i, *c_lam, *c_w_out,
      *final_g;
  float* out;
  float* xbuf;
  float* mods;
  bf16_t* hbuf;
  bf16_t* ebuf;
  bf16_t *wt_in_e, *wt_out_e, *wt_in_o, *wt_out_o, *wga, *wgi;
  unsigned* bar;
};

__device__ __forceinline__ bf16_t f2bf(float f) {
  uint32_t u = __float_as_uint(f);
  u += 0x7fffu + ((u >> 16) & 1u);
  return (bf16_t)(u >> 16);
}
__device__ __forceinline__ float bf2f(bf16_t b) { return __uint_as_float(((uint32_t)b) << 16); }
__device__ __forceinline__ uint32_t pack2(float a, float b) {
  return (uint32_t)f2bf(a) | ((uint32_t)f2bf(b) << 16);
}
__device__ __forceinline__ float lo_bf(uint32_t u) { return __uint_as_float(u << 16); }
__device__ __forceinline__ float hi_bf(uint32_t u) { return __uint_as_float(u & 0xffff0000u); }
__device__ __forceinline__ float silu_f(float x) { return x / (1.f + __expf(-x)); }
__device__ __forceinline__ float sigmoid_f(float x) { return 1.f / (1.f + __expf(-x)); }
__device__ __forceinline__ float gelu_f(float x) {
  float y = 0.7978845608028654f * (x + 0.044715f * x * x * x);
  float t = 1.f - 2.f / (1.f + __expf(2.f * y));
  return 0.5f * x * (1.f + t);
}
__device__ __forceinline__ f32x16 zero16() {
  f32x16 z;
#pragma unroll
  for (int i = 0; i < 16; ++i) z[i] = 0.f;
  return z;
}
__device__ __forceinline__ float wave_sum(float v) {
#pragma unroll
  for (int o = 32; o > 0; o >>= 1) v += __shfl_xor(v, o);
  return v;
}

__device__ __forceinline__ int otid() {
  int t = threadIdx.x;
  asm volatile("" : "+v"(t));
  return t;
}

struct EvenBufs {
  bf16_t *ug, *vg, *gas, *qb, *gbs, *kb, *vtl, *vtc;
};
__device__ __forceinline__ EvenBufs even_bufs(const Params& p) {
  EvenBufs e;
  e.ug = p.ebuf;
  e.vg = e.ug + (size_t)NR * 512;
  e.gas = e.vg + (size_t)NR * 512;
  e.qb = e.gas + (size_t)NR * 512;
  e.gbs = e.qb + (size_t)NR * 512;
  e.kb = e.gbs + (size_t)NR * 512;
  e.vtl = e.kb + (size_t)NR * 128;
  e.vtc = e.vtl + (size_t)NBATCH * 128 * SEQL;
  return e;
}
struct OddBufs {
  bf16_t *xr, *sg, *sb;
};
__device__ __forceinline__ OddBufs odd_bufs(const Params& p) {
  OddBufs o;
  o.xr = p.ebuf;
  o.sg = o.xr + (size_t)NR * 1024;
  o.sb = o.sg + (size_t)NR * 1024;
  return o;
}

__device__ void transpose_item(const Params& p, int item, char* smem) {
  float* tile = (float*)smem;
  const float* src;
  bf16_t* dst;
  int K, N, local;
  if (item < 1408) { src = p.ab_w_in; dst = p.wt_in_e; K = 1024; N = 2816; local = item; }
  else if (item < 1920) { src = p.ab_w_out; dst = p.wt_out_e; K = 1024; N = 1024; local = item - 1408; }
  else if (item < 2944) { src = p.c_w_in; dst = p.wt_in_o; K = 1024; N = 2048; local = item - 1920; }
  else if (item < 3456) { src = p.c_w_out; dst = p.wt_out_o; K = 1024; N = 1024; local = item - 2944; }
  else if (item < 3712) { src = p.c_w_a; dst = p.wga; K = 256; N = 256; local = item - 3456; }
  else { src = p.c_w_i; dst = p.wgi; K = 256; N = 256; local = item - 3712; }
  const int ntn = N / 64;
  const int tpb = (K / 64) * ntn;
  const int bi = local / tpb;
  const int rem = local % tpb;
  const int k0 = (rem / ntn) * 64, n0 = (rem % ntn) * 64;
  src += (size_t)bi * K * N;
  dst += (size_t)bi * K * N;
  const int tid = otid();
  __syncthreads();
#pragma unroll
  for (int i = 0; i < 16; ++i) {
    int rr = i * 4 + (tid >> 6), cc = tid & 63;
    tile[rr * 65 + cc] = src[(size_t)(k0 + rr) * N + n0 + cc];
  }
  __syncthreads();
#pragma unroll
  for (int i = 0; i < 16; ++i) {
    int n = i * 4 + (tid >> 6), k = tid & 63;
    dst[(size_t)(n0 + n) * K + k0 + k] = f2bf(tile[k * 65 + n]);
  }
}

__device__ void mods_item(const Params& p, int item, char* smem) {
  float* sc = (float*)smem;
  float* red = sc + 9 * 1024;
  const int tid = otid();
  const int l = item / 96, n0 = (item % 96) * 32;
  __syncthreads();
  for (int i = tid; i < 9 * 1024; i += NTHREADS) {
    int j = i >> 10, k = i & 1023;
    float v = (j < 8) ? p.c[j * 1024 + k] : p.c_ctx[k];
    sc[i] = silu_f(v);
  }
  __syncthreads();
  const int col = tid & 31, kg = tid >> 5;
  float acc[9];
#pragma unroll
  for (int j = 0; j < 9; ++j) acc[j] = 0.f;
  const float* w = p.w_mod + ((size_t)l * 1024 + kg * 128) * 3072 + n0 + col;
#pragma unroll 8
  for (int k = 0; k < 128; ++k) {
    float wv = w[(size_t)k * 3072];
#pragma unroll
    for (int j = 0; j < 9; ++j) acc[j] += sc[j * 1024 + kg * 128 + k] * wv;
  }
#pragma unroll
  for (int j = 0; j < 9; ++j) red[(kg * 9 + j) * 32 + col] = acc[j];
  __syncthreads();
  for (int i = tid; i < 9 * 32; i += NTHREADS) {
    int j = i >> 5, cc = i & 31;
    float s = 0.f;
#pragma unroll
    for (int g = 0; g < 8; ++g) s += red[(g * 9 + j) * 32 + cc];
    p.mods[((size_t)l * 9 + j) * 3072 + n0 + cc] = s + p.b_mod[l * 3072 + n0 + cc];
  }
}

__device__ void phase0(const Params& p, char* smem) {
  const int total = 3968 + 384;
  for (int item = blockIdx.x; item < total; item += gridDim.x) {
    if (item < 384) mods_item(p, item, smem);
    else transpose_item(p, item - 384, smem);
  }
}

__device__ void phase_prep(const Params& p, int layer) {
  const int tid = otid();
  const int lane = tid & 63;
  const int gw = blockIdx.x * 4 + (tid >> 6);
  const int nw = gridDim.x * 4;
  const float* ng = p.norm_g + layer * 1024;
  for (int R = gw; R < NR; R += nw) {
    const float* src;
    if (layer == 0) src = (R < NL) ? p.x + (size_t)R * 1024 : p.ctx + (size_t)(R - NL) * 1024;
    else src = p.xbuf + (size_t)R * 1024;
    const int bidx = (R < NL) ? (R >> 12) : 8;
    const float* md = p.mods + ((size_t)layer * 9 + bidx) * 3072;
    float4 v[4];
#pragma unroll
    for (int i = 0; i < 4; ++i) v[i] = ((const float4*)src)[lane + 64 * i];
    float ss = 0.f;
#pragma unroll
    for (int i = 0; i < 4; ++i) ss += v[i].x * v[i].x + v[i].y * v[i].y + v[i].z * v[i].z + v[i].w * v[i].w;
    ss = wave_sum(ss);
    const float rstd = rsqrtf(ss * (1.f / 1024.f) + 1e-6f);
#pragma unroll
    for (int i = 0; i < 4; ++i) {
      const int k4 = lane + 64 * i;
      float4 g = ((const float4*)ng)[k4];
      float4 sh = ((const float4*)md)[k4];
      float4 sc = ((const float4*)(md + 1024))[k4];
      float h0 = v[i].x * rstd * g.x * (1.f + sc.x) + sh.x;
      float h1 = v[i].y * rstd * g.y * (1.f + sc.y) + sh.y;
      float h2 = v[i].z * rstd * g.z * (1.f + sc.z) + sh.z;
      float h3 = v[i].w * rstd * g.w * (1.f + sc.w) + sh.w;
      u32x2 pk;
      pk.x = pack2(h0, h1);
      pk.y = pack2(h2, h3);
      *(u32x2*)(p.hbuf + (size_t)R * 1024 + k4 * 4) = pk;
      if (layer == 0) ((float4*)(p.xbuf + (size_t)R * 1024))[k4] = v[i];
    }
  }
}

__device__ void phase_final(const Params& p) {
  const int tid = otid();
  const int lane = tid & 63;
  const int gw = blockIdx.x * 4 + (tid >> 6);
  const int nw = gridDim.x * 4;
  for (int R = gw; R < NL; R += nw) {
    const float* src = p.xbuf + (size_t)R * 1024;
    float4 v[4];
#pragma unroll
    for (int i = 0; i < 4; ++i) v[i] = ((const float4*)src)[lane + 64 * i];
    float ss = 0.f;
#pragma unroll
    for (int i = 0; i < 4; ++i) ss += v[i].x * v[i].x + v[i].y * v[i].y + v[i].z * v[i].z + v[i].w * v[i].w;
    ss = wave_sum(ss);
    const float rstd = rsqrtf(ss * (1.f / 1024.f) + 1e-6f);
#pragma unroll
    for (int i = 0; i < 4; ++i) {
      const int k4 = lane + 64 * i;
      float4 g = ((const float4*)p.final_g)[k4];
      float4 o;
      o.x = v[i].x * rstd * g.x;
      o.y = v[i].y * rstd * g.y;
      o.z = v[i].z * rstd * g.z;
      o.w = v[i].w * rstd * g.w;
      ((float4*)(p.out + (size_t)R * 1024))[k4] = o;
    }
  }
}

constexpr int GS = 72;

__device__ __forceinline__ u32x4 add_bf16x8(u32x4 a, u32x4 b) {
  u32x4 r;
  r.x = pack2(lo_bf(a.x) + lo_bf(b.x), hi_bf(a.x) + hi_bf(b.x));
  r.y = pack2(lo_bf(a.y) + lo_bf(b.y), hi_bf(a.y) + hi_bf(b.y));
  r.z = pack2(lo_bf(a.z) + lo_bf(b.z), hi_bf(a.z) + hi_bf(b.z));
  r.w = pack2(lo_bf(a.w) + lo_bf(b.w), hi_bf(a.w) + hi_bf(b.w));
  return r;
}

template <int AMODE, class Epi>
__device__ void gemm_phase(const bf16_t* __restrict__ A0, const bf16_t* __restrict__ A1,
                           const bf16_t* __restrict__ Bt, int Mtiles, int Ntiles, char* smem, Epi epi) {
  bf16_t* As = (bf16_t*)smem;
  bf16_t* Bs = As + 128 * GS;
  const int tid = otid(), lane = tid & 63, w = tid >> 6;
  const int wm = w >> 1, wn = w & 1;
  const int r = lane & 31, h = lane >> 5;
  const int lrow = tid >> 3, kc = tid & 7;
  const int total = Mtiles * Ntiles;
  for (int tile = blockIdx.x; tile < total; tile += gridDim.x) {
    const int mt = tile / Ntiles, nt = tile % Ntiles;
    const int m0 = mt * 128, n0 = nt * 128;
    const size_t aoff = (size_t)(m0 + lrow) * 1024 + kc * 8;
    const bf16_t* bp = Bt + (size_t)(n0 + lrow) * 1024 + kc * 8;
    u32x4 ra[4], ra1[4], rb[4];
#pragma unroll
    for (int i = 0; i < 4; ++i) {
      ra[i] = *(const u32x4*)(A0 + aoff + (size_t)i * 32 * 1024);
      if (AMODE == 1) ra1[i] = *(const u32x4*)(A1 + aoff + (size_t)i * 32 * 1024);
      rb[i] = *(const u32x4*)(bp + (size_t)i * 32 * 1024);
    }
    f32x16 acc[2][2];
#pragma unroll
    for (int mi = 0; mi < 2; ++mi)
#pragma unroll
      for (int ni = 0; ni < 2; ++ni) acc[mi][ni] = zero16();
    for (int kt = 0; kt < 16; ++kt) {
      __syncthreads();
#pragma unroll
      for (int i = 0; i < 4; ++i) {
        u32x4 av = ra[i];
        if (AMODE == 1) av = add_bf16x8(av, ra1[i]);
        *(u32x4*)(As + (lrow + 32 * i) * GS + kc * 8) = av;
        *(u32x4*)(Bs + (lrow + 32 * i) * GS + kc * 8) = rb[i];
      }
      __syncthreads();
      if (kt < 15) {
        const int k0 = (kt + 1) * 64;
#pragma unroll
        for (int i = 0; i < 4; ++i) {
          ra[i] = *(const u32x4*)(A0 + aoff + (size_t)i * 32 * 1024 + k0);
          if (AMODE == 1) ra1[i] = *(const u32x4*)(A1 + aoff + (size_t)i * 32 * 1024 + k0);
          rb[i] = *(const u32x4*)(bp + (size_t)i * 32 * 1024 + k0);
        }
      }
      const bf16_t* Aw = As + (wm * 64 + r) * GS + h * 8;
      const bf16_t* Bw = Bs + (wn * 64 + r) * GS + h * 8;
#pragma unroll
      for (int ks = 0; ks < 4; ++ks) {
        bf16x8 a0 = *(const bf16x8*)(Aw + ks * 16);
        bf16x8 a1 = *(const bf16x8*)(Aw + 32 * GS + ks * 16);
        bf16x8 b0 = *(const bf16x8*)(Bw + ks * 16);
        bf16x8 b1 = *(const bf16x8*)(Bw + 32 * GS + ks * 16);
        acc[0][0] = __builtin_amdgcn_mfma_f32_32x32x16_bf16(a0, b0, acc[0][0], 0, 0, 0);
        acc[0][1] = __builtin_amdgcn_mfma_f32_32x32x16_bf16(a0, b1, acc[0][1], 0, 0, 0);
        acc[1][0] = __builtin_amdgcn_mfma_f32_32x32x16_bf16(a1, b0, acc[1][0], 0, 0, 0);
        acc[1][1] = __builtin_amdgcn_mfma_f32_32x32x16_bf16(a1, b1, acc[1][1], 0, 0, 0);
      }
    }
    epi(acc, m0 + wm * 64, n0 + wn * 64, lane);
  }
}


struct EpiEvenIn {
  EvenBufs e;
  __device__ void operator()(f32x16 (&acc)[2][2], int rb, int cb, int lane) const {
    const int r = lane & 31, h = lane >> 5;
    if (cb < 1536 || cb >= 2304) {
      bf16_t* dst;
      int c0;
      int mode;
      if (cb < 512) { dst = e.ug; c0 = cb; mode = 0; }
      else if (cb < 1024) { dst = e.vg; c0 = cb - 512; mode = 0; }
      else if (cb < 1536) { dst = e.gas; c0 = cb - 1024; mode = 1; }
      else { dst = e.gbs; c0 = cb - 2304; mode = 1; }
#pragma unroll
      for (int mi = 0; mi < 2; ++mi)
#pragma unroll
        for (int ni = 0; ni < 2; ++ni)
#pragma unroll
          for (int reg = 0; reg < 16; ++reg) {
            const int row = rb + mi * 32 + (reg & 3) + 8 * (reg >> 2) + 4 * h;
            const int col = c0 + ni * 32 + r;
            float v = acc[mi][ni][reg];
            v = (mode == 0) ? gelu_f(v) : silu_f(v);
            dst[(size_t)row * 512 + col] = f2bf(v);
          }
    } else if (cb < 2176) {
      const bool isq = cb < 2048;
      bf16_t* dst = isq ? e.qb : e.kb;
      const int c0 = isq ? (cb - 1536) : (cb - 2048);
      const int ld = isq ? 512 : 128;
      const float scale = isq ? 0.125f : 1.f;
      const bool latent = rb < NL;
      const float inv_freq = exp2f(-(float)(r & 15) * 0.8304820237218406f);
#pragma unroll
      for (int mi = 0; mi < 2; ++mi)
#pragma unroll
        for (int reg = 0; reg < 16; ++reg) {
          const int row = rb + mi * 32 + (reg & 3) + 8 * (reg >> 2) + 4 * h;
          float x1 = acc[mi][0][reg], x2 = acc[mi][1][reg];
          float o1 = x1, o2 = x2;
          if (latent) {
            const int t = row & (SEQL - 1);
            const float pos = (float)((r < 16) ? (t >> 6) : (t & 63));
            const float ang = pos * inv_freq;
            const float cs = __cosf(ang), sn = __sinf(ang);
            o1 = x1 * cs - x2 * sn;
            o2 = x2 * cs + x1 * sn;
          }
          dst[(size_t)row * ld + c0 + r] = f2bf(o1 * scale);
          dst[(size_t)row * ld + c0 + 32 + r] = f2bf(o2 * scale);
        }
    } else {
      const int kvh = (cb - 2176) >> 6;
      const bool latent = rb < NL;
#pragma unroll
      for (int mi = 0; mi < 2; ++mi)
#pragma unroll
        for (int ni = 0; ni < 2; ++ni)
#pragma unroll
          for (int q4 = 0; q4 < 4; ++q4) {
            const int row = rb + mi * 32 + 8 * q4 + 4 * h;
            const int d = ni * 32 + r;
            u32x2 pk;
            pk.x = pack2(acc[mi][ni][q4 * 4 + 0], acc[mi][ni][q4 * 4 + 1]);
            pk.y = pack2(acc[mi][ni][q4 * 4 + 2], acc[mi][ni][q4 * 4 + 3]);
            if (latent) {
              const int b = row >> 12, t = row & (SEQL - 1);
              *(u32x2*)(e.vtl + ((size_t)((b * 2 + kvh) * 64 + d)) * SEQL + t) = pk;
            } else {
              const int rr = row - NL;
              const int b = rr >> 8, t = rr & (LCTX - 1);
              *(u32x2*)(e.vtc + ((size_t)((b * 2 + kvh) * 64 + d)) * LCTX + t) = pk;
            }
          }
    }
  }
};

struct EpiOddIn {
  OddBufs o;
  __device__ void operator()(f32x16 (&acc)[2][2], int rb, int cb, int lane) const {
    const int r = lane & 31, h = lane >> 5;
    const bool isg = cb >= 1024;
    bf16_t* dst = isg ? o.sg : o.xr;
    const int c0 = isg ? cb - 1024 : cb;
#pragma unroll
    for (int mi = 0; mi < 2; ++mi)
#pragma unroll
      for (int ni = 0; ni < 2; ++ni)
#pragma unroll
        for (int reg = 0; reg < 16; ++reg) {
          const int row = rb + mi * 32 + (reg & 3) + 8 * (reg >> 2) + 4 * h;
          const int col = c0 + ni * 32 + r;
          float v = acc[mi][ni][reg];
          if (isg) v = silu_f(v);
          dst[(size_t)row * 1024 + col] = f2bf(v);
        }
  }
};

struct EpiOut {
  float* xbuf;
  const float* mods_l;
  __device__ void operator()(f32x16 (&acc)[2][2], int rb, int cb, int lane) const {
    const int r = lane & 31, h = lane >> 5;
    const int bidx = (rb < NL) ? (rb >> 12) : 8;
    const float* gate = mods_l + (size_t)bidx * 3072 + 2048;
#pragma unroll
    for (int ni = 0; ni < 2; ++ni) {
      const int col = cb + ni * 32 + r;
      const float gv = gate[col];
#pragma unroll
      for (int mi = 0; mi < 2; ++mi)
#pragma unroll
        for (int reg = 0; reg < 16; ++reg) {
          const int row = rb + mi * 32 + (reg & 3) + 8 * (reg >> 2) + 4 * h;
          float* px = xbuf + (size_t)row * 1024 + col;
          *px = *px + gv * acc[mi][ni][reg];
        }
    }
  }
};

constexpr int AS = 72;

__device__ void attn_item(const Params& p, const EvenBufs& e, int item, char* smem, int ei) {
  bf16_t* Ks = (bf16_t*)smem;
  bf16_t* Vs = Ks + 64 * AS;
  const int tid = otid(), lane = tid & 63, w = tid >> 6;
  const int r = lane & 31, h = lane >> 5;
  int b, hq, start, R0;
  bool isctx;
  if (item < 2048) {
    b = item >> 8;
    hq = (item >> 5) & 7;
    const int qblk = item & 31;
    start = qblk * 128;
    R0 = b * SEQL + start;
    isctx = false;
  } else {
    const int it = item - 2048;
    b = it >> 4;
    hq = (it >> 1) & 7;
    start = (it & 1) * 128;
    R0 = NL + b * LCTX + start;
    isctx = true;
  }
  const int kvh = hq >> 2;
  const int qrow = R0 + w * 32 + r;
  bf16x8 qf[4];
#pragma unroll
  for (int s = 0; s < 4; ++s) qf[s] = *(const bf16x8*)(e.qb + (size_t)qrow * 512 + hq * 64 + s * 16 + h * 8);
  float m = p.b_sink[ei * 8 + hq], l = 1.f;
  f32x16 o[2];
  o[0] = zero16();
  o[1] = zero16();
  const int nblk = isctx ? 4 : 10;
  for (int kb = 0; kb < nblk; ++kb) {
    int krow0, kpos0 = 0, vstride;
    const bf16_t* vt;
    bool local = false;
    if (kb < 4) {
      krow0 = NL + b * LCTX + kb * 64;
      vt = e.vtc + (size_t)((b * 2 + kvh) * 64) * LCTX + kb * 64;
      vstride = LCTX;
    } else {
      kpos0 = start - 128 + (kb - 4) * 64;
      if (kpos0 < 0 || kpos0 >= SEQL) continue;
      krow0 = b * SEQL + kpos0;
      vt = e.vtl + (size_t)((b * 2 + kvh) * 64) * SEQL + kpos0;
      vstride = SEQL;
      local = true;
    }
    __syncthreads();
#pragma unroll
    for (int i = 0; i < 2; ++i) {
      const int c = tid + 256 * i;
      const int rr = c >> 3, cc = c & 7;
      *(u32x4*)(Ks + rr * AS + cc * 8) = *(const u32x4*)(e.kb + (size_t)(krow0 + rr) * 128 + kvh * 64 + cc * 8);
      *(u32x4*)(Vs + rr * AS + cc * 8) = *(const u32x4*)(vt + (size_t)rr * vstride + cc * 8);
    }
    __syncthreads();
    f32x16 s[2];
#pragma unroll
    for (int kt = 0; kt < 2; ++kt) {
      s[kt] = zero16();
#pragma unroll
      for (int ks = 0; ks < 4; ++ks) {
        bf16x8 a = *(const bf16x8*)(Ks + (kt * 32 + r) * AS + ks * 16 + h * 8);
        s[kt] = __builtin_amdgcn_mfma_f32_32x32x16_bf16(a, qf[ks], s[kt], 0, 0, 0);
      }
    }
    if (local) {
      const int qpos = start + w * 32 + r;
#pragma unroll
      for (int kt = 0; kt < 2; ++kt)
#pragma unroll
        for (int reg = 0; reg < 16; ++reg) {
          const int kpos = kpos0 + kt * 32 + (reg & 3) + 8 * (reg >> 2) + 4 * h;
          const int diff = qpos - kpos;
          if (diff > 128 || diff < -128) s[kt][reg] = -1e30f;
        }
    }
    float mx = m;
#pragma unroll
    for (int kt = 0; kt < 2; ++kt)
#pragma unroll
      for (int reg = 0; reg < 16; ++reg) mx = fmaxf(mx, s[kt][reg]);
    mx = fmaxf(mx, __shfl_xor(mx, 32));
    const float alpha = __expf(m - mx);
    m = mx;
    float rs = 0.f;
#pragma unroll
    for (int kt = 0; kt < 2; ++kt)
#pragma unroll
      for (int reg = 0; reg < 16; ++reg) {
        const float pv = __expf(s[kt][reg] - mx);
        rs += pv;
        s[kt][reg] = pv;
      }
    rs += __shfl_xor(rs, 32);
    l = l * alpha + rs;
#pragma unroll
    for (int dt = 0; dt < 2; ++dt)
#pragma unroll
      for (int reg = 0; reg < 16; ++reg) o[dt][reg] *= alpha;
#pragma unroll
    for (int kt = 0; kt < 2; ++kt)
#pragma unroll
      for (int sp = 0; sp < 2; ++sp) {
        union { bf16x8 v; uint32_t u[4]; } pf;
#pragma unroll
        for (int j = 0; j < 4; ++j) pf.u[j] = pack2(s[kt][8 * sp + 2 * j], s[kt][8 * sp + 2 * j + 1]);
#pragma unroll
        for (int dt = 0; dt < 2; ++dt) {
          const bf16_t* vp = Vs + (dt * 32 + r) * AS + kt * 32 + sp * 16 + 4 * h;
          union { bf16x8 v; u32x2 u[2]; } af;
          af.u[0] = *(const u32x2*)(vp);
          af.u[1] = *(const u32x2*)(vp + 8);
          o[dt] = __builtin_amdgcn_mfma_f32_32x32x16_bf16(af.v, pf.v, o[dt], 0, 0, 0);
        }
      }
  }
  const float inv = 1.f / l;
  bf16_t* ymix = p.hbuf;
#pragma unroll
  for (int dt = 0; dt < 2; ++dt)
#pragma unroll
    for (int q4 = 0; q4 < 4; ++q4) {
      const int d0 = dt * 32 + 8 * q4 + 4 * h;
      const u32x2 g = *(const u32x2*)(e.gbs + (size_t)qrow * 512 + hq * 64 + d0);
      u32x2 pk;
      pk.x = pack2(o[dt][q4 * 4 + 0] * inv * lo_bf(g.x), o[dt][q4 * 4 + 1] * inv * hi_bf(g.x));
      pk.y = pack2(o[dt][q4 * 4 + 2] * inv * lo_bf(g.y), o[dt][q4 * 4 + 3] * inv * hi_bf(g.y));
      *(u32x2*)(ymix + (size_t)qrow * 1024 + 512 + hq * 64 + d0) = pk;
    }
}

constexpr int MS = 136;

__device__ void gmlp_item(const Params& p, const EvenBufs& e, int item, char* smem, int ei) {
  bf16_t* Ws = (bf16_t*)smem;
  bf16_t* VT = Ws + 128 * MS;
  const int tid = otid(), lane = tid & 63, w = tid >> 6;
  const int r = lane & 31, h = lane >> 5;
  const int wm = w >> 1, wn = w & 1;
  const int rt = item >> 2, g = item & 3;
  const int R0 = rt * 128;
  __syncthreads();
  {
    const float4* wsrc = (const float4*)(p.a_w_s + (size_t)(ei * 4 + g) * 128 * 128);
#pragma unroll
    for (int i = 0; i < 16; ++i) {
      const int idx = tid + 256 * i;
      const int pp = idx >> 5, q4 = idx & 31;
      float4 v = wsrc[idx];
      u32x2 pk;
      pk.x = pack2(v.x, v.y);
      pk.y = pack2(v.z, v.w);
      *(u32x2*)(Ws + pp * MS + q4 * 4) = pk;
    }
  }
#pragma unroll 1
  for (int hp = 0; hp < 2; ++hp) {
    const int q = hp * 64 + (tid >> 2), qt = tid & 3;
    const bf16_t* vsrc = e.vg + (size_t)(R0 + q) * 512 + g * 128 + qt * 32;
    float xv[32];
#pragma unroll
    for (int i = 0; i < 4; ++i) {
      u32x4 u = *(const u32x4*)(vsrc + i * 8);
      xv[i * 8 + 0] = lo_bf(u.x); xv[i * 8 + 1] = hi_bf(u.x);
      xv[i * 8 + 2] = lo_bf(u.y); xv[i * 8 + 3] = hi_bf(u.y);
      xv[i * 8 + 4] = lo_bf(u.z); xv[i * 8 + 5] = hi_bf(u.z);
      xv[i * 8 + 6] = lo_bf(u.w); xv[i * 8 + 7] = hi_bf(u.w);
    }
    float sm = 0.f;
#pragma unroll
    for (int j = 0; j < 32; ++j) sm += xv[j];
    sm += __shfl_xor(sm, 1);
    sm += __shfl_xor(sm, 2);
    const float mean = sm * (1.f / 128.f);
    float sq = 0.f;
#pragma unroll
    for (int j = 0; j < 32; ++j) { float dlt = xv[j] - mean; sq += dlt * dlt; }
    sq += __shfl_xor(sq, 1);
    sq += __shfl_xor(sq, 2);
    const float rstd = rsqrtf(sq * (1.f / 128.f) + 1e-6f);
    const float* lg = p.a_ln_g + ei * 512 + g * 128 + qt * 32;
    const float* lb = p.a_ln_b + ei * 512 + g * 128 + qt * 32;
#pragma unroll
    for (int j = 0; j < 32; ++j) {
      const float val = (xv[j] - mean) * rstd * lg[j] + lb[j];
      VT[(qt * 32 + j) * MS + q] = f2bf(val);
    }
  }
  __syncthreads();
  f32x16 acc[2][2];
#pragma unroll
  for (int mi = 0; mi < 2; ++mi)
#pragma unroll
    for (int ni = 0; ni < 2; ++ni) acc[mi][ni] = zero16();
  const bf16_t* Aw = Ws + (wm * 64 + r) * MS + h * 8;
  const bf16_t* Bw = VT + (wn * 64 + r) * MS + h * 8;
#pragma unroll
  for (int ks = 0; ks < 8; ++ks) {
    bf16x8 a0 = *(const bf16x8*)(Aw + ks * 16);
    bf16x8 a1 = *(const bf16x8*)(Aw + 32 * MS + ks * 16);
    bf16x8 b0 = *(const bf16x8*)(Bw + ks * 16);
    bf16x8 b1 = *(const bf16x8*)(Bw + 32 * MS + ks * 16);
    acc[0][0] = __builtin_amdgcn_mfma_f32_32x32x16_bf16(a0, b0, acc[0][0], 0, 0, 0);
    acc[0][1] = __builtin_amdgcn_mfma_f32_32x32x16_bf16(a0, b1, acc[0][1], 0, 0, 0);
    acc[1][0] = __builtin_amdgcn_mfma_f32_32x32x16_bf16(a1, b0, acc[1][0], 0, 0, 0);
    acc[1][1] = __builtin_amdgcn_mfma_f32_32x32x16_bf16(a1, b1, acc[1][1], 0, 0, 0);
  }
  bf16_t* ymix = p.hbuf;
  const float* bs = p.a_b_s + (ei * 4 + g) * 128;
#pragma unroll
  for (int mi = 0; mi < 2; ++mi)
#pragma unroll
    for (int reg = 0; reg < 16; ++reg) {
      const int prow = wm * 64 + mi * 32 + (reg & 3) + 8 * (reg >> 2) + 4 * h;
      const float bsv = bs[prow];
      const size_t row = (size_t)(R0 + prow);
#pragma unroll
      for (int ni = 0; ni < 2; ++ni) {
        const int col = g * 128 + wn * 64 + ni * 32 + r;
        const float sv = acc[mi][ni][reg] + bsv;
        const float y = bf2f(e.ug[row * 512 + col]) * sv * bf2f(e.gas[row * 512 + col]);
        ymix[row * 1024 + col] = f2bf(y);
      }
    }
}

__device__ void phase_even_mix(const Params& p, char* smem, int ei) {
  const EvenBufs e = even_bufs(p);
  const int n_attn = 2048 + 128, n_gmlp = 1088;
  for (int item = blockIdx.x; item < n_attn + n_gmlp; item += gridDim.x) {
    if (item < n_attn) attn_item(p, e, item, smem, ei);
    else gmlp_item(p, e, item - n_attn, smem, ei);
  }
}

constexpr int ZS = 264;

__device__ void rglru_item(const Params& p, const OddBufs& ob, int item, char* smem, int oi, bool need_ctx) {
  bf16_t* Zs = (bf16_t*)smem;
  bf16_t* Bs = Zs + 64 * ZS;
  float* segA = (float*)(Bs + 64 * ZS);
  float* segB = segA + 256;
  float* carry = segB + 256;
  float* La = (float*)Zs;
  float* Gz = La + 2048;
  const int tid = otid(), lane = tid & 63, w = tid >> 6;
  const int r = lane & 31, h = lane >> 5;
  const int wm = w >> 1, wn = w & 1;
  const int b = item >> 6, dir = (item >> 5) & 1, cs = item & 31;
  const int hd = cs >> 3, j0 = (cs & 7) * 32, c0 = cs * 32;
  bf16_t* sout = dir ? ob.sb : p.hbuf;
  __syncthreads();
  {
    const size_t mo = ((size_t)((oi * 2 + dir) * 4 + hd)) * 65536 + (size_t)j0 * 256;
    const bf16_t* wa = p.wga + mo;
    const bf16_t* wi = p.wgi + mo;
#pragma unroll
    for (int i = 0; i < 8; ++i) {
      const int c = tid + 256 * i;
      const int n = c >> 5, kc = c & 31;
      const bf16_t* src = (n < 32) ? (wa + n * 256 + kc * 8) : (wi + (n - 32) * 256 + kc * 8);
      *(u32x4*)(Bs + n * ZS + kc * 8) = *(const u32x4*)src;
    }
    if (tid < 32) carry[tid] = 0.f;
  }
  const int cc = tid & 31, seg8 = tid >> 5;
  const int chb = hd * 256 + cc * 8;
  float cw[4][8], cbias[8];
#pragma unroll
  for (int j = 0; j < 4; ++j)
#pragma unroll
    for (int e2 = 0; e2 < 8; ++e2) cw[j][e2] = p.c_conv_w[((size_t)oi * 4 + j) * 1024 + chb + e2];
#pragma unroll
  for (int e2 = 0; e2 < 8; ++e2) cbias[e2] = p.c_conv_b[oi * 1024 + chb + e2];
  const int gch = (oi * 2 + dir) * 1024 + c0 + r;
  const float gbias = wn ? p.c_b_i[gch] : p.c_b_a[gch];
  const float spl = log1pf(__expf(-p.c_lam[gch]));
  const int sc_c = tid & 31, sc_sg = tid >> 5;

  for (int step = 0; step < 68; ++step) {
    int Rs, Ls, ti;
    bool wr;
    if (step < 4) { Rs = NL + b * LCTX; Ls = LCTX; ti = dir ? 3 - step : step; wr = need_ctx; }
    else { Rs = b * SEQL; Ls = SEQL; ti = dir ? 63 - (step - 4) : (step - 4); wr = true; }
    const int t0 = ti * 64;
    __syncthreads();
#pragma unroll 1
    for (int hp = 0; hp < 2; ++hp) {
      float xw[7][8];
      const int rbase = seg8 * 8 + hp * 4;
#pragma unroll
      for (int jj = 0; jj < 7; ++jj) {
        const int t = t0 + rbase - 2 + jj;
        u32x4 u = (u32x4){0u, 0u, 0u, 0u};
        if (t >= 0 && t < Ls) u = *(const u32x4*)(ob.xr + (size_t)(Rs + t) * 1024 + chb);
        xw[jj][0] = lo_bf(u.x); xw[jj][1] = hi_bf(u.x);
        xw[jj][2] = lo_bf(u.y); xw[jj][3] = hi_bf(u.y);
        xw[jj][4] = lo_bf(u.z); xw[jj][5] = hi_bf(u.z);
        xw[jj][6] = lo_bf(u.w); xw[jj][7] = hi_bf(u.w);
      }
#pragma unroll
      for (int i = 0; i < 4; ++i) {
        float z[8];
#pragma unroll
        for (int e2 = 0; e2 < 8; ++e2) {
          float a = cbias[e2];
#pragma unroll
          for (int j = 0; j < 4; ++j) a += cw[j][e2] * xw[i + j][e2];
          z[e2] = a;
        }
        u32x4 pk;
        pk.x = pack2(z[0], z[1]); pk.y = pack2(z[2], z[3]);
        pk.z = pack2(z[4], z[5]); pk.w = pack2(z[6], z[7]);
        *(u32x4*)(Zs + (rbase + i) * ZS + cc * 8) = pk;
      }
    }
    __syncthreads();
    f32x16 acc = zero16();
    {
      const bf16_t* Aw = Zs + (wm * 32 + r) * ZS + h * 8;
      const bf16_t* Bw = Bs + (wn * 32 + r) * ZS + h * 8;
#pragma unroll
      for (int ks = 0; ks < 16; ++ks) {
        bf16x8 a = *(const bf16x8*)(Aw + ks * 16);
        bf16x8 bb = *(const bf16x8*)(Bw + ks * 16);
        acc = __builtin_amdgcn_mfma_f32_32x32x16_bf16(a, bb, acc, 0, 0, 0);
      }
    }
    float vals[16];
#pragma unroll
    for (int reg = 0; reg < 16; ++reg) {
      const int row = wm * 32 + (reg & 3) + 8 * (reg >> 2) + 4 * h;
      const float sgm = sigmoid_f(acc[reg] + gbias);
      if (wn == 0) vals[reg] = -8.f * sgm * spl;
      else vals[reg] = sgm * bf2f(Zs[row * ZS + j0 + r]);
    }
    __syncthreads();
    {
      float* dstb = wn ? Gz : La;
#pragma unroll
      for (int reg = 0; reg < 16; ++reg) {
        const int row = wm * 32 + (reg & 3) + 8 * (reg >> 2) + 4 * h;
        dstb[row * 32 + r] = vals[reg];
      }
    }
    __syncthreads();
    float av[8], bv[8];
    {
      float A = 1.f, Bv = 0.f;
#pragma unroll
      for (int i = 0; i < 8; ++i) {
        const int pidx = sc_sg * 8 + i;
        const int row = dir ? 63 - pidx : pidx;
        const float la = La[row * 32 + sc_c];
        const float a = __expf(la);
        const float mult = sqrtf(-expm1f(2.f * la));
        const float bx = mult * Gz[row * 32 + sc_c];
        av[i] = a;
        bv[i] = bx;
        Bv = a * Bv + bx;
        A *= a;
      }
      segA[sc_sg * 32 + sc_c] = A;
      segB[sc_sg * 32 + sc_c] = Bv;
    }
    __syncthreads();
    {
      float hh = carry[(step & 1) * 32 + sc_c];
      for (int s2 = 0; s2 < sc_sg; ++s2) hh = segA[s2 * 32 + sc_c] * hh + segB[s2 * 32 + sc_c];
#pragma unroll
      for (int i = 0; i < 8; ++i) {
        const int pidx = sc_sg * 8 + i;
        const int row = dir ? 63 - pidx : pidx;
        hh = av[i] * hh + bv[i];
        if (wr) {
          const size_t off = (size_t)(Rs + t0 + row) * 1024 + c0 + sc_c;
          sout[off] = f2bf(hh * bf2f(ob.sg[off]));
        }
      }
      if (sc_sg == 7) carry[((step + 1) & 1) * 32 + sc_c] = hh;
    }
  }
}

__device__ void phase_rglru(const Params& p, char* smem, int oi, bool need_ctx) {
  const OddBufs ob = odd_bufs(p);
  for (int item = blockIdx.x; item < 512; item += gridDim.x) rglru_item(p, ob, item, smem, oi, need_ctx);
}

#define LAUNDER(f) q.f = p.f + z
#define XB_TMO      128
#define XB_XCNT(j)  (256  + 64 * (j))
#define XB_XSUB(j)  (1280 + 64 * (j))
#define XB_XGEN(j)  (2304 + 64 * (j))
#define XB_TOP      3328
#define XB_TOPGEN   3392
#define XCD_BAR_WORDS 3456
#define XB_SPIN_CAP (1u << 18)
#define LAS __attribute__((address_space(3)))

__device__ __forceinline__ unsigned xb_ld(unsigned* p)              { return __hip_atomic_load(p, __ATOMIC_RELAXED, __HIP_MEMORY_SCOPE_AGENT); }
__device__ __forceinline__ unsigned xb_add(unsigned* p, unsigned v) { return __hip_atomic_fetch_add(p, v, __ATOMIC_RELAXED, __HIP_MEMORY_SCOPE_AGENT); }
__device__ __forceinline__ unsigned xb_xcc_id() { return (unsigned)__builtin_amdgcn_s_getreg((3 << 11) | 20) & 0xFu; }
#define XB_SPIN(cond, bar) do { unsigned _sp = 0; while (cond) { __builtin_amdgcn_s_sleep(1); \
    if ((++_sp & 255u) == 0u) { if (xb_ld(&(bar)[XB_TMO])) break; if (_sp > XB_SPIN_CAP) { atomicAdd(&(bar)[XB_TMO], 1u); break; } } } } while (0)

struct XcdBarrier {
    unsigned* bar; unsigned x;
    volatile LAS unsigned* st;
};

__device__ __forceinline__ XcdBarrier xcd_barrier_post(unsigned* bar, volatile LAS unsigned* st) {
    XcdBarrier b; b.bar = bar; b.x = xb_xcc_id(); b.st = st;
    if (threadIdx.x == 0) (void)xb_add(&bar[XB_XCNT(b.x)], 1u);
    return b;
}
__device__ __forceinline__ void xcd_barrier_complete(unsigned* bar, unsigned x, unsigned& nloc, unsigned& nx) {
    const unsigned G = gridDim.x * gridDim.y * gridDim.z;
    unsigned sum, cnt, mine, sp = 0u;
    for (;;) {
        sum = 0u; cnt = 0u; mine = 0u;
#pragma unroll
        for (unsigned j = 0; j < 16; ++j) { const unsigned c = xb_ld(&bar[XB_XCNT(j)]); sum += c; cnt += (c > 0u) ? 1u : 0u; mine = (j == x) ? c : mine; }
        if (sum == G) break;
        __builtin_amdgcn_s_sleep(1);
        if ((++sp & 255u) == 0u) { if (xb_ld(&bar[XB_TMO])) break; if (sp > XB_SPIN_CAP) { atomicAdd(&bar[XB_TMO], 1u); break; } }
    }
    nloc = mine > 0u ? mine : 1u; nx = cnt > 0u ? cnt : 1u;
}

__device__ __forceinline__ void xcd_barrier(const XcdBarrier& b) {
    asm volatile("s_waitcnt vmcnt(0)" ::: "memory");
    __syncthreads();
    if (threadIdx.x == 0) {
        unsigned* bar = b.bar;
        __builtin_amdgcn_s_waitcnt(0);
        unsigned nloc = b.st[0], nx = b.st[1];
        if (nloc == 0u) { xcd_barrier_complete(bar, b.x, nloc, nx); b.st[0] = nloc; b.st[1] = nx; }
        const unsigned old = xb_add(&bar[XB_XSUB(b.x)], 1u);
        const unsigned gen = old / nloc;
        if (old + 1u == (gen + 1u) * nloc) {
            __builtin_amdgcn_fence(__ATOMIC_RELEASE, "agent");
            asm volatile("s_waitcnt vmcnt(0)" ::: "memory");
            const unsigned og = xb_add(&bar[XB_TOP], 1u);
            const unsigned tg = og / nx;
            if (og + 1u == (tg + 1u) * nx) xb_add(&bar[XB_TOPGEN], 1u);
            else XB_SPIN(xb_ld(&bar[XB_TOPGEN]) == tg, bar);
            __builtin_amdgcn_fence(__ATOMIC_ACQUIRE, "agent");
            xb_add(&bar[XB_XGEN(b.x)], 1u);
            asm volatile("s_waitcnt vmcnt(0)" ::: "memory");
        } else {
            XB_SPIN(xb_ld(&bar[XB_XGEN(b.x)]) == gen, bar);
            __builtin_amdgcn_fence(__ATOMIC_ACQUIRE, "agent");
            asm volatile("s_waitcnt vmcnt(0)" ::: "memory");
        }
    }
    __syncthreads();
}


__device__ __forceinline__ void launder(Params& q, const Params& p) {
  long z;
  asm volatile("s_mov_b64 %0, 0" : "=s"(z));
  LAUNDER(x); LAUNDER(c); LAUNDER(ctx); LAUNDER(c_ctx); LAUNDER(norm_g); LAUNDER(w_mod); LAUNDER(b_mod);
  LAUNDER(ab_w_in); LAUNDER(a_ln_g); LAUNDER(a_ln_b); LAUNDER(a_w_s); LAUNDER(a_b_s); LAUNDER(b_sink);
  LAUNDER(ab_w_out); LAUNDER(c_w_in); LAUNDER(c_conv_w); LAUNDER(c_conv_b); LAUNDER(c_w_a); LAUNDER(c_b_a);
  LAUNDER(c_w_i); LAUNDER(c_b_i); LAUNDER(c_lam); LAUNDER(c_w_out); LAUNDER(final_g); LAUNDER(out);
  LAUNDER(xbuf); LAUNDER(mods); LAUNDER(hbuf); LAUNDER(ebuf); LAUNDER(wt_in_e); LAUNDER(wt_out_e);
  LAUNDER(wt_in_o); LAUNDER(wt_out_o); LAUNDER(wga); LAUNDER(wgi);
}

constexpr int NPHASES = 18;

__device__ void run_phase(const Params& p0, int ph, char* smem) {
  if (ph == 0) { Params p; launder(p, p0); phase0(p, smem); return; }
  if (ph == 17) { Params p; launder(p, p0); phase_final(p); return; }
  const int layer = (ph - 1) >> 2, sub = (ph - 1) & 3;
  const int idx = layer >> 1;
  const bool even = (layer & 1) == 0;
  const bool need_ctx = layer < 3;
  if (sub == 0) { Params p; launder(p, p0); phase_prep(p, layer); return; }
  if (even) {
    if (sub == 1) {
      Params p; launder(p, p0);
      EpiEvenIn epi; epi.e = even_bufs(p);
      gemm_phase<0>(p.hbuf, nullptr, p.wt_in_e + (size_t)idx * 2816 * 1024, NR / 128, 22, smem, epi);
    } else if (sub == 2) {
      Params p; launder(p, p0);
      phase_even_mix(p, smem, idx);
    } else {
      Params p; launder(p, p0);
      EpiOut epi; epi.xbuf = p.xbuf; epi.mods_l = p.mods + (size_t)layer * 9 * 3072;
      gemm_phase<0>(p.hbuf, nullptr, p.wt_out_e + (size_t)idx * 1024 * 1024, NR / 128, 8, smem, epi);
    }
  } else {
    if (sub == 1) {
      Params p; launder(p, p0);
      EpiOddIn epi; epi.o = odd_bufs(p);
      gemm_phase<0>(p.hbuf, nullptr, p.wt_in_o + (size_t)idx * 2048 * 1024, NR / 128, 16, smem, epi);
    } else if (sub == 2) {
      Params p; launder(p, p0);
      phase_rglru(p, smem, idx, need_ctx);
    } else {
      Params p; launder(p, p0);
      EpiOut epi; epi.xbuf = p.xbuf; epi.mods_l = p.mods + (size_t)layer * 9 * 3072;
      const OddBufs ob = odd_bufs(p);
      gemm_phase<1>(p.hbuf, ob.sb, p.wt_out_o + (size_t)idx * 1024 * 1024, (need_ctx ? NR : NL) / 128, 8, smem, epi);
    }
  }
}

__global__ void __launch_bounds__(NTHREADS, 2) mega_kernel(Params p, int ph_lo, int ph_hi, int use_bar) {
  __shared__ __attribute__((aligned(16))) char smem[SMEM_BYTES];
  __shared__ uint4 xb_words;
  if (threadIdx.x == 0) xb_words = make_uint4(0u, 0u, 0u, 0u);
  __syncthreads();
  XcdBarrier xb;
  if (use_bar == 1) xb = xcd_barrier_post(p.bar, (volatile LAS unsigned*)&xb_words);
  for (int ph = ph_lo; ph < ph_hi; ++ph) {
    run_phase(p, ph, smem);
    if (ph + 1 < ph_hi) {
      if (use_bar == 1) xcd_barrier(xb);
      else if (use_bar == 2) cg::this_grid().sync();
    }
  }
}

extern "C" void kernel_launch(void* const* d_in, const int* in_sizes, int n_in, void* d_out, int out_size,
                              void* d_ws, size_t ws_size, hipStream_t stream) {
  static int grid_blocks = 0;
  if (!grid_blocks) {
    int dev = 0, cus = 0, per_cu = 0;
    hipGetDevice(&dev);
    hipDeviceGetAttribute(&cus, hipDeviceAttributeMultiprocessorCount, dev);
    hipOccupancyMaxActiveBlocksPerMultiprocessor(&per_cu, mega_kernel, NTHREADS, 0);
    if (per_cu < 1) per_cu = 1;
    if (per_cu > 2) per_cu = 2;
    grid_blocks = cus * per_cu;
  }
  Params p{};
  const float** fp = (const float**)&p;
  for (int i = 0; i < 24; ++i) fp[i] = (const float*)d_in[i];
  p.out = (float*)d_out;
  char* ws = (char*)d_ws;
  size_t off = 0;
  auto take = [&](size_t bytes) { char* q = ws + off; off += (bytes + 255) & ~(size_t)255; return q; };
  p.xbuf = (float*)take((size_t)NR * 1024 * 4);
  p.mods = (float*)take((size_t)4 * 9 * 3072 * 4);
  p.hbuf = (bf16_t*)take((size_t)NR * 1024 * 2);
  p.ebuf = (bf16_t*)take((size_t)NR * 3072 * 2);
  p.wt_in_e = (bf16_t*)take((size_t)2 * 2816 * 1024 * 2);
  p.wt_out_e = (bf16_t*)take((size_t)2 * 1024 * 1024 * 2);
  p.wt_in_o = (bf16_t*)take((size_t)2 * 2048 * 1024 * 2);
  p.wt_out_o = (bf16_t*)take((size_t)2 * 1024 * 1024 * 2);
  p.wga = (bf16_t*)take((size_t)16 * 65536 * 2);
  p.wgi = (bf16_t*)take((size_t)16 * 65536 * 2);
  p.bar = (unsigned*)take((size_t)XCD_BAR_WORDS * 4);
  if (off > ws_size) fprintf(stderr, "workspace too small: need %zu have %zu\n", off, ws_size);
#if COOP
  hipMemsetAsync(p.bar, 0, (size_t)XCD_BAR_WORDS * 4, stream);
  int lo = 0, hi = NPHASES, ub = 1;
  void* args[] = {&p, &lo, &hi, &ub};
  hipError_t e = hipLaunchCooperativeKernel((void*)mega_kernel, dim3(grid_blocks), dim3(NTHREADS), args, 0, stream);
  if (e != hipSuccess) fprintf(stderr, "cooperative launch failed: %s (grid %d)\n", hipGetErrorString(e), grid_blocks);
#else
  for (int ph = 0; ph < NPHASES; ++ph) mega_kernel<<<grid_blocks, NTHREADS, 0, stream>>>(p, ph, ph + 1, 0);
#endif
}
```

```cpp
#include <hip/hip_runtime.h>
#include <hip/hip_cooperative_groups.h>
#include <stdint.h>
#include <stdio.h>
namespace cg = cooperative_groups;

#ifndef COOP
#define COOP 1
#endif

typedef unsigned short bf16_t;
typedef __attribute__((ext_vector_type(8))) short bf16x8;
typedef __attribute__((ext_vector_type(16))) float f32x16;
typedef __attribute__((ext_vector_type(4))) unsigned int u32x4;
typedef __attribute__((ext_vector_type(2))) unsigned int u32x2;

constexpr int DM = 1024;
constexpr int NBATCH = 8;
constexpr int SEQL = 4096;
constexpr int LCTX = 256;
constexpr int NL = NBATCH * SEQL;
constexpr int NC = NBATCH * LCTX;
constexpr int NR = NL + NC;
constexpr int SMEM_BYTES = 72 * 1024;
constexpr int NTHREADS = 256;

struct Params {
  const float *x, *c, *ctx, *c_ctx, *norm_g, *w_mod, *b_mod, *ab_w_in, *a_ln_g, *a_ln_b, *a_w_s, *a_b_s,
      *b_sink, *ab_w_out, *c_w_in, *c_conv_w, *c_conv_b, *c_w_a, *c_b_a, *c_w_i, *c_b_i, *c_lam, *c_w_out,
      *final_g;
  float* out;
  float* xbuf;
  float* mods;
  bf16_t* hbuf;
  bf16_t* ebuf;
  bf16_t *wt_in_e, *wt_out_e, *wt_in_o, *wt_out_o, *wga, *wgi;
  unsigned* bar;
};

typedef __bf16 hwbf16x2 __attribute__((ext_vector_type(2)));
typedef float f32x2v __attribute__((ext_vector_type(2)));
__device__ __forceinline__ uint32_t pack2(float a, float b) {
  f32x2v v = {a, b};
  hwbf16x2 r = __builtin_convertvector(v, hwbf16x2);
  return __builtin_bit_cast(uint32_t, r);
}
__device__ __forceinline__ bf16_t f2bf(float f) { return (bf16_t)(pack2(f, f) & 0xffffu); }
__device__ __forceinline__ float bf2f(bf16_t b) { return __uint_as_float(((uint32_t)b) << 16); }
__device__ __forceinline__ float lo_bf(uint32_t u) { return __uint_as_float(u << 16); }
__device__ __forceinline__ float hi_bf(uint32_t u) { return __uint_as_float(u & 0xffff0000u); }
__device__ __forceinline__ float frcp(float x) { return __builtin_amdgcn_rcpf(x); }
__device__ __forceinline__ float silu_f(float x) { return x * frcp(1.f + __expf(-x)); }
__device__ __forceinline__ float sigmoid_f(float x) { return frcp(1.f + __expf(-x)); }
__device__ __forceinline__ float gelu_f(float x) {
  float y = 0.7978845608028654f * (x + 0.044715f * x * x * x);
  float t = 1.f - 2.f * frcp(1.f + __expf(2.f * y));
  return 0.5f * x * (1.f + t);
}
__device__ __forceinline__ f32x16 zero16() {
  f32x16 z;
#pragma unroll
  for (int i = 0; i < 16; ++i) z[i] = 0.f;
  return z;
}
__device__ __forceinline__ float wave_sum(float v) {
#pragma unroll
  for (int o = 32; o > 0; o >>= 1) v += __shfl_xor(v, o);
  return v;
}

__device__ __forceinline__ int otid() {
  int t = threadIdx.x;
  asm volatile("" : "+v"(t));
  return t;
}

struct EvenBufs {
  bf16_t *ug, *vg, *gas, *qb, *gbs, *kb, *vtl, *vtc;
};
__device__ __forceinline__ EvenBufs even_bufs(const Params& p) {
  EvenBufs e;
  e.ug = p.ebuf;
  e.vg = e.ug + (size_t)NR * 512;
  e.gas = e.vg + (size_t)NR * 512;
  e.qb = e.gas + (size_t)NR * 512;
  e.gbs = e.qb + (size_t)NR * 512;
  e.kb = e.gbs + (size_t)NR * 512;
  e.vtl = e.kb + (size_t)NR * 128;
  e.vtc = e.vtl + (size_t)NBATCH * 128 * SEQL;
  return e;
}
struct OddBufs {
  bf16_t *xr, *sg, *sb;
};
__device__ __forceinline__ OddBufs odd_bufs(const Params& p) {
  OddBufs o;
  o.xr = p.ebuf;
  o.sg = o.xr + (size_t)NR * 1024;
  o.sb = o.xr;
  return o;
}

__device__ void transpose_item(const Params& p, int item, char* smem) {
  float* tile = (float*)smem;
  const float* src;
  bf16_t* dst;
  int K, N, local;
  if (item < 1408) { src = p.ab_w_in; dst = p.wt_in_e; K = 1024; N = 2816; local = item; }
  else if (item < 1920) { src = p.ab_w_out; dst = p.wt_out_e; K = 1024; N = 1024; local = item - 1408; }
  else if (item < 2944) { src = p.c_w_in; dst = p.wt_in_o; K = 1024; N = 2048; local = item - 1920; }
  else if (item < 3456) { src = p.c_w_out; dst = p.wt_out_o; K = 1024; N = 1024; local = item - 2944; }
  else if (item < 3712) { src = p.c_w_a; dst = p.wga; K = 256; N = 256; local = item - 3456; }
  else { src = p.c_w_i; dst = p.wgi; K = 256; N = 256; local = item - 3712; }
  const int ntn = N / 64;
  const int tpb = (K / 64) * ntn;
  const int bi = local / tpb;
  const int rem = local % tpb;
  const int k0 = (rem / ntn) * 64, n0 = (rem % ntn) * 64;
  src += (size_t)bi * K * N;
  dst += (size_t)bi * K * N;
  const int tid = otid();
  __syncthreads();
#pragma unroll
  for (int i = 0; i < 16; ++i) {
    int rr = i * 4 + (tid >> 6), cc = tid & 63;
    tile[rr * 65 + cc] = src[(size_t)(k0 + rr) * N + n0 + cc];
  }
  __syncthreads();
#pragma unroll
  for (int i = 0; i < 16; ++i) {
    int n = i * 4 + (tid >> 6), k = tid & 63;
    dst[(size_t)(n0 + n) * K + k0 + k] = f2bf(tile[k * 65 + n]);
  }
}

__device__ void mods_item(const Params& p, int item, char* smem) {
  float* sc = (float*)smem;
  float* red = sc + 9 * 1024;
  const int tid = otid();
  const int l = item / 96, n0 = (item % 96) * 32;
  __syncthreads();
  for (int i = tid; i < 9 * 1024; i += NTHREADS) {
    int j = i >> 10, k = i & 1023;
    float v = (j < 8) ? p.c[j * 1024 + k] : p.c_ctx[k];
    sc[i] = silu_f(v);
  }
  __syncthreads();
  const int col = tid & 31, kg = tid >> 5;
  float acc[9];
#pragma unroll
  for (int j = 0; j < 9; ++j) acc[j] = 0.f;
  const float* w = p.w_mod + ((size_t)l * 1024 + kg * 128) * 3072 + n0 + col;
#pragma unroll 8
  for (int k = 0; k < 128; ++k) {
    float wv = w[(size_t)k * 3072];
#pragma unroll
    for (int j = 0; j < 9; ++j) acc[j] += sc[j * 1024 + kg * 128 + k] * wv;
  }
#pragma unroll
  for (int j = 0; j < 9; ++j) red[(kg * 9 + j) * 32 + col] = acc[j];
  __syncthreads();
  for (int i = tid; i < 9 * 32; i += NTHREADS) {
    int j = i >> 5, cc = i & 31;
    float s = 0.f;
#pragma unroll
    for (int g = 0; g < 8; ++g) s += red[(g * 9 + j) * 32 + cc];
    p.mods[((size_t)l * 9 + j) * 3072 + n0 + cc] = s + p.b_mod[l * 3072 + n0 + cc];
  }
}

__device__ void phase0(const Params& p, char* smem) {
  const int total = 3968 + 384;
  for (int item = blockIdx.x; item < total; item += gridDim.x) {
    if (item < 384) mods_item(p, item, smem);
    else transpose_item(p, item - 384, smem);
  }
}

__device__ void phase_prep(const Params& p, int layer) {
  const int tid = otid();
  const int lane = tid & 63;
  const int gw = blockIdx.x * 4 + (tid >> 6);
  const int nw = gridDim.x * 4;
  const float* ng = p.norm_g + layer * 1024;
  for (int R = gw; R < NR; R += nw) {
    const float* src;
    if (layer == 0) src = (R < NL) ? p.x + (size_t)R * 1024 : p.ctx + (size_t)(R - NL) * 1024;
    else src = p.xbuf + (size_t)R * 1024;
    const int bidx = (R < NL) ? (R >> 12) : 8;
    const float* md = p.mods + ((size_t)layer * 9 + bidx) * 3072;
    float4 v[4];
#pragma unroll
    for (int i = 0; i < 4; ++i) v[i] = ((const float4*)src)[lane + 64 * i];
    float ss = 0.f;
#pragma unroll
    for (int i = 0; i < 4; ++i) ss += v[i].x * v[i].x + v[i].y * v[i].y + v[i].z * v[i].z + v[i].w * v[i].w;
    ss = wave_sum(ss);
    const float rstd = rsqrtf(ss * (1.f / 1024.f) + 1e-6f);
#pragma unroll
    for (int i = 0; i < 4; ++i) {
      const int k4 = lane + 64 * i;
      float4 g = ((const float4*)ng)[k4];
      float4 sh = ((const float4*)md)[k4];
      float4 sc = ((const float4*)(md + 1024))[k4];
      float h0 = v[i].x * rstd * g.x * (1.f + sc.x) + sh.x;
      float h1 = v[i].y * rstd * g.y * (1.f + sc.y) + sh.y;
      float h2 = v[i].z * rstd * g.z * (1.f + sc.z) + sh.z;
      float h3 = v[i].w * rstd * g.w * (1.f + sc.w) + sh.w;
      u32x2 pk;
      pk.x = pack2(h0, h1);
      pk.y = pack2(h2, h3);
      *(u32x2*)(p.hbuf + (size_t)R * 1024 + k4 * 4) = pk;
      if (layer == 0) ((float4*)(p.xbuf + (size_t)R * 1024))[k4] = v[i];
    }
  }
}

__device__ void phase_final(const Params& p) {
  const int tid = otid();
  const int lane = tid & 63;
  const int gw = blockIdx.x * 4 + (tid >> 6);
  const int nw = gridDim.x * 4;
  for (int R = gw; R < NL; R += nw) {
    const float* src = p.xbuf + (size_t)R * 1024;
    float4 v[4];
#pragma unroll
    for (int i = 0; i < 4; ++i) v[i] = ((const float4*)src)[lane + 64 * i];
    float ss = 0.f;
#pragma unroll
    for (int i = 0; i < 4; ++i) ss += v[i].x * v[i].x + v[i].y * v[i].y + v[i].z * v[i].z + v[i].w * v[i].w;
    ss = wave_sum(ss);
    const float rstd = rsqrtf(ss * (1.f / 1024.f) + 1e-6f);
#pragma unroll
    for (int i = 0; i < 4; ++i) {
      const int k4 = lane + 64 * i;
      float4 g = ((const float4*)p.final_g)[k4];
      float4 o;
      o.x = v[i].x * rstd * g.x;
      o.y = v[i].y * rstd * g.y;
      o.z = v[i].z * rstd * g.z;
      o.w = v[i].w * rstd * g.w;
      ((float4*)(p.out + (size_t)R * 1024))[k4] = o;
    }
  }
}

constexpr int GS = 72;

__device__ __forceinline__ u32x4 add_bf16x8(u32x4 a, u32x4 b) {
  u32x4 r;
  r.x = pack2(lo_bf(a.x) + lo_bf(b.x), hi_bf(a.x) + hi_bf(b.x));
  r.y = pack2(lo_bf(a.y) + lo_bf(b.y), hi_bf(a.y) + hi_bf(b.y));
  r.z = pack2(lo_bf(a.z) + lo_bf(b.z), hi_bf(a.z) + hi_bf(b.z));
  r.w = pack2(lo_bf(a.w) + lo_bf(b.w), hi_bf(a.w) + hi_bf(b.w));
  return r;
}

template <int AMODE, class Epi>
__device__ void gemm_phase(const bf16_t* __restrict__ A0, const bf16_t* __restrict__ A1,
                           const bf16_t* __restrict__ Bt, int Mtiles, int Ntiles, char* smem, Epi epi) {
  bf16_t* As = (bf16_t*)smem;
  bf16_t* Bs = As + 128 * GS;
  const int tid = otid(), lane = tid & 63, w = tid >> 6;
  const int wm = w >> 1, wn = w & 1;
  const int r = lane & 31, h = lane >> 5;
  const int lrow = tid >> 3, kc = tid & 7;
  const int total = Mtiles * Ntiles;
  for (int tile = blockIdx.x; tile < total; tile += gridDim.x) {
    const int mt = tile / Ntiles, nt = tile % Ntiles;
    const int m0 = mt * 128, n0 = nt * 128;
    const size_t aoff = (size_t)(m0 + lrow) * 1024 + kc * 8;
    const bf16_t* bp = Bt + (size_t)(n0 + lrow) * 1024 + kc * 8;
    u32x4 ra[4], ra1[4], rb[4];
#pragma unroll
    for (int i = 0; i < 4; ++i) {
      ra[i] = *(const u32x4*)(A0 + aoff + (size_t)i * 32 * 1024);
      if (AMODE == 1) ra1[i] = *(const u32x4*)(A1 + aoff + (size_t)i * 32 * 1024);
      rb[i] = *(const u32x4*)(bp + (size_t)i * 32 * 1024);
    }
    f32x16 acc[2][2];
#pragma unroll
    for (int mi = 0; mi < 2; ++mi)
#pragma unroll
      for (int ni = 0; ni < 2; ++ni) acc[mi][ni] = zero16();
    for (int kt = 0; kt < 16; ++kt) {
      __syncthreads();
#pragma unroll
      for (int i = 0; i < 4; ++i) {
        u32x4 av = ra[i];
        if (AMODE == 1) av = add_bf16x8(av, ra1[i]);
        *(u32x4*)(As + (lrow + 32 * i) * GS + kc * 8) = av;
        *(u32x4*)(Bs + (lrow + 32 * i) * GS + kc * 8) = rb[i];
      }
      __syncthreads();
      if (kt < 15) {
        const int k0 = (kt + 1) * 64;
#pragma unroll
        for (int i = 0; i < 4; ++i) {
          ra[i] = *(const u32x4*)(A0 + aoff + (size_t)i * 32 * 1024 + k0);
          if (AMODE == 1) ra1[i] = *(const u32x4*)(A1 + aoff + (size_t)i * 32 * 1024 + k0);
          rb[i] = *(const u32x4*)(bp + (size_t)i * 32 * 1024 + k0);
        }
      }
      const bf16_t* Aw = As + (wm * 64 + r) * GS + h * 8;
      const bf16_t* Bw = Bs + (wn * 64 + r) * GS + h * 8;
#pragma unroll
      for (int ks = 0; ks < 4; ++ks) {
        bf16x8 a0 = *(const bf16x8*)(Aw + ks * 16);
        bf16x8 a1 = *(const bf16x8*)(Aw + 32 * GS + ks * 16);
        bf16x8 b0 = *(const bf16x8*)(Bw + ks * 16);
        bf16x8 b1 = *(const bf16x8*)(Bw + 32 * GS + ks * 16);
        acc[0][0] = __builtin_amdgcn_mfma_f32_32x32x16_bf16(a0, b0, acc[0][0], 0, 0, 0);
        acc[0][1] = __builtin_amdgcn_mfma_f32_32x32x16_bf16(a0, b1, acc[0][1], 0, 0, 0);
        acc[1][0] = __builtin_amdgcn_mfma_f32_32x32x16_bf16(a1, b0, acc[1][0], 0, 0, 0);
        acc[1][1] = __builtin_amdgcn_mfma_f32_32x32x16_bf16(a1, b1, acc[1][1], 0, 0, 0);
      }
    }
    epi(acc, m0 + wm * 64, n0 + wn * 64, lane);
  }
}


struct EpiEvenIn {
  EvenBufs e;
  __device__ void operator()(f32x16 (&acc)[2][2], int rb, int cb, int lane) const {
    const int r = lane & 31, h = lane >> 5;
    if (cb < 1536 || cb >= 2304) {
      bf16_t* dst;
      int c0;
      int mode;
      if (cb < 512) { dst = e.ug; c0 = cb; mode = 0; }
      else if (cb < 1024) { dst = e.vg; c0 = cb - 512; mode = 0; }
      else if (cb < 1536) { dst = e.gas; c0 = cb - 1024; mode = 1; }
      else { dst = e.gbs; c0 = cb - 2304; mode = 1; }
#pragma unroll
      for (int mi = 0; mi < 2; ++mi)
#pragma unroll
        for (int ni = 0; ni < 2; ++ni)
#pragma unroll
          for (int reg = 0; reg < 16; ++reg) {
            const int row = rb + mi * 32 + (reg & 3) + 8 * (reg >> 2) + 4 * h;
            const int col = c0 + ni * 32 + r;
            float v = acc[mi][ni][reg];
            v = (mode == 0) ? gelu_f(v) : silu_f(v);
            dst[(size_t)row * 512 + col] = f2bf(v);
          }
    } else if (cb < 2176) {
      const bool isq = cb < 2048;
      bf16_t* dst = isq ? e.qb : e.kb;
      const int c0 = isq ? (cb - 1536) : (cb - 2048);
      const int ld = isq ? 512 : 128;
      const float scale = isq ? 0.125f : 1.f;
      const bool latent = rb < NL;
      const float inv_freq = exp2f(-(float)(r & 15) * 0.8304820237218406f);
#pragma unroll
      for (int mi = 0; mi < 2; ++mi)
#pragma unroll
        for (int reg = 0; reg < 16; ++reg) {
          const int row = rb + mi * 32 + (reg & 3) + 8 * (reg >> 2) + 4 * h;
          float x1 = acc[mi][0][reg], x2 = acc[mi][1][reg];
          float o1 = x1, o2 = x2;
          if (latent) {
            const int t = row & (SEQL - 1);
            const float pos = (float)((r < 16) ? (t >> 6) : (t & 63));
            const float ang = pos * inv_freq;
            const float cs = __cosf(ang), sn = __sinf(ang);
            o1 = x1 * cs - x2 * sn;
            o2 = x2 * cs + x1 * sn;
          }
          dst[(size_t)row * ld + c0 + r] = f2bf(o1 * scale);
          dst[(size_t)row * ld + c0 + 32 + r] = f2bf(o2 * scale);
        }
    } else {
      const int kvh = (cb - 2176) >> 6;
      const bool latent = rb < NL;
#pragma unroll
      for (int mi = 0; mi < 2; ++mi)
#pragma unroll
        for (int ni = 0; ni < 2; ++ni)
#pragma unroll
          for (int q4 = 0; q4 < 4; ++q4) {
            const int row = rb + mi * 32 + 8 * q4 + 4 * h;
            const int d = ni * 32 + r;
            u32x2 pk;
            pk.x = pack2(acc[mi][ni][q4 * 4 + 0], acc[mi][ni][q4 * 4 + 1]);
            pk.y = pack2(acc[mi][ni][q4 * 4 + 2], acc[mi][ni][q4 * 4 + 3]);
            if (latent) {
              const int b = row >> 12, t = row & (SEQL - 1);
              *(u32x2*)(e.vtl + ((size_t)((b * 2 + kvh) * 64 + d)) * SEQL + t) = pk;
            } else {
              const int rr = row - NL;
              const int b = rr >> 8, t = rr & (LCTX - 1);
              *(u32x2*)(e.vtc + ((size_t)((b * 2 + kvh) * 64 + d)) * LCTX + t) = pk;
            }
          }
    }
  }
};

struct EpiOddIn {
  OddBufs o;
  __device__ void operator()(f32x16 (&acc)[2][2], int rb, int cb, int lane) const {
    const int r = lane & 31, h = lane >> 5;
    const bool isg = cb >= 1024;
    bf16_t* dst = isg ? o.sg : o.xr;
    const int c0 = isg ? cb - 1024 : cb;
#pragma unroll
    for (int mi = 0; mi < 2; ++mi)
#pragma unroll
      for (int ni = 0; ni < 2; ++ni)
#pragma unroll
        for (int reg = 0; reg < 16; ++reg) {
          const int row = rb + mi * 32 + (reg & 3) + 8 * (reg >> 2) + 4 * h;
          const int col = c0 + ni * 32 + r;
          float v = acc[mi][ni][reg];
          if (isg) v = silu_f(v);
          dst[(size_t)row * 1024 + col] = f2bf(v);
        }
  }
};

struct EpiOut {
  float* xbuf;
  const float* mods_l;
  __device__ void operator()(f32x16 (&acc)[2][2], int rb, int cb, int lane) const {
    const int r = lane & 31, h = lane >> 5;
    const int bidx = (rb < NL) ? (rb >> 12) : 8;
    const float* gate = mods_l + (size_t)bidx * 3072 + 2048;
#pragma unroll
    for (int ni = 0; ni < 2; ++ni) {
      const int col = cb + ni * 32 + r;
      const float gv = gate[col];
#pragma unroll
      for (int mi = 0; mi < 2; ++mi)
#pragma unroll
        for (int reg = 0; reg < 16; ++reg) {
          const int row = rb + mi * 32 + (reg & 3) + 8 * (reg >> 2) + 4 * h;
          float* px = xbuf + (size_t)row * 1024 + col;
          *px = *px + gv * acc[mi][ni][reg];
        }
    }
  }
};

constexpr int AS = 72;

__device__ void attn_item(const Params& p, const EvenBufs& e, int item, char* smem, int ei) {
  bf16_t* Ks = (bf16_t*)smem;
  bf16_t* Vs = Ks + 64 * AS;
  const int tid = otid(), lane = tid & 63, w = tid >> 6;
  const int r = lane & 31, h = lane >> 5;
  int b, hq, start, R0;
  bool isctx;
  if (item < 2048) {
    b = item >> 8;
    hq = (item >> 5) & 7;
    const int qblk = item & 31;
    start = qblk * 128;
    R0 = b * SEQL + start;
    isctx = false;
  } else {
    const int it = item - 2048;
    b = it >> 4;
    hq = (it >> 1) & 7;
    start = (it & 1) * 128;
    R0 = NL + b * LCTX + start;
    isctx = true;
  }
  const int kvh = hq >> 2;
  const int qrow = R0 + w * 32 + r;
  bf16x8 qf[4];
#pragma unroll
  for (int s = 0; s < 4; ++s) qf[s] = *(const bf16x8*)(e.qb + (size_t)qrow * 512 + hq * 64 + s * 16 + h * 8);
  float m = p.b_sink[ei * 8 + hq], l = 1.f;
  f32x16 o[2];
  o[0] = zero16();
  o[1] = zero16();
  const int nblk = isctx ? 4 : 10;
  for (int kb = 0; kb < nblk; ++kb) {
    int krow0, kpos0 = 0, vstride;
    const bf16_t* vt;
    bool local = false;
    if (kb < 4) {
      krow0 = NL + b * LCTX + kb * 64;
      vt = e.vtc + (size_t)((b * 2 + kvh) * 64) * LCTX + kb * 64;
      vstride = LCTX;
    } else {
      kpos0 = start - 128 + (kb - 4) * 64;
      if (kpos0 < 0 || kpos0 >= SEQL) continue;
      krow0 = b * SEQL + kpos0;
      vt = e.vtl + (size_t)((b * 2 + kvh) * 64) * SEQL + kpos0;
      vstride = SEQL;
      local = true;
    }
    __syncthreads();
#pragma unroll
    for (int i = 0; i < 2; ++i) {
      const int c = tid + 256 * i;
      const int rr = c >> 3, cc = c & 7;
      *(u32x4*)(Ks + rr * AS + cc * 8) = *(const u32x4*)(e.kb + (size_t)(krow0 + rr) * 128 + kvh * 64 + cc * 8);
      *(u32x4*)(Vs + rr * AS + cc * 8) = *(const u32x4*)(vt + (size_t)rr * vstride + cc * 8);
    }
    __syncthreads();
    f32x16 s[2];
#pragma unroll
    for (int kt = 0; kt < 2; ++kt) {
      s[kt] = zero16();
#pragma unroll
      for (int ks = 0; ks < 4; ++ks) {
        bf16x8 a = *(const bf16x8*)(Ks + (kt * 32 + r) * AS + ks * 16 + h * 8);
        s[kt] = __builtin_amdgcn_mfma_f32_32x32x16_bf16(a, qf[ks], s[kt], 0, 0, 0);
      }
    }
    if (local) {
      const int qpos = start + w * 32 + r;
#pragma unroll
      for (int kt = 0; kt < 2; ++kt)
#pragma unroll
        for (int reg = 0; reg < 16; ++reg) {
          const int kpos = kpos0 + kt * 32 + (reg & 3) + 8 * (reg >> 2) + 4 * h;
          const int diff = qpos - kpos;
          if (diff > 128 || diff < -128) s[kt][reg] = -1e30f;
        }
    }
    float mx = m;
#pragma unroll
    for (int kt = 0; kt < 2; ++kt)
#pragma unroll
      for (int reg = 0; reg < 16; ++reg) mx = fmaxf(mx, s[kt][reg]);
    mx = fmaxf(mx, __shfl_xor(mx, 32));
    const float alpha = __expf(m - mx);
    m = mx;
    float rs = 0.f;
#pragma unroll
    for (int kt = 0; kt < 2; ++kt)
#pragma unroll
      for (int reg = 0; reg < 16; ++reg) {
        const float pv = __expf(s[kt][reg] - mx);
        rs += pv;
        s[kt][reg] = pv;
      }
    rs += __shfl_xor(rs, 32);
    l = l * alpha + rs;
#pragma unroll
    for (int dt = 0; dt < 2; ++dt)
#pragma unroll
      for (int reg = 0; reg < 16; ++reg) o[dt][reg] *= alpha;
#pragma unroll
    for (int kt = 0; kt < 2; ++kt)
#pragma unroll
      for (int sp = 0; sp < 2; ++sp) {
        union { bf16x8 v; uint32_t u[4]; } pf;
#pragma unroll
        for (int j = 0; j < 4; ++j) pf.u[j] = pack2(s[kt][8 * sp + 2 * j], s[kt][8 * sp + 2 * j + 1]);
#pragma unroll
        for (int dt = 0; dt < 2; ++dt) {
          const bf16_t* vp = Vs + (dt * 32 + r) * AS + kt * 32 + sp * 16 + 4 * h;
          union { bf16x8 v; u32x2 u[2]; } af;
          af.u[0] = *(const u32x2*)(vp);
          af.u[1] = *(const u32x2*)(vp + 8);
          o[dt] = __builtin_amdgcn_mfma_f32_32x32x16_bf16(af.v, pf.v, o[dt], 0, 0, 0);
        }
      }
  }
  const float inv = 1.f / l;
  bf16_t* ymix = p.hbuf;
#pragma unroll
  for (int dt = 0; dt < 2; ++dt)
#pragma unroll
    for (int q4 = 0; q4 < 4; ++q4) {
      const int d0 = dt * 32 + 8 * q4 + 4 * h;
      const u32x2 g = *(const u32x2*)(e.gbs + (size_t)qrow * 512 + hq * 64 + d0);
      u32x2 pk;
      pk.x = pack2(o[dt][q4 * 4 + 0] * inv * lo_bf(g.x), o[dt][q4 * 4 + 1] * inv * hi_bf(g.x));
      pk.y = pack2(o[dt][q4 * 4 + 2] * inv * lo_bf(g.y), o[dt][q4 * 4 + 3] * inv * hi_bf(g.y));
      *(u32x2*)(ymix + (size_t)qrow * 1024 + 512 + hq * 64 + d0) = pk;
    }
}

constexpr int MS = 136;

__device__ void gmlp_item(const Params& p, const EvenBufs& e, int item, char* smem, int ei) {
  bf16_t* Ws = (bf16_t*)smem;
  bf16_t* VT = Ws + 128 * MS;
  const int tid = otid(), lane = tid & 63, w = tid >> 6;
  const int r = lane & 31, h = lane >> 5;
  const int wm = w >> 1, wn = w & 1;
  const int rt = item >> 2, g = item & 3;
  const int R0 = rt * 128;
  __syncthreads();
  {
    const float4* wsrc = (const float4*)(p.a_w_s + (size_t)(ei * 4 + g) * 128 * 128);
#pragma unroll
    for (int i = 0; i < 16; ++i) {
      const int idx = tid + 256 * i;
      const int pp = idx >> 5, q4 = idx & 31;
      float4 v = wsrc[idx];
      u32x2 pk;
      pk.x = pack2(v.x, v.y);
      pk.y = pack2(v.z, v.w);
      *(u32x2*)(Ws + pp * MS + q4 * 4) = pk;
    }
  }
#pragma unroll 1
  for (int hp = 0; hp < 2; ++hp) {
    const int q = hp * 64 + (tid >> 2), qt = tid & 3;
    const bf16_t* vsrc = e.vg + (size_t)(R0 + q) * 512 + g * 128 + qt * 32;
    float xv[32];
#pragma unroll
    for (int i = 0; i < 4; ++i) {
      u32x4 u = *(const u32x4*)(vsrc + i * 8);
      xv[i * 8 + 0] = lo_bf(u.x); xv[i * 8 + 1] = hi_bf(u.x);
      xv[i * 8 + 2] = lo_bf(u.y); xv[i * 8 + 3] = hi_bf(u.y);
      xv[i * 8 + 4] = lo_bf(u.z); xv[i * 8 + 5] = hi_bf(u.z);
      xv[i * 8 + 6] = lo_bf(u.w); xv[i * 8 + 7] = hi_bf(u.w);
    }
    float sm = 0.f;
#pragma unroll
    for (int j = 0; j < 32; ++j) sm += xv[j];
    sm += __shfl_xor(sm, 1);
    sm += __shfl_xor(sm, 2);
    const float mean = sm * (1.f / 128.f);
    float sq = 0.f;
#pragma unroll
    for (int j = 0; j < 32; ++j) { float dlt = xv[j] - mean; sq += dlt * dlt; }
    sq += __shfl_xor(sq, 1);
    sq += __shfl_xor(sq, 2);
    const float rstd = rsqrtf(sq * (1.f / 128.f) + 1e-6f);
    const float* lg = p.a_ln_g + ei * 512 + g * 128 + qt * 32;
    const float* lb = p.a_ln_b + ei * 512 + g * 128 + qt * 32;
#pragma unroll
    for (int j = 0; j < 32; ++j) {
      const float val = (xv[j] - mean) * rstd * lg[j] + lb[j];
      VT[(qt * 32 + j) * MS + q] = f2bf(val);
    }
  }
  __syncthreads();
  f32x16 acc[2][2];
#pragma unroll
  for (int mi = 0; mi < 2; ++mi)
#pragma unroll
    for (int ni = 0; ni < 2; ++ni) acc[mi][ni] = zero16();
  const bf16_t* Aw = Ws + (wm * 64 + r) * MS + h * 8;
  const bf16_t* Bw = VT + (wn * 64 + r) * MS + h * 8;
#pragma unroll
  for (int ks = 0; ks < 8; ++ks) {
    bf16x8 a0 = *(const bf16x8*)(Aw + ks * 16);
    bf16x8 a1 = *(const bf16x8*)(Aw + 32 * MS + ks * 16);
    bf16x8 b0 = *(const bf16x8*)(Bw + ks * 16);
    bf16x8 b1 = *(const bf16x8*)(Bw + 32 * MS + ks * 16);
    acc[0][0] = __builtin_amdgcn_mfma_f32_32x32x16_bf16(a0, b0, acc[0][0], 0, 0, 0);
    acc[0][1] = __builtin_amdgcn_mfma_f32_32x32x16_bf16(a0, b1, acc[0][1], 0, 0, 0);
    acc[1][0] = __builtin_amdgcn_mfma_f32_32x32x16_bf16(a1, b0, acc[1][0], 0, 0, 0);
    acc[1][1] = __builtin_amdgcn_mfma_f32_32x32x16_bf16(a1, b1, acc[1][1], 0, 0, 0);
  }
  bf16_t* ymix = p.hbuf;
  const float* bs = p.a_b_s + (ei * 4 + g) * 128;
#pragma unroll
  for (int mi = 0; mi < 2; ++mi)
#pragma unroll
    for (int reg = 0; reg < 16; ++reg) {
      const int prow = wm * 64 + mi * 32 + (reg & 3) + 8 * (reg >> 2) + 4 * h;
      const float bsv = bs[prow];
      const size_t row = (size_t)(R0 + prow);
#pragma unroll
      for (int ni = 0; ni < 2; ++ni) {
        const int col = g * 128 + wn * 64 + ni * 32 + r;
        const float sv = acc[mi][ni][reg] + bsv;
        const float y = bf2f(e.ug[row * 512 + col]) * sv * bf2f(e.gas[row * 512 + col]);
        ymix[row * 1024 + col] = f2bf(y);
      }
    }
}

__device__ void phase_even_mix(const Params& p, char* smem, int ei) {
  const EvenBufs e = even_bufs(p);
  const int n_attn = 2048 + 128, n_gmlp = 1088;
  for (int item = blockIdx.x; item < n_attn + n_gmlp; item += gridDim.x) {
    if (item < n_attn) attn_item(p, e, item, smem, ei);
    else gmlp_item(p, e, item - n_attn, smem, ei);
  }
}

__device__ void phase_conv(const Params& p, int oi) {
  const OddBufs ob = odd_bufs(p);
  const bf16_t* xr = ob.xr;
  bf16_t* zb = ob.sg + (size_t)NR * 1024;
  const int tid = otid();
  const int total = (NR / 8) * 128;
  for (int id = blockIdx.x * NTHREADS + tid; id < total; id += gridDim.x * NTHREADS) {
    const int chunk = id & 127, rg = id >> 7;
    const int R0 = rg * 8;
    int t0, Ls;
    if (R0 < NL) { t0 = R0 & (SEQL - 1); Ls = SEQL; } else { t0 = (R0 - NL) & (LCTX - 1); Ls = LCTX; }
    const int chb = chunk * 8;
    float cw[4][8], cbias[8];
#pragma unroll
    for (int j = 0; j < 4; ++j) {
      const float4 w0 = *(const float4*)(p.c_conv_w + ((size_t)oi * 4 + j) * 1024 + chb);
      const float4 w1 = *(const float4*)(p.c_conv_w + ((size_t)oi * 4 + j) * 1024 + chb + 4);
      cw[j][0] = w0.x; cw[j][1] = w0.y; cw[j][2] = w0.z; cw[j][3] = w0.w;
      cw[j][4] = w1.x; cw[j][5] = w1.y; cw[j][6] = w1.z; cw[j][7] = w1.w;
    }
    {
      const float4 b0 = *(const float4*)(p.c_conv_b + oi * 1024 + chb);
      const float4 b1 = *(const float4*)(p.c_conv_b + oi * 1024 + chb + 4);
      cbias[0] = b0.x; cbias[1] = b0.y; cbias[2] = b0.z; cbias[3] = b0.w;
      cbias[4] = b1.x; cbias[5] = b1.y; cbias[6] = b1.z; cbias[7] = b1.w;
    }
    float xw[11][8];
#pragma unroll
    for (int jj = 0; jj < 11; ++jj) {
      const int t = t0 - 2 + jj;
      u32x4 u = (u32x4){0u, 0u, 0u, 0u};
      if (t >= 0 && t < Ls) u = *(const u32x4*)(xr + (size_t)(R0 - 2 + jj) * 1024 + chb);
      xw[jj][0] = lo_bf(u.x); xw[jj][1] = hi_bf(u.x);
      xw[jj][2] = lo_bf(u.y); xw[jj][3] = hi_bf(u.y);
      xw[jj][4] = lo_bf(u.z); xw[jj][5] = hi_bf(u.z);
      xw[jj][6] = lo_bf(u.w); xw[jj][7] = hi_bf(u.w);
    }
#pragma unroll
    for (int i = 0; i < 8; ++i) {
      float z[8];
#pragma unroll
      for (int e2 = 0; e2 < 8; ++e2) {
        float a = cbias[e2];
#pragma unroll
        for (int j = 0; j < 4; ++j) a += cw[j][e2] * xw[i + j][e2];
        z[e2] = a;
      }
      u32x4 pk;
      pk.x = pack2(z[0], z[1]); pk.y = pack2(z[2], z[3]);
      pk.z = pack2(z[4], z[5]); pk.w = pack2(z[6], z[7]);
      *(u32x4*)(zb + (size_t)(R0 + i) * 1024 + chb) = pk;
    }
  }
}

constexpr int ZS = 264;

template <int DIR>
__device__ void rglru_item(const Params& p, const OddBufs& ob, int item, char* smem, int oi, bool need_ctx) {
  bf16_t* Zs = (bf16_t*)smem;
  float* segA = (float*)(Zs + 128 * ZS);
  float* segB = segA + 256;
  float* carry = segB + 256;
  float* La = (float*)Zs;
  float* Gz = La + 4096;
  const int tid = otid(), lane = tid & 63, w = tid >> 6;
  const int r = lane & 31, h = lane >> 5;
  const int wm = w >> 1, wn = w & 1;
  const int b = item >> 6, cs = item & 31;
  constexpr int dir = DIR;
  const int hd = cs >> 3, j0 = (cs & 7) * 32, c0 = cs * 32;
  bf16_t* sout = dir ? ob.sb : p.hbuf;
  const bf16_t* zb = ob.sg + (size_t)NR * 1024;
  __syncthreads();
  if (tid < 32) carry[tid] = 0.f;
  bf16x8 bfr[16];
  {
    const size_t mo = ((size_t)((oi * 2 + dir) * 4 + hd)) * 65536 + (size_t)(j0 + r) * 256 + h * 8;
    const bf16_t* wsrc = (wn ? p.wgi : p.wga) + mo;
#pragma unroll
    for (int ks = 0; ks < 16; ++ks) bfr[ks] = *(const bf16x8*)(wsrc + ks * 16);
  }
  const int gch = (oi * 2 + dir) * 1024 + c0 + r;
  const float gbias = wn ? p.c_b_i[gch] : p.c_b_a[gch];
  const float spl = log1pf(__expf(-p.c_lam[gch]));
  const int sc_c = tid & 31, sc_sg = tid >> 5;
  const int lrow = tid >> 5, kc = tid & 31;

  u32x4 zt[8];
  {
    const int Rs0 = NL + b * LCTX;
    const int ti0 = dir ? 1 : 0;
    const bf16_t* src = zb + (size_t)(Rs0 + ti0 * 128 + lrow) * 1024 + hd * 256 + kc * 8;
#pragma unroll
    for (int i = 0; i < 8; ++i) zt[i] = *(const u32x4*)(src + (size_t)i * 8 * 1024);
  }
  for (int step = 0; step < 34; ++step) {
    int Rs, ti;
    bool wr;
    if (step < 2) { Rs = NL + b * LCTX; ti = dir ? 1 - step : step; wr = need_ctx; }
    else { Rs = b * SEQL; ti = dir ? 31 - (step - 2) : (step - 2); wr = true; }
    const int t0 = ti * 128;
    __syncthreads();
    {
      const bf16_t* src2 = zb + (size_t)(Rs + t0 + lrow + 64) * 1024 + hd * 256 + kc * 8;
      u32x4 z2[8];
#pragma unroll
      for (int i = 0; i < 8; ++i) z2[i] = *(const u32x4*)(src2 + (size_t)i * 8 * 1024);
#pragma unroll
      for (int i = 0; i < 8; ++i) *(u32x4*)(Zs + (lrow + 8 * i) * ZS + kc * 8) = zt[i];
#pragma unroll
      for (int i = 0; i < 8; ++i) *(u32x4*)(Zs + (lrow + 64 + 8 * i) * ZS + kc * 8) = z2[i];
    }
    __syncthreads();
    if (step + 1 < 34) {
      const int ns = step + 1;
      int nRs, nti;
      if (ns < 2) { nRs = NL + b * LCTX; nti = dir ? 1 - ns : ns; }
      else { nRs = b * SEQL; nti = dir ? 31 - (ns - 2) : (ns - 2); }
      const bf16_t* src = zb + (size_t)(nRs + nti * 128 + lrow) * 1024 + hd * 256 + kc * 8;
#pragma unroll
      for (int i = 0; i < 8; ++i) zt[i] = *(const u32x4*)(src + (size_t)i * 8 * 1024);
    }
    f32x16 acc[2];
    acc[0] = zero16();
    acc[1] = zero16();
    {
      const bf16_t* Aw = Zs + (wm * 64 + r) * ZS + h * 8;
#pragma unroll
      for (int ks = 0; ks < 16; ++ks) {
        bf16x8 a0 = *(const bf16x8*)(Aw + ks * 16);
        bf16x8 a1 = *(const bf16x8*)(Aw + 32 * ZS + ks * 16);
        acc[0] = __builtin_amdgcn_mfma_f32_32x32x16_bf16(a0, bfr[ks], acc[0], 0, 0, 0);
        acc[1] = __builtin_amdgcn_mfma_f32_32x32x16_bf16(a1, bfr[ks], acc[1], 0, 0, 0);
      }
    }
#pragma unroll
    for (int mi = 0; mi < 2; ++mi)
#pragma unroll
      for (int reg = 0; reg < 16; ++reg) {
        const int row = wm * 64 + mi * 32 + (reg & 3) + 8 * (reg >> 2) + 4 * h;
        const float sgm = sigmoid_f(acc[mi][reg] + gbias);
        if (wn == 0) acc[mi][reg] = -8.f * sgm * spl;
        else acc[mi][reg] = sgm * bf2f(Zs[row * ZS + j0 + r]);
      }
    __syncthreads();
    {
      float* dstb = wn ? Gz : La;
#pragma unroll
      for (int mi = 0; mi < 2; ++mi)
#pragma unroll
        for (int reg = 0; reg < 16; ++reg) {
          const int row = wm * 64 + mi * 32 + (reg & 3) + 8 * (reg >> 2) + 4 * h;
          dstb[row * 32 + r] = acc[mi][reg];
        }
    }
    __syncthreads();
    const int sbase = DIR ? (7 - sc_sg) * 16 : sc_sg * 16;
    const unsigned voff = (unsigned)(sbase * 1024 + c0 + sc_c);
    const bf16_t* sgp = ob.sg + (size_t)(Rs + t0) * 1024;
    bf16_t* sop = sout + (size_t)(Rs + t0) * 1024;
    const float* Lap = La + sbase * 32 + sc_c;
    const float* Gzp = Gz + sbase * 32 + sc_c;
    bf16_t sgv[16];
    if (wr) {
#pragma unroll
      for (int i = 0; i < 16; ++i) sgv[i] = sgp[voff + (DIR ? 15 - i : i) * 1024];
    }
    {
      float A = 1.f, Bv = 0.f;
      float* Law = La + sbase * 32 + sc_c;
      float* Gzw = Gz + sbase * 32 + sc_c;
#pragma unroll
      for (int i = 0; i < 16; ++i) {
        const int ro = (DIR ? 15 - i : i) * 32;
        const float la = Lap[ro];
        const float a = __expf(la);
        const float mult = __builtin_amdgcn_sqrtf(fmaf(-a, a, 1.f));
        const float bx = mult * Gzp[ro];
        Law[ro] = a;
        Gzw[ro] = bx;
        Bv = a * Bv + bx;
        A *= a;
      }
      segA[sc_sg * 32 + sc_c] = A;
      segB[sc_sg * 32 + sc_c] = Bv;
    }
    __syncthreads();
    {
      float hh = carry[(step & 1) * 32 + sc_c];
      for (int s2 = 0; s2 < sc_sg; ++s2) hh = segA[s2 * 32 + sc_c] * hh + segB[s2 * 32 + sc_c];
#pragma unroll
      for (int i = 0; i < 16; ++i) {
        const int ro = (DIR ? 15 - i : i);
        hh = Lap[ro * 32] * hh + Gzp[ro * 32];
        if (wr) sop[voff + ro * 1024] = f2bf(hh * bf2f(sgv[i]));
      }
      if (sc_sg == 7) carry[((step + 1) & 1) * 32 + sc_c] = hh;
    }
  }
}

__device__ void phase_rglru(const Params& p, char* smem, int oi, bool need_ctx) {
  const OddBufs ob = odd_bufs(p);
  for (int item = blockIdx.x; item < 512; item += gridDim.x) {
    if ((item >> 5) & 1) rglru_item<1>(p, ob, item, smem, oi, need_ctx);
    else rglru_item<0>(p, ob, item, smem, oi, need_ctx);
  }
}

#define XB_TMO      128
#define XB_XCNT(j)  (256  + 64 * (j))
#define XB_XSUB(j)  (1280 + 64 * (j))
#define XB_XGEN(j)  (2304 + 64 * (j))
#define XB_TOP      3328
#define XB_TOPGEN   3392
#define XCD_BAR_WORDS 3456
#define XB_SPIN_CAP (1u << 18)
#define LAS __attribute__((address_space(3)))

__device__ __forceinline__ unsigned xb_ld(unsigned* p)              { return __hip_atomic_load(p, __ATOMIC_RELAXED, __HIP_MEMORY_SCOPE_AGENT); }
__device__ __forceinline__ unsigned xb_add(unsigned* p, unsigned v) { return __hip_atomic_fetch_add(p, v, __ATOMIC_RELAXED, __HIP_MEMORY_SCOPE_AGENT); }
__device__ __forceinline__ unsigned xb_xcc_id() { return (unsigned)__builtin_amdgcn_s_getreg((3 << 11) | 20) & 0xFu; }
#define XB_SPIN(cond, bar) do { unsigned _sp = 0; while (cond) { __builtin_amdgcn_s_sleep(1); \
    if ((++_sp & 255u) == 0u) { if (xb_ld(&(bar)[XB_TMO])) break; if (_sp > XB_SPIN_CAP) { atomicAdd(&(bar)[XB_TMO], 1u); break; } } } } while (0)

struct XcdBarrier {
    unsigned* bar; unsigned x;
    volatile LAS unsigned* st;
};

__device__ __forceinline__ XcdBarrier xcd_barrier_post(unsigned* bar, volatile LAS unsigned* st) {
    XcdBarrier b; b.bar = bar; b.x = xb_xcc_id(); b.st = st;
    if (threadIdx.x == 0) (void)xb_add(&bar[XB_XCNT(b.x)], 1u);
    return b;
}
__device__ __forceinline__ void xcd_barrier_complete(unsigned* bar, unsigned x, unsigned& nloc, unsigned& nx) {
    const unsigned G = gridDim.x * gridDim.y * gridDim.z;
    unsigned sum, cnt, mine, sp = 0u;
    for (;;) {
        sum = 0u; cnt = 0u; mine = 0u;
#pragma unroll
        for (unsigned j = 0; j < 16; ++j) { const unsigned c = xb_ld(&bar[XB_XCNT(j)]); sum += c; cnt += (c > 0u) ? 1u : 0u; mine = (j == x) ? c : mine; }
        if (sum == G) break;
        __builtin_amdgcn_s_sleep(1);
        if ((++sp & 255u) == 0u) { if (xb_ld(&bar[XB_TMO])) break; if (sp > XB_SPIN_CAP) { atomicAdd(&bar[XB_TMO], 1u); break; } }
    }
    nloc = mine > 0u ? mine : 1u; nx = cnt > 0u ? cnt : 1u;
}

__device__ __forceinline__ void xcd_barrier(const XcdBarrier& b) {
    asm volatile("s_waitcnt vmcnt(0)" ::: "memory");
    __syncthreads();
    if (threadIdx.x == 0) {
        unsigned* bar = b.bar;
        __builtin_amdgcn_s_waitcnt(0);
        unsigned nloc = b.st[0], nx = b.st[1];
        if (nloc == 0u) { xcd_barrier_complete(bar, b.x, nloc, nx); b.st[0] = nloc; b.st[1] = nx; }
        const unsigned old = xb_add(&bar[XB_XSUB(b.x)], 1u);
        const unsigned gen = old / nloc;
        if (old + 1u == (gen + 1u) * nloc) {
            __builtin_amdgcn_fence(__ATOMIC_RELEASE, "agent");
            asm volatile("s_waitcnt vmcnt(0)" ::: "memory");
            const unsigned og = xb_add(&bar[XB_TOP], 1u);
            const unsigned tg = og / nx;
            if (og + 1u == (tg + 1u) * nx) xb_add(&bar[XB_TOPGEN], 1u);
            else XB_SPIN(xb_ld(&bar[XB_TOPGEN]) == tg, bar);
            __builtin_amdgcn_fence(__ATOMIC_ACQUIRE, "agent");
            xb_add(&bar[XB_XGEN(b.x)], 1u);
            asm volatile("s_waitcnt vmcnt(0)" ::: "memory");
        } else {
            XB_SPIN(xb_ld(&bar[XB_XGEN(b.x)]) == gen, bar);
            __builtin_amdgcn_fence(__ATOMIC_ACQUIRE, "agent");
            asm volatile("s_waitcnt vmcnt(0)" ::: "memory");
        }
    }
    __syncthreads();
}


#define LAUNDER(f) q.f = p.f + z
__device__ __forceinline__ void launder(Params& q, const Params& p) {
  long z;
  asm volatile("s_mov_b64 %0, 0" : "=s"(z));
  LAUNDER(x); LAUNDER(c); LAUNDER(ctx); LAUNDER(c_ctx); LAUNDER(norm_g); LAUNDER(w_mod); LAUNDER(b_mod);
  LAUNDER(ab_w_in); LAUNDER(a_ln_g); LAUNDER(a_ln_b); LAUNDER(a_w_s); LAUNDER(a_b_s); LAUNDER(b_sink);
  LAUNDER(ab_w_out); LAUNDER(c_w_in); LAUNDER(c_conv_w); LAUNDER(c_conv_b); LAUNDER(c_w_a); LAUNDER(c_b_a);
  LAUNDER(c_w_i); LAUNDER(c_b_i); LAUNDER(c_lam); LAUNDER(c_w_out); LAUNDER(final_g); LAUNDER(out);
  LAUNDER(xbuf); LAUNDER(mods); LAUNDER(hbuf); LAUNDER(ebuf); LAUNDER(wt_in_e); LAUNDER(wt_out_e);
  LAUNDER(wt_in_o); LAUNDER(wt_out_o); LAUNDER(wga); LAUNDER(wgi);
}

constexpr int NPHASES = 20;

__device__ void run_phase(const Params& p0, int ph, char* smem) {
  if (ph == 0) { Params p; launder(p, p0); phase0(p, smem); return; }
  if (ph == 19) { Params p; launder(p, p0); phase_final(p); return; }
  int layer, sub;
  if (ph < 5) { layer = 0; sub = ph - 1; }
  else if (ph < 10) { layer = 1; sub = ph - 5; }
  else if (ph < 14) { layer = 2; sub = ph - 10; }
  else { layer = 3; sub = ph - 14; }
  const int idx = layer >> 1;
  const bool even = (layer & 1) == 0;
  const bool need_ctx = layer < 3;
  if (sub == 0) { Params p; launder(p, p0); phase_prep(p, layer); return; }
  if (even) {
    if (sub == 1) {
      Params p; launder(p, p0);
      EpiEvenIn epi; epi.e = even_bufs(p);
      gemm_phase<0>(p.hbuf, nullptr, p.wt_in_e + (size_t)idx * 2816 * 1024, NR / 128, 22, smem, epi);
    } else if (sub == 2) {
      Params p; launder(p, p0);
      phase_even_mix(p, smem, idx);
    } else {
      Params p; launder(p, p0);
      EpiOut epi; epi.xbuf = p.xbuf; epi.mods_l = p.mods + (size_t)layer * 9 * 3072;
      gemm_phase<0>(p.hbuf, nullptr, p.wt_out_e + (size_t)idx * 1024 * 1024, NR / 128, 8, smem, epi);
    }
  } else {
    if (sub == 1) {
      Params p; launder(p, p0);
      EpiOddIn epi; epi.o = odd_bufs(p);
      gemm_phase<0>(p.hbuf, nullptr, p.wt_in_o + (size_t)idx * 2048 * 1024, NR / 128, 16, smem, epi);
    } else if (sub == 2) {
      Params p; launder(p, p0);
      phase_conv(p, idx);
    } else if (sub == 3) {
      Params p; launder(p, p0);
      phase_rglru(p, smem, idx, need_ctx);
    } else {
      Params p; launder(p, p0);
      EpiOut epi; epi.xbuf = p.xbuf; epi.mods_l = p.mods + (size_t)layer * 9 * 3072;
      const OddBufs ob = odd_bufs(p);
      gemm_phase<1>(p.hbuf, ob.sb, p.wt_out_o + (size_t)idx * 1024 * 1024, (need_ctx ? NR : NL) / 128, 8, smem, epi);
    }
  }
}

__global__ void __launch_bounds__(NTHREADS, 2) mega_kernel(Params p, int ph_lo, int ph_hi, int use_bar) {
  __shared__ __attribute__((aligned(16))) char smem[SMEM_BYTES];
  __shared__ uint4 xb_words;
  if (threadIdx.x == 0) xb_words = make_uint4(0u, 0u, 0u, 0u);
  __syncthreads();
  XcdBarrier xb;
  if (use_bar == 1) xb = xcd_barrier_post(p.bar, (volatile LAS unsigned*)&xb_words);
  for (int ph = ph_lo; ph < ph_hi; ++ph) {
    run_phase(p, ph, smem);
    if (ph + 1 < ph_hi) {
      if (use_bar == 1) xcd_barrier(xb);
      else if (use_bar == 2) cg::this_grid().sync();
    }
  }
}

extern "C" void kernel_launch(void* const* d_in, const int* in_sizes, int n_in, void* d_out, int out_size,
                              void* d_ws, size_t ws_size, hipStream_t stream) {
  static int grid_blocks = 0;
  if (!grid_blocks) {
    int dev = 0, cus = 0, per_cu = 0;
    hipGetDevice(&dev);
    hipDeviceGetAttribute(&cus, hipDeviceAttributeMultiprocessorCount, dev);
    hipOccupancyMaxActiveBlocksPerMultiprocessor(&per_cu, mega_kernel, NTHREADS, 0);
    if (per_cu < 1) per_cu = 1;
    if (per_cu > 2) per_cu = 2;
    grid_blocks = cus * per_cu;
  }
  Params p{};
  const float** fp = (const float**)&p;
  for (int i = 0; i < 24; ++i) fp[i] = (const float*)d_in[i];
  p.out = (float*)d_out;
  char* ws = (char*)d_ws;
  size_t off = 0;
  auto take = [&](size_t bytes) { char* q = ws + off; off += (bytes + 255) & ~(size_t)255; return q; };
  p.xbuf = (float*)take((size_t)NR * 1024 * 4);
  p.mods = (float*)take((size_t)4 * 9 * 3072 * 4);
  p.hbuf = (bf16_t*)take((size_t)NR * 1024 * 2);
  p.ebuf = (bf16_t*)take((size_t)NR * 3072 * 2);
  p.wt_in_e = (bf16_t*)take((size_t)2 * 2816 * 1024 * 2);
  p.wt_out_e = (bf16_t*)take((size_t)2 * 1024 * 1024 * 2);
  p.wt_in_o = (bf16_t*)take((size_t)2 * 2048 * 1024 * 2);
  p.wt_out_o = (bf16_t*)take((size_t)2 * 1024 * 1024 * 2);
  p.wga = (bf16_t*)take((size_t)16 * 65536 * 2);
  p.wgi = (bf16_t*)take((size_t)16 * 65536 * 2);
  p.bar = (unsigned*)take((size_t)XCD_BAR_WORDS * 4);
  if (off > ws_size) fprintf(stderr, "workspace too small: need %zu have %zu\n", off, ws_size);
#if COOP
  hipMemsetAsync(p.bar, 0, (size_t)XCD_BAR_WORDS * 4, stream);
  int lo = 0, hi = NPHASES, ub = 1;
  void* args[] = {&p, &lo, &hi, &ub};
  hipError_t e = hipLaunchCooperativeKernel((void*)mega_kernel, dim3(grid_blocks), dim3(NTHREADS), args, 0, stream);
  if (e != hipSuccess) fprintf(stderr, "cooperative launch failed: %s (grid %d)\n", hipGetErrorString(e), grid_blocks);
#else
  for (int ph = 0; ph < NPHASES; ++ph) mega_kernel<<<grid_blocks, NTHREADS, 0, stream>>>(p, ph, ph + 1, 0);
#endif
}
```

```cpp
#include <hip/hip_runtime.h>
#include <hip/hip_cooperative_groups.h>
#include <stdint.h>
#include <stdio.h>
namespace cg = cooperative_groups;

#ifndef COOP
#define COOP 1
#endif

typedef unsigned short bf16_t;
typedef __attribute__((ext_vector_type(8))) short bf16x8;
typedef __attribute__((ext_vector_type(16))) float f32x16;
typedef __attribute__((ext_vector_type(4))) unsigned int u32x4;
typedef __attribute__((ext_vector_type(2))) unsigned int u32x2;

constexpr int DM = 1024;
constexpr int NBATCH = 8;
constexpr int SEQL = 4096;
constexpr int LCTX = 256;
constexpr int NL = NBATCH * SEQL;
constexpr int NC = NBATCH * LCTX;
constexpr int NR = NL + NC;
constexpr int SMEM_BYTES = 72 * 1024;
constexpr int NTHREADS = 256;

struct Params {
  const float *x, *c, *ctx, *c_ctx, *norm_g, *w_mod, *b_mod, *ab_w_in, *a_ln_g, *a_ln_b, *a_w_s, *a_b_s,
      *b_sink, *ab_w_out, *c_w_in, *c_conv_w, *c_conv_b, *c_w_a, *c_b_a, *c_w_i, *c_b_i, *c_lam, *c_w_out,
      *final_g;
  float* out;
  float* xbuf;
  float* mods;
  bf16_t* hbuf;
  bf16_t* ebuf;
  bf16_t *wt_in_e, *wt_out_e, *wt_in_o, *wt_out_o, *wga, *wgi;
  unsigned* bar;
};

typedef __bf16 hwbf16x2 __attribute__((ext_vector_type(2)));
typedef float f32x2v __attribute__((ext_vector_type(2)));
__device__ __forceinline__ uint32_t pack2(float a, float b) {
  f32x2v v = {a, b};
  hwbf16x2 r = __builtin_convertvector(v, hwbf16x2);
  return __builtin_bit_cast(uint32_t, r);
}
__device__ __forceinline__ bf16_t f2bf(float f) { return (bf16_t)(pack2(f, f) & 0xffffu); }
__device__ __forceinline__ float bf2f(bf16_t b) { return __uint_as_float(((uint32_t)b) << 16); }
__device__ __forceinline__ float lo_bf(uint32_t u) { return __uint_as_float(u << 16); }
__device__ __forceinline__ float hi_bf(uint32_t u) { return __uint_as_float(u & 0xffff0000u); }
__device__ __forceinline__ float frcp(float x) { return __builtin_amdgcn_rcpf(x); }
__device__ __forceinline__ float silu_f(float x) { return x * frcp(1.f + __expf(-x)); }
__device__ __forceinline__ float sigmoid_f(float x) { return frcp(1.f + __expf(-x)); }
__device__ __forceinline__ float gelu_f(float x) {
  float y = 0.7978845608028654f * (x + 0.044715f * x * x * x);
  float t = 1.f - 2.f * frcp(1.f + __expf(2.f * y));
  return 0.5f * x * (1.f + t);
}
__device__ __forceinline__ f32x16 zero16() {
  f32x16 z;
#pragma unroll
  for (int i = 0; i < 16; ++i) z[i] = 0.f;
  return z;
}
__device__ __forceinline__ float wave_sum(float v) {
#pragma unroll
  for (int o = 32; o > 0; o >>= 1) v += __shfl_xor(v, o);
  return v;
}

__device__ __forceinline__ int otid() {
  int t = threadIdx.x;
  asm volatile("" : "+v"(t));
  return t;
}

struct EvenBufs {
  bf16_t *ug, *vg, *gas, *qb, *gbs, *kb, *vtl, *vtc;
};
__device__ __forceinline__ EvenBufs even_bufs(const Params& p) {
  EvenBufs e;
  e.ug = p.ebuf;
  e.vg = e.ug + (size_t)NR * 512;
  e.gas = e.vg + (size_t)NR * 512;
  e.qb = e.gas + (size_t)NR * 512;
  e.gbs = e.qb + (size_t)NR * 512;
  e.kb = e.gbs + (size_t)NR * 512;
  e.vtl = e.kb + (size_t)NR * 128;
  e.vtc = e.vtl + (size_t)NBATCH * 128 * SEQL;
  return e;
}
struct OddBufs {
  bf16_t *xr, *sg, *sb;
};
__device__ __forceinline__ OddBufs odd_bufs(const Params& p) {
  OddBufs o;
  o.xr = p.ebuf;
  o.sg = o.xr + (size_t)NR * 1024;
  o.sb = o.xr;
  return o;
}

__device__ void transpose_item(const Params& p, int item, char* smem) {
  float* tile = (float*)smem;
  const float* src;
  bf16_t* dst;
  int K, N, local;
  if (item < 1408) { src = p.ab_w_in; dst = p.wt_in_e; K = 1024; N = 2816; local = item; }
  else if (item < 1920) { src = p.ab_w_out; dst = p.wt_out_e; K = 1024; N = 1024; local = item - 1408; }
  else if (item < 2944) { src = p.c_w_in; dst = p.wt_in_o; K = 1024; N = 2048; local = item - 1920; }
  else if (item < 3456) { src = p.c_w_out; dst = p.wt_out_o; K = 1024; N = 1024; local = item - 2944; }
  else if (item < 3712) { src = p.c_w_a; dst = p.wga; K = 256; N = 256; local = item - 3456; }
  else { src = p.c_w_i; dst = p.wgi; K = 256; N = 256; local = item - 3712; }
  const int ntn = N / 64;
  const int tpb = (K / 64) * ntn;
  const int bi = local / tpb;
  const int rem = local % tpb;
  const int k0 = (rem / ntn) * 64, n0 = (rem % ntn) * 64;
  src += (size_t)bi * K * N;
  dst += (size_t)bi * K * N;
  const int tid = otid();
  __syncthreads();
#pragma unroll
  for (int i = 0; i < 16; ++i) {
    int rr = i * 4 + (tid >> 6), cc = tid & 63;
    tile[rr * 65 + cc] = src[(size_t)(k0 + rr) * N + n0 + cc];
  }
  __syncthreads();
#pragma unroll
  for (int i = 0; i < 16; ++i) {
    int n = i * 4 + (tid >> 6), k = tid & 63;
    dst[(size_t)(n0 + n) * K + k0 + k] = f2bf(tile[k * 65 + n]);
  }
}

__device__ void mods_item(const Params& p, int item, char* smem) {
  float* sc = (float*)smem;
  float* red = sc + 9 * 1024;
  const int tid = otid();
  const int l = item / 96, n0 = (item % 96) * 32;
  __syncthreads();
  for (int i = tid; i < 9 * 1024; i += NTHREADS) {
    int j = i >> 10, k = i & 1023;
    float v = (j < 8) ? p.c[j * 1024 + k] : p.c_ctx[k];
    sc[i] = silu_f(v);
  }
  __syncthreads();
  const int col = tid & 31, kg = tid >> 5;
  float acc[9];
#pragma unroll
  for (int j = 0; j < 9; ++j) acc[j] = 0.f;
  const float* w = p.w_mod + ((size_t)l * 1024 + kg * 128) * 3072 + n0 + col;
#pragma unroll 8
  for (int k = 0; k < 128; ++k) {
    float wv = w[(size_t)k * 3072];
#pragma unroll
    for (int j = 0; j < 9; ++j) acc[j] += sc[j * 1024 + kg * 128 + k] * wv;
  }
#pragma unroll
  for (int j = 0; j < 9; ++j) red[(kg * 9 + j) * 32 + col] = acc[j];
  __syncthreads();
  for (int i = tid; i < 9 * 32; i += NTHREADS) {
    int j = i >> 5, cc = i & 31;
    float s = 0.f;
#pragma unroll
    for (int g = 0; g < 8; ++g) s += red[(g * 9 + j) * 32 + cc];
    p.mods[((size_t)l * 9 + j) * 3072 + n0 + cc] = s + p.b_mod[l * 3072 + n0 + cc];
  }
}

__device__ void phase0(const Params& p, char* smem) {
  const int total = 3968 + 384;
  for (int item = blockIdx.x; item < total; item += gridDim.x) {
    if (item < 384) mods_item(p, item, smem);
    else transpose_item(p, item - 384, smem);
  }
}

__device__ void phase_prep(const Params& p, int layer) {
  const int tid = otid();
  const int lane = tid & 63;
  const int gw = blockIdx.x * 4 + (tid >> 6);
  const int nw = gridDim.x * 4;
  const float* ng = p.norm_g + layer * 1024;
  for (int R = gw; R < NR; R += nw) {
    const float* src;
    if (layer == 0) src = (R < NL) ? p.x + (size_t)R * 1024 : p.ctx + (size_t)(R - NL) * 1024;
    else src = p.xbuf + (size_t)R * 1024;
    const int bidx = (R < NL) ? (R >> 12) : 8;
    const float* md = p.mods + ((size_t)layer * 9 + bidx) * 3072;
    float4 v[4];
#pragma unroll
    for (int i = 0; i < 4; ++i) v[i] = ((const float4*)src)[lane + 64 * i];
    float ss = 0.f;
#pragma unroll
    for (int i = 0; i < 4; ++i) ss += v[i].x * v[i].x + v[i].y * v[i].y + v[i].z * v[i].z + v[i].w * v[i].w;
    ss = wave_sum(ss);
    const float rstd = rsqrtf(ss * (1.f / 1024.f) + 1e-6f);
#pragma unroll
    for (int i = 0; i < 4; ++i) {
      const int k4 = lane + 64 * i;
      float4 g = ((const float4*)ng)[k4];
      float4 sh = ((const float4*)md)[k4];
      float4 sc = ((const float4*)(md + 1024))[k4];
      float h0 = v[i].x * rstd * g.x * (1.f + sc.x) + sh.x;
      float h1 = v[i].y * rstd * g.y * (1.f + sc.y) + sh.y;
      float h2 = v[i].z * rstd * g.z * (1.f + sc.z) + sh.z;
      float h3 = v[i].w * rstd * g.w * (1.f + sc.w) + sh.w;
      u32x2 pk;
      pk.x = pack2(h0, h1);
      pk.y = pack2(h2, h3);
      *(u32x2*)(p.hbuf + (size_t)R * 1024 + k4 * 4) = pk;
      if (layer == 0) ((float4*)(p.xbuf + (size_t)R * 1024))[k4] = v[i];
    }
  }
}

__device__ void phase_final(const Params& p) {
  const int tid = otid();
  const int lane = tid & 63;
  const int gw = blockIdx.x * 4 + (tid >> 6);
  const int nw = gridDim.x * 4;
  for (int R = gw; R < NL; R += nw) {
    const float* src = p.xbuf + (size_t)R * 1024;
    float4 v[4];
#pragma unroll
    for (int i = 0; i < 4; ++i) v[i] = ((const float4*)src)[lane + 64 * i];
    float ss = 0.f;
#pragma unroll
    for (int i = 0; i < 4; ++i) ss += v[i].x * v[i].x + v[i].y * v[i].y + v[i].z * v[i].z + v[i].w * v[i].w;
    ss = wave_sum(ss);
    const float rstd = rsqrtf(ss * (1.f / 1024.f) + 1e-6f);
#pragma unroll
    for (int i = 0; i < 4; ++i) {
      const int k4 = lane + 64 * i;
      float4 g = ((const float4*)p.final_g)[k4];
      float4 o;
      o.x = v[i].x * rstd * g.x;
      o.y = v[i].y * rstd * g.y;
      o.z = v[i].z * rstd * g.z;
      o.w = v[i].w * rstd * g.w;
      ((float4*)(p.out + (size_t)R * 1024))[k4] = o;
    }
  }
}

constexpr int GS = 72;

__device__ __forceinline__ u32x4 add_bf16x8(u32x4 a, u32x4 b) {
  u32x4 r;
  r.x = pack2(lo_bf(a.x) + lo_bf(b.x), hi_bf(a.x) + hi_bf(b.x));
  r.y = pack2(lo_bf(a.y) + lo_bf(b.y), hi_bf(a.y) + hi_bf(b.y));
  r.z = pack2(lo_bf(a.z) + lo_bf(b.z), hi_bf(a.z) + hi_bf(b.z));
  r.w = pack2(lo_bf(a.w) + lo_bf(b.w), hi_bf(a.w) + hi_bf(b.w));
  return r;
}

template <int AMODE, class Epi>
__device__ void gemm_phase(const bf16_t* __restrict__ A0, const bf16_t* __restrict__ A1,
                           const bf16_t* __restrict__ Bt, int Mtiles, int Ntiles, char* smem, Epi epi) {
  constexpr int PD = (AMODE == 1) ? 1 : 2;
  constexpr int BUF = 2 * 128 * GS;
  bf16_t* S0 = (bf16_t*)smem;
  const int tid = otid(), lane = tid & 63, w = __builtin_amdgcn_readfirstlane(tid >> 6);
  const int wm = w >> 1, wn = w & 1;
  const int r = lane & 31, h = lane >> 5;
  const int lrow = tid >> 3, kc = tid & 7;
  const int total = Mtiles * Ntiles;
  const int woff = lrow * GS + kc * 8;
  const int aro = (wm * 64 + r) * GS + h * 8;
  const int bro = 128 * GS + (wn * 64 + r) * GS + h * 8;
  const bool swz = ((gridDim.x & 7) == 0) && ((Mtiles & 7) == 0);
  const int xcd = blockIdx.x & 7;
  const int Mx = Mtiles >> 3;
  const int lstart = swz ? (int)(blockIdx.x >> 3) : (int)blockIdx.x;
  const int lstep = swz ? (int)(gridDim.x >> 3) : (int)gridDim.x;
  const int lend = swz ? Mx * Ntiles : total;
  for (int L = lstart; L < lend; L += lstep) {
    int mt, nt;
    if (swz) {
      const int gfull = 8 * Ntiles;
      const int mg = L / gfull, rem = L - mg * gfull;
      const int gs = min(8, Mx - mg * 8);
      nt = rem / gs;
      mt = xcd * Mx + mg * 8 + (rem - nt * gs);
    } else {
      mt = L / Ntiles;
      nt = L - mt * Ntiles;
    }
    const int m0 = mt * 128, n0 = nt * 128;
    const size_t aoff = (size_t)(m0 + lrow) * 1024 + kc * 8;
    const bf16_t* ap = A0 + aoff;
    const bf16_t* ap1 = (AMODE == 1) ? (A1 + aoff) : A0;
    const bf16_t* bp = Bt + (size_t)(n0 + lrow) * 1024 + kc * 8;
    u32x4 ra[PD][4], ra1[PD][4], rb[PD][4];
#define G_LOAD(S, KT)                                                                              \
    {                                                                                              \
      _Pragma("unroll") for (int i = 0; i < 4; ++i) {                                              \
        ra[S][i] = *(const u32x4*)(ap + (size_t)i * 32 * 1024 + (KT) * 64);                        \
        if (AMODE == 1) ra1[S][i] = *(const u32x4*)(ap1 + (size_t)i * 32 * 1024 + (KT) * 64);     \
        rb[S][i] = *(const u32x4*)(bp + (size_t)i * 32 * 1024 + (KT) * 64);                        \
      }                                                                                            \
    }
#define L_WRITE(S, BUFI)                                                                           \
    {                                                                                              \
      bf16_t* dstA = S0 + (BUFI) * BUF + woff;                                                     \
      _Pragma("unroll") for (int i = 0; i < 4; ++i) {                                              \
        u32x4 av = ra[S][i];                                                                       \
        if (AMODE == 1) av = add_bf16x8(av, ra1[S][i]);                                            \
        *(u32x4*)(dstA + 32 * i * GS) = av;                                                        \
        *(u32x4*)(dstA + 128 * GS + 32 * i * GS) = rb[S][i];                                       \
      }                                                                                            \
    }
    G_LOAD(0, 0);
    L_WRITE(0, 0);
#pragma unroll
    for (int s = 0; s < PD; ++s) G_LOAD(s, 1 + s);
    f32x16 acc[2][2];
#pragma unroll
    for (int mi = 0; mi < 2; ++mi)
#pragma unroll
      for (int ni = 0; ni < 2; ++ni) acc[mi][ni] = zero16();
#pragma unroll 1
    for (int kt0 = 0; kt0 < 16; kt0 += 2) {
#pragma unroll
      for (int u = 0; u < 2; ++u) {
        const int kt = kt0 + u;
        constexpr int dummy = 0; (void)dummy;
        const int s = (PD == 2) ? u : 0;
        __syncthreads();
        L_WRITE(s, (u ^ 1));
        {
          const int ktl = (kt + 1 + PD < 16) ? (kt + 1 + PD) : 15;
          G_LOAD(s, ktl);
        }
        const bf16_t* Aw = S0 + u * BUF + aro;
        const bf16_t* Bw = S0 + u * BUF + bro;
#pragma unroll
        for (int ks = 0; ks < 4; ++ks) {
          bf16x8 a0 = *(const bf16x8*)(Aw + ks * 16);
          bf16x8 a1 = *(const bf16x8*)(Aw + 32 * GS + ks * 16);
          bf16x8 b0 = *(const bf16x8*)(Bw + ks * 16);
          bf16x8 b1 = *(const bf16x8*)(Bw + 32 * GS + ks * 16);
          acc[0][0] = __builtin_amdgcn_mfma_f32_32x32x16_bf16(a0, b0, acc[0][0], 0, 0, 0);
          acc[0][1] = __builtin_amdgcn_mfma_f32_32x32x16_bf16(a0, b1, acc[0][1], 0, 0, 0);
          acc[1][0] = __builtin_amdgcn_mfma_f32_32x32x16_bf16(a1, b0, acc[1][0], 0, 0, 0);
          acc[1][1] = __builtin_amdgcn_mfma_f32_32x32x16_bf16(a1, b1, acc[1][1], 0, 0, 0);
        }
      }
    }
#undef G_LOAD
#undef L_WRITE
    epi(acc, m0 + wm * 64, n0 + wn * 64, lane);
  }
}


struct EpiEvenIn {
  EvenBufs e;
  __device__ void operator()(f32x16 (&acc)[2][2], int rb, int cb, int lane) const {
    const int r = lane & 31, h = lane >> 5;
    if (cb < 1536 || cb >= 2304) {
      bf16_t* dst;
      int c0;
      int mode;
      if (cb < 512) { dst = e.ug; c0 = cb; mode = 0; }
      else if (cb < 1024) { dst = e.vg; c0 = cb - 512; mode = 0; }
      else if (cb < 1536) { dst = e.gas; c0 = cb - 1024; mode = 1; }
      else { dst = e.gbs; c0 = cb - 2304; mode = 1; }
#pragma unroll
      for (int mi = 0; mi < 2; ++mi)
#pragma unroll
        for (int ni = 0; ni < 2; ++ni)
#pragma unroll
          for (int reg = 0; reg < 16; ++reg) {
            const int row = rb + mi * 32 + (reg & 3) + 8 * (reg >> 2) + 4 * h;
            const int col = c0 + ni * 32 + r;
            float v = acc[mi][ni][reg];
            v = (mode == 0) ? gelu_f(v) : silu_f(v);
            dst[(size_t)row * 512 + col] = f2bf(v);
          }
    } else if (cb < 2176) {
      const bool isq = cb < 2048;
      bf16_t* dst = isq ? e.qb : e.kb;
      const int c0 = isq ? (cb - 1536) : (cb - 2048);
      const int ld = isq ? 512 : 128;
      const float scale = isq ? 0.125f : 1.f;
      const bool latent = rb < NL;
      const float inv_freq = exp2f(-(float)(r & 15) * 0.8304820237218406f);
#pragma unroll
      for (int mi = 0; mi < 2; ++mi)
#pragma unroll
        for (int reg = 0; reg < 16; ++reg) {
          const int row = rb + mi * 32 + (reg & 3) + 8 * (reg >> 2) + 4 * h;
          float x1 = acc[mi][0][reg], x2 = acc[mi][1][reg];
          float o1 = x1, o2 = x2;
          if (latent) {
            const int t = row & (SEQL - 1);
            const float pos = (float)((r < 16) ? (t >> 6) : (t & 63));
            const float ang = pos * inv_freq;
            const float cs = __cosf(ang), sn = __sinf(ang);
            o1 = x1 * cs - x2 * sn;
            o2 = x2 * cs + x1 * sn;
          }
          dst[(size_t)row * ld + c0 + r] = f2bf(o1 * scale);
          dst[(size_t)row * ld + c0 + 32 + r] = f2bf(o2 * scale);
        }
    } else {
      const int kvh = (cb - 2176) >> 6;
      const bool latent = rb < NL;
#pragma unroll
      for (int mi = 0; mi < 2; ++mi)
#pragma unroll
        for (int ni = 0; ni < 2; ++ni)
#pragma unroll
          for (int q4 = 0; q4 < 4; ++q4) {
            const int row = rb + mi * 32 + 8 * q4 + 4 * h;
            const int d = ni * 32 + r;
            u32x2 pk;
            pk.x = pack2(acc[mi][ni][q4 * 4 + 0], acc[mi][ni][q4 * 4 + 1]);
            pk.y = pack2(acc[mi][ni][q4 * 4 + 2], acc[mi][ni][q4 * 4 + 3]);
            if (latent) {
              const int b = row >> 12, t = row & (SEQL - 1);
              *(u32x2*)(e.vtl + ((size_t)((b * 2 + kvh) * 64 + d)) * SEQL + t) = pk;
            } else {
              const int rr = row - NL;
              const int b = rr >> 8, t = rr & (LCTX - 1);
              *(u32x2*)(e.vtc + ((size_t)((b * 2 + kvh) * 64 + d)) * LCTX + t) = pk;
            }
          }
    }
  }
};

struct EpiOddIn {
  OddBufs o;
  __device__ void operator()(f32x16 (&acc)[2][2], int rb, int cb, int lane) const {
    const int r = lane & 31, h = lane >> 5;
    const bool isg = cb >= 1024;
    bf16_t* dst = isg ? o.sg : o.xr;
    const int c0 = isg ? cb - 1024 : cb;
#pragma unroll
    for (int mi = 0; mi < 2; ++mi)
#pragma unroll
      for (int ni = 0; ni < 2; ++ni)
#pragma unroll
        for (int reg = 0; reg < 16; ++reg) {
          const int row = rb + mi * 32 + (reg & 3) + 8 * (reg >> 2) + 4 * h;
          const int col = c0 + ni * 32 + r;
          float v = acc[mi][ni][reg];
          if (isg) v = silu_f(v);
          dst[(size_t)row * 1024 + col] = f2bf(v);
        }
  }
};

struct EpiOut {
  float* xbuf;
  const float* mods_l;
  __device__ void operator()(f32x16 (&acc)[2][2], int rb, int cb, int lane) const {
    const int r = lane & 31, h = lane >> 5;
    const int bidx = (rb < NL) ? (rb >> 12) : 8;
    const float* gate = mods_l + (size_t)bidx * 3072 + 2048;
#pragma unroll
    for (int ni = 0; ni < 2; ++ni) {
      const int col = cb + ni * 32 + r;
      const float gv = gate[col];
#pragma unroll
      for (int mi = 0; mi < 2; ++mi)
#pragma unroll
        for (int reg = 0; reg < 16; ++reg) {
          const int row = rb + mi * 32 + (reg & 3) + 8 * (reg >> 2) + 4 * h;
          float* px = xbuf + (size_t)row * 1024 + col;
          *px = *px + gv * acc[mi][ni][reg];
        }
    }
  }
};

constexpr int AS = 72;

__device__ void attn_item(const Params& p, const EvenBufs& e, int item, char* smem, int ei) {
  bf16_t* Ks = (bf16_t*)smem;
  bf16_t* Vs = Ks + 64 * AS;
  const int tid = otid(), lane = tid & 63, w = __builtin_amdgcn_readfirstlane(tid >> 6);
  const int r = lane & 31, h = lane >> 5;
  int b, hq, start, R0;
  bool isctx;
  if (item < 2048) {
    b = item >> 8;
    hq = (item >> 5) & 7;
    const int qblk = item & 31;
    start = qblk * 128;
    R0 = b * SEQL + start;
    isctx = false;
  } else {
    const int it = item - 2048;
    b = it >> 4;
    hq = (it >> 1) & 7;
    start = (it & 1) * 128;
    R0 = NL + b * LCTX + start;
    isctx = true;
  }
  const int kvh = hq >> 2;
  const int qrow = R0 + w * 32 + r;
  bf16x8 qf[4];
#pragma unroll
  for (int s = 0; s < 4; ++s) qf[s] = *(const bf16x8*)(e.qb + (size_t)qrow * 512 + hq * 64 + s * 16 + h * 8);
  float m = p.b_sink[ei * 8 + hq], l = 1.f;
  f32x16 o[2];
  o[0] = zero16();
  o[1] = zero16();
  const int nblk = isctx ? 4 : 10;
  for (int kb = 0; kb < nblk; ++kb) {
    int krow0, kpos0 = 0, vstride;
    const bf16_t* vt;
    bool local = false;
    if (kb < 4) {
      krow0 = NL + b * LCTX + kb * 64;
      vt = e.vtc + (size_t)((b * 2 + kvh) * 64) * LCTX + kb * 64;
      vstride = LCTX;
    } else {
      kpos0 = start - 128 + (kb - 4) * 64;
      if (kpos0 < 0 || kpos0 >= SEQL) continue;
      krow0 = b * SEQL + kpos0;
      vt = e.vtl + (size_t)((b * 2 + kvh) * 64) * SEQL + kpos0;
      vstride = SEQL;
      local = true;
    }
    __syncthreads();
#pragma unroll
    for (int i = 0; i < 2; ++i) {
      const int c = tid + 256 * i;
      const int rr = c >> 3, cc = c & 7;
      *(u32x4*)(Ks + rr * AS + cc * 8) = *(const u32x4*)(e.kb + (size_t)(krow0 + rr) * 128 + kvh * 64 + cc * 8);
      *(u32x4*)(Vs + rr * AS + cc * 8) = *(const u32x4*)(vt + (size_t)rr * vstride + cc * 8);
    }
    __syncthreads();
    f32x16 s[2];
#pragma unroll
    for (int kt = 0; kt < 2; ++kt) {
      s[kt] = zero16();
#pragma unroll
      for (int ks = 0; ks < 4; ++ks) {
        bf16x8 a = *(const bf16x8*)(Ks + (kt * 32 + r) * AS + ks * 16 + h * 8);
        s[kt] = __builtin_amdgcn_mfma_f32_32x32x16_bf16(a, qf[ks], s[kt], 0, 0, 0);
      }
    }
    if (local) {
      const int qpos = start + w * 32 + r;
#pragma unroll
      for (int kt = 0; kt < 2; ++kt)
#pragma unroll
        for (int reg = 0; reg < 16; ++reg) {
          const int kpos = kpos0 + kt * 32 + (reg & 3) + 8 * (reg >> 2) + 4 * h;
          const int diff = qpos - kpos;
          if (diff > 128 || diff < -128) s[kt][reg] = -1e30f;
        }
    }
    float mx = m;
#pragma unroll
    for (int kt = 0; kt < 2; ++kt)
#pragma unroll
      for (int reg = 0; reg < 16; ++reg) mx = fmaxf(mx, s[kt][reg]);
    mx = fmaxf(mx, __shfl_xor(mx, 32));
    const float alpha = __expf(m - mx);
    m = mx;
    float rs = 0.f;
#pragma unroll
    for (int kt = 0; kt < 2; ++kt)
#pragma unroll
      for (int reg = 0; reg < 16; ++reg) {
        const float pv = __expf(s[kt][reg] - mx);
        rs += pv;
        s[kt][reg] = pv;
      }
    rs += __shfl_xor(rs, 32);
    l = l * alpha + rs;
#pragma unroll
    for (int dt = 0; dt < 2; ++dt)
#pragma unroll
      for (int reg = 0; reg < 16; ++reg) o[dt][reg] *= alpha;
#pragma unroll
    for (int kt = 0; kt < 2; ++kt)
#pragma unroll
      for (int sp = 0; sp < 2; ++sp) {
        union { bf16x8 v; uint32_t u[4]; } pf;
#pragma unroll
        for (int j = 0; j < 4; ++j) pf.u[j] = pack2(s[kt][8 * sp + 2 * j], s[kt][8 * sp + 2 * j + 1]);
#pragma unroll
        for (int dt = 0; dt < 2; ++dt) {
          const bf16_t* vp = Vs + (dt * 32 + r) * AS + kt * 32 + sp * 16 + 4 * h;
          union { bf16x8 v; u32x2 u[2]; } af;
          af.u[0] = *(const u32x2*)(vp);
          af.u[1] = *(const u32x2*)(vp + 8);
          o[dt] = __builtin_amdgcn_mfma_f32_32x32x16_bf16(af.v, pf.v, o[dt], 0, 0, 0);
        }
      }
  }
  const float inv = 1.f / l;
  bf16_t* ymix = p.hbuf;
#pragma unroll
  for (int dt = 0; dt < 2; ++dt)
#pragma unroll
    for (int q4 = 0; q4 < 4; ++q4) {
      const int d0 = dt * 32 + 8 * q4 + 4 * h;
      const u32x2 g = *(const u32x2*)(e.gbs + (size_t)qrow * 512 + hq * 64 + d0);
      u32x2 pk;
      pk.x = pack2(o[dt][q4 * 4 + 0] * inv * lo_bf(g.x), o[dt][q4 * 4 + 1] * inv * hi_bf(g.x));
      pk.y = pack2(o[dt][q4 * 4 + 2] * inv * lo_bf(g.y), o[dt][q4 * 4 + 3] * inv * hi_bf(g.y));
      *(u32x2*)(ymix + (size_t)qrow * 1024 + 512 + hq * 64 + d0) = pk;
    }
}

constexpr int MS = 136;

__device__ void gmlp_item(const Params& p, const EvenBufs& e, int item, char* smem, int ei) {
  bf16_t* Ws = (bf16_t*)smem;
  bf16_t* VT = Ws + 128 * MS;
  const int tid = otid(), lane = tid & 63, w = __builtin_amdgcn_readfirstlane(tid >> 6);
  const int r = lane & 31, h = lane >> 5;
  const int wm = w >> 1, wn = w & 1;
  const int rt = item >> 2, g = item & 3;
  const int R0 = rt * 128;
  __syncthreads();
  {
    const float4* wsrc = (const float4*)(p.a_w_s + (size_t)(ei * 4 + g) * 128 * 128);
#pragma unroll
    for (int i = 0; i < 16; ++i) {
      const int idx = tid + 256 * i;
      const int pp = idx >> 5, q4 = idx & 31;
      float4 v = wsrc[idx];
      u32x2 pk;
      pk.x = pack2(v.x, v.y);
      pk.y = pack2(v.z, v.w);
      *(u32x2*)(Ws + pp * MS + q4 * 4) = pk;
    }
  }
#pragma unroll 1
  for (int hp = 0; hp < 2; ++hp) {
    const int q = hp * 64 + (tid >> 2), qt = tid & 3;
    const bf16_t* vsrc = e.vg + (size_t)(R0 + q) * 512 + g * 128 + qt * 32;
    float xv[32];
#pragma unroll
    for (int i = 0; i < 4; ++i) {
      u32x4 u = *(const u32x4*)(vsrc + i * 8);
      xv[i * 8 + 0] = lo_bf(u.x); xv[i * 8 + 1] = hi_bf(u.x);
      xv[i * 8 + 2] = lo_bf(u.y); xv[i * 8 + 3] = hi_bf(u.y);
      xv[i * 8 + 4] = lo_bf(u.z); xv[i * 8 + 5] = hi_bf(u.z);
      xv[i * 8 + 6] = lo_bf(u.w); xv[i * 8 + 7] = hi_bf(u.w);
    }
    float sm = 0.f;
#pragma unroll
    for (int j = 0; j < 32; ++j) sm += xv[j];
    sm += __shfl_xor(sm, 1);
    sm += __shfl_xor(sm, 2);
    const float mean = sm * (1.f / 128.f);
    float sq = 0.f;
#pragma unroll
    for (int j = 0; j < 32; ++j) { float dlt = xv[j] - mean; sq += dlt * dlt; }
    sq += __shfl_xor(sq, 1);
    sq += __shfl_xor(sq, 2);
    const float rstd = rsqrtf(sq * (1.f / 128.f) + 1e-6f);
    const float* lg = p.a_ln_g + ei * 512 + g * 128 + qt * 32;
    const float* lb = p.a_ln_b + ei * 512 + g * 128 + qt * 32;
#pragma unroll
    for (int j = 0; j < 32; ++j) {
      const float val = (xv[j] - mean) * rstd * lg[j] + lb[j];
      VT[(qt * 32 + j) * MS + q] = f2bf(val);
    }
  }
  __syncthreads();
  f32x16 acc[2][2];
#pragma unroll
  for (int mi = 0; mi < 2; ++mi)
#pragma unroll
    for (int ni = 0; ni < 2; ++ni) acc[mi][ni] = zero16();
  const bf16_t* Aw = Ws + (wm * 64 + r) * MS + h * 8;
  const bf16_t* Bw = VT + (wn * 64 + r) * MS + h * 8;
#pragma unroll
  for (int ks = 0; ks < 8; ++ks) {
    bf16x8 a0 = *(const bf16x8*)(Aw + ks * 16);
    bf16x8 a1 = *(const bf16x8*)(Aw + 32 * MS + ks * 16);
    bf16x8 b0 = *(const bf16x8*)(Bw + ks * 16);
    bf16x8 b1 = *(const bf16x8*)(Bw + 32 * MS + ks * 16);
    acc[0][0] = __builtin_amdgcn_mfma_f32_32x32x16_bf16(a0, b0, acc[0][0], 0, 0, 0);
    acc[0][1] = __builtin_amdgcn_mfma_f32_32x32x16_bf16(a0, b1, acc[0][1], 0, 0, 0);
    acc[1][0] = __builtin_amdgcn_mfma_f32_32x32x16_bf16(a1, b0, acc[1][0], 0, 0, 0);
    acc[1][1] = __builtin_amdgcn_mfma_f32_32x32x16_bf16(a1, b1, acc[1][1], 0, 0, 0);
  }
  bf16_t* ymix = p.hbuf;
  const float* bs = p.a_b_s + (ei * 4 + g) * 128;
#pragma unroll
  for (int mi = 0; mi < 2; ++mi)
#pragma unroll
    for (int reg = 0; reg < 16; ++reg) {
      const int prow = wm * 64 + mi * 32 + (reg & 3) + 8 * (reg >> 2) + 4 * h;
      const float bsv = bs[prow];
      const size_t row = (size_t)(R0 + prow);
#pragma unroll
      for (int ni = 0; ni < 2; ++ni) {
        const int col = g * 128 + wn * 64 + ni * 32 + r;
        const float sv = acc[mi][ni][reg] + bsv;
        const float y = bf2f(e.ug[row * 512 + col]) * sv * bf2f(e.gas[row * 512 + col]);
        ymix[row * 1024 + col] = f2bf(y);
      }
    }
}

__device__ void phase_even_mix(const Params& p, char* smem, int ei) {
  const EvenBufs e = even_bufs(p);
  const int n_attn = 2048 + 128, n_gmlp = 1088;
  for (int item = blockIdx.x; item < n_attn + n_gmlp; item += gridDim.x) {
    if (item < n_attn) attn_item(p, e, item, smem, ei);
    else gmlp_item(p, e, item - n_attn, smem, ei);
  }
}

__device__ void phase_conv(const Params& p, int oi) {
  const OddBufs ob = odd_bufs(p);
  const bf16_t* xr = ob.xr;
  bf16_t* zb = ob.sg + (size_t)NR * 1024;
  const int tid = otid();
  const int total = (NR / 8) * 128;
  for (int id = blockIdx.x * NTHREADS + tid; id < total; id += gridDim.x * NTHREADS) {
    const int chunk = id & 127, rg = id >> 7;
    const int R0 = rg * 8;
    int t0, Ls;
    if (R0 < NL) { t0 = R0 & (SEQL - 1); Ls = SEQL; } else { t0 = (R0 - NL) & (LCTX - 1); Ls = LCTX; }
    const int chb = chunk * 8;
    float cw[4][8], cbias[8];
#pragma unroll
    for (int j = 0; j < 4; ++j) {
      const float4 w0 = *(const float4*)(p.c_conv_w + ((size_t)oi * 4 + j) * 1024 + chb);
      const float4 w1 = *(const float4*)(p.c_conv_w + ((size_t)oi * 4 + j) * 1024 + chb + 4);
      cw[j][0] = w0.x; cw[j][1] = w0.y; cw[j][2] = w0.z; cw[j][3] = w0.w;
      cw[j][4] = w1.x; cw[j][5] = w1.y; cw[j][6] = w1.z; cw[j][7] = w1.w;
    }
    {
      const float4 b0 = *(const float4*)(p.c_conv_b + oi * 1024 + chb);
      const float4 b1 = *(const float4*)(p.c_conv_b + oi * 1024 + chb + 4);
      cbias[0] = b0.x; cbias[1] = b0.y; cbias[2] = b0.z; cbias[3] = b0.w;
      cbias[4] = b1.x; cbias[5] = b1.y; cbias[6] = b1.z; cbias[7] = b1.w;
    }
    float xw[11][8];
#pragma unroll
    for (int jj = 0; jj < 11; ++jj) {
      const int t = t0 - 2 + jj;
      u32x4 u = (u32x4){0u, 0u, 0u, 0u};
      if (t >= 0 && t < Ls) u = *(const u32x4*)(xr + (size_t)(R0 - 2 + jj) * 1024 + chb);
      xw[jj][0] = lo_bf(u.x); xw[jj][1] = hi_bf(u.x);
      xw[jj][2] = lo_bf(u.y); xw[jj][3] = hi_bf(u.y);
      xw[jj][4] = lo_bf(u.z); xw[jj][5] = hi_bf(u.z);
      xw[jj][6] = lo_bf(u.w); xw[jj][7] = hi_bf(u.w);
    }
#pragma unroll
    for (int i = 0; i < 8; ++i) {
      float z[8];
#pragma unroll
      for (int e2 = 0; e2 < 8; ++e2) {
        float a = cbias[e2];
#pragma unroll
        for (int j = 0; j < 4; ++j) a += cw[j][e2] * xw[i + j][e2];
        z[e2] = a;
      }
      u32x4 pk;
      pk.x = pack2(z[0], z[1]); pk.y = pack2(z[2], z[3]);
      pk.z = pack2(z[4], z[5]); pk.w = pack2(z[6], z[7]);
      *(u32x4*)(zb + (size_t)(R0 + i) * 1024 + chb) = pk;
    }
  }
}

constexpr int ZS = 264;

template <int DIR>
__device__ void rglru_item(const Params& p, const OddBufs& ob, int item, char* smem, int oi, bool need_ctx) {
  bf16_t* Zs = (bf16_t*)smem;
  float* segA = (float*)(Zs + 128 * ZS);
  float* segB = segA + 256;
  float* carry = segB + 256;
  float* La = (float*)Zs;
  float* Gz = La + 4096;
  const int tid = otid(), lane = tid & 63, w = __builtin_amdgcn_readfirstlane(tid >> 6);
  const int r = lane & 31, h = lane >> 5;
  const int wm = w >> 1, wn = w & 1;
  const int b = item >> 6, cs = item & 31;
  constexpr int dir = DIR;
  const int hd = cs >> 3, j0 = (cs & 7) * 32, c0 = cs * 32;
  bf16_t* sout = dir ? ob.sb : p.hbuf;
  const bf16_t* zb = ob.sg + (size_t)NR * 1024;
  __syncthreads();
  if (tid < 32) carry[tid] = 0.f;
  bf16x8 bfr[16];
  {
    const size_t mo = ((size_t)((oi * 2 + dir) * 4 + hd)) * 65536 + (size_t)(j0 + r) * 256 + h * 8;
    const bf16_t* wsrc = (wn ? p.wgi : p.wga) + mo;
#pragma unroll
    for (int ks = 0; ks < 16; ++ks) bfr[ks] = *(const bf16x8*)(wsrc + ks * 16);
  }
  const int gch = (oi * 2 + dir) * 1024 + c0 + r;
  const float gbias = wn ? p.c_b_i[gch] : p.c_b_a[gch];
  const float spl = log1pf(__expf(-p.c_lam[gch]));
  const int sc_c = tid & 31, sc_sg = tid >> 5;
  const int lrow = tid >> 5, kc = tid & 31;

  u32x4 zt[4];
  {
    const int Rs0 = NL + b * LCTX;
    const int ti0 = dir ? 1 : 0;
    const bf16_t* src = zb + (size_t)(Rs0 + ti0 * 128 + lrow) * 1024 + hd * 256 + kc * 8;
#pragma unroll
    for (int i = 0; i < 4; ++i) zt[i] = *(const u32x4*)(src + (size_t)i * 8 * 1024);
  }
  const int sbase = DIR ? (7 - sc_sg) * 16 : sc_sg * 16;
  const unsigned voff = (unsigned)(sbase * 1024 + c0 + sc_c);
  for (int step = 0; step < 34; ++step) {
    int Rs, ti;
    bool wr;
    if (step < 2) { Rs = NL + b * LCTX; ti = dir ? 1 - step : step; wr = need_ctx; }
    else { Rs = b * SEQL; ti = dir ? 31 - (step - 2) : (step - 2); wr = true; }
    const int t0 = ti * 128;
    __syncthreads();
    {
      const bf16_t* src2 = zb + (size_t)(Rs + t0 + lrow + 32) * 1024 + hd * 256 + kc * 8;
      u32x4 z2[12];
#pragma unroll
      for (int i = 0; i < 12; ++i) z2[i] = *(const u32x4*)(src2 + (size_t)i * 8 * 1024);
#pragma unroll
      for (int i = 0; i < 4; ++i) *(u32x4*)(Zs + (lrow + 8 * i) * ZS + kc * 8) = zt[i];
#pragma unroll
      for (int i = 0; i < 12; ++i) *(u32x4*)(Zs + (lrow + 32 + 8 * i) * ZS + kc * 8) = z2[i];
    }
    const bf16_t* sgp = ob.sg + (size_t)(Rs + t0) * 1024;
    bf16_t sgv[16];
    if (wr) {
#pragma unroll
      for (int i = 0; i < 16; ++i) sgv[i] = sgp[voff + (DIR ? 15 - i : i) * 1024];
    }
    __syncthreads();
    f32x16 acc[2];
    acc[0] = zero16();
    acc[1] = zero16();
    {
      const bf16_t* Aw = Zs + (wm * 64 + r) * ZS + h * 8;
#pragma unroll
      for (int ks = 0; ks < 16; ++ks) {
        bf16x8 a0 = *(const bf16x8*)(Aw + ks * 16);
        bf16x8 a1 = *(const bf16x8*)(Aw + 32 * ZS + ks * 16);
        acc[0] = __builtin_amdgcn_mfma_f32_32x32x16_bf16(a0, bfr[ks], acc[0], 0, 0, 0);
        acc[1] = __builtin_amdgcn_mfma_f32_32x32x16_bf16(a1, bfr[ks], acc[1], 0, 0, 0);
      }
    }
    if (wn == 0) {
#pragma unroll
      for (int mi = 0; mi < 2; ++mi)
#pragma unroll
        for (int reg = 0; reg < 16; ++reg) acc[mi][reg] = -8.f * spl * sigmoid_f(acc[mi][reg] + gbias);
    } else {
#pragma unroll
      for (int mi = 0; mi < 2; ++mi) {
        float zv[16];
#pragma unroll
        for (int reg = 0; reg < 16; ++reg) {
          const int row = wm * 64 + mi * 32 + (reg & 3) + 8 * (reg >> 2) + 4 * h;
          zv[reg] = bf2f(Zs[row * ZS + j0 + r]);
        }
#pragma unroll
        for (int reg = 0; reg < 16; ++reg) acc[mi][reg] = zv[reg] * sigmoid_f(acc[mi][reg] + gbias);
        asm volatile("" ::: "memory");
      }
    }
    __syncthreads();
    {
      float* dstb = wn ? Gz : La;
#pragma unroll
      for (int mi = 0; mi < 2; ++mi)
#pragma unroll
        for (int reg = 0; reg < 16; ++reg) {
          const int row = wm * 64 + mi * 32 + (reg & 3) + 8 * (reg >> 2) + 4 * h;
          dstb[row * 32 + r] = acc[mi][reg];
        }
    }
    __syncthreads();
    if (step + 1 < 34) {
      const int ns = step + 1;
      int nRs, nti;
      if (ns < 2) { nRs = NL + b * LCTX; nti = dir ? 1 - ns : ns; }
      else { nRs = b * SEQL; nti = dir ? 31 - (ns - 2) : (ns - 2); }
      const bf16_t* src = zb + (size_t)(nRs + nti * 128 + lrow) * 1024 + hd * 256 + kc * 8;
#pragma unroll
      for (int i = 0; i < 4; ++i) zt[i] = *(const u32x4*)(src + (size_t)i * 8 * 1024);
    }
    bf16_t* sop = sout + (size_t)(Rs + t0) * 1024;
    const float* Lap = La + sbase * 32 + sc_c;
    const float* Gzp = Gz + sbase * 32 + sc_c;
    {
      float A = 1.f, Bv = 0.f;
      float* Law = La + sbase * 32 + sc_c;
      float* Gzw = Gz + sbase * 32 + sc_c;
#pragma unroll
      for (int i = 0; i < 16; ++i) {
        const int ro = (DIR ? 15 - i : i) * 32;
        const float la = Lap[ro];
        const float a = __expf(la);
        const float mult = __builtin_amdgcn_sqrtf(fmaf(-a, a, 1.f));
        const float bx = mult * Gzp[ro];
        Law[ro] = a;
        Gzw[ro] = bx;
        Bv = a * Bv + bx;
        A *= a;
      }
      segA[sc_sg * 32 + sc_c] = A;
      segB[sc_sg * 32 + sc_c] = Bv;
    }
    __syncthreads();
    {
      float hh = carry[(step & 1) * 32 + sc_c];
      {
        float sa[7], sbv[7];
#pragma unroll
        for (int s2 = 0; s2 < 7; ++s2) { sa[s2] = segA[s2 * 32 + sc_c]; sbv[s2] = segB[s2 * 32 + sc_c]; }
#pragma unroll
        for (int s2 = 0; s2 < 7; ++s2) hh = (s2 < sc_sg) ? (sa[s2] * hh + sbv[s2]) : hh;
      }
#pragma unroll
      for (int i = 0; i < 16; ++i) {
        const int ro = (DIR ? 15 - i : i);
        hh = Lap[ro * 32] * hh + Gzp[ro * 32];
        if (wr) sop[voff + ro * 1024] = f2bf(hh * bf2f(sgv[i]));
      }
      if (sc_sg == 7) carry[((step + 1) & 1) * 32 + sc_c] = hh;
    }
  }
}

__device__ void phase_rglru(const Params& p, char* smem, int oi, bool need_ctx) {
  const OddBufs ob = odd_bufs(p);
  for (int it0 = blockIdx.x; it0 < 512; it0 += gridDim.x) {
    const int xcd = it0 & 7, slot = it0 >> 3;
    const int grp = xcd * 4 + (slot >> 4), j = slot & 15;
    const int item = ((grp >> 2) << 6) | ((j >> 3) << 5) | ((grp & 3) << 3) | (j & 7);
    if ((item >> 5) & 1) rglru_item<1>(p, ob, item, smem, oi, need_ctx);
    else rglru_item<0>(p, ob, item, smem, oi, need_ctx);
  }
}

#define XB_TMO      128
#define XB_XCNT(j)  (256  + 64 * (j))
#define XB_XSUB(j)  (1280 + 64 * (j))
#define XB_XGEN(j)  (2304 + 64 * (j))
#define XB_TOP      3328
#define XB_TOPGEN   3392
#define XCD_BAR_WORDS 3456
#define XB_SPIN_CAP (1u << 18)
#define LAS __attribute__((address_space(3)))

__device__ __forceinline__ unsigned xb_ld(unsigned* p)              { return __hip_atomic_load(p, __ATOMIC_RELAXED, __HIP_MEMORY_SCOPE_AGENT); }
__device__ __forceinline__ unsigned xb_add(unsigned* p, unsigned v) { return __hip_atomic_fetch_add(p, v, __ATOMIC_RELAXED, __HIP_MEMORY_SCOPE_AGENT); }
__device__ __forceinline__ unsigned xb_xcc_id() { return (unsigned)__builtin_amdgcn_s_getreg((3 << 11) | 20) & 0xFu; }
#define XB_SPIN(cond, bar) do { unsigned _sp = 0; while (cond) { __builtin_amdgcn_s_sleep(1); \
    if ((++_sp & 255u) == 0u) { if (xb_ld(&(bar)[XB_TMO])) break; if (_sp > XB_SPIN_CAP) { atomicAdd(&(bar)[XB_TMO], 1u); break; } } } } while (0)

struct XcdBarrier {
    unsigned* bar; unsigned x;
    volatile LAS unsigned* st;
};

__device__ __forceinline__ XcdBarrier xcd_barrier_post(unsigned* bar, volatile LAS unsigned* st) {
    XcdBarrier b; b.bar = bar; b.x = xb_xcc_id(); b.st = st;
    if (threadIdx.x == 0) (void)xb_add(&bar[XB_XCNT(b.x)], 1u);
    return b;
}
__device__ __forceinline__ void xcd_barrier_complete(unsigned* bar, unsigned x, unsigned& nloc, unsigned& nx) {
    const unsigned G = gridDim.x * gridDim.y * gridDim.z;
    unsigned sum, cnt, mine, sp = 0u;
    for (;;) {
        sum = 0u; cnt = 0u; mine = 0u;
#pragma unroll
        for (unsigned j = 0; j < 16; ++j) { const unsigned c = xb_ld(&bar[XB_XCNT(j)]); sum += c; cnt += (c > 0u) ? 1u : 0u; mine = (j == x) ? c : mine; }
        if (sum == G) break;
        __builtin_amdgcn_s_sleep(1);
        if ((++sp & 255u) == 0u) { if (xb_ld(&bar[XB_TMO])) break; if (sp > XB_SPIN_CAP) { atomicAdd(&bar[XB_TMO], 1u); break; } }
    }
    nloc = mine > 0u ? mine : 1u; nx = cnt > 0u ? cnt : 1u;
}

__device__ __forceinline__ void xcd_barrier(const XcdBarrier& b) {
    asm volatile("s_waitcnt vmcnt(0)" ::: "memory");
    __syncthreads();
    if (threadIdx.x == 0) {
        unsigned* bar = b.bar;
        __builtin_amdgcn_s_waitcnt(0);
        unsigned nloc = b.st[0], nx = b.st[1];
        if (nloc == 0u) { xcd_barrier_complete(bar, b.x, nloc, nx); b.st[0] = nloc; b.st[1] = nx; }
        const unsigned old = xb_add(&bar[XB_XSUB(b.x)], 1u);
        const unsigned gen = old / nloc;
        if (old + 1u == (gen + 1u) * nloc) {
            __builtin_amdgcn_fence(__ATOMIC_RELEASE, "agent");
            asm volatile("s_waitcnt vmcnt(0)" ::: "memory");
            const unsigned og = xb_add(&bar[XB_TOP], 1u);
            const unsigned tg = og / nx;
            if (og + 1u == (tg + 1u) * nx) xb_add(&bar[XB_TOPGEN], 1u);
            else XB_SPIN(xb_ld(&bar[XB_TOPGEN]) == tg, bar);
            __builtin_amdgcn_fence(__ATOMIC_ACQUIRE, "agent");
            xb_add(&bar[XB_XGEN(b.x)], 1u);
            asm volatile("s_waitcnt vmcnt(0)" ::: "memory");
        } else {
            XB_SPIN(xb_ld(&bar[XB_XGEN(b.x)]) == gen, bar);
            __builtin_amdgcn_fence(__ATOMIC_ACQUIRE, "agent");
            asm volatile("s_waitcnt vmcnt(0)" ::: "memory");
        }
    }
    __syncthreads();
}


#define LAUNDER(f) q.f = p.f + z
__device__ __forceinline__ void launder(Params& q, const Params& p) {
  long z;
  asm volatile("s_mov_b64 %0, 0" : "=s"(z));
  LAUNDER(x); LAUNDER(c); LAUNDER(ctx); LAUNDER(c_ctx); LAUNDER(norm_g); LAUNDER(w_mod); LAUNDER(b_mod);
  LAUNDER(ab_w_in); LAUNDER(a_ln_g); LAUNDER(a_ln_b); LAUNDER(a_w_s); LAUNDER(a_b_s); LAUNDER(b_sink);
  LAUNDER(ab_w_out); LAUNDER(c_w_in); LAUNDER(c_conv_w); LAUNDER(c_conv_b); LAUNDER(c_w_a); LAUNDER(c_b_a);
  LAUNDER(c_w_i); LAUNDER(c_b_i); LAUNDER(c_lam); LAUNDER(c_w_out); LAUNDER(final_g); LAUNDER(out);
  LAUNDER(xbuf); LAUNDER(mods); LAUNDER(hbuf); LAUNDER(ebuf); LAUNDER(wt_in_e); LAUNDER(wt_out_e);
  LAUNDER(wt_in_o); LAUNDER(wt_out_o); LAUNDER(wga); LAUNDER(wgi);
}

constexpr int NPHASES = 20;

__device__ void run_phase(const Params& p0, int ph, char* smem) {
  if (ph == 0) { Params p; launder(p, p0); phase0(p, smem); return; }
  if (ph == 19) { Params p; launder(p, p0); phase_final(p); return; }
  int layer, sub;
  if (ph < 5) { layer = 0; sub = ph - 1; }
  else if (ph < 10) { layer = 1; sub = ph - 5; }
  else if (ph < 14) { layer = 2; sub = ph - 10; }
  else { layer = 3; sub = ph - 14; }
  const int idx = layer >> 1;
  const bool even = (layer & 1) == 0;
  const bool need_ctx = layer < 3;
  if (sub == 0) { Params p; launder(p, p0); phase_prep(p, layer); return; }
  if (even) {
    if (sub == 1) {
      Params p; launder(p, p0);
      EpiEvenIn epi; epi.e = even_bufs(p);
      gemm_phase<0>(p.hbuf, nullptr, p.wt_in_e + (size_t)idx * 2816 * 1024, NR / 128, 22, smem, epi);
    } else if (sub == 2) {
      Params p; launder(p, p0);
      phase_even_mix(p, smem, idx);
    } else {
      Params p; launder(p, p0);
      EpiOut epi; epi.xbuf = p.xbuf; epi.mods_l = p.mods + (size_t)layer * 9 * 3072;
      gemm_phase<0>(p.hbuf, nullptr, p.wt_out_e + (size_t)idx * 1024 * 1024, NR / 128, 8, smem, epi);
    }
  } else {
    if (sub == 1) {
      Params p; launder(p, p0);
      EpiOddIn epi; epi.o = odd_bufs(p);
      gemm_phase<0>(p.hbuf, nullptr, p.wt_in_o + (size_t)idx * 2048 * 1024, NR / 128, 16, smem, epi);
    } else if (sub == 2) {
      Params p; launder(p, p0);
      phase_conv(p, idx);
    } else if (sub == 3) {
      Params p; launder(p, p0);
      phase_rglru(p, smem, idx, need_ctx);
    } else {
      Params p; launder(p, p0);
      EpiOut epi; epi.xbuf = p.xbuf; epi.mods_l = p.mods + (size_t)layer * 9 * 3072;
      const OddBufs ob = odd_bufs(p);
      gemm_phase<1>(p.hbuf, ob.sb, p.wt_out_o + (size_t)idx * 1024 * 1024, (need_ctx ? NR : NL) / 128, 8, smem, epi);
    }
  }
}

__global__ void __launch_bounds__(NTHREADS, 2) mega_kernel(Params p, int ph_lo, int ph_hi, int use_bar) {
  __shared__ __attribute__((aligned(16))) char smem[SMEM_BYTES];
  __shared__ uint4 xb_words;
  if (threadIdx.x == 0) xb_words = make_uint4(0u, 0u, 0u, 0u);
  __syncthreads();
  if (use_bar == 1) (void)xcd_barrier_post(p.bar, (volatile LAS unsigned*)&xb_words);
  for (int ph = ph_lo; ph < ph_hi; ++ph) {
    run_phase(p, ph, smem);
    if (ph + 1 < ph_hi) {
      if (use_bar == 1) {
        XcdBarrier xb;
        xb.bar = p.bar; xb.x = xb_xcc_id(); xb.st = (volatile LAS unsigned*)&xb_words;
        xcd_barrier(xb);
      } else if (use_bar == 2) cg::this_grid().sync();
    }
  }
}

extern "C" void kernel_launch(void* const* d_in, const int* in_sizes, int n_in, void* d_out, int out_size,
                              void* d_ws, size_t ws_size, hipStream_t stream) {
  static int grid_blocks = 0;
  if (!grid_blocks) {
    int dev = 0, cus = 0, per_cu = 0;
    hipGetDevice(&dev);
    hipDeviceGetAttribute(&cus, hipDeviceAttributeMultiprocessorCount, dev);
    hipOccupancyMaxActiveBlocksPerMultiprocessor(&per_cu, mega_kernel, NTHREADS, 0);
    if (per_cu < 1) per_cu = 1;
    if (per_cu > 2) per_cu = 2;
    grid_blocks = cus * per_cu;
  }
  Params p{};
  const float** fp = (const float**)&p;
  for (int i = 0; i < 24; ++i) fp[i] = (const float*)d_in[i];
  p.out = (float*)d_out;
  char* ws = (char*)d_ws;
  size_t off = 0;
  auto take = [&](size_t bytes) { char* q = ws + off; off += (bytes + 255) & ~(size_t)255; return q; };
  p.xbuf = (float*)take((size_t)NR * 1024 * 4);
  p.mods = (float*)take((size_t)4 * 9 * 3072 * 4);
  p.hbuf = (bf16_t*)take((size_t)NR * 1024 * 2);
  p.ebuf = (bf16_t*)take((size_t)NR * 3072 * 2);
  p.wt_in_e = (bf16_t*)take((size_t)2 * 2816 * 1024 * 2);
  p.wt_out_e = (bf16_t*)take((size_t)2 * 1024 * 1024 * 2);
  p.wt_in_o = (bf16_t*)take((size_t)2 * 2048 * 1024 * 2);
  p.wt_out_o = (bf16_t*)take((size_t)2 * 1024 * 1024 * 2);
  p.wga = (bf16_t*)take((size_t)16 * 65536 * 2);
  p.wgi = (bf16_t*)take((size_t)16 * 65536 * 2);
  p.bar = (unsigned*)take((size_t)XCD_BAR_WORDS * 4);
  if (off > ws_size) fprintf(stderr, "workspace too small: need %zu have %zu\n", off, ws_size);
#if COOP
  hipMemsetAsync(p.bar, 0, (size_t)XCD_BAR_WORDS * 4, stream);
  int lo = 0, hi = NPHASES, ub = 1;
  void* args[] = {&p, &lo, &hi, &ub};
  hipError_t e = hipLaunchCooperativeKernel((void*)mega_kernel, dim3(grid_blocks), dim3(NTHREADS), args, 0, stream);
  if (e != hipSuccess) fprintf(stderr, "cooperative launch failed: %s (grid %d)\n", hipGetErrorString(e), grid_blocks);
#else
  for (int ph = 0; ph < NPHASES; ++ph) mega_kernel<<<grid_blocks, NTHREADS, 0, stream>>>(p, ph, ph + 1, 0);
#endif
}
```

```cpp
#include <hip/hip_runtime.h>
#include <hip/hip_cooperative_groups.h>
#include <stdint.h>
#include <stdio.h>
namespace cg = cooperative_groups;

#ifndef COOP
#define COOP 1
#endif

typedef unsigned short bf16_t;
typedef __attribute__((ext_vector_type(8))) short bf16x8;
typedef __attribute__((ext_vector_type(16))) float f32x16;
typedef __attribute__((ext_vector_type(4))) unsigned int u32x4;
typedef __attribute__((ext_vector_type(2))) unsigned int u32x2;

constexpr int DM = 1024;
constexpr int NBATCH = 8;
constexpr int SEQL = 4096;
constexpr int LCTX = 256;
constexpr int NL = NBATCH * SEQL;
constexpr int NC = NBATCH * LCTX;
constexpr int NR = NL + NC;
constexpr int SMEM_BYTES = 72 * 1024;
constexpr int NTHREADS = 256;

struct Params {
  const float *x, *c, *ctx, *c_ctx, *norm_g, *w_mod, *b_mod, *ab_w_in, *a_ln_g, *a_ln_b, *a_w_s, *a_b_s,
      *b_sink, *ab_w_out, *c_w_in, *c_conv_w, *c_conv_b, *c_w_a, *c_b_a, *c_w_i, *c_b_i, *c_lam, *c_w_out,
      *final_g;
  float* out;
  float* xbuf;
  float* mods;
  bf16_t* hbuf;
  bf16_t* ebuf;
  bf16_t *wt_in_e, *wt_out_e, *wt_in_o, *wt_out_o, *wga, *wgi;
  unsigned* bar;
};

typedef __bf16 hwbf16x2 __attribute__((ext_vector_type(2)));
typedef float f32x2v __attribute__((ext_vector_type(2)));
__device__ __forceinline__ uint32_t pack2(float a, float b) {
  f32x2v v = {a, b};
  hwbf16x2 r = __builtin_convertvector(v, hwbf16x2);
  return __builtin_bit_cast(uint32_t, r);
}
__device__ __forceinline__ bf16_t f2bf(float f) { return (bf16_t)(pack2(f, f) & 0xffffu); }
__device__ __forceinline__ float bf2f(bf16_t b) { return __uint_as_float(((uint32_t)b) << 16); }
__device__ __forceinline__ float lo_bf(uint32_t u) { return __uint_as_float(u << 16); }
__device__ __forceinline__ float hi_bf(uint32_t u) { return __uint_as_float(u & 0xffff0000u); }
__device__ __forceinline__ float frcp(float x) { return __builtin_amdgcn_rcpf(x); }
__device__ __forceinline__ float silu_f(float x) { return x * frcp(1.f + __expf(-x)); }
__device__ __forceinline__ float sigmoid_f(float x) { return frcp(1.f + __expf(-x)); }
__device__ __forceinline__ float gelu_f(float x) {
  float y = 0.7978845608028654f * (x + 0.044715f * x * x * x);
  float t = 1.f - 2.f * frcp(1.f + __expf(2.f * y));
  return 0.5f * x * (1.f + t);
}
__device__ __forceinline__ f32x16 zero16() {
  f32x16 z;
#pragma unroll
  for (int i = 0; i < 16; ++i) z[i] = 0.f;
  return z;
}
__device__ __forceinline__ float wave_sum(float v) {
#pragma unroll
  for (int o = 32; o > 0; o >>= 1) v += __shfl_xor(v, o);
  return v;
}

__device__ __forceinline__ int otid() {
  int t = threadIdx.x;
  asm volatile("" : "+v"(t));
  return t;
}

struct EvenBufs {
  bf16_t *ug, *vg, *gas, *qb, *gbs, *kb, *vtl, *vtc;
};
__device__ __forceinline__ EvenBufs even_bufs(const Params& p) {
  EvenBufs e;
  e.ug = p.ebuf;
  e.vg = e.ug + (size_t)NR * 512;
  e.gas = e.vg + (size_t)NR * 512;
  e.qb = e.gas + (size_t)NR * 512;
  e.gbs = e.qb + (size_t)NR * 512;
  e.kb = e.gbs + (size_t)NR * 512;
  e.vtl = e.kb + (size_t)NR * 128;
  e.vtc = e.vtl + (size_t)NBATCH * 128 * SEQL;
  return e;
}
struct OddBufs {
  bf16_t *xr, *sg, *sb;
};
__device__ __forceinline__ OddBufs odd_bufs(const Params& p) {
  OddBufs o;
  o.xr = p.ebuf;
  o.sg = o.xr + (size_t)NR * 1024;
  o.sb = o.xr;
  return o;
}

__device__ void transpose_item(const Params& p, int item, char* smem) {
  float* tile = (float*)smem;
  const float* src;
  bf16_t* dst;
  int K, N, local;
  if (item < 1408) { src = p.ab_w_in; dst = p.wt_in_e; K = 1024; N = 2816; local = item; }
  else if (item < 1920) { src = p.ab_w_out; dst = p.wt_out_e; K = 1024; N = 1024; local = item - 1408; }
  else if (item < 2944) { src = p.c_w_in; dst = p.wt_in_o; K = 1024; N = 2048; local = item - 1920; }
  else if (item < 3456) { src = p.c_w_out; dst = p.wt_out_o; K = 1024; N = 1024; local = item - 2944; }
  else if (item < 3712) { src = p.c_w_a; dst = p.wga; K = 256; N = 256; local = item - 3456; }
  else { src = p.c_w_i; dst = p.wgi; K = 256; N = 256; local = item - 3712; }
  const int ntn = N / 64;
  const int tpb = (K / 64) * ntn;
  const int bi = local / tpb;
  const int rem = local % tpb;
  const int k0 = (rem / ntn) * 64, n0 = (rem % ntn) * 64;
  src += (size_t)bi * K * N;
  dst += (size_t)bi * K * N;
  const int tid = otid();
  __syncthreads();
#pragma unroll
  for (int i = 0; i < 16; ++i) {
    int rr = i * 4 + (tid >> 6), cc = tid & 63;
    tile[rr * 65 + cc] = src[(size_t)(k0 + rr) * N + n0 + cc];
  }
  __syncthreads();
#pragma unroll
  for (int i = 0; i < 16; ++i) {
    int n = i * 4 + (tid >> 6), k = tid & 63;
    dst[(size_t)(n0 + n) * K + k0 + k] = f2bf(tile[k * 65 + n]);
  }
}

__device__ void mods_item(const Params& p, int item, char* smem) {
  float* sc = (float*)smem;
  float* red = sc + 9 * 1024;
  const int tid = otid();
  const int l = item / 96, n0 = (item % 96) * 32;
  __syncthreads();
  for (int i = tid; i < 9 * 1024; i += NTHREADS) {
    int j = i >> 10, k = i & 1023;
    float v = (j < 8) ? p.c[j * 1024 + k] : p.c_ctx[k];
    sc[i] = silu_f(v);
  }
  __syncthreads();
  const int col = tid & 31, kg = tid >> 5;
  float acc[9];
#pragma unroll
  for (int j = 0; j < 9; ++j) acc[j] = 0.f;
  const float* w = p.w_mod + ((size_t)l * 1024 + kg * 128) * 3072 + n0 + col;
#pragma unroll 32
  for (int k = 0; k < 128; ++k) {
    float wv = w[(size_t)k * 3072];
#pragma unroll
    for (int j = 0; j < 9; ++j) acc[j] += sc[j * 1024 + kg * 128 + k] * wv;
  }
#pragma unroll
  for (int j = 0; j < 9; ++j) red[(kg * 9 + j) * 32 + col] = acc[j];
  __syncthreads();
  for (int i = tid; i < 9 * 32; i += NTHREADS) {
    int j = i >> 5, cc = i & 31;
    float s = 0.f;
#pragma unroll
    for (int g = 0; g < 8; ++g) s += red[(g * 9 + j) * 32 + cc];
    p.mods[((size_t)l * 9 + j) * 3072 + n0 + cc] = s + p.b_mod[l * 3072 + n0 + cc];
  }
}

__device__ void phase0(const Params& p, char* smem) {
  const int total = 3968 + 384;
  for (int item = blockIdx.x; item < total; item += gridDim.x) {
    if (item < 384) mods_item(p, item, smem);
    else transpose_item(p, item - 384, smem);
  }
}

__device__ void phase_prep(const Params& p, int layer) {
  const int tid = otid();
  const int lane = tid & 63;
  const int gw = blockIdx.x * 4 + (tid >> 6);
  const int nw = gridDim.x * 4;
  const float* ng = p.norm_g + layer * 1024;
  for (int R = gw; R < NR; R += nw) {
    const float* src;
    if (layer == 0) src = (R < NL) ? p.x + (size_t)R * 1024 : p.ctx + (size_t)(R - NL) * 1024;
    else src = p.xbuf + (size_t)R * 1024;
    const int bidx = (R < NL) ? (R >> 12) : 8;
    const float* md = p.mods + ((size_t)layer * 9 + bidx) * 3072;
    float4 v[4];
#pragma unroll
    for (int i = 0; i < 4; ++i) v[i] = ((const float4*)src)[lane + 64 * i];
    float ss = 0.f;
#pragma unroll
    for (int i = 0; i < 4; ++i) ss += v[i].x * v[i].x + v[i].y * v[i].y + v[i].z * v[i].z + v[i].w * v[i].w;
    ss = wave_sum(ss);
    const float rstd = rsqrtf(ss * (1.f / 1024.f) + 1e-6f);
#pragma unroll
    for (int i = 0; i < 4; ++i) {
      const int k4 = lane + 64 * i;
      float4 g = ((const float4*)ng)[k4];
      float4 sh = ((const float4*)md)[k4];
      float4 sc = ((const float4*)(md + 1024))[k4];
      float h0 = v[i].x * rstd * g.x * (1.f + sc.x) + sh.x;
      float h1 = v[i].y * rstd * g.y * (1.f + sc.y) + sh.y;
      float h2 = v[i].z * rstd * g.z * (1.f + sc.z) + sh.z;
      float h3 = v[i].w * rstd * g.w * (1.f + sc.w) + sh.w;
      u32x2 pk;
      pk.x = pack2(h0, h1);
      pk.y = pack2(h2, h3);
      *(u32x2*)(p.hbuf + (size_t)R * 1024 + k4 * 4) = pk;
      if (layer == 0) ((float4*)(p.xbuf + (size_t)R * 1024))[k4] = v[i];
    }
  }
}

__device__ void phase_final(const Params& p) {
  const int tid = otid();
  const int lane = tid & 63;
  const int gw = blockIdx.x * 4 + (tid >> 6);
  const int nw = gridDim.x * 4;
  for (int R = gw; R < NL; R += nw) {
    const float* src = p.xbuf + (size_t)R * 1024;
    float4 v[4];
#pragma unroll
    for (int i = 0; i < 4; ++i) v[i] = ((const float4*)src)[lane + 64 * i];
    float ss = 0.f;
#pragma unroll
    for (int i = 0; i < 4; ++i) ss += v[i].x * v[i].x + v[i].y * v[i].y + v[i].z * v[i].z + v[i].w * v[i].w;
    ss = wave_sum(ss);
    const float rstd = rsqrtf(ss * (1.f / 1024.f) + 1e-6f);
#pragma unroll
    for (int i = 0; i < 4; ++i) {
      const int k4 = lane + 64 * i;
      float4 g = ((const float4*)p.final_g)[k4];
      float4 o;
      o.x = v[i].x * rstd * g.x;
      o.y = v[i].y * rstd * g.y;
      o.z = v[i].z * rstd * g.z;
      o.w = v[i].w * rstd * g.w;
      ((float4*)(p.out + (size_t)R * 1024))[k4] = o;
    }
  }
}

constexpr int GS = 72;

__device__ __forceinline__ u32x4 add_bf16x8(u32x4 a, u32x4 b) {
  u32x4 r;
  r.x = pack2(lo_bf(a.x) + lo_bf(b.x), hi_bf(a.x) + hi_bf(b.x));
  r.y = pack2(lo_bf(a.y) + lo_bf(b.y), hi_bf(a.y) + hi_bf(b.y));
  r.z = pack2(lo_bf(a.z) + lo_bf(b.z), hi_bf(a.z) + hi_bf(b.z));
  r.w = pack2(lo_bf(a.w) + lo_bf(b.w), hi_bf(a.w) + hi_bf(b.w));
  return r;
}

template <int AMODE, class Epi>
__device__ void gemm_phase(const bf16_t* __restrict__ A0, const bf16_t* __restrict__ A1,
                           const bf16_t* __restrict__ Bt, int Mtiles, int Ntiles, char* smem, Epi epi) {
  constexpr int PD = (AMODE == 1) ? 1 : 2;
  constexpr int BUF = 2 * 128 * GS;
  bf16_t* S0 = (bf16_t*)smem;
  const int tid = otid(), lane = tid & 63, w = __builtin_amdgcn_readfirstlane(tid >> 6);
  const int wm = w >> 1, wn = w & 1;
  const int r = lane & 31, h = lane >> 5;
  const int lrow = tid >> 3, kc = tid & 7;
  const int total = Mtiles * Ntiles;
  const int woff = lrow * GS + kc * 8;
  const int aro = (wm * 64 + r) * GS + h * 8;
  const int bro = 128 * GS + (wn * 64 + r) * GS + h * 8;
  const bool swz = ((gridDim.x & 7) == 0) && ((Mtiles & 7) == 0);
  const int xcd = blockIdx.x & 7;
  const int Mx = Mtiles >> 3;
  const int lstart = swz ? (int)(blockIdx.x >> 3) : (int)blockIdx.x;
  const int lstep = swz ? (int)(gridDim.x >> 3) : (int)gridDim.x;
  const int lend = swz ? Mx * Ntiles : total;
  for (int L = lstart; L < lend; L += lstep) {
    int mt, nt;
    if (swz) {
      const int gfull = 8 * Ntiles;
      const int mg = L / gfull, rem = L - mg * gfull;
      const int gs = min(8, Mx - mg * 8);
      nt = rem / gs;
      mt = xcd * Mx + mg * 8 + (rem - nt * gs);
    } else {
      mt = L / Ntiles;
      nt = L - mt * Ntiles;
    }
    const int m0 = mt * 128, n0 = nt * 128;
    const size_t aoff = (size_t)(m0 + lrow) * 1024 + kc * 8;
    const bf16_t* ap = A0 + aoff;
    const bf16_t* ap1 = (AMODE == 1) ? (A1 + aoff) : A0;
    const bf16_t* bp = Bt + (size_t)(n0 + lrow) * 1024 + kc * 8;
    u32x4 ra[PD][4], ra1[PD][4], rb[PD][4];
#define G_LOAD(S, KT)                                                                              \
    {                                                                                              \
      _Pragma("unroll") for (int i = 0; i < 4; ++i) {                                              \
        ra[S][i] = *(const u32x4*)(ap + (size_t)i * 32 * 1024 + (KT) * 64);                        \
        if (AMODE == 1) ra1[S][i] = *(const u32x4*)(ap1 + (size_t)i * 32 * 1024 + (KT) * 64);     \
        rb[S][i] = *(const u32x4*)(bp + (size_t)i * 32 * 1024 + (KT) * 64);                        \
      }                                                                                            \
    }
#define L_WRITE(S, BUFI)                                                                           \
    {                                                                                              \
      bf16_t* dstA = S0 + (BUFI) * BUF + woff;                                                     \
      _Pragma("unroll") for (int i = 0; i < 4; ++i) {                                              \
        u32x4 av = ra[S][i];                                                                       \
        if (AMODE == 1) av = add_bf16x8(av, ra1[S][i]);                                            \
        *(u32x4*)(dstA + 32 * i * GS) = av;                                                        \
        *(u32x4*)(dstA + 128 * GS + 32 * i * GS) = rb[S][i];                                       \
      }                                                                                            \
    }
    G_LOAD(0, 0);
    L_WRITE(0, 0);
#pragma unroll
    for (int s = 0; s < PD; ++s) G_LOAD(s, 1 + s);
    f32x16 acc[2][2];
#pragma unroll
    for (int mi = 0; mi < 2; ++mi)
#pragma unroll
      for (int ni = 0; ni < 2; ++ni) acc[mi][ni] = zero16();
#pragma unroll 1
    for (int kt0 = 0; kt0 < 16; kt0 += 2) {
#pragma unroll
      for (int u = 0; u < 2; ++u) {
        const int kt = kt0 + u;
        constexpr int dummy = 0; (void)dummy;
        const int s = (PD == 2) ? u : 0;
        __syncthreads();
        L_WRITE(s, (u ^ 1));
        {
          const int ktl = (kt + 1 + PD < 16) ? (kt + 1 + PD) : 15;
          G_LOAD(s, ktl);
        }
        const bf16_t* Aw = S0 + u * BUF + aro;
        const bf16_t* Bw = S0 + u * BUF + bro;
#pragma unroll
        for (int ks = 0; ks < 4; ++ks) {
          bf16x8 a0 = *(const bf16x8*)(Aw + ks * 16);
          bf16x8 a1 = *(const bf16x8*)(Aw + 32 * GS + ks * 16);
          bf16x8 b0 = *(const bf16x8*)(Bw + ks * 16);
          bf16x8 b1 = *(const bf16x8*)(Bw + 32 * GS + ks * 16);
          acc[0][0] = __builtin_amdgcn_mfma_f32_32x32x16_bf16(a0, b0, acc[0][0], 0, 0, 0);
          acc[0][1] = __builtin_amdgcn_mfma_f32_32x32x16_bf16(a0, b1, acc[0][1], 0, 0, 0);
          acc[1][0] = __builtin_amdgcn_mfma_f32_32x32x16_bf16(a1, b0, acc[1][0], 0, 0, 0);
          acc[1][1] = __builtin_amdgcn_mfma_f32_32x32x16_bf16(a1, b1, acc[1][1], 0, 0, 0);
        }
      }
    }
#undef G_LOAD
#undef L_WRITE
    epi(acc, m0 + wm * 64, n0 + wn * 64, lane);
  }
}


struct EpiEvenIn {
  EvenBufs e;
  __device__ void operator()(f32x16 (&acc)[2][2], int rb, int cb, int lane) const {
    const int r = lane & 31, h = lane >> 5;
    if (cb < 1536 || cb >= 2304) {
      bf16_t* dst;
      int c0;
      int mode;
      if (cb < 512) { dst = e.ug; c0 = cb; mode = 0; }
      else if (cb < 1024) { dst = e.vg; c0 = cb - 512; mode = 0; }
      else if (cb < 1536) { dst = e.gas; c0 = cb - 1024; mode = 1; }
      else { dst = e.gbs; c0 = cb - 2304; mode = 1; }
#pragma unroll
      for (int mi = 0; mi < 2; ++mi)
#pragma unroll
        for (int ni = 0; ni < 2; ++ni)
#pragma unroll
          for (int reg = 0; reg < 16; ++reg) {
            const int row = rb + mi * 32 + (reg & 3) + 8 * (reg >> 2) + 4 * h;
            const int col = c0 + ni * 32 + r;
            float v = acc[mi][ni][reg];
            v = (mode == 0) ? gelu_f(v) : silu_f(v);
            dst[(size_t)row * 512 + col] = f2bf(v);
          }
    } else if (cb < 2176) {
      const bool isq = cb < 2048;
      bf16_t* dst = isq ? e.qb : e.kb;
      const int c0 = isq ? (cb - 1536) : (cb - 2048);
      const int ld = isq ? 512 : 128;
      const float scale = isq ? 0.125f : 1.f;
      const bool latent = rb < NL;
      const float inv_freq = exp2f(-(float)(r & 15) * 0.8304820237218406f);
#pragma unroll
      for (int mi = 0; mi < 2; ++mi)
#pragma unroll
        for (int reg = 0; reg < 16; ++reg) {
          const int row = rb + mi * 32 + (reg & 3) + 8 * (reg >> 2) + 4 * h;
          float x1 = acc[mi][0][reg], x2 = acc[mi][1][reg];
          float o1 = x1, o2 = x2;
          if (latent) {
            const int t = row & (SEQL - 1);
            const float pos = (float)((r < 16) ? (t >> 6) : (t & 63));
            const float ang = pos * inv_freq;
            const float cs = __cosf(ang), sn = __sinf(ang);
            o1 = x1 * cs - x2 * sn;
            o2 = x2 * cs + x1 * sn;
          }
          dst[(size_t)row * ld + c0 + r] = f2bf(o1 * scale);
          dst[(size_t)row * ld + c0 + 32 + r] = f2bf(o2 * scale);
        }
    } else {
      const int kvh = (cb - 2176) >> 6;
      const bool latent = rb < NL;
#pragma unroll
      for (int mi = 0; mi < 2; ++mi)
#pragma unroll
        for (int ni = 0; ni < 2; ++ni)
#pragma unroll
          for (int q4 = 0; q4 < 4; ++q4) {
            const int row = rb + mi * 32 + 8 * q4 + 4 * h;
            const int d = ni * 32 + r;
            u32x2 pk;
            pk.x = pack2(acc[mi][ni][q4 * 4 + 0], acc[mi][ni][q4 * 4 + 1]);
            pk.y = pack2(acc[mi][ni][q4 * 4 + 2], acc[mi][ni][q4 * 4 + 3]);
            if (latent) {
              const int b = row >> 12, t = row & (SEQL - 1);
              *(u32x2*)(e.vtl + ((size_t)((b * 2 + kvh) * 64 + d)) * SEQL + t) = pk;
            } else {
              const int rr = row - NL;
              const int b = rr >> 8, t = rr & (LCTX - 1);
              *(u32x2*)(e.vtc + ((size_t)((b * 2 + kvh) * 64 + d)) * LCTX + t) = pk;
            }
          }
    }
  }
};

struct EpiOddIn {
  OddBufs o;
  __device__ void operator()(f32x16 (&acc)[2][2], int rb, int cb, int lane) const {
    const int r = lane & 31, h = lane >> 5;
    const bool isg = cb >= 1024;
    bf16_t* dst = isg ? o.sg : o.xr;
    const int c0 = isg ? cb - 1024 : cb;
#pragma unroll
    for (int mi = 0; mi < 2; ++mi)
#pragma unroll
      for (int ni = 0; ni < 2; ++ni)
#pragma unroll
        for (int reg = 0; reg < 16; ++reg) {
          const int row = rb + mi * 32 + (reg & 3) + 8 * (reg >> 2) + 4 * h;
          const int col = c0 + ni * 32 + r;
          float v = acc[mi][ni][reg];
          if (isg) v = silu_f(v);
          dst[(size_t)row * 1024 + col] = f2bf(v);
        }
  }
};

struct EpiOut {
  float* xbuf;
  const float* mods_l;
  __device__ void operator()(f32x16 (&acc)[2][2], int rb, int cb, int lane) const {
    const int r = lane & 31, h = lane >> 5;
    const int bidx = (rb < NL) ? (rb >> 12) : 8;
    const float* gate = mods_l + (size_t)bidx * 3072 + 2048;
#pragma unroll
    for (int ni = 0; ni < 2; ++ni) {
      const int col = cb + ni * 32 + r;
      const float gv = gate[col];
#pragma unroll
      for (int mi = 0; mi < 2; ++mi)
#pragma unroll
        for (int reg = 0; reg < 16; ++reg) {
          const int row = rb + mi * 32 + (reg & 3) + 8 * (reg >> 2) + 4 * h;
          float* px = xbuf + (size_t)row * 1024 + col;
          *px = *px + gv * acc[mi][ni][reg];
        }
    }
  }
};

constexpr int AS = 72;

__device__ void attn_item(const Params& p, const EvenBufs& e, int item, char* smem, int ei) {
  bf16_t* Ks = (bf16_t*)smem;
  bf16_t* Vs = Ks + 64 * AS;
  const int tid = otid(), lane = tid & 63, w = __builtin_amdgcn_readfirstlane(tid >> 6);
  const int r = lane & 31, h = lane >> 5;
  int b, hq, start, R0;
  bool isctx;
  if (item < 2048) {
    b = item >> 8;
    hq = (item >> 5) & 7;
    const int qblk = item & 31;
    start = qblk * 128;
    R0 = b * SEQL + start;
    isctx = false;
  } else {
    const int it = item - 2048;
    b = it >> 4;
    hq = (it >> 1) & 7;
    start = (it & 1) * 128;
    R0 = NL + b * LCTX + start;
    isctx = true;
  }
  const int kvh = hq >> 2;
  const int qrow = R0 + w * 32 + r;
  bf16x8 qf[4];
#pragma unroll
  for (int s = 0; s < 4; ++s) qf[s] = *(const bf16x8*)(e.qb + (size_t)qrow * 512 + hq * 64 + s * 16 + h * 8);
  float m = p.b_sink[ei * 8 + hq], l = 1.f;
  f32x16 o[2];
  o[0] = zero16();
  o[1] = zero16();
  const int nblk = isctx ? 4 : 10;
  auto kb_desc = [&](int kb, const bf16_t*& kp, const bf16_t*& vp, int& vstride, int& kpos0, bool& local) -> bool {
    if (kb < 4) {
      kp = e.kb + (size_t)(NL + b * LCTX + kb * 64) * 128 + kvh * 64;
      vp = e.vtc + (size_t)((b * 2 + kvh) * 64) * LCTX + kb * 64;
      vstride = LCTX; kpos0 = 0; local = false;
      return true;
    }
    kpos0 = start - 128 + (kb - 4) * 64;
    local = true;
    if (kpos0 < 0 || kpos0 >= SEQL) return false;
    kp = e.kb + (size_t)(b * SEQL + kpos0) * 128 + kvh * 64;
    vp = e.vtl + (size_t)((b * 2 + kvh) * 64) * SEQL + kpos0;
    vstride = SEQL;
    return true;
  };
  const int lr0 = tid >> 3, lc0 = tid & 7;
  u32x4 pk0, pk1, pv0, pv1;
  int kbn = 0;
  {
    const bf16_t *kp, *vp; int vs, kp0; bool lc;
    while (!kb_desc(kbn, kp, vp, vs, kp0, lc)) ++kbn;
    pk0 = *(const u32x4*)(kp + (size_t)lr0 * 128 + lc0 * 8);
    pk1 = *(const u32x4*)(kp + (size_t)(lr0 + 32) * 128 + lc0 * 8);
    pv0 = *(const u32x4*)(vp + (size_t)lr0 * vs + lc0 * 8);
    pv1 = *(const u32x4*)(vp + (size_t)(lr0 + 32) * vs + lc0 * 8);
  }
  while (kbn < nblk) {
    const int kb = kbn;
    int kpos0 = 0;
    bool local = false;
    {
      const bf16_t *kp, *vp; int vs;
      kb_desc(kb, kp, vp, vs, kpos0, local);
    }
    __syncthreads();
    *(u32x4*)(Ks + lr0 * AS + lc0 * 8) = pk0;
    *(u32x4*)(Ks + (lr0 + 32) * AS + lc0 * 8) = pk1;
    *(u32x4*)(Vs + lr0 * AS + lc0 * 8) = pv0;
    *(u32x4*)(Vs + (lr0 + 32) * AS + lc0 * 8) = pv1;
    __syncthreads();
    {
      const bf16_t *kp = nullptr, *vp = nullptr; int vs = 0, kp0; bool lc;
      ++kbn;
      while (kbn < nblk && !kb_desc(kbn, kp, vp, vs, kp0, lc)) ++kbn;
      if (kbn < nblk) {
        pk0 = *(const u32x4*)(kp + (size_t)lr0 * 128 + lc0 * 8);
        pk1 = *(const u32x4*)(kp + (size_t)(lr0 + 32) * 128 + lc0 * 8);
        pv0 = *(const u32x4*)(vp + (size_t)lr0 * vs + lc0 * 8);
        pv1 = *(const u32x4*)(vp + (size_t)(lr0 + 32) * vs + lc0 * 8);
      }
    }
    f32x16 s[2];
#pragma unroll
    for (int kt = 0; kt < 2; ++kt) {
      s[kt] = zero16();
#pragma unroll
      for (int ks = 0; ks < 4; ++ks) {
        bf16x8 a = *(const bf16x8*)(Ks + (kt * 32 + r) * AS + ks * 16 + h * 8);
        s[kt] = __builtin_amdgcn_mfma_f32_32x32x16_bf16(a, qf[ks], s[kt], 0, 0, 0);
      }
    }
    if (local) {
      const int qpos = start + w * 32 + r;
#pragma unroll
      for (int kt = 0; kt < 2; ++kt)
#pragma unroll
        for (int reg = 0; reg < 16; ++reg) {
          const int kpos = kpos0 + kt * 32 + (reg & 3) + 8 * (reg >> 2) + 4 * h;
          const int diff = qpos - kpos;
          if (diff > 128 || diff < -128) s[kt][reg] = -1e30f;
        }
    }
    float mx = m;
#pragma unroll
    for (int kt = 0; kt < 2; ++kt)
#pragma unroll
      for (int reg = 0; reg < 16; ++reg) mx = fmaxf(mx, s[kt][reg]);
    mx = fmaxf(mx, __shfl_xor(mx, 32));
    const float alpha = __expf(m - mx);
    m = mx;
    float rs = 0.f;
#pragma unroll
    for (int kt = 0; kt < 2; ++kt)
#pragma unroll
      for (int reg = 0; reg < 16; ++reg) {
        const float pv = __expf(s[kt][reg] - mx);
        rs += pv;
        s[kt][reg] = pv;
      }
    rs += __shfl_xor(rs, 32);
    l = l * alpha + rs;
#pragma unroll
    for (int dt = 0; dt < 2; ++dt)
#pragma unroll
      for (int reg = 0; reg < 16; ++reg) o[dt][reg] *= alpha;
#pragma unroll
    for (int kt = 0; kt < 2; ++kt)
#pragma unroll
      for (int sp = 0; sp < 2; ++sp) {
        union { bf16x8 v; uint32_t u[4]; } pf;
#pragma unroll
        for (int j = 0; j < 4; ++j) pf.u[j] = pack2(s[kt][8 * sp + 2 * j], s[kt][8 * sp + 2 * j + 1]);
#pragma unroll
        for (int dt = 0; dt < 2; ++dt) {
          const bf16_t* vp = Vs + (dt * 32 + r) * AS + kt * 32 + sp * 16 + 4 * h;
          union { bf16x8 v; u32x2 u[2]; } af;
          af.u[0] = *(const u32x2*)(vp);
          af.u[1] = *(const u32x2*)(vp + 8);
          o[dt] = __builtin_amdgcn_mfma_f32_32x32x16_bf16(af.v, pf.v, o[dt], 0, 0, 0);
        }
      }
  }
  const float inv = 1.f / l;
  bf16_t* ymix = p.hbuf;
#pragma unroll
  for (int dt = 0; dt < 2; ++dt)
#pragma unroll
    for (int q4 = 0; q4 < 4; ++q4) {
      const int d0 = dt * 32 + 8 * q4 + 4 * h;
      const u32x2 g = *(const u32x2*)(e.gbs + (size_t)qrow * 512 + hq * 64 + d0);
      u32x2 pk;
      pk.x = pack2(o[dt][q4 * 4 + 0] * inv * lo_bf(g.x), o[dt][q4 * 4 + 1] * inv * hi_bf(g.x));
      pk.y = pack2(o[dt][q4 * 4 + 2] * inv * lo_bf(g.y), o[dt][q4 * 4 + 3] * inv * hi_bf(g.y));
      *(u32x2*)(ymix + (size_t)qrow * 1024 + 512 + hq * 64 + d0) = pk;
    }
}

constexpr int MS = 136;

__device__ void gmlp_item(const Params& p, const EvenBufs& e, int item, char* smem, int ei) {
  bf16_t* Ws = (bf16_t*)smem;
  bf16_t* VT = Ws + 128 * MS;
  const int tid = otid(), lane = tid & 63, w = __builtin_amdgcn_readfirstlane(tid >> 6);
  const int r = lane & 31, h = lane >> 5;
  const int wm = w >> 1, wn = w & 1;
  const int rt = item >> 2, g = item & 3;
  const int R0 = rt * 128;
  __syncthreads();
  {
    const float4* wsrc = (const float4*)(p.a_w_s + (size_t)(ei * 4 + g) * 128 * 128);
#pragma unroll
    for (int i = 0; i < 16; ++i) {
      const int idx = tid + 256 * i;
      const int pp = idx >> 5, q4 = idx & 31;
      float4 v = wsrc[idx];
      u32x2 pk;
      pk.x = pack2(v.x, v.y);
      pk.y = pack2(v.z, v.w);
      *(u32x2*)(Ws + pp * MS + q4 * 4) = pk;
    }
  }
#pragma unroll 1
  for (int hp = 0; hp < 2; ++hp) {
    const int q = hp * 64 + (tid >> 2), qt = tid & 3;
    const bf16_t* vsrc = e.vg + (size_t)(R0 + q) * 512 + g * 128 + qt * 32;
    float xv[32];
#pragma unroll
    for (int i = 0; i < 4; ++i) {
      u32x4 u = *(const u32x4*)(vsrc + i * 8);
      xv[i * 8 + 0] = lo_bf(u.x); xv[i * 8 + 1] = hi_bf(u.x);
      xv[i * 8 + 2] = lo_bf(u.y); xv[i * 8 + 3] = hi_bf(u.y);
      xv[i * 8 + 4] = lo_bf(u.z); xv[i * 8 + 5] = hi_bf(u.z);
      xv[i * 8 + 6] = lo_bf(u.w); xv[i * 8 + 7] = hi_bf(u.w);
    }
    float sm = 0.f;
#pragma unroll
    for (int j = 0; j < 32; ++j) sm += xv[j];
    sm += __shfl_xor(sm, 1);
    sm += __shfl_xor(sm, 2);
    const float mean = sm * (1.f / 128.f);
    float sq = 0.f;
#pragma unroll
    for (int j = 0; j < 32; ++j) { float dlt = xv[j] - mean; sq += dlt * dlt; }
    sq += __shfl_xor(sq, 1);
    sq += __shfl_xor(sq, 2);
    const float rstd = rsqrtf(sq * (1.f / 128.f) + 1e-6f);
    const float* lg = p.a_ln_g + ei * 512 + g * 128 + qt * 32;
    const float* lb = p.a_ln_b + ei * 512 + g * 128 + qt * 32;
#pragma unroll
    for (int j = 0; j < 32; ++j) {
      const float val = (xv[j] - mean) * rstd * lg[j] + lb[j];
      VT[(qt * 32 + j) * MS + q] = f2bf(val);
    }
  }
  __syncthreads();
  f32x16 acc[2][2];
#pragma unroll
  for (int mi = 0; mi < 2; ++mi)
#pragma unroll
    for (int ni = 0; ni < 2; ++ni) acc[mi][ni] = zero16();
  const bf16_t* Aw = Ws + (wm * 64 + r) * MS + h * 8;
  const bf16_t* Bw = VT + (wn * 64 + r) * MS + h * 8;
#pragma unroll
  for (int ks = 0; ks < 8; ++ks) {
    bf16x8 a0 = *(const bf16x8*)(Aw + ks * 16);
    bf16x8 a1 = *(const bf16x8*)(Aw + 32 * MS + ks * 16);
    bf16x8 b0 = *(const bf16x8*)(Bw + ks * 16);
    bf16x8 b1 = *(const bf16x8*)(Bw + 32 * MS + ks * 16);
    acc[0][0] = __builtin_amdgcn_mfma_f32_32x32x16_bf16(a0, b0, acc[0][0], 0, 0, 0);
    acc[0][1] = __builtin_amdgcn_mfma_f32_32x32x16_bf16(a0, b1, acc[0][1], 0, 0, 0);
    acc[1][0] = __builtin_amdgcn_mfma_f32_32x32x16_bf16(a1, b0, acc[1][0], 0, 0, 0);
    acc[1][1] = __builtin_amdgcn_mfma_f32_32x32x16_bf16(a1, b1, acc[1][1], 0, 0, 0);
  }
  bf16_t* ymix = p.hbuf;
  const float* bs = p.a_b_s + (ei * 4 + g) * 128;
#pragma unroll
  for (int mi = 0; mi < 2; ++mi)
#pragma unroll
    for (int reg = 0; reg < 16; ++reg) {
      const int prow = wm * 64 + mi * 32 + (reg & 3) + 8 * (reg >> 2) + 4 * h;
      const float bsv = bs[prow];
      const size_t row = (size_t)(R0 + prow);
#pragma unroll
      for (int ni = 0; ni < 2; ++ni) {
        const int col = g * 128 + wn * 64 + ni * 32 + r;
        const float sv = acc[mi][ni][reg] + bsv;
        const float y = bf2f(e.ug[row * 512 + col]) * sv * bf2f(e.gas[row * 512 + col]);
        ymix[row * 1024 + col] = f2bf(y);
      }
    }
}

__device__ void phase_even_mix(const Params& p, char* smem, int ei) {
  const EvenBufs e = even_bufs(p);
  const int n_attn = 2048 + 128, n_gmlp = 1088;
  for (int item = blockIdx.x; item < n_attn + n_gmlp; item += gridDim.x) {
    if (item < n_attn) attn_item(p, e, item, smem, ei);
    else gmlp_item(p, e, item - n_attn, smem, ei);
  }
}

__device__ void phase_conv(const Params& p, int oi) {
  const OddBufs ob = odd_bufs(p);
  const bf16_t* xr = ob.xr;
  bf16_t* zb = ob.sg + (size_t)NR * 1024;
  const int tid = otid();
  const int total = (NR / 8) * 128;
  for (int id = blockIdx.x * NTHREADS + tid; id < total; id += gridDim.x * NTHREADS) {
    const int chunk = id & 127, rg = id >> 7;
    const int R0 = rg * 8;
    int t0, Ls;
    if (R0 < NL) { t0 = R0 & (SEQL - 1); Ls = SEQL; } else { t0 = (R0 - NL) & (LCTX - 1); Ls = LCTX; }
    const int chb = chunk * 8;
    float cw[4][8], cbias[8];
#pragma unroll
    for (int j = 0; j < 4; ++j) {
      const float4 w0 = *(const float4*)(p.c_conv_w + ((size_t)oi * 4 + j) * 1024 + chb);
      const float4 w1 = *(const float4*)(p.c_conv_w + ((size_t)oi * 4 + j) * 1024 + chb + 4);
      cw[j][0] = w0.x; cw[j][1] = w0.y; cw[j][2] = w0.z; cw[j][3] = w0.w;
      cw[j][4] = w1.x; cw[j][5] = w1.y; cw[j][6] = w1.z; cw[j][7] = w1.w;
    }
    {
      const float4 b0 = *(const float4*)(p.c_conv_b + oi * 1024 + chb);
      const float4 b1 = *(const float4*)(p.c_conv_b + oi * 1024 + chb + 4);
      cbias[0] = b0.x; cbias[1] = b0.y; cbias[2] = b0.z; cbias[3] = b0.w;
      cbias[4] = b1.x; cbias[5] = b1.y; cbias[6] = b1.z; cbias[7] = b1.w;
    }
    float xw[11][8];
#pragma unroll
    for (int jj = 0; jj < 11; ++jj) {
      const int t = t0 - 2 + jj;
      u32x4 u = (u32x4){0u, 0u, 0u, 0u};
      if (t >= 0 && t < Ls) u = *(const u32x4*)(xr + (size_t)(R0 - 2 + jj) * 1024 + chb);
      xw[jj][0] = lo_bf(u.x); xw[jj][1] = hi_bf(u.x);
      xw[jj][2] = lo_bf(u.y); xw[jj][3] = hi_bf(u.y);
      xw[jj][4] = lo_bf(u.z); xw[jj][5] = hi_bf(u.z);
      xw[jj][6] = lo_bf(u.w); xw[jj][7] = hi_bf(u.w);
    }
#pragma unroll
    for (int i = 0; i < 8; ++i) {
      float z[8];
#pragma unroll
      for (int e2 = 0; e2 < 8; ++e2) {
        float a = cbias[e2];
#pragma unroll
        for (int j = 0; j < 4; ++j) a += cw[j][e2] * xw[i + j][e2];
        z[e2] = a;
      }
      u32x4 pk;
      pk.x = pack2(z[0], z[1]); pk.y = pack2(z[2], z[3]);
      pk.z = pack2(z[4], z[5]); pk.w = pack2(z[6], z[7]);
      *(u32x4*)(zb + (size_t)(R0 + i) * 1024 + chb) = pk;
    }
  }
}

constexpr int ZS = 264;

template <int DIR>
__device__ void rglru_item(const Params& p, const OddBufs& ob, int item, char* smem, int oi, bool need_ctx) {
  bf16_t* Zs = (bf16_t*)smem;
  float* segA = (float*)(Zs + 128 * ZS);
  float* segB = segA + 256;
  float* carry = segB + 256;
  float* La = (float*)Zs;
  float* Gz = La + 4096;
  const int tid = otid(), lane = tid & 63, w = __builtin_amdgcn_readfirstlane(tid >> 6);
  const int r = lane & 31, h = lane >> 5;
  const int wm = w >> 1, wn = w & 1;
  const int b = item >> 6, cs = item & 31;
  constexpr int dir = DIR;
  const int hd = cs >> 3, j0 = (cs & 7) * 32, c0 = cs * 32;
  bf16_t* sout = dir ? ob.sb : p.hbuf;
  const bf16_t* zb = ob.sg + (size_t)NR * 1024;
  __syncthreads();
  if (tid < 32) carry[tid] = 0.f;
  bf16x8 bfr[16];
  {
    const size_t mo = ((size_t)((oi * 2 + dir) * 4 + hd)) * 65536 + (size_t)(j0 + r) * 256 + h * 8;
    const bf16_t* wsrc = (wn ? p.wgi : p.wga) + mo;
#pragma unroll
    for (int ks = 0; ks < 16; ++ks) bfr[ks] = *(const bf16x8*)(wsrc + ks * 16);
  }
  const int gch = (oi * 2 + dir) * 1024 + c0 + r;
  const float gbias = wn ? p.c_b_i[gch] : p.c_b_a[gch];
  const float spl = log1pf(__expf(-p.c_lam[gch]));
  const int sc_c = tid & 31, sc_sg = tid >> 5;
  const int lrow = tid >> 5, kc = tid & 31;

  u32x4 zt[4];
  {
    const int Rs0 = NL + b * LCTX;
    const int ti0 = dir ? 1 : 0;
    const bf16_t* src = zb + (size_t)(Rs0 + ti0 * 128 + lrow) * 1024 + hd * 256 + kc * 8;
#pragma unroll
    for (int i = 0; i < 4; ++i) zt[i] = *(const u32x4*)(src + (size_t)i * 8 * 1024);
  }
  const int sbase = DIR ? (7 - sc_sg) * 16 : sc_sg * 16;
  const unsigned voff = (unsigned)(sbase * 1024 + c0 + sc_c);
  for (int step = 0; step < 34; ++step) {
    int Rs, ti;
    bool wr;
    if (step < 2) { Rs = NL + b * LCTX; ti = dir ? 1 - step : step; wr = need_ctx; }
    else { Rs = b * SEQL; ti = dir ? 31 - (step - 2) : (step - 2); wr = true; }
    const int t0 = ti * 128;
    __syncthreads();
    {
      const bf16_t* src2 = zb + (size_t)(Rs + t0 + lrow + 32) * 1024 + hd * 256 + kc * 8;
      u32x4 z2[12];
#pragma unroll
      for (int i = 0; i < 12; ++i) z2[i] = *(const u32x4*)(src2 + (size_t)i * 8 * 1024);
#pragma unroll
      for (int i = 0; i < 4; ++i) *(u32x4*)(Zs + (lrow + 8 * i) * ZS + kc * 8) = zt[i];
#pragma unroll
      for (int i = 0; i < 12; ++i) *(u32x4*)(Zs + (lrow + 32 + 8 * i) * ZS + kc * 8) = z2[i];
    }
    const bf16_t* sgp = ob.sg + (size_t)(Rs + t0) * 1024;
    bf16_t sgv[16];
    if (wr) {
#pragma unroll
      for (int i = 0; i < 16; ++i) sgv[i] = sgp[voff + (DIR ? 15 - i : i) * 1024];
    }
    __syncthreads();
    f32x16 acc[2];
    acc[0] = zero16();
    acc[1] = zero16();
    {
      const bf16_t* Aw = Zs + (wm * 64 + r) * ZS + h * 8;
#pragma unroll
      for (int ks = 0; ks < 16; ++ks) {
        bf16x8 a0 = *(const bf16x8*)(Aw + ks * 16);
        bf16x8 a1 = *(const bf16x8*)(Aw + 32 * ZS + ks * 16);
        acc[0] = __builtin_amdgcn_mfma_f32_32x32x16_bf16(a0, bfr[ks], acc[0], 0, 0, 0);
        acc[1] = __builtin_amdgcn_mfma_f32_32x32x16_bf16(a1, bfr[ks], acc[1], 0, 0, 0);
      }
    }
    if (wn == 0) {
#pragma unroll
      for (int mi = 0; mi < 2; ++mi)
#pragma unroll
        for (int reg = 0; reg < 16; ++reg) acc[mi][reg] = -8.f * spl * sigmoid_f(acc[mi][reg] + gbias);
    } else {
#pragma unroll
      for (int mi = 0; mi < 2; ++mi) {
        float zv[16];
#pragma unroll
        for (int reg = 0; reg < 16; ++reg) {
          const int row = wm * 64 + mi * 32 + (reg & 3) + 8 * (reg >> 2) + 4 * h;
          zv[reg] = bf2f(Zs[row * ZS + j0 + r]);
        }
#pragma unroll
        for (int reg = 0; reg < 16; ++reg) acc[mi][reg] = zv[reg] * sigmoid_f(acc[mi][reg] + gbias);
        asm volatile("" ::: "memory");
      }
    }
    __syncthreads();
    {
      float* dstb = wn ? Gz : La;
#pragma unroll
      for (int mi = 0; mi < 2; ++mi)
#pragma unroll
        for (int reg = 0; reg < 16; ++reg) {
          const int row = wm * 64 + mi * 32 + (reg & 3) + 8 * (reg >> 2) + 4 * h;
          dstb[row * 32 + r] = acc[mi][reg];
        }
    }
    __syncthreads();
    if (step + 1 < 34) {
      const int ns = step + 1;
      int nRs, nti;
      if (ns < 2) { nRs = NL + b * LCTX; nti = dir ? 1 - ns : ns; }
      else { nRs = b * SEQL; nti = dir ? 31 - (ns - 2) : (ns - 2); }
      const bf16_t* src = zb + (size_t)(nRs + nti * 128 + lrow) * 1024 + hd * 256 + kc * 8;
#pragma unroll
      for (int i = 0; i < 4; ++i) zt[i] = *(const u32x4*)(src + (size_t)i * 8 * 1024);
    }
    bf16_t* sop = sout + (size_t)(Rs + t0) * 1024;
    const float* Lap = La + sbase * 32 + sc_c;
    const float* Gzp = Gz + sbase * 32 + sc_c;
    {
      float A = 1.f, Bv = 0.f;
      float* Law = La + sbase * 32 + sc_c;
      float* Gzw = Gz + sbase * 32 + sc_c;
#pragma unroll
      for (int i = 0; i < 16; ++i) {
        const int ro = (DIR ? 15 - i : i) * 32;
        const float la = Lap[ro];
        const float a = __expf(la);
        const float mult = __builtin_amdgcn_sqrtf(fmaf(-a, a, 1.f));
        const float bx = mult * Gzp[ro];
        Law[ro] = a;
        Gzw[ro] = bx;
        Bv = a * Bv + bx;
        A *= a;
      }
      segA[sc_sg * 32 + sc_c] = A;
      segB[sc_sg * 32 + sc_c] = Bv;
    }
    __syncthreads();
    {
      float hh = carry[(step & 1) * 32 + sc_c];
      {
        float sa[7], sbv[7];
#pragma unroll
        for (int s2 = 0; s2 < 7; ++s2) { sa[s2] = segA[s2 * 32 + sc_c]; sbv[s2] = segB[s2 * 32 + sc_c]; }
#pragma unroll
        for (int s2 = 0; s2 < 7; ++s2) hh = (s2 < sc_sg) ? (sa[s2] * hh + sbv[s2]) : hh;
      }
#pragma unroll
      for (int i = 0; i < 16; ++i) {
        const int ro = (DIR ? 15 - i : i);
        hh = Lap[ro * 32] * hh + Gzp[ro * 32];
        if (wr) sop[voff + ro * 1024] = f2bf(hh * bf2f(sgv[i]));
      }
      if (sc_sg == 7) carry[((step + 1) & 1) * 32 + sc_c] = hh;
    }
  }
}

__device__ void phase_rglru(const Params& p, char* smem, int oi, bool need_ctx) {
  const OddBufs ob = odd_bufs(p);
  for (int it0 = blockIdx.x; it0 < 512; it0 += gridDim.x) {
    const int xcd = it0 & 7, slot = it0 >> 3;
    const int grp = xcd * 4 + (slot >> 4), j = slot & 15;
    const int item = ((grp >> 2) << 6) | ((j >> 3) << 5) | ((grp & 3) << 3) | (j & 7);
    if ((item >> 5) & 1) rglru_item<1>(p, ob, item, smem, oi, need_ctx);
    else rglru_item<0>(p, ob, item, smem, oi, need_ctx);
  }
}

#define XB_TMO      128
#define XB_XCNT(j)  (256  + 64 * (j))
#define XB_XSUB(j)  (1280 + 64 * (j))
#define XB_XGEN(j)  (2304 + 64 * (j))
#define XB_TOP      3328
#define XB_TOPGEN   3392
#define XCD_BAR_WORDS 3456
#define XB_SPIN_CAP (1u << 18)
#define LAS __attribute__((address_space(3)))

__device__ __forceinline__ unsigned xb_ld(unsigned* p)              { return __hip_atomic_load(p, __ATOMIC_RELAXED, __HIP_MEMORY_SCOPE_AGENT); }
__device__ __forceinline__ unsigned xb_add(unsigned* p, unsigned v) { return __hip_atomic_fetch_add(p, v, __ATOMIC_RELAXED, __HIP_MEMORY_SCOPE_AGENT); }
__device__ __forceinline__ unsigned xb_xcc_id() { return (unsigned)__builtin_amdgcn_s_getreg((3 << 11) | 20) & 0xFu; }
#define XB_SPIN(cond, bar) do { unsigned _sp = 0; while (cond) { __builtin_amdgcn_s_sleep(1); \
    if ((++_sp & 255u) == 0u) { if (xb_ld(&(bar)[XB_TMO])) break; if (_sp > XB_SPIN_CAP) { atomicAdd(&(bar)[XB_TMO], 1u); break; } } } } while (0)

struct XcdBarrier {
    unsigned* bar; unsigned x;
    volatile LAS unsigned* st;
};

__device__ __forceinline__ XcdBarrier xcd_barrier_post(unsigned* bar, volatile LAS unsigned* st) {
    XcdBarrier b; b.bar = bar; b.x = xb_xcc_id(); b.st = st;
    if (threadIdx.x == 0) (void)xb_add(&bar[XB_XCNT(b.x)], 1u);
    return b;
}
__device__ __forceinline__ void xcd_barrier_complete(unsigned* bar, unsigned x, unsigned& nloc, unsigned& nx) {
    const unsigned G = gridDim.x * gridDim.y * gridDim.z;
    unsigned sum, cnt, mine, sp = 0u;
    for (;;) {
        sum = 0u; cnt = 0u; mine = 0u;
#pragma unroll
        for (unsigned j = 0; j < 16; ++j) { const unsigned c = xb_ld(&bar[XB_XCNT(j)]); sum += c; cnt += (c > 0u) ? 1u : 0u; mine = (j == x) ? c : mine; }
        if (sum == G) break;
        __builtin_amdgcn_s_sleep(1);
        if ((++sp & 255u) == 0u) { if (xb_ld(&bar[XB_TMO])) break; if (sp > XB_SPIN_CAP) { atomicAdd(&bar[XB_TMO], 1u); break; } }
    }
    nloc = mine > 0u ? mine : 1u; nx = cnt > 0u ? cnt : 1u;
}

__device__ __forceinline__ void xcd_barrier(const XcdBarrier& b) {
    asm volatile("s_waitcnt vmcnt(0)" ::: "memory");
    __syncthreads();
    if (threadIdx.x == 0) {
        unsigned* bar = b.bar;
        __builtin_amdgcn_s_waitcnt(0);
        unsigned nloc = b.st[0], nx = b.st[1];
        if (nloc == 0u) { xcd_barrier_complete(bar, b.x, nloc, nx); b.st[0] = nloc; b.st[1] = nx; }
        const unsigned old = xb_add(&bar[XB_XSUB(b.x)], 1u);
        const unsigned gen = old / nloc;
        if (old + 1u == (gen + 1u) * nloc) {
            __builtin_amdgcn_fence(__ATOMIC_RELEASE, "agent");
            asm volatile("s_waitcnt vmcnt(0)" ::: "memory");
            const unsigned og = xb_add(&bar[XB_TOP], 1u);
            const unsigned tg = og / nx;
            if (og + 1u == (tg + 1u) * nx) xb_add(&bar[XB_TOPGEN], 1u);
            else XB_SPIN(xb_ld(&bar[XB_TOPGEN]) == tg, bar);
            __builtin_amdgcn_fence(__ATOMIC_ACQUIRE, "agent");
            xb_add(&bar[XB_XGEN(b.x)], 1u);
            asm volatile("s_waitcnt vmcnt(0)" ::: "memory");
        } else {
            XB_SPIN(xb_ld(&bar[XB_XGEN(b.x)]) == gen, bar);
            __builtin_amdgcn_fence(__ATOMIC_ACQUIRE, "agent");
            asm volatile("s_waitcnt vmcnt(0)" ::: "memory");
        }
    }
    __syncthreads();
}


#define LAUNDER(f) q.f = p.f + z
__device__ __forceinline__ void launder(Params& q, const Params& p) {
  long z;
  asm volatile("s_mov_b64 %0, 0" : "=s"(z));
  LAUNDER(x); LAUNDER(c); LAUNDER(ctx); LAUNDER(c_ctx); LAUNDER(norm_g); LAUNDER(w_mod); LAUNDER(b_mod);
  LAUNDER(ab_w_in); LAUNDER(a_ln_g); LAUNDER(a_ln_b); LAUNDER(a_w_s); LAUNDER(a_b_s); LAUNDER(b_sink);
  LAUNDER(ab_w_out); LAUNDER(c_w_in); LAUNDER(c_conv_w); LAUNDER(c_conv_b); LAUNDER(c_w_a); LAUNDER(c_b_a);
  LAUNDER(c_w_i); LAUNDER(c_b_i); LAUNDER(c_lam); LAUNDER(c_w_out); LAUNDER(final_g); LAUNDER(out);
  LAUNDER(xbuf); LAUNDER(mods); LAUNDER(hbuf); LAUNDER(ebuf); LAUNDER(wt_in_e); LAUNDER(wt_out_e);
  LAUNDER(wt_in_o); LAUNDER(wt_out_o); LAUNDER(wga); LAUNDER(wgi);
}

constexpr int NPHASES = 20;

__device__ void run_phase(const Params& p0, int ph, char* smem) {
  if (ph == 0) { Params p; launder(p, p0); phase0(p, smem); return; }
  if (ph == 19) { Params p; launder(p, p0); phase_final(p); return; }
  int layer, sub;
  if (ph < 5) { layer = 0; sub = ph - 1; }
  else if (ph < 10) { layer = 1; sub = ph - 5; }
  else if (ph < 14) { layer = 2; sub = ph - 10; }
  else { layer = 3; sub = ph - 14; }
  const int idx = layer >> 1;
  const bool even = (layer & 1) == 0;
  const bool need_ctx = layer < 3;
  if (sub == 0) { Params p; launder(p, p0); phase_prep(p, layer); return; }
  if (even) {
    if (sub == 1) {
      Params p; launder(p, p0);
      EpiEvenIn epi; epi.e = even_bufs(p);
      gemm_phase<0>(p.hbuf, nullptr, p.wt_in_e + (size_t)idx * 2816 * 1024, NR / 128, 22, smem, epi);
    } else if (sub == 2) {
      Params p; launder(p, p0);
      phase_even_mix(p, smem, idx);
    } else {
      Params p; launder(p, p0);
      EpiOut epi; epi.xbuf = p.xbuf; epi.mods_l = p.mods + (size_t)layer * 9 * 3072;
      gemm_phase<0>(p.hbuf, nullptr, p.wt_out_e + (size_t)idx * 1024 * 1024, NR / 128, 8, smem, epi);
    }
  } else {
    if (sub == 1) {
      Params p; launder(p, p0);
      EpiOddIn epi; epi.o = odd_bufs(p);
      gemm_phase<0>(p.hbuf, nullptr, p.wt_in_o + (size_t)idx * 2048 * 1024, NR / 128, 16, smem, epi);
    } else if (sub == 2) {
      Params p; launder(p, p0);
      phase_conv(p, idx);
    } else if (sub == 3) {
      Params p; launder(p, p0);
      phase_rglru(p, smem, idx, need_ctx);
    } else {
      Params p; launder(p, p0);
      EpiOut epi; epi.xbuf = p.xbuf; epi.mods_l = p.mods + (size_t)layer * 9 * 3072;
      const OddBufs ob = odd_bufs(p);
      gemm_phase<1>(p.hbuf, ob.sb, p.wt_out_o + (size_t)idx * 1024 * 1024, (need_ctx ? NR : NL) / 128, 8, smem, epi);
    }
  }
}

__global__ void __launch_bounds__(NTHREADS, 2) mega_kernel(Params p, int ph_lo, int ph_hi, int use_bar) {
  __shared__ __attribute__((aligned(16))) char smem[SMEM_BYTES];
  __shared__ uint4 xb_words;
  if (threadIdx.x == 0) xb_words = make_uint4(0u, 0u, 0u, 0u);
  __syncthreads();
  if (use_bar == 1) (void)xcd_barrier_post(p.bar, (volatile LAS unsigned*)&xb_words);
  for (int ph = ph_lo; ph < ph_hi; ++ph) {
    run_phase(p, ph, smem);
    if (ph + 1 < ph_hi) {
      if (use_bar == 1) {
        XcdBarrier xb;
        xb.bar = p.bar; xb.x = xb_xcc_id(); xb.st = (volatile LAS unsigned*)&xb_words;
        xcd_barrier(xb);
      } else if (use_bar == 2) cg::this_grid().sync();
    }
  }
}

extern "C" void kernel_launch(void* const* d_in, const int* in_sizes, int n_in, void* d_out, int out_size,
                              void* d_ws, size_t ws_size, hipStream_t stream) {
  static int grid_blocks = 0;
  if (!grid_blocks) {
    int dev = 0, cus = 0, per_cu = 0;
    hipGetDevice(&dev);
    hipDeviceGetAttribute(&cus, hipDeviceAttributeMultiprocessorCount, dev);
    hipOccupancyMaxActiveBlocksPerMultiprocessor(&per_cu, mega_kernel, NTHREADS, 0);
    if (per_cu < 1) per_cu = 1;
    if (per_cu > 2) per_cu = 2;
    grid_blocks = cus * per_cu;
  }
  Params p{};
  const float** fp = (const float**)&p;
  for (int i = 0; i < 24; ++i) fp[i] = (const float*)d_in[i];
  p.out = (float*)d_out;
  char* ws = (char*)d_ws;
  size_t off = 0;
  auto take = [&](size_t bytes) { char* q = ws + off; off += (bytes + 255) & ~(size_t)255; return q; };
  p.xbuf = (float*)take((size_t)NR * 1024 * 4);
  p.mods = (float*)take((size_t)4 * 9 * 3072 * 4);
  p.hbuf = (bf16_t*)take((size_t)NR * 1024 * 2);
  p.ebuf = (bf16_t*)take((size_t)NR * 3072 * 2);
  p.wt_in_e = (bf16_t*)take((size_t)2 * 2816 * 1024 * 2);
  p.wt_out_e = (bf16_t*)take((size_t)2 * 1024 * 1024 * 2);
  p.wt_in_o = (bf16_t*)take((size_t)2 * 2048 * 1024 * 2);
  p.wt_out_o = (bf16_t*)take((size_t)2 * 1024 * 1024 * 2);
  p.wga = (bf16_t*)take((size_t)16 * 65536 * 2);
  p.wgi = (bf16_t*)take((size_t)16 * 65536 * 2);
  p.bar = (unsigned*)take((size_t)XCD_BAR_WORDS * 4);
  if (off > ws_size) fprintf(stderr, "workspace too small: need %zu have %zu\n", off, ws_size);
#if COOP
  hipMemsetAsync(p.bar, 0, (size_t)XCD_BAR_WORDS * 4, stream);
  int lo = 0, hi = NPHASES, ub = 1;
  void* args[] = {&p, &lo, &hi, &ub};
  hipError_t e = hipLaunchCooperativeKernel((void*)mega_kernel, dim3(grid_blocks), dim3(NTHREADS), args, 0, stream);
  if (e != hipSuccess) fprintf(stderr, "cooperative launch failed: %s (grid %d)\n", hipGetErrorString(e), grid_blocks);
#else
  for (int ph = 0; ph < NPHASES; ++ph) mega_kernel<<<grid_blocks, NTHREADS, 0, stream>>>(p, ph, ph + 1, 0);
#endif
}
```

```cpp
#include <hip/hip_runtime.h>
#include <hip/hip_cooperative_groups.h>
#include <stdint.h>
#include <stdio.h>
namespace cg = cooperative_groups;

#ifndef COOP
#define COOP 1
#endif

typedef unsigned short bf16_t;
typedef __attribute__((ext_vector_type(8))) short bf16x8;
typedef __attribute__((ext_vector_type(16))) float f32x16;
typedef __attribute__((ext_vector_type(4))) unsigned int u32x4;
typedef __attribute__((ext_vector_type(2))) unsigned int u32x2;

constexpr int DM = 1024;
constexpr int NBATCH = 8;
constexpr int SEQL = 4096;
constexpr int LCTX = 256;
constexpr int NL = NBATCH * SEQL;
constexpr int NC = NBATCH * LCTX;
constexpr int NR = NL + NC;
constexpr int SMEM_BYTES = 72 * 1024;
constexpr int NTHREADS = 256;

struct Params {
  const float *x, *c, *ctx, *c_ctx, *norm_g, *w_mod, *b_mod, *ab_w_in, *a_ln_g, *a_ln_b, *a_w_s, *a_b_s,
      *b_sink, *ab_w_out, *c_w_in, *c_conv_w, *c_conv_b, *c_w_a, *c_b_a, *c_w_i, *c_b_i, *c_lam, *c_w_out,
      *final_g;
  float* out;
  float* xbuf;
  float* mods;
  bf16_t* hbuf;
  bf16_t* ebuf;
  bf16_t *wt_in_e, *wt_out_e, *wt_in_o, *wt_out_o, *wga, *wgi;
  unsigned* bar;
};

typedef __bf16 hwbf16x2 __attribute__((ext_vector_type(2)));
typedef float f32x2v __attribute__((ext_vector_type(2)));
__device__ __forceinline__ uint32_t pack2(float a, float b) {
  f32x2v v = {a, b};
  hwbf16x2 r = __builtin_convertvector(v, hwbf16x2);
  return __builtin_bit_cast(uint32_t, r);
}
__device__ __forceinline__ bf16_t f2bf(float f) { return (bf16_t)(pack2(f, f) & 0xffffu); }
__device__ __forceinline__ float bf2f(bf16_t b) { return __uint_as_float(((uint32_t)b) << 16); }
__device__ __forceinline__ float lo_bf(uint32_t u) { return __uint_as_float(u << 16); }
__device__ __forceinline__ float hi_bf(uint32_t u) { return __uint_as_float(u & 0xffff0000u); }
__device__ __forceinline__ float frcp(float x) { return __builtin_amdgcn_rcpf(x); }
__device__ __forceinline__ float silu_f(float x) { return x * frcp(1.f + __expf(-x)); }
__device__ __forceinline__ float sigmoid_f(float x) { return frcp(1.f + __expf(-x)); }
__device__ __forceinline__ float gelu_f(float x) {
  float y = 0.7978845608028654f * (x + 0.044715f * x * x * x);
  float t = 1.f - 2.f * frcp(1.f + __expf(2.f * y));
  return 0.5f * x * (1.f + t);
}
__device__ __forceinline__ f32x16 zero16() {
  f32x16 z;
#pragma unroll
  for (int i = 0; i < 16; ++i) z[i] = 0.f;
  return z;
}
__device__ __forceinline__ float wave_sum(float v) {
#pragma unroll
  for (int o = 32; o > 0; o >>= 1) v += __shfl_xor(v, o);
  return v;
}

__device__ __forceinline__ int otid() {
  int t = threadIdx.x;
  asm volatile("" : "+v"(t));
  return t;
}

struct EvenBufs {
  bf16_t *ug, *vg, *gas, *qb, *gbs, *kb, *vtl, *vtc;
};
__device__ __forceinline__ EvenBufs even_bufs(const Params& p) {
  EvenBufs e;
  e.ug = p.ebuf;
  e.vg = e.ug + (size_t)NR * 512;
  e.gas = e.vg + (size_t)NR * 512;
  e.qb = e.gas + (size_t)NR * 512;
  e.gbs = e.qb + (size_t)NR * 512;
  e.kb = e.gbs + (size_t)NR * 512;
  e.vtl = e.kb + (size_t)NR * 128;
  e.vtc = e.vtl + (size_t)NBATCH * 128 * SEQL;
  return e;
}
struct OddBufs {
  bf16_t *xr, *sg, *sb;
};
__device__ __forceinline__ OddBufs odd_bufs(const Params& p) {
  OddBufs o;
  o.xr = p.ebuf;
  o.sg = o.xr + (size_t)NR * 1024;
  o.sb = o.xr;
  return o;
}

__device__ void transpose_item(const Params& p, int item, char* smem) {
  float* tile = (float*)smem;
  const float* src;
  bf16_t* dst;
  int K, N, local;
  if (item < 1408) { src = p.ab_w_in; dst = p.wt_in_e; K = 1024; N = 2816; local = item; }
  else if (item < 1920) { src = p.ab_w_out; dst = p.wt_out_e; K = 1024; N = 1024; local = item - 1408; }
  else if (item < 2944) { src = p.c_w_in; dst = p.wt_in_o; K = 1024; N = 2048; local = item - 1920; }
  else if (item < 3456) { src = p.c_w_out; dst = p.wt_out_o; K = 1024; N = 1024; local = item - 2944; }
  else if (item < 3712) { src = p.c_w_a; dst = p.wga; K = 256; N = 256; local = item - 3456; }
  else { src = p.c_w_i; dst = p.wgi; K = 256; N = 256; local = item - 3712; }
  const int ntn = N / 64;
  const int tpb = (K / 64) * ntn;
  const int bi = local / tpb;
  const int rem = local % tpb;
  const int k0 = (rem / ntn) * 64, n0 = (rem % ntn) * 64;
  src += (size_t)bi * K * N;
  dst += (size_t)bi * K * N;
  const int tid = otid();
  __syncthreads();
#pragma unroll
  for (int i = 0; i < 16; ++i) {
    int rr = i * 4 + (tid >> 6), cc = tid & 63;
    tile[rr * 65 + cc] = src[(size_t)(k0 + rr) * N + n0 + cc];
  }
  __syncthreads();
#pragma unroll
  for (int i = 0; i < 16; ++i) {
    int n = i * 4 + (tid >> 6), k = tid & 63;
    dst[(size_t)(n0 + n) * K + k0 + k] = f2bf(tile[k * 65 + n]);
  }
}

__device__ void mods_item(const Params& p, int item, char* smem) {
  float* sc = (float*)smem;
  float* red = sc + 9 * 1024;
  const int tid = otid();
  const int l = item / 96, n0 = (item % 96) * 32;
  __syncthreads();
  for (int i = tid; i < 9 * 1024; i += NTHREADS) {
    int j = i >> 10, k = i & 1023;
    float v = (j < 8) ? p.c[j * 1024 + k] : p.c_ctx[k];
    sc[i] = silu_f(v);
  }
  __syncthreads();
  const int col = tid & 31, kg = tid >> 5;
  float acc[9];
#pragma unroll
  for (int j = 0; j < 9; ++j) acc[j] = 0.f;
  const float* w = p.w_mod + ((size_t)l * 1024 + kg * 128) * 3072 + n0 + col;
#pragma unroll 32
  for (int k = 0; k < 128; ++k) {
    float wv = w[(size_t)k * 3072];
#pragma unroll
    for (int j = 0; j < 9; ++j) acc[j] += sc[j * 1024 + kg * 128 + k] * wv;
  }
#pragma unroll
  for (int j = 0; j < 9; ++j) red[(kg * 9 + j) * 32 + col] = acc[j];
  __syncthreads();
  for (int i = tid; i < 9 * 32; i += NTHREADS) {
    int j = i >> 5, cc = i & 31;
    float s = 0.f;
#pragma unroll
    for (int g = 0; g < 8; ++g) s += red[(g * 9 + j) * 32 + cc];
    p.mods[((size_t)l * 9 + j) * 3072 + n0 + cc] = s + p.b_mod[l * 3072 + n0 + cc];
  }
}

__device__ void phase0(const Params& p, char* smem) {
  const int total = 3968 + 384;
  for (int item = blockIdx.x; item < total; item += gridDim.x) {
    if (item < 384) mods_item(p, item, smem);
    else transpose_item(p, item - 384, smem);
  }
}

__device__ void phase_prep(const Params& p, int layer) {
  const int tid = otid();
  const int lane = tid & 63;
  const int gw = blockIdx.x * 4 + (tid >> 6);
  const int nw = gridDim.x * 4;
  const float* ng = p.norm_g + layer * 1024;
  for (int R = gw; R < NR; R += nw) {
    const float* src;
    if (layer == 0) src = (R < NL) ? p.x + (size_t)R * 1024 : p.ctx + (size_t)(R - NL) * 1024;
    else src = p.xbuf + (size_t)R * 1024;
    const int bidx = (R < NL) ? (R >> 12) : 8;
    const float* md = p.mods + ((size_t)layer * 9 + bidx) * 3072;
    float4 v[4];
#pragma unroll
    for (int i = 0; i < 4; ++i) v[i] = ((const float4*)src)[lane + 64 * i];
    float ss = 0.f;
#pragma unroll
    for (int i = 0; i < 4; ++i) ss += v[i].x * v[i].x + v[i].y * v[i].y + v[i].z * v[i].z + v[i].w * v[i].w;
    ss = wave_sum(ss);
    const float rstd = rsqrtf(ss * (1.f / 1024.f) + 1e-6f);
#pragma unroll
    for (int i = 0; i < 4; ++i) {
      const int k4 = lane + 64 * i;
      float4 g = ((const float4*)ng)[k4];
      float4 sh = ((const float4*)md)[k4];
      float4 sc = ((const float4*)(md + 1024))[k4];
      float h0 = v[i].x * rstd * g.x * (1.f + sc.x) + sh.x;
      float h1 = v[i].y * rstd * g.y * (1.f + sc.y) + sh.y;
      float h2 = v[i].z * rstd * g.z * (1.f + sc.z) + sh.z;
      float h3 = v[i].w * rstd * g.w * (1.f + sc.w) + sh.w;
      u32x2 pk;
      pk.x = pack2(h0, h1);
      pk.y = pack2(h2, h3);
      *(u32x2*)(p.hbuf + (size_t)R * 1024 + k4 * 4) = pk;
      if (layer == 0) ((float4*)(p.xbuf + (size_t)R * 1024))[k4] = v[i];
    }
  }
}

__device__ void phase_final(const Params& p) {
  const int tid = otid();
  const int lane = tid & 63;
  const int gw = blockIdx.x * 4 + (tid >> 6);
  const int nw = gridDim.x * 4;
  for (int R = gw; R < NL; R += nw) {
    const float* src = p.xbuf + (size_t)R * 1024;
    float4 v[4];
#pragma unroll
    for (int i = 0; i < 4; ++i) v[i] = ((const float4*)src)[lane + 64 * i];
    float ss = 0.f;
#pragma unroll
    for (int i = 0; i < 4; ++i) ss += v[i].x * v[i].x + v[i].y * v[i].y + v[i].z * v[i].z + v[i].w * v[i].w;
    ss = wave_sum(ss);
    const float rstd = rsqrtf(ss * (1.f / 1024.f) + 1e-6f);
#pragma unroll
    for (int i = 0; i < 4; ++i) {
      const int k4 = lane + 64 * i;
      float4 g = ((const float4*)p.final_g)[k4];
      float4 o;
      o.x = v[i].x * rstd * g.x;
      o.y = v[i].y * rstd * g.y;
      o.z = v[i].z * rstd * g.z;
      o.w = v[i].w * rstd * g.w;
      ((float4*)(p.out + (size_t)R * 1024))[k4] = o;
    }
  }
}

constexpr int GS = 72;

__device__ __forceinline__ u32x4 add_bf16x8(u32x4 a, u32x4 b) {
  u32x4 r;
  r.x = pack2(lo_bf(a.x) + lo_bf(b.x), hi_bf(a.x) + hi_bf(b.x));
  r.y = pack2(lo_bf(a.y) + lo_bf(b.y), hi_bf(a.y) + hi_bf(b.y));
  r.z = pack2(lo_bf(a.z) + lo_bf(b.z), hi_bf(a.z) + hi_bf(b.z));
  r.w = pack2(lo_bf(a.w) + lo_bf(b.w), hi_bf(a.w) + hi_bf(b.w));
  return r;
}

template <int AMODE, class Epi>
__device__ void gemm_phase(const bf16_t* __restrict__ A0, const bf16_t* __restrict__ A1,
                           const bf16_t* __restrict__ Bt, int Mtiles, int Ntiles, char* smem, Epi epi) {
  constexpr int PD = (AMODE == 1) ? 1 : 2;
  constexpr int BUF = 2 * 128 * GS;
  bf16_t* S0 = (bf16_t*)smem;
  const int tid = otid(), lane = tid & 63, w = __builtin_amdgcn_readfirstlane(tid >> 6);
  const int wm = w >> 1, wn = w & 1;
  const int r = lane & 31, h = lane >> 5;
  const int lrow = tid >> 3, kc = tid & 7;
  const int total = Mtiles * Ntiles;
  const int woff = lrow * GS + kc * 8;
  const int aro = (wm * 64 + r) * GS + h * 8;
  const int bro = 128 * GS + (wn * 64 + r) * GS + h * 8;
  const bool swz = ((gridDim.x & 7) == 0) && ((Mtiles & 7) == 0);
  const int xcd = blockIdx.x & 7;
  const int Mx = Mtiles >> 3;
  const int lstart = swz ? (int)(blockIdx.x >> 3) : (int)blockIdx.x;
  const int lstep = swz ? (int)(gridDim.x >> 3) : (int)gridDim.x;
  const int lend = swz ? Mx * Ntiles : total;
  for (int L = lstart; L < lend; L += lstep) {
    int mt, nt;
    if (swz) {
      const int gfull = 8 * Ntiles;
      const int mg = L / gfull, rem = L - mg * gfull;
      const int gs = min(8, Mx - mg * 8);
      nt = rem / gs;
      mt = xcd * Mx + mg * 8 + (rem - nt * gs);
    } else {
      mt = L / Ntiles;
      nt = L - mt * Ntiles;
    }
    const int m0 = mt * 128, n0 = nt * 128;
    const size_t aoff = (size_t)(m0 + lrow) * 1024 + kc * 8;
    const bf16_t* ap = A0 + aoff;
    const bf16_t* ap1 = (AMODE == 1) ? (A1 + aoff) : A0;
    const bf16_t* bp = Bt + (size_t)(n0 + lrow) * 1024 + kc * 8;
    u32x4 ra[PD][4], ra1[PD][4], rb[PD][4];
#define G_LOAD(S, KT)                                                                              \
    {                                                                                              \
      _Pragma("unroll") for (int i = 0; i < 4; ++i) {                                              \
        ra[S][i] = *(const u32x4*)(ap + (size_t)i * 32 * 1024 + (KT) * 64);                        \
        if (AMODE == 1) ra1[S][i] = *(const u32x4*)(ap1 + (size_t)i * 32 * 1024 + (KT) * 64);     \
        rb[S][i] = *(const u32x4*)(bp + (size_t)i * 32 * 1024 + (KT) * 64);                        \
      }                                                                                            \
    }
#define L_WRITE(S, BUFI)                                                                           \
    {                                                                                              \
      bf16_t* dstA = S0 + (BUFI) * BUF + woff;                                                     \
      _Pragma("unroll") for (int i = 0; i < 4; ++i) {                                              \
        u32x4 av = ra[S][i];                                                                       \
        if (AMODE == 1) av = add_bf16x8(av, ra1[S][i]);                                            \
        *(u32x4*)(dstA + 32 * i * GS) = av;                                                        \
        *(u32x4*)(dstA + 128 * GS + 32 * i * GS) = rb[S][i];                                       \
      }                                                                                            \
    }
    G_LOAD(0, 0);
    L_WRITE(0, 0);
#pragma unroll
    for (int s = 0; s < PD; ++s) G_LOAD(s, 1 + s);
    f32x16 acc[2][2];
#pragma unroll
    for (int mi = 0; mi < 2; ++mi)
#pragma unroll
      for (int ni = 0; ni < 2; ++ni) acc[mi][ni] = zero16();
#pragma unroll 1
    for (int kt0 = 0; kt0 < 16; kt0 += 2) {
#pragma unroll
      for (int u = 0; u < 2; ++u) {
        const int kt = kt0 + u;
        constexpr int dummy = 0; (void)dummy;
        const int s = (PD == 2) ? u : 0;
        __syncthreads();
        L_WRITE(s, (u ^ 1));
        {
          const int ktl = (kt + 1 + PD < 16) ? (kt + 1 + PD) : 15;
          G_LOAD(s, ktl);
        }
        const bf16_t* Aw = S0 + u * BUF + aro;
        const bf16_t* Bw = S0 + u * BUF + bro;
#pragma unroll
        for (int ks = 0; ks < 4; ++ks) {
          bf16x8 a0 = *(const bf16x8*)(Aw + ks * 16);
          bf16x8 a1 = *(const bf16x8*)(Aw + 32 * GS + ks * 16);
          bf16x8 b0 = *(const bf16x8*)(Bw + ks * 16);
          bf16x8 b1 = *(const bf16x8*)(Bw + 32 * GS + ks * 16);
          acc[0][0] = __builtin_amdgcn_mfma_f32_32x32x16_bf16(a0, b0, acc[0][0], 0, 0, 0);
          acc[0][1] = __builtin_amdgcn_mfma_f32_32x32x16_bf16(a0, b1, acc[0][1], 0, 0, 0);
          acc[1][0] = __builtin_amdgcn_mfma_f32_32x32x16_bf16(a1, b0, acc[1][0], 0, 0, 0);
          acc[1][1] = __builtin_amdgcn_mfma_f32_32x32x16_bf16(a1, b1, acc[1][1], 0, 0, 0);
        }
      }
    }
#undef G_LOAD
#undef L_WRITE
    epi(acc, m0 + wm * 64, n0 + wn * 64, lane);
  }
}

template <class Epi>
__device__ void gemm_phase_big(const bf16_t* __restrict__ A0, const bf16_t* __restrict__ Bt, int Mtiles  ,
                               int Ntiles, char* smem, Epi epi) {
  bf16_t* As = (bf16_t*)smem;
  bf16_t* Bs = As + 256 * GS;
  const int tid = otid(), lane = tid & 63, w = __builtin_amdgcn_readfirstlane(tid >> 6);
  const int wm = w >> 1, wn = w & 1;
  const int r = lane & 31, h = lane >> 5;
  const int lrow = tid >> 3, kc = tid & 7;
  const bool swz = ((gridDim.x & 7) == 0) && ((Mtiles & 7) == 0);
  const int xcd = blockIdx.x & 7;
  const int Mx = Mtiles >> 3;
  const int lstart = swz ? (int)(blockIdx.x >> 3) : (int)blockIdx.x;
  const int lstep = swz ? (int)(gridDim.x >> 3) : (int)gridDim.x;
  const int lend = swz ? Mx * Ntiles : Mtiles * Ntiles;
  for (int L = lstart; L < lend; L += lstep) {
    int mt, nt;
    if (swz) {
      const int gfull = 8 * Ntiles;
      const int mg = L / gfull, rem = L - mg * gfull;
      const int gs = min(8, Mx - mg * 8);
      nt = rem / gs;
      mt = xcd * Mx + mg * 8 + (rem - nt * gs);
    } else {
      mt = L / Ntiles;
      nt = L - mt * Ntiles;
    }
    const int m0 = mt * 256, n0 = nt * 128;
    const bf16_t* ap = A0 + (size_t)(m0 + lrow) * 1024 + kc * 8;
    const bf16_t* bp = Bt + (size_t)(n0 + lrow) * 1024 + kc * 8;
    u32x4 ra[8], rb[4];
#pragma unroll
    for (int i = 0; i < 8; ++i) ra[i] = *(const u32x4*)(ap + (size_t)i * 32 * 1024);
#pragma unroll
    for (int i = 0; i < 4; ++i) rb[i] = *(const u32x4*)(bp + (size_t)i * 32 * 1024);
    f32x16 acc[2][2][2];
#pragma unroll
    for (int hf = 0; hf < 2; ++hf)
#pragma unroll
      for (int mi = 0; mi < 2; ++mi)
#pragma unroll
        for (int ni = 0; ni < 2; ++ni) acc[hf][mi][ni] = zero16();
#pragma unroll 1
    for (int kt = 0; kt < 16; ++kt) {
      __syncthreads();
#pragma unroll
      for (int i = 0; i < 8; ++i) *(u32x4*)(As + (lrow + 32 * i) * GS + kc * 8) = ra[i];
#pragma unroll
      for (int i = 0; i < 4; ++i) *(u32x4*)(Bs + (lrow + 32 * i) * GS + kc * 8) = rb[i];
      __syncthreads();
      {
        const int k0 = ((kt + 1 < 16) ? (kt + 1) : 15) * 64;
#pragma unroll
        for (int i = 0; i < 8; ++i) ra[i] = *(const u32x4*)(ap + (size_t)i * 32 * 1024 + k0);
#pragma unroll
        for (int i = 0; i < 4; ++i) rb[i] = *(const u32x4*)(bp + (size_t)i * 32 * 1024 + k0);
      }
      const bf16_t* Aw = As + (wm * 128 + r) * GS + h * 8;
      const bf16_t* Bw = Bs + (wn * 64 + r) * GS + h * 8;
#pragma unroll
      for (int ks = 0; ks < 4; ++ks) {
        bf16x8 b0 = *(const bf16x8*)(Bw + ks * 16);
        bf16x8 b1 = *(const bf16x8*)(Bw + 32 * GS + ks * 16);
#pragma unroll
        for (int hf = 0; hf < 2; ++hf) {
          bf16x8 a0 = *(const bf16x8*)(Aw + (hf * 64) * GS + ks * 16);
          bf16x8 a1 = *(const bf16x8*)(Aw + (hf * 64 + 32) * GS + ks * 16);
          acc[hf][0][0] = __builtin_amdgcn_mfma_f32_32x32x16_bf16(a0, b0, acc[hf][0][0], 0, 0, 0);
          acc[hf][0][1] = __builtin_amdgcn_mfma_f32_32x32x16_bf16(a0, b1, acc[hf][0][1], 0, 0, 0);
          acc[hf][1][0] = __builtin_amdgcn_mfma_f32_32x32x16_bf16(a1, b0, acc[hf][1][0], 0, 0, 0);
          acc[hf][1][1] = __builtin_amdgcn_mfma_f32_32x32x16_bf16(a1, b1, acc[hf][1][1], 0, 0, 0);
        }
      }
    }
    epi(acc[0], m0 + wm * 128, n0 + wn * 64, lane);
    epi(acc[1], m0 + wm * 128 + 64, n0 + wn * 64, lane);
  }
}


struct EpiEvenIn {
  EvenBufs e;
  __device__ void operator()(f32x16 (&acc)[2][2], int rb, int cb, int lane) const {
    const int r = lane & 31, h = lane >> 5;
    if (cb < 1536 || cb >= 2304) {
      bf16_t* dst;
      int c0;
      int mode;
      if (cb < 512) { dst = e.ug; c0 = cb; mode = 0; }
      else if (cb < 1024) { dst = e.vg; c0 = cb - 512; mode = 0; }
      else if (cb < 1536) { dst = e.gas; c0 = cb - 1024; mode = 1; }
      else { dst = e.gbs; c0 = cb - 2304; mode = 1; }
#pragma unroll
      for (int mi = 0; mi < 2; ++mi)
#pragma unroll
        for (int ni = 0; ni < 2; ++ni)
#pragma unroll
          for (int reg = 0; reg < 16; ++reg) {
            const int row = rb + mi * 32 + (reg & 3) + 8 * (reg >> 2) + 4 * h;
            const int col = c0 + ni * 32 + r;
            float v = acc[mi][ni][reg];
            v = (mode == 0) ? gelu_f(v) : silu_f(v);
            dst[(size_t)row * 512 + col] = f2bf(v);
          }
    } else if (cb < 2176) {
      const bool isq = cb < 2048;
      bf16_t* dst = isq ? e.qb : e.kb;
      const int c0 = isq ? (cb - 1536) : (cb - 2048);
      const int ld = isq ? 512 : 128;
      const float scale = isq ? 0.125f : 1.f;
      const bool latent = rb < NL;
      const float inv_freq = exp2f(-(float)(r & 15) * 0.8304820237218406f);
#pragma unroll
      for (int mi = 0; mi < 2; ++mi)
#pragma unroll
        for (int reg = 0; reg < 16; ++reg) {
          const int row = rb + mi * 32 + (reg & 3) + 8 * (reg >> 2) + 4 * h;
          float x1 = acc[mi][0][reg], x2 = acc[mi][1][reg];
          float o1 = x1, o2 = x2;
          if (latent) {
            const int t = row & (SEQL - 1);
            const float pos = (float)((r < 16) ? (t >> 6) : (t & 63));
            const float ang = pos * inv_freq;
            const float cs = __cosf(ang), sn = __sinf(ang);
            o1 = x1 * cs - x2 * sn;
            o2 = x2 * cs + x1 * sn;
          }
          dst[(size_t)row * ld + c0 + r] = f2bf(o1 * scale);
          dst[(size_t)row * ld + c0 + 32 + r] = f2bf(o2 * scale);
        }
    } else {
      const int kvh = (cb - 2176) >> 6;
      const bool latent = rb < NL;
#pragma unroll
      for (int mi = 0; mi < 2; ++mi)
#pragma unroll
        for (int ni = 0; ni < 2; ++ni)
#pragma unroll
          for (int q4 = 0; q4 < 4; ++q4) {
            const int row = rb + mi * 32 + 8 * q4 + 4 * h;
            const int d = ni * 32 + r;
            u32x2 pk;
            pk.x = pack2(acc[mi][ni][q4 * 4 + 0], acc[mi][ni][q4 * 4 + 1]);
            pk.y = pack2(acc[mi][ni][q4 * 4 + 2], acc[mi][ni][q4 * 4 + 3]);
            if (latent) {
              const int b = row >> 12, t = row & (SEQL - 1);
              *(u32x2*)(e.vtl + ((size_t)((b * 2 + kvh) * 64 + d)) * SEQL + t) = pk;
            } else {
              const int rr = row - NL;
              const int b = rr >> 8, t = rr & (LCTX - 1);
              *(u32x2*)(e.vtc + ((size_t)((b * 2 + kvh) * 64 + d)) * LCTX + t) = pk;
            }
          }
    }
  }
};

struct EpiOddIn {
  OddBufs o;
  __device__ void operator()(f32x16 (&acc)[2][2], int rb, int cb, int lane) const {
    const int r = lane & 31, h = lane >> 5;
    const bool isg = cb >= 1024;
    bf16_t* dst = isg ? o.sg : o.xr;
    const int c0 = isg ? cb - 1024 : cb;
#pragma unroll
    for (int mi = 0; mi < 2; ++mi)
#pragma unroll
      for (int ni = 0; ni < 2; ++ni)
#pragma unroll
        for (int reg = 0; reg < 16; ++reg) {
          const int row = rb + mi * 32 + (reg & 3) + 8 * (reg >> 2) + 4 * h;
          const int col = c0 + ni * 32 + r;
          float v = acc[mi][ni][reg];
          if (isg) v = silu_f(v);
          dst[(size_t)row * 1024 + col] = f2bf(v);
        }
  }
};

struct EpiOut {
  float* xbuf;
  const float* mods_l;
  __device__ void operator()(f32x16 (&acc)[2][2], int rb, int cb, int lane) const {
    const int r = lane & 31, h = lane >> 5;
    const int bidx = (rb < NL) ? (rb >> 12) : 8;
    const float* gate = mods_l + (size_t)bidx * 3072 + 2048;
#pragma unroll
    for (int ni = 0; ni < 2; ++ni) {
      const int col = cb + ni * 32 + r;
      const float gv = gate[col];
#pragma unroll
      for (int mi = 0; mi < 2; ++mi)
#pragma unroll
        for (int reg = 0; reg < 16; ++reg) {
          const int row = rb + mi * 32 + (reg & 3) + 8 * (reg >> 2) + 4 * h;
          float* px = xbuf + (size_t)row * 1024 + col;
          *px = *px + gv * acc[mi][ni][reg];
        }
    }
  }
};

constexpr int AS = 72;

__device__ void attn_item(const Params& p, const EvenBufs& e, int item, char* smem, int ei) {
  bf16_t* Ks = (bf16_t*)smem;
  bf16_t* Vs = Ks + 64 * AS;
  const int tid = otid(), lane = tid & 63, w = __builtin_amdgcn_readfirstlane(tid >> 6);
  const int r = lane & 31, h = lane >> 5;
  int b, hq, start, R0;
  bool isctx;
  if (item < 2048) {
    b = item >> 8;
    hq = (item >> 5) & 7;
    const int qblk = item & 31;
    start = qblk * 128;
    R0 = b * SEQL + start;
    isctx = false;
  } else {
    const int it = item - 2048;
    b = it >> 4;
    hq = (it >> 1) & 7;
    start = (it & 1) * 128;
    R0 = NL + b * LCTX + start;
    isctx = true;
  }
  const int kvh = hq >> 2;
  const int qrow = R0 + w * 32 + r;
  bf16x8 qf[4];
#pragma unroll
  for (int s = 0; s < 4; ++s) qf[s] = *(const bf16x8*)(e.qb + (size_t)qrow * 512 + hq * 64 + s * 16 + h * 8);
  float m = p.b_sink[ei * 8 + hq], l = 1.f;
  f32x16 o[2];
  o[0] = zero16();
  o[1] = zero16();
  const int nblk = isctx ? 4 : 10;
  auto kb_desc = [&](int kb, const bf16_t*& kp, const bf16_t*& vp, int& vstride, int& kpos0, bool& local) -> bool {
    if (kb < 4) {
      kp = e.kb + (size_t)(NL + b * LCTX + kb * 64) * 128 + kvh * 64;
      vp = e.vtc + (size_t)((b * 2 + kvh) * 64) * LCTX + kb * 64;
      vstride = LCTX; kpos0 = 0; local = false;
      return true;
    }
    kpos0 = start - 128 + (kb - 4) * 64;
    local = true;
    if (kpos0 < 0 || kpos0 >= SEQL) return false;
    kp = e.kb + (size_t)(b * SEQL + kpos0) * 128 + kvh * 64;
    vp = e.vtl + (size_t)((b * 2 + kvh) * 64) * SEQL + kpos0;
    vstride = SEQL;
    return true;
  };
  const int lr0 = tid >> 3, lc0 = tid & 7;
  u32x4 pk0, pk1, pv0, pv1;
  int kbn = 0;
  {
    const bf16_t *kp, *vp; int vs, kp0; bool lc;
    while (!kb_desc(kbn, kp, vp, vs, kp0, lc)) ++kbn;
    pk0 = *(const u32x4*)(kp + (size_t)lr0 * 128 + lc0 * 8);
    pk1 = *(const u32x4*)(kp + (size_t)(lr0 + 32) * 128 + lc0 * 8);
    pv0 = *(const u32x4*)(vp + (size_t)lr0 * vs + lc0 * 8);
    pv1 = *(const u32x4*)(vp + (size_t)(lr0 + 32) * vs + lc0 * 8);
  }
  while (kbn < nblk) {
    const int kb = kbn;
    int kpos0 = 0;
    bool local = false;
    {
      const bf16_t *kp, *vp; int vs;
      kb_desc(kb, kp, vp, vs, kpos0, local);
    }
    __syncthreads();
    *(u32x4*)(Ks + lr0 * AS + lc0 * 8) = pk0;
    *(u32x4*)(Ks + (lr0 + 32) * AS + lc0 * 8) = pk1;
    *(u32x4*)(Vs + lr0 * AS + lc0 * 8) = pv0;
    *(u32x4*)(Vs + (lr0 + 32) * AS + lc0 * 8) = pv1;
    __syncthreads();
    {
      const bf16_t *kp = nullptr, *vp = nullptr; int vs = 0, kp0; bool lc;
      ++kbn;
      while (kbn < nblk && !kb_desc(kbn, kp, vp, vs, kp0, lc)) ++kbn;
      if (kbn < nblk) {
        pk0 = *(const u32x4*)(kp + (size_t)lr0 * 128 + lc0 * 8);
        pk1 = *(const u32x4*)(kp + (size_t)(lr0 + 32) * 128 + lc0 * 8);
        pv0 = *(const u32x4*)(vp + (size_t)lr0 * vs + lc0 * 8);
        pv1 = *(const u32x4*)(vp + (size_t)(lr0 + 32) * vs + lc0 * 8);
      }
    }
    f32x16 s[2];
#pragma unroll
    for (int kt = 0; kt < 2; ++kt) {
      s[kt] = zero16();
#pragma unroll
      for (int ks = 0; ks < 4; ++ks) {
        bf16x8 a = *(const bf16x8*)(Ks + (kt * 32 + r) * AS + ks * 16 + h * 8);
        s[kt] = __builtin_amdgcn_mfma_f32_32x32x16_bf16(a, qf[ks], s[kt], 0, 0, 0);
      }
    }
    if (local) {
      const int qpos = start + w * 32 + r;
#pragma unroll
      for (int kt = 0; kt < 2; ++kt)
#pragma unroll
        for (int reg = 0; reg < 16; ++reg) {
          const int kpos = kpos0 + kt * 32 + (reg & 3) + 8 * (reg >> 2) + 4 * h;
          const int diff = qpos - kpos;
          if (diff > 128 || diff < -128) s[kt][reg] = -1e30f;
        }
    }
    float mx = m;
#pragma unroll
    for (int kt = 0; kt < 2; ++kt)
#pragma unroll
      for (int reg = 0; reg < 16; ++reg) mx = fmaxf(mx, s[kt][reg]);
    mx = fmaxf(mx, __shfl_xor(mx, 32));
    const float alpha = __expf(m - mx);
    m = mx;
    float rs = 0.f;
#pragma unroll
    for (int kt = 0; kt < 2; ++kt)
#pragma unroll
      for (int reg = 0; reg < 16; ++reg) {
        const float pv = __expf(s[kt][reg] - mx);
        rs += pv;
        s[kt][reg] = pv;
      }
    rs += __shfl_xor(rs, 32);
    l = l * alpha + rs;
#pragma unroll
    for (int dt = 0; dt < 2; ++dt)
#pragma unroll
      for (int reg = 0; reg < 16; ++reg) o[dt][reg] *= alpha;
#pragma unroll
    for (int kt = 0; kt < 2; ++kt)
#pragma unroll
      for (int sp = 0; sp < 2; ++sp) {
        union { bf16x8 v; uint32_t u[4]; } pf;
#pragma unroll
        for (int j = 0; j < 4; ++j) pf.u[j] = pack2(s[kt][8 * sp + 2 * j], s[kt][8 * sp + 2 * j + 1]);
#pragma unroll
        for (int dt = 0; dt < 2; ++dt) {
          const bf16_t* vp = Vs + (dt * 32 + r) * AS + kt * 32 + sp * 16 + 4 * h;
          union { bf16x8 v; u32x2 u[2]; } af;
          af.u[0] = *(const u32x2*)(vp);
          af.u[1] = *(const u32x2*)(vp + 8);
          o[dt] = __builtin_amdgcn_mfma_f32_32x32x16_bf16(af.v, pf.v, o[dt], 0, 0, 0);
        }
      }
  }
  const float inv = 1.f / l;
  bf16_t* ymix = p.hbuf;
#pragma unroll
  for (int dt = 0; dt < 2; ++dt)
#pragma unroll
    for (int q4 = 0; q4 < 4; ++q4) {
      const int d0 = dt * 32 + 8 * q4 + 4 * h;
      const u32x2 g = *(const u32x2*)(e.gbs + (size_t)qrow * 512 + hq * 64 + d0);
      u32x2 pk;
      pk.x = pack2(o[dt][q4 * 4 + 0] * inv * lo_bf(g.x), o[dt][q4 * 4 + 1] * inv * hi_bf(g.x));
      pk.y = pack2(o[dt][q4 * 4 + 2] * inv * lo_bf(g.y), o[dt][q4 * 4 + 3] * inv * hi_bf(g.y));
      *(u32x2*)(ymix + (size_t)qrow * 1024 + 512 + hq * 64 + d0) = pk;
    }
}

constexpr int MS = 136;

__device__ void gmlp_item(const Params& p, const EvenBufs& e, int item, char* smem, int ei) {
  bf16_t* Ws = (bf16_t*)smem;
  bf16_t* VT = Ws + 128 * MS;
  const int tid = otid(), lane = tid & 63, w = __builtin_amdgcn_readfirstlane(tid >> 6);
  const int r = lane & 31, h = lane >> 5;
  const int wm = w >> 1, wn = w & 1;
  const int rt = item >> 2, g = item & 3;
  const int R0 = rt * 128;
  __syncthreads();
  {
    const float4* wsrc = (const float4*)(p.a_w_s + (size_t)(ei * 4 + g) * 128 * 128);
#pragma unroll
    for (int i = 0; i < 16; ++i) {
      const int idx = tid + 256 * i;
      const int pp = idx >> 5, q4 = idx & 31;
      float4 v = wsrc[idx];
      u32x2 pk;
      pk.x = pack2(v.x, v.y);
      pk.y = pack2(v.z, v.w);
      *(u32x2*)(Ws + pp * MS + q4 * 4) = pk;
    }
  }
#pragma unroll 1
  for (int hp = 0; hp < 2; ++hp) {
    const int q = hp * 64 + (tid >> 2), qt = tid & 3;
    const bf16_t* vsrc = e.vg + (size_t)(R0 + q) * 512 + g * 128 + qt * 32;
    float xv[32];
#pragma unroll
    for (int i = 0; i < 4; ++i) {
      u32x4 u = *(const u32x4*)(vsrc + i * 8);
      xv[i * 8 + 0] = lo_bf(u.x); xv[i * 8 + 1] = hi_bf(u.x);
      xv[i * 8 + 2] = lo_bf(u.y); xv[i * 8 + 3] = hi_bf(u.y);
      xv[i * 8 + 4] = lo_bf(u.z); xv[i * 8 + 5] = hi_bf(u.z);
      xv[i * 8 + 6] = lo_bf(u.w); xv[i * 8 + 7] = hi_bf(u.w);
    }
    float sm = 0.f;
#pragma unroll
    for (int j = 0; j < 32; ++j) sm += xv[j];
    sm += __shfl_xor(sm, 1);
    sm += __shfl_xor(sm, 2);
    const float mean = sm * (1.f / 128.f);
    float sq = 0.f;
#pragma unroll
    for (int j = 0; j < 32; ++j) { float dlt = xv[j] - mean; sq += dlt * dlt; }
    sq += __shfl_xor(sq, 1);
    sq += __shfl_xor(sq, 2);
    const float rstd = rsqrtf(sq * (1.f / 128.f) + 1e-6f);
    const float* lg = p.a_ln_g + ei * 512 + g * 128 + qt * 32;
    const float* lb = p.a_ln_b + ei * 512 + g * 128 + qt * 32;
#pragma unroll
    for (int j = 0; j < 32; ++j) {
      const float val = (xv[j] - mean) * rstd * lg[j] + lb[j];
      VT[(qt * 32 + j) * MS + q] = f2bf(val);
    }
  }
  __syncthreads();
  f32x16 acc[2][2];
#pragma unroll
  for (int mi = 0; mi < 2; ++mi)
#pragma unroll
    for (int ni = 0; ni < 2; ++ni) acc[mi][ni] = zero16();
  const bf16_t* Aw = Ws + (wm * 64 + r) * MS + h * 8;
  const bf16_t* Bw = VT + (wn * 64 + r) * MS + h * 8;
#pragma unroll
  for (int ks = 0; ks < 8; ++ks) {
    bf16x8 a0 = *(const bf16x8*)(Aw + ks * 16);
    bf16x8 a1 = *(const bf16x8*)(Aw + 32 * MS + ks * 16);
    bf16x8 b0 = *(const bf16x8*)(Bw + ks * 16);
    bf16x8 b1 = *(const bf16x8*)(Bw + 32 * MS + ks * 16);
    acc[0][0] = __builtin_amdgcn_mfma_f32_32x32x16_bf16(a0, b0, acc[0][0], 0, 0, 0);
    acc[0][1] = __builtin_amdgcn_mfma_f32_32x32x16_bf16(a0, b1, acc[0][1], 0, 0, 0);
    acc[1][0] = __builtin_amdgcn_mfma_f32_32x32x16_bf16(a1, b0, acc[1][0], 0, 0, 0);
    acc[1][1] = __builtin_amdgcn_mfma_f32_32x32x16_bf16(a1, b1, acc[1][1], 0, 0, 0);
  }
  bf16_t* ymix = p.hbuf;
  const float* bs = p.a_b_s + (ei * 4 + g) * 128;
#pragma unroll
  for (int mi = 0; mi < 2; ++mi)
#pragma unroll
    for (int reg = 0; reg < 16; ++reg) {
      const int prow = wm * 64 + mi * 32 + (reg & 3) + 8 * (reg >> 2) + 4 * h;
      const float bsv = bs[prow];
      const size_t row = (size_t)(R0 + prow);
#pragma unroll
      for (int ni = 0; ni < 2; ++ni) {
        const int col = g * 128 + wn * 64 + ni * 32 + r;
        const float sv = acc[mi][ni][reg] + bsv;
        const float y = bf2f(e.ug[row * 512 + col]) * sv * bf2f(e.gas[row * 512 + col]);
        ymix[row * 1024 + col] = f2bf(y);
      }
    }
}

__device__ void phase_even_mix(const Params& p, char* smem, int ei) {
  const EvenBufs e = even_bufs(p);
  const int n_attn = 2048 + 128, n_gmlp = 1088;
  for (int item = blockIdx.x; item < n_attn + n_gmlp; item += gridDim.x) {
    if (item < n_attn) attn_item(p, e, item, smem, ei);
    else gmlp_item(p, e, item - n_attn, smem, ei);
  }
}

__device__ void phase_conv(const Params& p, int oi) {
  const OddBufs ob = odd_bufs(p);
  const bf16_t* xr = ob.xr;
  bf16_t* zb = ob.sg + (size_t)NR * 1024;
  const int tid = otid();
  const int total = (NR / 8) * 128;
  for (int id = blockIdx.x * NTHREADS + tid; id < total; id += gridDim.x * NTHREADS) {
    const int chunk = id & 127, rg = id >> 7;
    const int R0 = rg * 8;
    int t0, Ls;
    if (R0 < NL) { t0 = R0 & (SEQL - 1); Ls = SEQL; } else { t0 = (R0 - NL) & (LCTX - 1); Ls = LCTX; }
    const int chb = chunk * 8;
    float cw[4][8], cbias[8];
#pragma unroll
    for (int j = 0; j < 4; ++j) {
      const float4 w0 = *(const float4*)(p.c_conv_w + ((size_t)oi * 4 + j) * 1024 + chb);
      const float4 w1 = *(const float4*)(p.c_conv_w + ((size_t)oi * 4 + j) * 1024 + chb + 4);
      cw[j][0] = w0.x; cw[j][1] = w0.y; cw[j][2] = w0.z; cw[j][3] = w0.w;
      cw[j][4] = w1.x; cw[j][5] = w1.y; cw[j][6] = w1.z; cw[j][7] = w1.w;
    }
    {
      const float4 b0 = *(const float4*)(p.c_conv_b + oi * 1024 + chb);
      const float4 b1 = *(const float4*)(p.c_conv_b + oi * 1024 + chb + 4);
      cbias[0] = b0.x; cbias[1] = b0.y; cbias[2] = b0.z; cbias[3] = b0.w;
      cbias[4] = b1.x; cbias[5] = b1.y; cbias[6] = b1.z; cbias[7] = b1.w;
    }
    float xw[11][8];
#pragma unroll
    for (int jj = 0; jj < 11; ++jj) {
      const int t = t0 - 2 + jj;
      u32x4 u = (u32x4){0u, 0u, 0u, 0u};
      if (t >= 0 && t < Ls) u = *(const u32x4*)(xr + (size_t)(R0 - 2 + jj) * 1024 + chb);
      xw[jj][0] = lo_bf(u.x); xw[jj][1] = hi_bf(u.x);
      xw[jj][2] = lo_bf(u.y); xw[jj][3] = hi_bf(u.y);
      xw[jj][4] = lo_bf(u.z); xw[jj][5] = hi_bf(u.z);
      xw[jj][6] = lo_bf(u.w); xw[jj][7] = hi_bf(u.w);
    }
#pragma unroll
    for (int i = 0; i < 8; ++i) {
      float z[8];
#pragma unroll
      for (int e2 = 0; e2 < 8; ++e2) {
        float a = cbias[e2];
#pragma unroll
        for (int j = 0; j < 4; ++j) a += cw[j][e2] * xw[i + j][e2];
        z[e2] = a;
      }
      u32x4 pk;
      pk.x = pack2(z[0], z[1]); pk.y = pack2(z[2], z[3]);
      pk.z = pack2(z[4], z[5]); pk.w = pack2(z[6], z[7]);
      *(u32x4*)(zb + (size_t)(R0 + i) * 1024 + chb) = pk;
    }
  }
}

constexpr int ZS = 264;

template <int DIR>
__device__ void rglru_item(const Params& p, const OddBufs& ob, int item, char* smem, int oi, bool need_ctx) {
  bf16_t* Zs = (bf16_t*)smem;
  float* segA = (float*)(Zs + 128 * ZS);
  float* segB = segA + 256;
  float* carry = segB + 256;
  float* La = (float*)Zs;
  float* Gz = La + 4096;
  const int tid = otid(), lane = tid & 63, w = __builtin_amdgcn_readfirstlane(tid >> 6);
  const int r = lane & 31, h = lane >> 5;
  const int wm = w >> 1, wn = w & 1;
  const int b = item >> 6, cs = item & 31;
  constexpr int dir = DIR;
  const int hd = cs >> 3, j0 = (cs & 7) * 32, c0 = cs * 32;
  bf16_t* sout = dir ? ob.sb : p.hbuf;
  const bf16_t* zb = ob.sg + (size_t)NR * 1024;
  __syncthreads();
  if (tid < 32) carry[tid] = 0.f;
  bf16x8 bfr[16];
  {
    const size_t mo = ((size_t)((oi * 2 + dir) * 4 + hd)) * 65536 + (size_t)(j0 + r) * 256 + h * 8;
    const bf16_t* wsrc = (wn ? p.wgi : p.wga) + mo;
#pragma unroll
    for (int ks = 0; ks < 16; ++ks) bfr[ks] = *(const bf16x8*)(wsrc + ks * 16);
  }
  const int gch = (oi * 2 + dir) * 1024 + c0 + r;
  const float gbias = wn ? p.c_b_i[gch] : p.c_b_a[gch];
  const float spl = log1pf(__expf(-p.c_lam[gch]));
  const int sc_c = tid & 31, sc_sg = tid >> 5;
  const int lrow = tid >> 5, kc = tid & 31;

  u32x4 zt[4];
  {
    const int Rs0 = NL + b * LCTX;
    const int ti0 = dir ? 1 : 0;
    const bf16_t* src = zb + (size_t)(Rs0 + ti0 * 128 + lrow) * 1024 + hd * 256 + kc * 8;
#pragma unroll
    for (int i = 0; i < 4; ++i) zt[i] = *(const u32x4*)(src + (size_t)i * 8 * 1024);
  }
  const int sbase = DIR ? (7 - sc_sg) * 16 : sc_sg * 16;
  const unsigned voff = (unsigned)(sbase * 1024 + c0 + sc_c);
  for (int step = 0; step < 34; ++step) {
    int Rs, ti;
    bool wr;
    if (step < 2) { Rs = NL + b * LCTX; ti = dir ? 1 - step : step; wr = need_ctx; }
    else { Rs = b * SEQL; ti = dir ? 31 - (step - 2) : (step - 2); wr = true; }
    const int t0 = ti * 128;
    __syncthreads();
    {
      const bf16_t* src2 = zb + (size_t)(Rs + t0 + lrow + 32) * 1024 + hd * 256 + kc * 8;
      u32x4 z2[12];
#pragma unroll
      for (int i = 0; i < 12; ++i) z2[i] = *(const u32x4*)(src2 + (size_t)i * 8 * 1024);
#pragma unroll
      for (int i = 0; i < 4; ++i) *(u32x4*)(Zs + (lrow + 8 * i) * ZS + kc * 8) = zt[i];
#pragma unroll
      for (int i = 0; i < 12; ++i) *(u32x4*)(Zs + (lrow + 32 + 8 * i) * ZS + kc * 8) = z2[i];
    }
    const bf16_t* sgp = ob.sg + (size_t)(Rs + t0) * 1024;
    bf16_t sgv[16];
    if (wr) {
#pragma unroll
      for (int i = 0; i < 16; ++i) sgv[i] = sgp[voff + (DIR ? 15 - i : i) * 1024];
    }
    __syncthreads();
    f32x16 acc[2];
    acc[0] = zero16();
    acc[1] = zero16();
    {
      const bf16_t* Aw = Zs + (wm * 64 + r) * ZS + h * 8;
#pragma unroll
      for (int ks = 0; ks < 16; ++ks) {
        bf16x8 a0 = *(const bf16x8*)(Aw + ks * 16);
        bf16x8 a1 = *(const bf16x8*)(Aw + 32 * ZS + ks * 16);
        acc[0] = __builtin_amdgcn_mfma_f32_32x32x16_bf16(a0, bfr[ks], acc[0], 0, 0, 0);
        acc[1] = __builtin_amdgcn_mfma_f32_32x32x16_bf16(a1, bfr[ks], acc[1], 0, 0, 0);
      }
    }
    if (wn == 0) {
#pragma unroll
      for (int mi = 0; mi < 2; ++mi)
#pragma unroll
        for (int reg = 0; reg < 16; ++reg) acc[mi][reg] = -8.f * spl * sigmoid_f(acc[mi][reg] + gbias);
    } else {
#pragma unroll
      for (int mi = 0; mi < 2; ++mi) {
        float zv[16];
#pragma unroll
        for (int reg = 0; reg < 16; ++reg) {
          const int row = wm * 64 + mi * 32 + (reg & 3) + 8 * (reg >> 2) + 4 * h;
          zv[reg] = bf2f(Zs[row * ZS + j0 + r]);
        }
#pragma unroll
        for (int reg = 0; reg < 16; ++reg) acc[mi][reg] = zv[reg] * sigmoid_f(acc[mi][reg] + gbias);
        asm volatile("" ::: "memory");
      }
    }
    __syncthreads();
    {
      float* dstb = wn ? Gz : La;
#pragma unroll
      for (int mi = 0; mi < 2; ++mi)
#pragma unroll
        for (int reg = 0; reg < 16; ++reg) {
          const int row = wm * 64 + mi * 32 + (reg & 3) + 8 * (reg >> 2) + 4 * h;
          dstb[row * 32 + r] = acc[mi][reg];
        }
    }
    __syncthreads();
    if (step + 1 < 34) {
      const int ns = step + 1;
      int nRs, nti;
      if (ns < 2) { nRs = NL + b * LCTX; nti = dir ? 1 - ns : ns; }
      else { nRs = b * SEQL; nti = dir ? 31 - (ns - 2) : (ns - 2); }
      const bf16_t* src = zb + (size_t)(nRs + nti * 128 + lrow) * 1024 + hd * 256 + kc * 8;
#pragma unroll
      for (int i = 0; i < 4; ++i) zt[i] = *(const u32x4*)(src + (size_t)i * 8 * 1024);
    }
    bf16_t* sop = sout + (size_t)(Rs + t0) * 1024;
    const float* Lap = La + sbase * 32 + sc_c;
    const float* Gzp = Gz + sbase * 32 + sc_c;
    {
      float A = 1.f, Bv = 0.f;
      float* Law = La + sbase * 32 + sc_c;
      float* Gzw = Gz + sbase * 32 + sc_c;
#pragma unroll
      for (int i = 0; i < 16; ++i) {
        const int ro = (DIR ? 15 - i : i) * 32;
        const float la = Lap[ro];
        const float a = __expf(la);
        const float mult = __builtin_amdgcn_sqrtf(fmaf(-a, a, 1.f));
        const float bx = mult * Gzp[ro];
        Law[ro] = a;
        Gzw[ro] = bx;
        Bv = a * Bv + bx;
        A *= a;
      }
      segA[sc_sg * 32 + sc_c] = A;
      segB[sc_sg * 32 + sc_c] = Bv;
    }
    __syncthreads();
    {
      float hh = carry[(step & 1) * 32 + sc_c];
      {
        float sa[7], sbv[7];
#pragma unroll
        for (int s2 = 0; s2 < 7; ++s2) { sa[s2] = segA[s2 * 32 + sc_c]; sbv[s2] = segB[s2 * 32 + sc_c]; }
#pragma unroll
        for (int s2 = 0; s2 < 7; ++s2) hh = (s2 < sc_sg) ? (sa[s2] * hh + sbv[s2]) : hh;
      }
#pragma unroll
      for (int i = 0; i < 16; ++i) {
        const int ro = (DIR ? 15 - i : i);
        hh = Lap[ro * 32] * hh + Gzp[ro * 32];
        if (wr) sop[voff + ro * 1024] = f2bf(hh * bf2f(sgv[i]));
      }
      if (sc_sg == 7) carry[((step + 1) & 1) * 32 + sc_c] = hh;
    }
  }
}

__device__ void phase_rglru(const Params& p, char* smem, int oi, bool need_ctx) {
  const OddBufs ob = odd_bufs(p);
  for (int it0 = blockIdx.x; it0 < 512; it0 += gridDim.x) {
    const int xcd = it0 & 7, slot = it0 >> 3;
    const int grp = xcd * 4 + (slot >> 4), j = slot & 15;
    const int item = ((grp >> 2) << 6) | ((j >> 3) << 5) | ((grp & 3) << 3) | (j & 7);
    if ((item >> 5) & 1) rglru_item<1>(p, ob, item, smem, oi, need_ctx);
    else rglru_item<0>(p, ob, item, smem, oi, need_ctx);
  }
}

#define XB_TMO      128
#define XB_XCNT(j)  (256  + 64 * (j))
#define XB_XSUB(j)  (1280 + 64 * (j))
#define XB_XGEN(j)  (2304 + 64 * (j))
#define XB_TOP      3328
#define XB_TOPGEN   3392
#define XCD_BAR_WORDS 3456
#define XB_SPIN_CAP (1u << 18)
#define LAS __attribute__((address_space(3)))

__device__ __forceinline__ unsigned xb_ld(unsigned* p)              { return __hip_atomic_load(p, __ATOMIC_RELAXED, __HIP_MEMORY_SCOPE_AGENT); }
__device__ __forceinline__ unsigned xb_add(unsigned* p, unsigned v) { return __hip_atomic_fetch_add(p, v, __ATOMIC_RELAXED, __HIP_MEMORY_SCOPE_AGENT); }
__device__ __forceinline__ unsigned xb_xcc_id() { return (unsigned)__builtin_amdgcn_s_getreg((3 << 11) | 20) & 0xFu; }
#define XB_SPIN(cond, bar) do { unsigned _sp = 0; while (cond) { __builtin_amdgcn_s_sleep(1); \
    if ((++_sp & 255u) == 0u) { if (xb_ld(&(bar)[XB_TMO])) break; if (_sp > XB_SPIN_CAP) { atomicAdd(&(bar)[XB_TMO], 1u); break; } } } } while (0)

struct XcdBarrier {
    unsigned* bar; unsigned x;
    volatile LAS unsigned* st;
};

__device__ __forceinline__ XcdBarrier xcd_barrier_post(unsigned* bar, volatile LAS unsigned* st) {
    XcdBarrier b; b.bar = bar; b.x = xb_xcc_id(); b.st = st;
    if (threadIdx.x == 0) (void)xb_add(&bar[XB_XCNT(b.x)], 1u);
    return b;
}
__device__ __forceinline__ void xcd_barrier_complete(unsigned* bar, unsigned x, unsigned& nloc, unsigned& nx) {
    const unsigned G = gridDim.x * gridDim.y * gridDim.z;
    unsigned sum, cnt, mine, sp = 0u;
    for (;;) {
        sum = 0u; cnt = 0u; mine = 0u;
#pragma unroll
        for (unsigned j = 0; j < 16; ++j) { const unsigned c = xb_ld(&bar[XB_XCNT(j)]); sum += c; cnt += (c > 0u) ? 1u : 0u; mine = (j == x) ? c : mine; }
        if (sum == G) break;
        __builtin_amdgcn_s_sleep(1);
        if ((++sp & 255u) == 0u) { if (xb_ld(&bar[XB_TMO])) break; if (sp > XB_SPIN_CAP) { atomicAdd(&bar[XB_TMO], 1u); break; } }
    }
    nloc = mine > 0u ? mine : 1u; nx = cnt > 0u ? cnt : 1u;
}

__device__ __forceinline__ void xcd_barrier(const XcdBarrier& b) {
    asm volatile("s_waitcnt vmcnt(0)" ::: "memory");
    __syncthreads();
    if (threadIdx.x == 0) {
        unsigned* bar = b.bar;
        __builtin_amdgcn_s_waitcnt(0);
        unsigned nloc = b.st[0], nx = b.st[1];
        if (nloc == 0u) { xcd_barrier_complete(bar, b.x, nloc, nx); b.st[0] = nloc; b.st[1] = nx; }
        const unsigned old = xb_add(&bar[XB_XSUB(b.x)], 1u);
        const unsigned gen = old / nloc;
        if (old + 1u == (gen + 1u) * nloc) {
            __builtin_amdgcn_fence(__ATOMIC_RELEASE, "agent");
            asm volatile("s_waitcnt vmcnt(0)" ::: "memory");
            const unsigned og = xb_add(&bar[XB_TOP], 1u);
            const unsigned tg = og / nx;
            if (og + 1u == (tg + 1u) * nx) xb_add(&bar[XB_TOPGEN], 1u);
            else XB_SPIN(xb_ld(&bar[XB_TOPGEN]) == tg, bar);
            __builtin_amdgcn_fence(__ATOMIC_ACQUIRE, "agent");
            xb_add(&bar[XB_XGEN(b.x)], 1u);
            asm volatile("s_waitcnt vmcnt(0)" ::: "memory");
        } else {
            XB_SPIN(xb_ld(&bar[XB_XGEN(b.x)]) == gen, bar);
            __builtin_amdgcn_fence(__ATOMIC_ACQUIRE, "agent");
            asm volatile("s_waitcnt vmcnt(0)" ::: "memory");
        }
    }
    __syncthreads();
}


#define LAUNDER(f) q.f = p.f + z
__device__ __forceinline__ void launder(Params& q, const Params& p) {
  long z;
  asm volatile("s_mov_b64 %0, 0" : "=s"(z));
  LAUNDER(x); LAUNDER(c); LAUNDER(ctx); LAUNDER(c_ctx); LAUNDER(norm_g); LAUNDER(w_mod); LAUNDER(b_mod);
  LAUNDER(ab_w_in); LAUNDER(a_ln_g); LAUNDER(a_ln_b); LAUNDER(a_w_s); LAUNDER(a_b_s); LAUNDER(b_sink);
  LAUNDER(ab_w_out); LAUNDER(c_w_in); LAUNDER(c_conv_w); LAUNDER(c_conv_b); LAUNDER(c_w_a); LAUNDER(c_b_a);
  LAUNDER(c_w_i); LAUNDER(c_b_i); LAUNDER(c_lam); LAUNDER(c_w_out); LAUNDER(final_g); LAUNDER(out);
  LAUNDER(xbuf); LAUNDER(mods); LAUNDER(hbuf); LAUNDER(ebuf); LAUNDER(wt_in_e); LAUNDER(wt_out_e);
  LAUNDER(wt_in_o); LAUNDER(wt_out_o); LAUNDER(wga); LAUNDER(wgi);
}

constexpr int NPHASES = 20;

__device__ void run_phase(const Params& p0, int ph, char* smem) {
  if (ph == 0) { Params p; launder(p, p0); phase0(p, smem); return; }
  if (ph == 19) { Params p; launder(p, p0); phase_final(p); return; }
  int layer, sub;
  if (ph < 5) { layer = 0; sub = ph - 1; }
  else if (ph < 10) { layer = 1; sub = ph - 5; }
  else if (ph < 14) { layer = 2; sub = ph - 10; }
  else { layer = 3; sub = ph - 14; }
  const int idx = layer >> 1;
  const bool even = (layer & 1) == 0;
  const bool need_ctx = layer < 3;
  if (sub == 0) { Params p; launder(p, p0); phase_prep(p, layer); return; }
  if (even) {
    if (sub == 1) {
      Params p; launder(p, p0);
      EpiEvenIn epi; epi.e = even_bufs(p);
      gemm_phase_big(p.hbuf, p.wt_in_e + (size_t)idx * 2816 * 1024, NR / 256, 22, smem, epi);
    } else if (sub == 2) {
      Params p; launder(p, p0);
      phase_even_mix(p, smem, idx);
    } else {
      Params p; launder(p, p0);
      EpiOut epi; epi.xbuf = p.xbuf; epi.mods_l = p.mods + (size_t)layer * 9 * 3072;
      gemm_phase<0>(p.hbuf, nullptr, p.wt_out_e + (size_t)idx * 1024 * 1024, NR / 128, 8, smem, epi);
    }
  } else {
    if (sub == 1) {
      Params p; launder(p, p0);
      EpiOddIn epi; epi.o = odd_bufs(p);
      gemm_phase_big(p.hbuf, p.wt_in_o + (size_t)idx * 2048 * 1024, NR / 256, 16, smem, epi);
    } else if (sub == 2) {
      Params p; launder(p, p0);
      phase_conv(p, idx);
    } else if (sub == 3) {
      Params p; launder(p, p0);
      phase_rglru(p, smem, idx, need_ctx);
    } else {
      Params p; launder(p, p0);
      EpiOut epi; epi.xbuf = p.xbuf; epi.mods_l = p.mods + (size_t)layer * 9 * 3072;
      const OddBufs ob = odd_bufs(p);
      gemm_phase<1>(p.hbuf, ob.sb, p.wt_out_o + (size_t)idx * 1024 * 1024, (need_ctx ? NR : NL) / 128, 8, smem, epi);
    }
  }
}

__global__ void __launch_bounds__(NTHREADS, 2) mega_kernel(Params p, int ph_lo, int ph_hi, int use_bar) {
  __shared__ __attribute__((aligned(16))) char smem[SMEM_BYTES];
  __shared__ uint4 xb_words;
  if (threadIdx.x == 0) xb_words = make_uint4(0u, 0u, 0u, 0u);
  __syncthreads();
  if (use_bar == 1) (void)xcd_barrier_post(p.bar, (volatile LAS unsigned*)&xb_words);
  for (int ph = ph_lo; ph < ph_hi; ++ph) {
    run_phase(p, ph, smem);
    if (ph + 1 < ph_hi) {
      if (use_bar == 1) {
        XcdBarrier xb;
        xb.bar = p.bar; xb.x = xb_xcc_id(); xb.st = (volatile LAS unsigned*)&xb_words;
        xcd_barrier(xb);
      } else if (use_bar == 2) cg::this_grid().sync();
    }
  }
}

extern "C" void kernel_launch(void* const* d_in, const int* in_sizes, int n_in, void* d_out, int out_size,
                              void* d_ws, size_t ws_size, hipStream_t stream) {
  static int grid_blocks = 0;
  if (!grid_blocks) {
    int dev = 0, cus = 0, per_cu = 0;
    hipGetDevice(&dev);
    hipDeviceGetAttribute(&cus, hipDeviceAttributeMultiprocessorCount, dev);
    hipOccupancyMaxActiveBlocksPerMultiprocessor(&per_cu, mega_kernel, NTHREADS, 0);
    if (per_cu < 1) per_cu = 1;
    if (per_cu > 2) per_cu = 2;
    grid_blocks = cus * per_cu;
  }
  Params p{};
  const float** fp = (const float**)&p;
  for (int i = 0; i < 24; ++i) fp[i] = (const float*)d_in[i];
  p.out = (float*)d_out;
  char* ws = (char*)d_ws;
  size_t off = 0;
  auto take = [&](size_t bytes) { char* q = ws + off; off += (bytes + 255) & ~(size_t)255; return q; };
  p.xbuf = (float*)take((size_t)NR * 1024 * 4);
  p.mods = (float*)take((size_t)4 * 9 * 3072 * 4);
  p.hbuf = (bf16_t*)take((size_t)NR * 1024 * 2);
  p.ebuf = (bf16_t*)take((size_t)NR * 3072 * 2);
  p.wt_in_e = (bf16_t*)take((size_t)2 * 2816 * 1024 * 2);
  p.wt_out_e = (bf16_t*)take((size_t)2 * 1024 * 1024 * 2);
  p.wt_in_o = (bf16_t*)take((size_t)2 * 2048 * 1024 * 2);
  p.wt_out_o = (bf16_t*)take((size_t)2 * 1024 * 1024 * 2);
  p.wga = (bf16_t*)take((size_t)16 * 65536 * 2);
  p.wgi = (bf16_t*)take((size_t)16 * 65536 * 2);
  p.bar = (unsigned*)take((size_t)XCD_BAR_WORDS * 4);
  if (off > ws_size) fprintf(stderr, "workspace too small: need %zu have %zu\n", off, ws_size);
#if COOP
  hipMemsetAsync(p.bar, 0, (size_t)XCD_BAR_WORDS * 4, stream);
  int lo = 0, hi = NPHASES, ub = 1;
  void* args[] = {&p, &lo, &hi, &ub};
  hipError_t e = hipLaunchCooperativeKernel((void*)mega_kernel, dim3(grid_blocks), dim3(NTHREADS), args, 0, stream);
  if (e != hipSuccess) fprintf(stderr, "cooperative launch failed: %s (grid %d)\n", hipGetErrorString(e), grid_blocks);
#else
  for (int ph = 0; ph < NPHASES; ++ph) mega_kernel<<<grid_blocks, NTHREADS, 0, stream>>>(p, ph, ph + 1, 0);
#endif
}
```

```cpp
#include <hip/hip_runtime.h>
#include <hip/hip_cooperative_groups.h>
#include <stdint.h>
#include <stdio.h>
namespace cg = cooperative_groups;

#ifndef COOP
#define COOP 1
#endif

typedef unsigned short bf16_t;
typedef __attribute__((ext_vector_type(8))) short bf16x8;
typedef __attribute__((ext_vector_type(16))) float f32x16;
typedef __attribute__((ext_vector_type(4))) unsigned int u32x4;
typedef __attribute__((ext_vector_type(2))) unsigned int u32x2;

constexpr int DM = 1024;
constexpr int NBATCH = 8;
constexpr int SEQL = 4096;
constexpr int LCTX = 256;
constexpr int NL = NBATCH * SEQL;
constexpr int NC = NBATCH * LCTX;
constexpr int NR = NL + NC;
constexpr int SMEM_BYTES = 72 * 1024;
constexpr int NTHREADS = 256;

struct Params {
  const float *x, *c, *ctx, *c_ctx, *norm_g, *w_mod, *b_mod, *ab_w_in, *a_ln_g, *a_ln_b, *a_w_s, *a_b_s,
      *b_sink, *ab_w_out, *c_w_in, *c_conv_w, *c_conv_b, *c_w_a, *c_b_a, *c_w_i, *c_b_i, *c_lam, *c_w_out,
      *final_g;
  float* out;
  float* xbuf;
  float* mods;
  bf16_t* hbuf;
  bf16_t* ebuf;
  bf16_t *wt_in_e, *wt_out_e, *wt_in_o, *wt_out_o, *wga, *wgi;
  unsigned* bar;
};

typedef __bf16 hwbf16x2 __attribute__((ext_vector_type(2)));
typedef float f32x2v __attribute__((ext_vector_type(2)));
__device__ __forceinline__ uint32_t pack2(float a, float b) {
  f32x2v v = {a, b};
  hwbf16x2 r = __builtin_convertvector(v, hwbf16x2);
  return __builtin_bit_cast(uint32_t, r);
}
__device__ __forceinline__ bf16_t f2bf(float f) { return (bf16_t)(pack2(f, f) & 0xffffu); }
__device__ __forceinline__ float bf2f(bf16_t b) { return __uint_as_float(((uint32_t)b) << 16); }
__device__ __forceinline__ float lo_bf(uint32_t u) { return __uint_as_float(u << 16); }
__device__ __forceinline__ float hi_bf(uint32_t u) { return __uint_as_float(u & 0xffff0000u); }
__device__ __forceinline__ float frcp(float x) { return __builtin_amdgcn_rcpf(x); }
__device__ __forceinline__ float silu_f(float x) { return x * frcp(1.f + __expf(-x)); }
__device__ __forceinline__ float sigmoid_f(float x) { return frcp(1.f + __expf(-x)); }
__device__ __forceinline__ float gelu_f(float x) {
  float y = 0.7978845608028654f * (x + 0.044715f * x * x * x);
  float t = 1.f - 2.f * frcp(1.f + __expf(2.f * y));
  return 0.5f * x * (1.f + t);
}
__device__ __forceinline__ f32x16 zero16() {
  f32x16 z;
#pragma unroll
  for (int i = 0; i < 16; ++i) z[i] = 0.f;
  return z;
}
__device__ __forceinline__ float wave_sum(float v) {
#pragma unroll
  for (int o = 32; o > 0; o >>= 1) v += __shfl_xor(v, o);
  return v;
}

__device__ __forceinline__ int otid() {
  int t = threadIdx.x;
  asm volatile("" : "+v"(t));
  return t;
}

struct EvenBufs {
  bf16_t *ug, *vg, *gas, *qb, *gbs, *kb, *vtl, *vtc;
};
__device__ __forceinline__ EvenBufs even_bufs(const Params& p) {
  EvenBufs e;
  e.ug = p.ebuf;
  e.vg = e.ug + (size_t)NR * 512;
  e.gas = e.vg + (size_t)NR * 512;
  e.qb = e.gas + (size_t)NR * 512;
  e.gbs = e.qb + (size_t)NR * 512;
  e.kb = e.gbs + (size_t)NR * 512;
  e.vtl = e.kb + (size_t)NR * 128;
  e.vtc = e.vtl + (size_t)NBATCH * 128 * SEQL;
  return e;
}
struct OddBufs {
  bf16_t *xr, *sg, *sb;
};
__device__ __forceinline__ OddBufs odd_bufs(const Params& p) {
  OddBufs o;
  o.xr = p.ebuf;
  o.sg = o.xr + (size_t)NR * 1024;
  o.sb = o.xr;
  return o;
}

__device__ void transpose_item(const Params& p, int item, char* smem) {
  float* tile = (float*)smem;
  const float* src;
  bf16_t* dst;
  int K, N, local;
  if (item < 1408) { src = p.ab_w_in; dst = p.wt_in_e; K = 1024; N = 2816; local = item; }
  else if (item < 1920) { src = p.ab_w_out; dst = p.wt_out_e; K = 1024; N = 1024; local = item - 1408; }
  else if (item < 2944) { src = p.c_w_in; dst = p.wt_in_o; K = 1024; N = 2048; local = item - 1920; }
  else if (item < 3456) { src = p.c_w_out; dst = p.wt_out_o; K = 1024; N = 1024; local = item - 2944; }
  else if (item < 3712) { src = p.c_w_a; dst = p.wga; K = 256; N = 256; local = item - 3456; }
  else { src = p.c_w_i; dst = p.wgi; K = 256; N = 256; local = item - 3712; }
  const int ntn = N / 64;
  const int tpb = (K / 64) * ntn;
  const int bi = local / tpb;
  const int rem = local % tpb;
  const int k0 = (rem / ntn) * 64, n0 = (rem % ntn) * 64;
  src += (size_t)bi * K * N;
  dst += (size_t)bi * K * N;
  const int tid = otid();
  __syncthreads();
#pragma unroll
  for (int i = 0; i < 16; ++i) {
    int rr = i * 4 + (tid >> 6), cc = tid & 63;
    tile[rr * 65 + cc] = src[(size_t)(k0 + rr) * N + n0 + cc];
  }
  __syncthreads();
#pragma unroll
  for (int i = 0; i < 16; ++i) {
    int n = i * 4 + (tid >> 6), k = tid & 63;
    dst[(size_t)(n0 + n) * K + k0 + k] = f2bf(tile[k * 65 + n]);
  }
}

__device__ void mods_item(const Params& p, int item, char* smem) {
  float* sc = (float*)smem;
  float* red = sc + 9 * 1024;
  const int tid = otid();
  const int l = item / 96, n0 = (item % 96) * 32;
  __syncthreads();
  for (int i = tid; i < 9 * 1024; i += NTHREADS) {
    int j = i >> 10, k = i & 1023;
    float v = (j < 8) ? p.c[j * 1024 + k] : p.c_ctx[k];
    sc[i] = silu_f(v);
  }
  __syncthreads();
  const int col = tid & 31, kg = tid >> 5;
  float acc[9];
#pragma unroll
  for (int j = 0; j < 9; ++j) acc[j] = 0.f;
  const float* w = p.w_mod + ((size_t)l * 1024 + kg * 128) * 3072 + n0 + col;
#pragma unroll 32
  for (int k = 0; k < 128; ++k) {
    float wv = w[(size_t)k * 3072];
#pragma unroll
    for (int j = 0; j < 9; ++j) acc[j] += sc[j * 1024 + kg * 128 + k] * wv;
  }
#pragma unroll
  for (int j = 0; j < 9; ++j) red[(kg * 9 + j) * 32 + col] = acc[j];
  __syncthreads();
  for (int i = tid; i < 9 * 32; i += NTHREADS) {
    int j = i >> 5, cc = i & 31;
    float s = 0.f;
#pragma unroll
    for (int g = 0; g < 8; ++g) s += red[(g * 9 + j) * 32 + cc];
    p.mods[((size_t)l * 9 + j) * 3072 + n0 + cc] = s + p.b_mod[l * 3072 + n0 + cc];
  }
}

__device__ void phase0(const Params& p, char* smem) {
  const int total = 3968 + 384;
  for (int item = blockIdx.x; item < total; item += gridDim.x) {
    if (item < 384) mods_item(p, item, smem);
    else transpose_item(p, item - 384, smem);
  }
}

__device__ void phase_prep(const Params& p, int layer) {
  const int tid = otid();
  const int lane = tid & 63;
  const int gw = blockIdx.x * 4 + (tid >> 6);
  const int nw = gridDim.x * 4;
  const float* ng = p.norm_g + layer * 1024;
  for (int R = gw; R < NR; R += nw) {
    const float* src;
    if (layer == 0) src = (R < NL) ? p.x + (size_t)R * 1024 : p.ctx + (size_t)(R - NL) * 1024;
    else src = p.xbuf + (size_t)R * 1024;
    const int bidx = (R < NL) ? (R >> 12) : 8;
    const float* md = p.mods + ((size_t)layer * 9 + bidx) * 3072;
    float4 v[4];
#pragma unroll
    for (int i = 0; i < 4; ++i) v[i] = ((const float4*)src)[lane + 64 * i];
    float ss = 0.f;
#pragma unroll
    for (int i = 0; i < 4; ++i) ss += v[i].x * v[i].x + v[i].y * v[i].y + v[i].z * v[i].z + v[i].w * v[i].w;
    ss = wave_sum(ss);
    const float rstd = rsqrtf(ss * (1.f / 1024.f) + 1e-6f);
#pragma unroll
    for (int i = 0; i < 4; ++i) {
      const int k4 = lane + 64 * i;
      float4 g = ((const float4*)ng)[k4];
      float4 sh = ((const float4*)md)[k4];
      float4 sc = ((const float4*)(md + 1024))[k4];
      float h0 = v[i].x * rstd * g.x * (1.f + sc.x) + sh.x;
      float h1 = v[i].y * rstd * g.y * (1.f + sc.y) + sh.y;
      float h2 = v[i].z * rstd * g.z * (1.f + sc.z) + sh.z;
      float h3 = v[i].w * rstd * g.w * (1.f + sc.w) + sh.w;
      u32x2 pk;
      pk.x = pack2(h0, h1);
      pk.y = pack2(h2, h3);
      *(u32x2*)(p.hbuf + (size_t)R * 1024 + k4 * 4) = pk;
    }
  }
}

__device__ void phase_final(const Params& p) {
  const int tid = otid();
  const int lane = tid & 63;
  const int gw = blockIdx.x * 4 + (tid >> 6);
  const int nw = gridDim.x * 4;
  for (int R = gw; R < NL; R += nw) {
    const float* src = p.xbuf + (size_t)R * 1024;
    float4 v[4];
#pragma unroll
    for (int i = 0; i < 4; ++i) v[i] = ((const float4*)src)[lane + 64 * i];
    float ss = 0.f;
#pragma unroll
    for (int i = 0; i < 4; ++i) ss += v[i].x * v[i].x + v[i].y * v[i].y + v[i].z * v[i].z + v[i].w * v[i].w;
    ss = wave_sum(ss);
    const float rstd = rsqrtf(ss * (1.f / 1024.f) + 1e-6f);
#pragma unroll
    for (int i = 0; i < 4; ++i) {
      const int k4 = lane + 64 * i;
      float4 g = ((const float4*)p.final_g)[k4];
      float4 o;
      o.x = v[i].x * rstd * g.x;
      o.y = v[i].y * rstd * g.y;
      o.z = v[i].z * rstd * g.z;
      o.w = v[i].w * rstd * g.w;
      ((float4*)(p.out + (size_t)R * 1024))[k4] = o;
    }
  }
}

constexpr int GS = 72;

__device__ __forceinline__ u32x4 add_bf16x8(u32x4 a, u32x4 b) {
  u32x4 r;
  r.x = pack2(lo_bf(a.x) + lo_bf(b.x), hi_bf(a.x) + hi_bf(b.x));
  r.y = pack2(lo_bf(a.y) + lo_bf(b.y), hi_bf(a.y) + hi_bf(b.y));
  r.z = pack2(lo_bf(a.z) + lo_bf(b.z), hi_bf(a.z) + hi_bf(b.z));
  r.w = pack2(lo_bf(a.w) + lo_bf(b.w), hi_bf(a.w) + hi_bf(b.w));
  return r;
}

template <int AMODE, class Epi>
__device__ void gemm_phase(const bf16_t* __restrict__ A0, const bf16_t* __restrict__ A1,
                           const bf16_t* __restrict__ Bt, int Mtiles, int Ntiles, char* smem, Epi epi) {
  constexpr int PD = (AMODE == 1) ? 1 : 2;
  constexpr int BUF = 2 * 128 * GS;
  bf16_t* S0 = (bf16_t*)smem;
  const int tid = otid(), lane = tid & 63, w = __builtin_amdgcn_readfirstlane(tid >> 6);
  const int wm = w >> 1, wn = w & 1;
  const int r = lane & 31, h = lane >> 5;
  const int lrow = tid >> 3, kc = tid & 7;
  const int total = Mtiles * Ntiles;
  const int woff = lrow * GS + kc * 8;
  const int aro = (wm * 64 + r) * GS + h * 8;
  const int bro = 128 * GS + (wn * 64 + r) * GS + h * 8;
  const bool swz = ((gridDim.x & 7) == 0) && ((Mtiles & 7) == 0);
  const int xcd = blockIdx.x & 7;
  const int Mx = Mtiles >> 3;
  const int lstart = swz ? (int)(blockIdx.x >> 3) : (int)blockIdx.x;
  const int lstep = swz ? (int)(gridDim.x >> 3) : (int)gridDim.x;
  const int lend = swz ? Mx * Ntiles : total;
  for (int L = lstart; L < lend; L += lstep) {
    int mt, nt;
    if (swz) {
      const int gfull = 8 * Ntiles;
      const int mg = L / gfull, rem = L - mg * gfull;
      const int gs = min(8, Mx - mg * 8);
      nt = rem / gs;
      mt = xcd * Mx + mg * 8 + (rem - nt * gs);
    } else {
      mt = L / Ntiles;
      nt = L - mt * Ntiles;
    }
    const int m0 = mt * 128, n0 = nt * 128;
    const size_t aoff = (size_t)(m0 + lrow) * 1024 + kc * 8;
    const bf16_t* ap = A0 + aoff;
    const bf16_t* ap1 = (AMODE == 1) ? (A1 + aoff) : A0;
    const bf16_t* bp = Bt + (size_t)(n0 + lrow) * 1024 + kc * 8;
    u32x4 ra[PD][4], ra1[PD][4], rb[PD][4];
#define G_LOAD(S, KT)                                                                              \
    {                                                                                              \
      _Pragma("unroll") for (int i = 0; i < 4; ++i) {                                              \
        ra[S][i] = *(const u32x4*)(ap + (size_t)i * 32 * 1024 + (KT) * 64);                        \
        if (AMODE == 1) ra1[S][i] = *(const u32x4*)(ap1 + (size_t)i * 32 * 1024 + (KT) * 64);     \
        rb[S][i] = *(const u32x4*)(bp + (size_t)i * 32 * 1024 + (KT) * 64);                        \
      }                                                                                            \
    }
#define L_WRITE(S, BUFI)                                                                           \
    {                                                                                              \
      bf16_t* dstA = S0 + (BUFI) * BUF + woff;                                                     \
      _Pragma("unroll") for (int i = 0; i < 4; ++i) {                                              \
        u32x4 av = ra[S][i];                                                                       \
        if (AMODE == 1) av = add_bf16x8(av, ra1[S][i]);                                            \
        *(u32x4*)(dstA + 32 * i * GS) = av;                                                        \
        *(u32x4*)(dstA + 128 * GS + 32 * i * GS) = rb[S][i];                                       \
      }                                                                                            \
    }
    G_LOAD(0, 0);
    L_WRITE(0, 0);
#pragma unroll
    for (int s = 0; s < PD; ++s) G_LOAD(s, 1 + s);
    f32x16 acc[2][2];
#pragma unroll
    for (int mi = 0; mi < 2; ++mi)
#pragma unroll
      for (int ni = 0; ni < 2; ++ni) acc[mi][ni] = zero16();
#pragma unroll 1
    for (int kt0 = 0; kt0 < 16; kt0 += 2) {
#pragma unroll
      for (int u = 0; u < 2; ++u) {
        const int kt = kt0 + u;
        constexpr int dummy = 0; (void)dummy;
        const int s = (PD == 2) ? u : 0;
        __syncthreads();
        L_WRITE(s, (u ^ 1));
        {
          const int ktl = (kt + 1 + PD < 16) ? (kt + 1 + PD) : 15;
          G_LOAD(s, ktl);
        }
        const bf16_t* Aw = S0 + u * BUF + aro;
        const bf16_t* Bw = S0 + u * BUF + bro;
#pragma unroll
        for (int ks = 0; ks < 4; ++ks) {
          bf16x8 a0 = *(const bf16x8*)(Aw + ks * 16);
          bf16x8 a1 = *(const bf16x8*)(Aw + 32 * GS + ks * 16);
          bf16x8 b0 = *(const bf16x8*)(Bw + ks * 16);
          bf16x8 b1 = *(const bf16x8*)(Bw + 32 * GS + ks * 16);
          acc[0][0] = __builtin_amdgcn_mfma_f32_32x32x16_bf16(a0, b0, acc[0][0], 0, 0, 0);
          acc[0][1] = __builtin_amdgcn_mfma_f32_32x32x16_bf16(a0, b1, acc[0][1], 0, 0, 0);
          acc[1][0] = __builtin_amdgcn_mfma_f32_32x32x16_bf16(a1, b0, acc[1][0], 0, 0, 0);
          acc[1][1] = __builtin_amdgcn_mfma_f32_32x32x16_bf16(a1, b1, acc[1][1], 0, 0, 0);
        }
      }
    }
#undef G_LOAD
#undef L_WRITE
    epi(acc, m0 + wm * 64, n0 + wn * 64, lane);
  }
}

template <class Epi>
__device__ void gemm_phase_big(const bf16_t* __restrict__ A0, const bf16_t* __restrict__ Bt, int Mtiles  ,
                               int Ntiles, char* smem, Epi epi) {
  bf16_t* As = (bf16_t*)smem;
  bf16_t* Bs = As + 256 * GS;
  const int tid = otid(), lane = tid & 63, w = __builtin_amdgcn_readfirstlane(tid >> 6);
  const int wm = w >> 1, wn = w & 1;
  const int r = lane & 31, h = lane >> 5;
  const int lrow = tid >> 3, kc = tid & 7;
  const bool swz = ((gridDim.x & 7) == 0) && ((Mtiles & 7) == 0);
  const int xcd = blockIdx.x & 7;
  const int Mx = Mtiles >> 3;
  const int lstart = swz ? (int)(blockIdx.x >> 3) : (int)blockIdx.x;
  const int lstep = swz ? (int)(gridDim.x >> 3) : (int)gridDim.x;
  const int lend = swz ? Mx * Ntiles : Mtiles * Ntiles;
  for (int L = lstart; L < lend; L += lstep) {
    int mt, nt;
    if (swz) {
      const int gfull = 8 * Ntiles;
      const int mg = L / gfull, rem = L - mg * gfull;
      const int gs = min(8, Mx - mg * 8);
      nt = rem / gs;
      mt = xcd * Mx + mg * 8 + (rem - nt * gs);
    } else {
      mt = L / Ntiles;
      nt = L - mt * Ntiles;
    }
    const int m0 = mt * 256, n0 = nt * 128;
    const bf16_t* ap = A0 + (size_t)(m0 + lrow) * 1024 + kc * 8;
    const bf16_t* bp = Bt + (size_t)(n0 + lrow) * 1024 + kc * 8;
    u32x4 ra[8], rb[4];
#pragma unroll
    for (int i = 0; i < 8; ++i) ra[i] = *(const u32x4*)(ap + (size_t)i * 32 * 1024);
#pragma unroll
    for (int i = 0; i < 4; ++i) rb[i] = *(const u32x4*)(bp + (size_t)i * 32 * 1024);
    f32x16 acc[2][2][2];
#pragma unroll
    for (int hf = 0; hf < 2; ++hf)
#pragma unroll
      for (int mi = 0; mi < 2; ++mi)
#pragma unroll
        for (int ni = 0; ni < 2; ++ni) acc[hf][mi][ni] = zero16();
#pragma unroll 1
    for (int kt = 0; kt < 16; ++kt) {
      __syncthreads();
#pragma unroll
      for (int i = 0; i < 8; ++i) *(u32x4*)(As + (lrow + 32 * i) * GS + kc * 8) = ra[i];
#pragma unroll
      for (int i = 0; i < 4; ++i) *(u32x4*)(Bs + (lrow + 32 * i) * GS + kc * 8) = rb[i];
      __syncthreads();
      {
        const int k0 = ((kt + 1 < 16) ? (kt + 1) : 15) * 64;
#pragma unroll
        for (int i = 0; i < 8; ++i) ra[i] = *(const u32x4*)(ap + (size_t)i * 32 * 1024 + k0);
#pragma unroll
        for (int i = 0; i < 4; ++i) rb[i] = *(const u32x4*)(bp + (size_t)i * 32 * 1024 + k0);
      }
      const bf16_t* Aw = As + (wm * 128 + r) * GS + h * 8;
      const bf16_t* Bw = Bs + (wn * 64 + r) * GS + h * 8;
#pragma unroll
      for (int ks = 0; ks < 4; ++ks) {
        bf16x8 b0 = *(const bf16x8*)(Bw + ks * 16);
        bf16x8 b1 = *(const bf16x8*)(Bw + 32 * GS + ks * 16);
#pragma unroll
        for (int hf = 0; hf < 2; ++hf) {
          bf16x8 a0 = *(const bf16x8*)(Aw + (hf * 64) * GS + ks * 16);
          bf16x8 a1 = *(const bf16x8*)(Aw + (hf * 64 + 32) * GS + ks * 16);
          acc[hf][0][0] = __builtin_amdgcn_mfma_f32_32x32x16_bf16(a0, b0, acc[hf][0][0], 0, 0, 0);
          acc[hf][0][1] = __builtin_amdgcn_mfma_f32_32x32x16_bf16(a0, b1, acc[hf][0][1], 0, 0, 0);
          acc[hf][1][0] = __builtin_amdgcn_mfma_f32_32x32x16_bf16(a1, b0, acc[hf][1][0], 0, 0, 0);
          acc[hf][1][1] = __builtin_amdgcn_mfma_f32_32x32x16_bf16(a1, b1, acc[hf][1][1], 0, 0, 0);
        }
      }
    }
    epi(acc[0], m0 + wm * 128, n0 + wn * 64, lane);
    epi(acc[1], m0 + wm * 128 + 64, n0 + wn * 64, lane);
  }
}


struct EpiEvenIn {
  EvenBufs e;
  __device__ void operator()(f32x16 (&acc)[2][2], int rb, int cb, int lane) const {
    const int r = lane & 31, h = lane >> 5;
    if (cb < 1536 || cb >= 2304) {
      bf16_t* dst;
      int c0;
      int mode;
      if (cb < 512) { dst = e.ug; c0 = cb; mode = 0; }
      else if (cb < 1024) { dst = e.vg; c0 = cb - 512; mode = 0; }
      else if (cb < 1536) { dst = e.gas; c0 = cb - 1024; mode = 1; }
      else { dst = e.gbs; c0 = cb - 2304; mode = 1; }
#pragma unroll
      for (int mi = 0; mi < 2; ++mi)
#pragma unroll
        for (int ni = 0; ni < 2; ++ni)
#pragma unroll
          for (int reg = 0; reg < 16; ++reg) {
            const int row = rb + mi * 32 + (reg & 3) + 8 * (reg >> 2) + 4 * h;
            const int col = c0 + ni * 32 + r;
            float v = acc[mi][ni][reg];
            v = (mode == 0) ? gelu_f(v) : silu_f(v);
            dst[(size_t)row * 512 + col] = f2bf(v);
          }
    } else if (cb < 2176) {
      const bool isq = cb < 2048;
      bf16_t* dst = isq ? e.qb : e.kb;
      const int c0 = isq ? (cb - 1536) : (cb - 2048);
      const int ld = isq ? 512 : 128;
      const float scale = isq ? 0.125f : 1.f;
      const bool latent = rb < NL;
      const float inv_freq = exp2f(-(float)(r & 15) * 0.8304820237218406f);
#pragma unroll
      for (int mi = 0; mi < 2; ++mi)
#pragma unroll
        for (int reg = 0; reg < 16; ++reg) {
          const int row = rb + mi * 32 + (reg & 3) + 8 * (reg >> 2) + 4 * h;
          float x1 = acc[mi][0][reg], x2 = acc[mi][1][reg];
          float o1 = x1, o2 = x2;
          if (latent) {
            const int t = row & (SEQL - 1);
            const float pos = (float)((r < 16) ? (t >> 6) : (t & 63));
            const float ang = pos * inv_freq;
            const float cs = __cosf(ang), sn = __sinf(ang);
            o1 = x1 * cs - x2 * sn;
            o2 = x2 * cs + x1 * sn;
          }
          dst[(size_t)row * ld + c0 + r] = f2bf(o1 * scale);
          dst[(size_t)row * ld + c0 + 32 + r] = f2bf(o2 * scale);
        }
    } else {
      const int kvh = (cb - 2176) >> 6;
      const bool latent = rb < NL;
#pragma unroll
      for (int mi = 0; mi < 2; ++mi)
#pragma unroll
        for (int ni = 0; ni < 2; ++ni)
#pragma unroll
          for (int q4 = 0; q4 < 4; ++q4) {
            const int row = rb + mi * 32 + 8 * q4 + 4 * h;
            const int d = ni * 32 + r;
            u32x2 pk;
            pk.x = pack2(acc[mi][ni][q4 * 4 + 0], acc[mi][ni][q4 * 4 + 1]);
            pk.y = pack2(acc[mi][ni][q4 * 4 + 2], acc[mi][ni][q4 * 4 + 3]);
            if (latent) {
              const int b = row >> 12, t = row & (SEQL - 1);
              *(u32x2*)(e.vtl + ((size_t)((b * 2 + kvh) * 64 + d)) * SEQL + t) = pk;
            } else {
              const int rr = row - NL;
              const int b = rr >> 8, t = rr & (LCTX - 1);
              *(u32x2*)(e.vtc + ((size_t)((b * 2 + kvh) * 64 + d)) * LCTX + t) = pk;
            }
          }
    }
  }
};

struct EpiOddIn {
  OddBufs o;
  __device__ void operator()(f32x16 (&acc)[2][2], int rb, int cb, int lane) const {
    const int r = lane & 31, h = lane >> 5;
    const bool isg = cb >= 1024;
    bf16_t* dst = isg ? o.sg : o.xr;
    const int c0 = isg ? cb - 1024 : cb;
#pragma unroll
    for (int mi = 0; mi < 2; ++mi)
#pragma unroll
      for (int ni = 0; ni < 2; ++ni)
#pragma unroll
        for (int reg = 0; reg < 16; ++reg) {
          const int row = rb + mi * 32 + (reg & 3) + 8 * (reg >> 2) + 4 * h;
          const int col = c0 + ni * 32 + r;
          float v = acc[mi][ni][reg];
          if (isg) v = silu_f(v);
          dst[(size_t)row * 1024 + col] = f2bf(v);
        }
  }
};

struct EpiOut {
  float* xbuf;
  const float* xin_lat;
  const float* xin_ctx;
  const float* mods_l;
  __device__ void operator()(f32x16 (&acc)[2][2], int rb, int cb, int lane) const {
    const int r = lane & 31, h = lane >> 5;
    const int bidx = (rb < NL) ? (rb >> 12) : 8;
    const float* gate = mods_l + (size_t)bidx * 3072 + 2048;
    const float* xin = (rb < NL) ? xin_lat : xin_ctx;
    const int rsub = (rb < NL) ? 0 : NL;
#pragma unroll
    for (int ni = 0; ni < 2; ++ni) {
      const int col = cb + ni * 32 + r;
      const float gv = gate[col];
#pragma unroll
      for (int mi = 0; mi < 2; ++mi)
#pragma unroll
        for (int reg = 0; reg < 16; ++reg) {
          const int row = rb + mi * 32 + (reg & 3) + 8 * (reg >> 2) + 4 * h;
          xbuf[(size_t)row * 1024 + col] = xin[(size_t)(row - rsub) * 1024 + col] + gv * acc[mi][ni][reg];
        }
    }
  }
};

constexpr int AS = 72;

__device__ void attn_item(const Params& p, const EvenBufs& e, int item, char* smem, int ei) {
  bf16_t* Ks = (bf16_t*)smem;
  bf16_t* Vs = Ks + 64 * AS;
  const int tid = otid(), lane = tid & 63, w = __builtin_amdgcn_readfirstlane(tid >> 6);
  const int r = lane & 31, h = lane >> 5;
  int b, hq, start, R0;
  bool isctx;
  if (item < 2048) {
    b = item >> 8;
    hq = (item >> 5) & 7;
    const int qblk = item & 31;
    start = qblk * 128;
    R0 = b * SEQL + start;
    isctx = false;
  } else {
    const int it = item - 2048;
    b = it >> 4;
    hq = (it >> 1) & 7;
    start = (it & 1) * 128;
    R0 = NL + b * LCTX + start;
    isctx = true;
  }
  const int kvh = hq >> 2;
  const int qrow = R0 + w * 32 + r;
  bf16x8 qf[4];
#pragma unroll
  for (int s = 0; s < 4; ++s) qf[s] = *(const bf16x8*)(e.qb + (size_t)qrow * 512 + hq * 64 + s * 16 + h * 8);
  float m = p.b_sink[ei * 8 + hq], l = 1.f;
  f32x16 o[2];
  o[0] = zero16();
  o[1] = zero16();
  const int nblk = isctx ? 4 : 10;
  auto kb_desc = [&](int kb, const bf16_t*& kp, const bf16_t*& vp, int& vstride, int& kpos0, bool& local) -> bool {
    if (kb < 4) {
      kp = e.kb + (size_t)(NL + b * LCTX + kb * 64) * 128 + kvh * 64;
      vp = e.vtc + (size_t)((b * 2 + kvh) * 64) * LCTX + kb * 64;
      vstride = LCTX; kpos0 = 0; local = false;
      return true;
    }
    kpos0 = start - 128 + (kb - 4) * 64;
    local = true;
    if (kpos0 < 0 || kpos0 >= SEQL) return false;
    kp = e.kb + (size_t)(b * SEQL + kpos0) * 128 + kvh * 64;
    vp = e.vtl + (size_t)((b * 2 + kvh) * 64) * SEQL + kpos0;
    vstride = SEQL;
    return true;
  };
  const int lr0 = tid >> 3, lc0 = tid & 7;
  u32x4 pk0, pk1, pv0, pv1;
  int kbn = 0;
  {
    const bf16_t *kp, *vp; int vs, kp0; bool lc;
    while (!kb_desc(kbn, kp, vp, vs, kp0, lc)) ++kbn;
    pk0 = *(const u32x4*)(kp + (size_t)lr0 * 128 + lc0 * 8);
    pk1 = *(const u32x4*)(kp + (size_t)(lr0 + 32) * 128 + lc0 * 8);
    pv0 = *(const u32x4*)(vp + (size_t)lr0 * vs + lc0 * 8);
    pv1 = *(const u32x4*)(vp + (size_t)(lr0 + 32) * vs + lc0 * 8);
  }
  while (kbn < nblk) {
    const int kb = kbn;
    int kpos0 = 0;
    bool local = false;
    {
      const bf16_t *kp, *vp; int vs;
      kb_desc(kb, kp, vp, vs, kpos0, local);
    }
    __syncthreads();
    *(u32x4*)(Ks + lr0 * AS + lc0 * 8) = pk0;
    *(u32x4*)(Ks + (lr0 + 32) * AS + lc0 * 8) = pk1;
    *(u32x4*)(Vs + lr0 * AS + lc0 * 8) = pv0;
    *(u32x4*)(Vs + (lr0 + 32) * AS + lc0 * 8) = pv1;
    __syncthreads();
    {
      const bf16_t *kp = nullptr, *vp = nullptr; int vs = 0, kp0; bool lc;
      ++kbn;
      while (kbn < nblk && !kb_desc(kbn, kp, vp, vs, kp0, lc)) ++kbn;
      if (kbn < nblk) {
        pk0 = *(const u32x4*)(kp + (size_t)lr0 * 128 + lc0 * 8);
        pk1 = *(const u32x4*)(kp + (size_t)(lr0 + 32) * 128 + lc0 * 8);
        pv0 = *(const u32x4*)(vp + (size_t)lr0 * vs + lc0 * 8);
        pv1 = *(const u32x4*)(vp + (size_t)(lr0 + 32) * vs + lc0 * 8);
      }
    }
    f32x16 s[2];
#pragma unroll
    for (int kt = 0; kt < 2; ++kt) {
      s[kt] = zero16();
#pragma unroll
      for (int ks = 0; ks < 4; ++ks) {
        bf16x8 a = *(const bf16x8*)(Ks + (kt * 32 + r) * AS + ks * 16 + h * 8);
        s[kt] = __builtin_amdgcn_mfma_f32_32x32x16_bf16(a, qf[ks], s[kt], 0, 0, 0);
      }
    }
    if (local) {
      const int qpos = start + w * 32 + r;
#pragma unroll
      for (int kt = 0; kt < 2; ++kt)
#pragma unroll
        for (int reg = 0; reg < 16; ++reg) {
          const int kpos = kpos0 + kt * 32 + (reg & 3) + 8 * (reg >> 2) + 4 * h;
          const int diff = qpos - kpos;
          if (diff > 128 || diff < -128) s[kt][reg] = -1e30f;
        }
    }
    float mx = m;
#pragma unroll
    for (int kt = 0; kt < 2; ++kt)
#pragma unroll
      for (int reg = 0; reg < 16; ++reg) mx = fmaxf(mx, s[kt][reg]);
    mx = fmaxf(mx, __shfl_xor(mx, 32));
    const float alpha = __expf(m - mx);
    m = mx;
    float rs = 0.f;
#pragma unroll
    for (int kt = 0; kt < 2; ++kt)
#pragma unroll
      for (int reg = 0; reg < 16; ++reg) {
        const float pv = __expf(s[kt][reg] - mx);
        rs += pv;
        s[kt][reg] = pv;
      }
    rs += __shfl_xor(rs, 32);
    l = l * alpha + rs;
#pragma unroll
    for (int dt = 0; dt < 2; ++dt)
#pragma unroll
      for (int reg = 0; reg < 16; ++reg) o[dt][reg] *= alpha;
#pragma unroll
    for (int kt = 0; kt < 2; ++kt)
#pragma unroll
      for (int sp = 0; sp < 2; ++sp) {
        union { bf16x8 v; uint32_t u[4]; } pf;
#pragma unroll
        for (int j = 0; j < 4; ++j) pf.u[j] = pack2(s[kt][8 * sp + 2 * j], s[kt][8 * sp + 2 * j + 1]);
#pragma unroll
        for (int dt = 0; dt < 2; ++dt) {
          const bf16_t* vp = Vs + (dt * 32 + r) * AS + kt * 32 + sp * 16 + 4 * h;
          union { bf16x8 v; u32x2 u[2]; } af;
          af.u[0] = *(const u32x2*)(vp);
          af.u[1] = *(const u32x2*)(vp + 8);
          o[dt] = __builtin_amdgcn_mfma_f32_32x32x16_bf16(af.v, pf.v, o[dt], 0, 0, 0);
        }
      }
  }
  const float inv = 1.f / l;
  bf16_t* ymix = p.hbuf;
#pragma unroll
  for (int dt = 0; dt < 2; ++dt)
#pragma unroll
    for (int q4 = 0; q4 < 4; ++q4) {
      const int d0 = dt * 32 + 8 * q4 + 4 * h;
      const u32x2 g = *(const u32x2*)(e.gbs + (size_t)qrow * 512 + hq * 64 + d0);
      u32x2 pk;
      pk.x = pack2(o[dt][q4 * 4 + 0] * inv * lo_bf(g.x), o[dt][q4 * 4 + 1] * inv * hi_bf(g.x));
      pk.y = pack2(o[dt][q4 * 4 + 2] * inv * lo_bf(g.y), o[dt][q4 * 4 + 3] * inv * hi_bf(g.y));
      *(u32x2*)(ymix + (size_t)qrow * 1024 + 512 + hq * 64 + d0) = pk;
    }
}

constexpr int MS = 136;

__device__ void gmlp_item(const Params& p, const EvenBufs& e, int item, char* smem, int ei) {
  bf16_t* Ws = (bf16_t*)smem;
  bf16_t* VT = Ws + 128 * MS;
  const int tid = otid(), lane = tid & 63, w = __builtin_amdgcn_readfirstlane(tid >> 6);
  const int r = lane & 31, h = lane >> 5;
  const int wm = w >> 1, wn = w & 1;
  const int rt = item >> 2, g = item & 3;
  const int R0 = rt * 128;
  __syncthreads();
  {
    const float4* wsrc = (const float4*)(p.a_w_s + (size_t)(ei * 4 + g) * 128 * 128);
#pragma unroll
    for (int i = 0; i < 16; ++i) {
      const int idx = tid + 256 * i;
      const int pp = idx >> 5, q4 = idx & 31;
      float4 v = wsrc[idx];
      u32x2 pk;
      pk.x = pack2(v.x, v.y);
      pk.y = pack2(v.z, v.w);
      *(u32x2*)(Ws + pp * MS + q4 * 4) = pk;
    }
  }
#pragma unroll 1
  for (int hp = 0; hp < 2; ++hp) {
    const int q = hp * 64 + (tid >> 2), qt = tid & 3;
    const bf16_t* vsrc = e.vg + (size_t)(R0 + q) * 512 + g * 128 + qt * 32;
    float xv[32];
#pragma unroll
    for (int i = 0; i < 4; ++i) {
      u32x4 u = *(const u32x4*)(vsrc + i * 8);
      xv[i * 8 + 0] = lo_bf(u.x); xv[i * 8 + 1] = hi_bf(u.x);
      xv[i * 8 + 2] = lo_bf(u.y); xv[i * 8 + 3] = hi_bf(u.y);
      xv[i * 8 + 4] = lo_bf(u.z); xv[i * 8 + 5] = hi_bf(u.z);
      xv[i * 8 + 6] = lo_bf(u.w); xv[i * 8 + 7] = hi_bf(u.w);
    }
    float sm = 0.f;
#pragma unroll
    for (int j = 0; j < 32; ++j) sm += xv[j];
    sm += __shfl_xor(sm, 1);
    sm += __shfl_xor(sm, 2);
    const float mean = sm * (1.f / 128.f);
    float sq = 0.f;
#pragma unroll
    for (int j = 0; j < 32; ++j) { float dlt = xv[j] - mean; sq += dlt * dlt; }
    sq += __shfl_xor(sq, 1);
    sq += __shfl_xor(sq, 2);
    const float rstd = rsqrtf(sq * (1.f / 128.f) + 1e-6f);
    const float* lg = p.a_ln_g + ei * 512 + g * 128 + qt * 32;
    const float* lb = p.a_ln_b + ei * 512 + g * 128 + qt * 32;
#pragma unroll
    for (int j = 0; j < 32; ++j) {
      const float val = (xv[j] - mean) * rstd * lg[j] + lb[j];
      VT[(qt * 32 + j) * MS + q] = f2bf(val);
    }
  }
  __syncthreads();
  f32x16 acc[2][2];
#pragma unroll
  for (int mi = 0; mi < 2; ++mi)
#pragma unroll
    for (int ni = 0; ni < 2; ++ni) acc[mi][ni] = zero16();
  const bf16_t* Aw = Ws + (wm * 64 + r) * MS + h * 8;
  const bf16_t* Bw = VT + (wn * 64 + r) * MS + h * 8;
#pragma unroll
  for (int ks = 0; ks < 8; ++ks) {
    bf16x8 a0 = *(const bf16x8*)(Aw + ks * 16);
    bf16x8 a1 = *(const bf16x8*)(Aw + 32 * MS + ks * 16);
    bf16x8 b0 = *(const bf16x8*)(Bw + ks * 16);
    bf16x8 b1 = *(const bf16x8*)(Bw + 32 * MS + ks * 16);
    acc[0][0] = __builtin_amdgcn_mfma_f32_32x32x16_bf16(a0, b0, acc[0][0], 0, 0, 0);
    acc[0][1] = __builtin_amdgcn_mfma_f32_32x32x16_bf16(a0, b1, acc[0][1], 0, 0, 0);
    acc[1][0] = __builtin_amdgcn_mfma_f32_32x32x16_bf16(a1, b0, acc[1][0], 0, 0, 0);
    acc[1][1] = __builtin_amdgcn_mfma_f32_32x32x16_bf16(a1, b1, acc[1][1], 0, 0, 0);
  }
  bf16_t* ymix = p.hbuf;
  const float* bs = p.a_b_s + (ei * 4 + g) * 128;
#pragma unroll
  for (int mi = 0; mi < 2; ++mi)
#pragma unroll
    for (int reg = 0; reg < 16; ++reg) {
      const int prow = wm * 64 + mi * 32 + (reg & 3) + 8 * (reg >> 2) + 4 * h;
      const float bsv = bs[prow];
      const size_t row = (size_t)(R0 + prow);
#pragma unroll
      for (int ni = 0; ni < 2; ++ni) {
        const int col = g * 128 + wn * 64 + ni * 32 + r;
        const float sv = acc[mi][ni][reg] + bsv;
        const float y = bf2f(e.ug[row * 512 + col]) * sv * bf2f(e.gas[row * 512 + col]);
        ymix[row * 1024 + col] = f2bf(y);
      }
    }
}

__device__ void phase_even_mix(const Params& p, char* smem, int ei) {
  const EvenBufs e = even_bufs(p);
  const int n_attn = 2048 + 128, n_gmlp = 1088;
  for (int item = blockIdx.x; item < n_attn + n_gmlp; item += gridDim.x) {
    if (item < n_attn) attn_item(p, e, item, smem, ei);
    else gmlp_item(p, e, item - n_attn, smem, ei);
  }
}

__device__ void phase_conv(const Params& p, int oi) {
  const OddBufs ob = odd_bufs(p);
  const bf16_t* xr = ob.xr;
  bf16_t* zb = ob.sg + (size_t)NR * 1024;
  const int tid = otid();
  const int total = (NR / 8) * 128;
  for (int id = blockIdx.x * NTHREADS + tid; id < total; id += gridDim.x * NTHREADS) {
    const int chunk = id & 127, rg = id >> 7;
    const int R0 = rg * 8;
    int t0, Ls;
    if (R0 < NL) { t0 = R0 & (SEQL - 1); Ls = SEQL; } else { t0 = (R0 - NL) & (LCTX - 1); Ls = LCTX; }
    const int chb = chunk * 8;
    float cw[4][8], cbias[8];
#pragma unroll
    for (int j = 0; j < 4; ++j) {
      const float4 w0 = *(const float4*)(p.c_conv_w + ((size_t)oi * 4 + j) * 1024 + chb);
      const float4 w1 = *(const float4*)(p.c_conv_w + ((size_t)oi * 4 + j) * 1024 + chb + 4);
      cw[j][0] = w0.x; cw[j][1] = w0.y; cw[j][2] = w0.z; cw[j][3] = w0.w;
      cw[j][4] = w1.x; cw[j][5] = w1.y; cw[j][6] = w1.z; cw[j][7] = w1.w;
    }
    {
      const float4 b0 = *(const float4*)(p.c_conv_b + oi * 1024 + chb);
      const float4 b1 = *(const float4*)(p.c_conv_b + oi * 1024 + chb + 4);
      cbias[0] = b0.x; cbias[1] = b0.y; cbias[2] = b0.z; cbias[3] = b0.w;
      cbias[4] = b1.x; cbias[5] = b1.y; cbias[6] = b1.z; cbias[7] = b1.w;
    }
    float xw[11][8];
#pragma unroll
    for (int jj = 0; jj < 11; ++jj) {
      const int t = t0 - 2 + jj;
      u32x4 u = (u32x4){0u, 0u, 0u, 0u};
      if (t >= 0 && t < Ls) u = *(const u32x4*)(xr + (size_t)(R0 - 2 + jj) * 1024 + chb);
      xw[jj][0] = lo_bf(u.x); xw[jj][1] = hi_bf(u.x);
      xw[jj][2] = lo_bf(u.y); xw[jj][3] = hi_bf(u.y);
      xw[jj][4] = lo_bf(u.z); xw[jj][5] = hi_bf(u.z);
      xw[jj][6] = lo_bf(u.w); xw[jj][7] = hi_bf(u.w);
    }
#pragma unroll
    for (int i = 0; i < 8; ++i) {
      float z[8];
#pragma unroll
      for (int e2 = 0; e2 < 8; ++e2) {
        float a = cbias[e2];
#pragma unroll
        for (int j = 0; j < 4; ++j) a += cw[j][e2] * xw[i + j][e2];
        z[e2] = a;
      }
      u32x4 pk;
      pk.x = pack2(z[0], z[1]); pk.y = pack2(z[2], z[3]);
      pk.z = pack2(z[4], z[5]); pk.w = pack2(z[6], z[7]);
      *(u32x4*)(zb + (size_t)(R0 + i) * 1024 + chb) = pk;
    }
  }
}

constexpr int ZS = 264;

template <int DIR>
__device__ void rglru_item(const Params& p, const OddBufs& ob, int item, char* smem, int oi, bool need_ctx) {
  bf16_t* Zs = (bf16_t*)smem;
  float* segA = (float*)(Zs + 128 * ZS);
  float* segB = segA + 256;
  float* carry = segB + 256;
  float* La = (float*)Zs;
  float* Gz = La + 4096;
  const int tid = otid(), lane = tid & 63, w = __builtin_amdgcn_readfirstlane(tid >> 6);
  const int r = lane & 31, h = lane >> 5;
  const int wm = w >> 1, wn = w & 1;
  const int b = item >> 6, cs = item & 31;
  constexpr int dir = DIR;
  const int hd = cs >> 3, j0 = (cs & 7) * 32, c0 = cs * 32;
  bf16_t* sout = dir ? ob.sb : p.hbuf;
  const bf16_t* zb = ob.sg + (size_t)NR * 1024;
  __syncthreads();
  if (tid < 32) carry[tid] = 0.f;
  bf16x8 bfr[16];
  {
    const size_t mo = ((size_t)((oi * 2 + dir) * 4 + hd)) * 65536 + (size_t)(j0 + r) * 256 + h * 8;
    const bf16_t* wsrc = (wn ? p.wgi : p.wga) + mo;
#pragma unroll
    for (int ks = 0; ks < 16; ++ks) bfr[ks] = *(const bf16x8*)(wsrc + ks * 16);
  }
  const int gch = (oi * 2 + dir) * 1024 + c0 + r;
  const float gbias = wn ? p.c_b_i[gch] : p.c_b_a[gch];
  const float spl = log1pf(__expf(-p.c_lam[gch]));
  const int sc_c = tid & 31, sc_sg = tid >> 5;
  const int lrow = tid >> 5, kc = tid & 31;

  u32x4 zt[4];
  {
    const int Rs0 = NL + b * LCTX;
    const int ti0 = dir ? 1 : 0;
    const bf16_t* src = zb + (size_t)(Rs0 + ti0 * 128 + lrow) * 1024 + hd * 256 + kc * 8;
#pragma unroll
    for (int i = 0; i < 4; ++i) zt[i] = *(const u32x4*)(src + (size_t)i * 8 * 1024);
  }
  const int sbase = DIR ? (7 - sc_sg) * 16 : sc_sg * 16;
  const unsigned voff = (unsigned)(sbase * 1024 + c0 + sc_c);
  for (int step = 0; step < 34; ++step) {
    int Rs, ti;
    bool wr;
    if (step < 2) { Rs = NL + b * LCTX; ti = dir ? 1 - step : step; wr = need_ctx; }
    else { Rs = b * SEQL; ti = dir ? 31 - (step - 2) : (step - 2); wr = true; }
    const int t0 = ti * 128;
    __syncthreads();
    {
      const bf16_t* src2 = zb + (size_t)(Rs + t0 + lrow + 32) * 1024 + hd * 256 + kc * 8;
      u32x4 z2[12];
#pragma unroll
      for (int i = 0; i < 12; ++i) z2[i] = *(const u32x4*)(src2 + (size_t)i * 8 * 1024);
#pragma unroll
      for (int i = 0; i < 4; ++i) *(u32x4*)(Zs + (lrow + 8 * i) * ZS + kc * 8) = zt[i];
#pragma unroll
      for (int i = 0; i < 12; ++i) *(u32x4*)(Zs + (lrow + 32 + 8 * i) * ZS + kc * 8) = z2[i];
    }
    const bf16_t* sgp = ob.sg + (size_t)(Rs + t0) * 1024;
    bf16_t sgv[16];
    if (wr) {
#pragma unroll
      for (int i = 0; i < 16; ++i) sgv[i] = sgp[voff + (DIR ? 15 - i : i) * 1024];
    }
    __syncthreads();
    f32x16 acc[2];
    acc[0] = zero16();
    acc[1] = zero16();
    {
      const bf16_t* Aw = Zs + (wm * 64 + r) * ZS + h * 8;
#pragma unroll
      for (int ks = 0; ks < 16; ++ks) {
        bf16x8 a0 = *(const bf16x8*)(Aw + ks * 16);
        bf16x8 a1 = *(const bf16x8*)(Aw + 32 * ZS + ks * 16);
        acc[0] = __builtin_amdgcn_mfma_f32_32x32x16_bf16(a0, bfr[ks], acc[0], 0, 0, 0);
        acc[1] = __builtin_amdgcn_mfma_f32_32x32x16_bf16(a1, bfr[ks], acc[1], 0, 0, 0);
      }
    }
    if (wn == 0) {
#pragma unroll
      for (int mi = 0; mi < 2; ++mi)
#pragma unroll
        for (int reg = 0; reg < 16; ++reg) acc[mi][reg] = -8.f * spl * sigmoid_f(acc[mi][reg] + gbias);
    } else {
#pragma unroll
      for (int mi = 0; mi < 2; ++mi) {
        float zv[16];
#pragma unroll
        for (int reg = 0; reg < 16; ++reg) {
          const int row = wm * 64 + mi * 32 + (reg & 3) + 8 * (reg >> 2) + 4 * h;
          zv[reg] = bf2f(Zs[row * ZS + j0 + r]);
        }
#pragma unroll
        for (int reg = 0; reg < 16; ++reg) acc[mi][reg] = zv[reg] * sigmoid_f(acc[mi][reg] + gbias);
        asm volatile("" ::: "memory");
      }
    }
    __syncthreads();
    {
      float* dstb = wn ? Gz : La;
#pragma unroll
      for (int mi = 0; mi < 2; ++mi)
#pragma unroll
        for (int reg = 0; reg < 16; ++reg) {
          const int row = wm * 64 + mi * 32 + (reg & 3) + 8 * (reg >> 2) + 4 * h;
          dstb[row * 32 + r] = acc[mi][reg];
        }
    }
    __syncthreads();
    if (step + 1 < 34) {
      const int ns = step + 1;
      int nRs, nti;
      if (ns < 2) { nRs = NL + b * LCTX; nti = dir ? 1 - ns : ns; }
      else { nRs = b * SEQL; nti = dir ? 31 - (ns - 2) : (ns - 2); }
      const bf16_t* src = zb + (size_t)(nRs + nti * 128 + lrow) * 1024 + hd * 256 + kc * 8;
#pragma unroll
      for (int i = 0; i < 4; ++i) zt[i] = *(const u32x4*)(src + (size_t)i * 8 * 1024);
    }
    bf16_t* sop = sout + (size_t)(Rs + t0) * 1024;
    const float* Lap = La + sbase * 32 + sc_c;
    const float* Gzp = Gz + sbase * 32 + sc_c;
    {
      float A = 1.f, Bv = 0.f;
      float* Law = La + sbase * 32 + sc_c;
      float* Gzw = Gz + sbase * 32 + sc_c;
#pragma unroll
      for (int i = 0; i < 16; ++i) {
        const int ro = (DIR ? 15 - i : i) * 32;
        const float la = Lap[ro];
        const float a = __expf(la);
        const float mult = __builtin_amdgcn_sqrtf(fmaf(-a, a, 1.f));
        const float bx = mult * Gzp[ro];
        Law[ro] = a;
        Gzw[ro] = bx;
        Bv = a * Bv + bx;
        A *= a;
      }
      segA[sc_sg * 32 + sc_c] = A;
      segB[sc_sg * 32 + sc_c] = Bv;
    }
    __syncthreads();
    {
      float hh = carry[(step & 1) * 32 + sc_c];
      {
        float sa[7], sbv[7];
#pragma unroll
        for (int s2 = 0; s2 < 7; ++s2) { sa[s2] = segA[s2 * 32 + sc_c]; sbv[s2] = segB[s2 * 32 + sc_c]; }
#pragma unroll
        for (int s2 = 0; s2 < 7; ++s2) hh = (s2 < sc_sg) ? (sa[s2] * hh + sbv[s2]) : hh;
      }
#pragma unroll
      for (int i = 0; i < 16; ++i) {
        const int ro = (DIR ? 15 - i : i);
        hh = Lap[ro * 32] * hh + Gzp[ro * 32];
        if (wr) sop[voff + ro * 1024] = f2bf(hh * bf2f(sgv[i]));
      }
      if (sc_sg == 7) carry[((step + 1) & 1) * 32 + sc_c] = hh;
    }
  }
}

__device__ void phase_rglru(const Params& p, char* smem, int oi, bool need_ctx) {
  const OddBufs ob = odd_bufs(p);
  for (int it0 = blockIdx.x; it0 < 512; it0 += gridDim.x) {
    const int xcd = it0 & 7, slot = it0 >> 3;
    const int grp = xcd * 4 + (slot >> 4), j = slot & 15;
    const int item = ((grp >> 2) << 6) | ((j >> 3) << 5) | ((grp & 3) << 3) | (j & 7);
    if ((item >> 5) & 1) rglru_item<1>(p, ob, item, smem, oi, need_ctx);
    else rglru_item<0>(p, ob, item, smem, oi, need_ctx);
  }
}

#define XB_TMO      128
#define XB_XCNT(j)  (256  + 64 * (j))
#define XB_XSUB(j)  (1280 + 64 * (j))
#define XB_XGEN(j)  (2304 + 64 * (j))
#define XB_TOP      3328
#define XB_TOPGEN   3392
#define XCD_BAR_WORDS 3456
#define XB_SPIN_CAP (1u << 18)
#define LAS __attribute__((address_space(3)))

__device__ __forceinline__ unsigned xb_ld(unsigned* p)              { return __hip_atomic_load(p, __ATOMIC_RELAXED, __HIP_MEMORY_SCOPE_AGENT); }
__device__ __forceinline__ unsigned xb_add(unsigned* p, unsigned v) { return __hip_atomic_fetch_add(p, v, __ATOMIC_RELAXED, __HIP_MEMORY_SCOPE_AGENT); }
__device__ __forceinline__ unsigned xb_xcc_id() { return (unsigned)__builtin_amdgcn_s_getreg((3 << 11) | 20) & 0xFu; }
#define XB_SPIN(cond, bar) do { unsigned _sp = 0; while (cond) { __builtin_amdgcn_s_sleep(1); \
    if ((++_sp & 255u) == 0u) { if (xb_ld(&(bar)[XB_TMO])) break; if (_sp > XB_SPIN_CAP) { atomicAdd(&(bar)[XB_TMO], 1u); break; } } } } while (0)

struct XcdBarrier {
    unsigned* bar; unsigned x;
    volatile LAS unsigned* st;
};

__device__ __forceinline__ XcdBarrier xcd_barrier_post(unsigned* bar, volatile LAS unsigned* st) {
    XcdBarrier b; b.bar = bar; b.x = xb_xcc_id(); b.st = st;
    if (threadIdx.x == 0) (void)xb_add(&bar[XB_XCNT(b.x)], 1u);
    return b;
}
__device__ __forceinline__ void xcd_barrier_complete(unsigned* bar, unsigned x, unsigned& nloc, unsigned& nx) {
    const unsigned G = gridDim.x * gridDim.y * gridDim.z;
    unsigned sum, cnt, mine, sp = 0u;
    for (;;) {
        sum = 0u; cnt = 0u; mine = 0u;
#pragma unroll
        for (unsigned j = 0; j < 16; ++j) { const unsigned c = xb_ld(&bar[XB_XCNT(j)]); sum += c; cnt += (c > 0u) ? 1u : 0u; mine = (j == x) ? c : mine; }
        if (sum == G) break;
        __builtin_amdgcn_s_sleep(1);
        if ((++sp & 255u) == 0u) { if (xb_ld(&bar[XB_TMO])) break; if (sp > XB_SPIN_CAP) { atomicAdd(&bar[XB_TMO], 1u); break; } }
    }
    nloc = mine > 0u ? mine : 1u; nx = cnt > 0u ? cnt : 1u;
}

__device__ __forceinline__ void xcd_barrier(const XcdBarrier& b) {
    asm volatile("s_waitcnt vmcnt(0)" ::: "memory");
    __syncthreads();
    if (threadIdx.x == 0) {
        unsigned* bar = b.bar;
        __builtin_amdgcn_s_waitcnt(0);
        unsigned nloc = b.st[0], nx = b.st[1];
        if (nloc == 0u) { xcd_barrier_complete(bar, b.x, nloc, nx); b.st[0] = nloc; b.st[1] = nx; }
        const unsigned old = xb_add(&bar[XB_XSUB(b.x)], 1u);
        const unsigned gen = old / nloc;
        if (old + 1u == (gen + 1u) * nloc) {
            __builtin_amdgcn_fence(__ATOMIC_RELEASE, "agent");
            asm volatile("s_waitcnt vmcnt(0)" ::: "memory");
            const unsigned og = xb_add(&bar[XB_TOP], 1u);
            const unsigned tg = og / nx;
            if (og + 1u == (tg + 1u) * nx) xb_add(&bar[XB_TOPGEN], 1u);
            else XB_SPIN(xb_ld(&bar[XB_TOPGEN]) == tg, bar);
            __builtin_amdgcn_fence(__ATOMIC_ACQUIRE, "agent");
            xb_add(&bar[XB_XGEN(b.x)], 1u);
            asm volatile("s_waitcnt vmcnt(0)" ::: "memory");
        } else {
            XB_SPIN(xb_ld(&bar[XB_XGEN(b.x)]) == gen, bar);
            __builtin_amdgcn_fence(__ATOMIC_ACQUIRE, "agent");
            asm volatile("s_waitcnt vmcnt(0)" ::: "memory");
        }
    }
    __syncthreads();
}


#define LAUNDER(f) q.f = p.f + z
__device__ __forceinline__ void launder(Params& q, const Params& p) {
  long z;
  asm volatile("s_mov_b64 %0, 0" : "=s"(z));
  LAUNDER(x); LAUNDER(c); LAUNDER(ctx); LAUNDER(c_ctx); LAUNDER(norm_g); LAUNDER(w_mod); LAUNDER(b_mod);
  LAUNDER(ab_w_in); LAUNDER(a_ln_g); LAUNDER(a_ln_b); LAUNDER(a_w_s); LAUNDER(a_b_s); LAUNDER(b_sink);
  LAUNDER(ab_w_out); LAUNDER(c_w_in); LAUNDER(c_conv_w); LAUNDER(c_conv_b); LAUNDER(c_w_a); LAUNDER(c_b_a);
  LAUNDER(c_w_i); LAUNDER(c_b_i); LAUNDER(c_lam); LAUNDER(c_w_out); LAUNDER(final_g); LAUNDER(out);
  LAUNDER(xbuf); LAUNDER(mods); LAUNDER(hbuf); LAUNDER(ebuf); LAUNDER(wt_in_e); LAUNDER(wt_out_e);
  LAUNDER(wt_in_o); LAUNDER(wt_out_o); LAUNDER(wga); LAUNDER(wgi);
}

constexpr int NPHASES = 20;

__device__ void run_phase(const Params& p0, int ph, char* smem) {
  if (ph == 0) { Params p; launder(p, p0); phase0(p, smem); return; }
  if (ph == 19) { Params p; launder(p, p0); phase_final(p); return; }
  int layer, sub;
  if (ph < 5) { layer = 0; sub = ph - 1; }
  else if (ph < 10) { layer = 1; sub = ph - 5; }
  else if (ph < 14) { layer = 2; sub = ph - 10; }
  else { layer = 3; sub = ph - 14; }
  const int idx = layer >> 1;
  const bool even = (layer & 1) == 0;
  const bool need_ctx = layer < 3;
  if (sub == 0) { Params p; launder(p, p0); phase_prep(p, layer); return; }
  if (even) {
    if (sub == 1) {
      Params p; launder(p, p0);
      EpiEvenIn epi; epi.e = even_bufs(p);
      gemm_phase_big(p.hbuf, p.wt_in_e + (size_t)idx * 2816 * 1024, NR / 256, 22, smem, epi);
    } else if (sub == 2) {
      Params p; launder(p, p0);
      phase_even_mix(p, smem, idx);
    } else {
      Params p; launder(p, p0);
      EpiOut epi; epi.xbuf = p.xbuf; epi.mods_l = p.mods + (size_t)layer * 9 * 3072;
      epi.xin_lat = (layer == 0) ? p.x : p.xbuf;
      epi.xin_ctx = (layer == 0) ? p.ctx : p.xbuf + (size_t)NL * 1024;
      gemm_phase<0>(p.hbuf, nullptr, p.wt_out_e + (size_t)idx * 1024 * 1024, NR / 128, 8, smem, epi);
    }
  } else {
    if (sub == 1) {
      Params p; launder(p, p0);
      EpiOddIn epi; epi.o = odd_bufs(p);
      gemm_phase_big(p.hbuf, p.wt_in_o + (size_t)idx * 2048 * 1024, NR / 256, 16, smem, epi);
    } else if (sub == 2) {
      Params p; launder(p, p0);
      phase_conv(p, idx);
    } else if (sub == 3) {
      Params p; launder(p, p0);
      phase_rglru(p, smem, idx, need_ctx);
    } else {
      Params p; launder(p, p0);
      EpiOut epi; epi.xbuf = p.xbuf; epi.mods_l = p.mods + (size_t)layer * 9 * 3072;
      epi.xin_lat = (layer == 0) ? p.x : p.xbuf;
      epi.xin_ctx = (layer == 0) ? p.ctx : p.xbuf + (size_t)NL * 1024;
      const OddBufs ob = odd_bufs(p);
      gemm_phase<1>(p.hbuf, ob.sb, p.wt_out_o + (size_t)idx * 1024 * 1024, (need_ctx ? NR : NL) / 128, 8, smem, epi);
    }
  }
}

__global__ void __launch_bounds__(NTHREADS, 2) mega_kernel(Params p, int ph_lo, int ph_hi, int use_bar) {
  __shared__ __attribute__((aligned(16))) char smem[SMEM_BYTES];
  __shared__ uint4 xb_words;
  if (threadIdx.x == 0) xb_words = make_uint4(0u, 0u, 0u, 0u);
  __syncthreads();
  if (use_bar == 1) (void)xcd_barrier_post(p.bar, (volatile LAS unsigned*)&xb_words);
  for (int ph = ph_lo; ph < ph_hi; ++ph) {
    run_phase(p, ph, smem);
    if (ph + 1 < ph_hi) {
      if (use_bar == 1) {
        XcdBarrier xb;
        xb.bar = p.bar; xb.x = xb_xcc_id(); xb.st = (volatile LAS unsigned*)&xb_words;
        xcd_barrier(xb);
      } else if (use_bar == 2) cg::this_grid().sync();
    }
  }
}

extern "C" void kernel_launch(void* const* d_in, const int* in_sizes, int n_in, void* d_out, int out_size,
                              void* d_ws, size_t ws_size, hipStream_t stream) {
  static int grid_blocks = 0;
  if (!grid_blocks) {
    int dev = 0, cus = 0, per_cu = 0;
    hipGetDevice(&dev);
    hipDeviceGetAttribute(&cus, hipDeviceAttributeMultiprocessorCount, dev);
    hipOccupancyMaxActiveBlocksPerMultiprocessor(&per_cu, mega_kernel, NTHREADS, 0);
    if (per_cu < 1) per_cu = 1;
    if (per_cu > 2) per_cu = 2;
    grid_blocks = cus * per_cu;
  }
  Params p{};
  const float** fp = (const float**)&p;
  for (int i = 0; i < 24; ++i) fp[i] = (const float*)d_in[i];
  p.out = (float*)d_out;
  char* ws = (char*)d_ws;
  size_t off = 0;
  auto take = [&](size_t bytes) { char* q = ws + off; off += (bytes + 255) & ~(size_t)255; return q; };
  p.xbuf = (float*)take((size_t)NR * 1024 * 4);
  p.mods = (float*)take((size_t)4 * 9 * 3072 * 4);
  p.hbuf = (bf16_t*)take((size_t)NR * 1024 * 2);
  p.ebuf = (bf16_t*)take((size_t)NR * 3072 * 2);
  p.wt_in_e = (bf16_t*)take((size_t)2 * 2816 * 1024 * 2);
  p.wt_out_e = (bf16_t*)take((size_t)2 * 1024 * 1024 * 2);
  p.wt_in_o = (bf16_t*)take((size_t)2 * 2048 * 1024 * 2);
  p.wt_out_o = (bf16_t*)take((size_t)2 * 1024 * 1024 * 2);
  p.wga = (bf16_t*)take((size_t)16 * 65536 * 2);
  p.wgi = (bf16_t*)take((size_t)16 * 65536 * 2);
  p.bar = (unsigned*)take((size_t)XCD_BAR_WORDS * 4);
  if (off > ws_size) fprintf(stderr, "workspace too small: need %zu have %zu\n", off, ws_size);
#if COOP
  hipMemsetAsync(p.bar, 0, (size_t)XCD_BAR_WORDS * 4, stream);
  int lo = 0, hi = NPHASES, ub = 1;
  void* args[] = {&p, &lo, &hi, &ub};
  hipError_t e = hipLaunchCooperativeKernel((void*)mega_kernel, dim3(grid_blocks), dim3(NTHREADS), args, 0, stream);
  if (e != hipSuccess) fprintf(stderr, "cooperative launch failed: %s (grid %d)\n", hipGetErrorString(e), grid_blocks);
#else
  for (int ph = 0; ph < NPHASES; ++ph) mega_kernel<<<grid_blocks, NTHREADS, 0, stream>>>(p, ph, ph + 1, 0);
#endif
}
```

```cpp
#include <hip/hip_runtime.h>
#include <hip/hip_cooperative_groups.h>
#include <stdint.h>
#include <stdio.h>
namespace cg = cooperative_groups;

#ifndef COOP
#define COOP 1
#endif

typedef unsigned short bf16_t;
typedef __attribute__((ext_vector_type(8))) short bf16x8;
typedef __attribute__((ext_vector_type(16))) float f32x16;
typedef __attribute__((ext_vector_type(4))) unsigned int u32x4;
typedef __attribute__((ext_vector_type(2))) unsigned int u32x2;

constexpr int DM = 1024;
constexpr int NBATCH = 8;
constexpr int SEQL = 4096;
constexpr int LCTX = 256;
constexpr int NL = NBATCH * SEQL;
constexpr int NC = NBATCH * LCTX;
constexpr int NR = NL + NC;
constexpr int SMEM_BYTES = 72 * 1024;
constexpr int NTHREADS = 256;

struct Params {
  const float *x, *c, *ctx, *c_ctx, *norm_g, *w_mod, *b_mod, *ab_w_in, *a_ln_g, *a_ln_b, *a_w_s, *a_b_s,
      *b_sink, *ab_w_out, *c_w_in, *c_conv_w, *c_conv_b, *c_w_a, *c_b_a, *c_w_i, *c_b_i, *c_lam, *c_w_out,
      *final_g;
  float* out;
  float* xbuf;
  float* mods;
  bf16_t* hbuf;
  bf16_t* ebuf;
  bf16_t *wt_in_e, *wt_out_e, *wt_in_o, *wt_out_o, *wga, *wgi;
  unsigned* bar;
};

typedef __bf16 hwbf16x2 __attribute__((ext_vector_type(2)));
typedef float f32x2v __attribute__((ext_vector_type(2)));
__device__ __forceinline__ uint32_t pack2(float a, float b) {
  f32x2v v = {a, b};
  hwbf16x2 r = __builtin_convertvector(v, hwbf16x2);
  return __builtin_bit_cast(uint32_t, r);
}
__device__ __forceinline__ bf16_t f2bf(float f) { return (bf16_t)(pack2(f, f) & 0xffffu); }
__device__ __forceinline__ float bf2f(bf16_t b) { return __uint_as_float(((uint32_t)b) << 16); }
__device__ __forceinline__ float lo_bf(uint32_t u) { return __uint_as_float(u << 16); }
__device__ __forceinline__ float hi_bf(uint32_t u) { return __uint_as_float(u & 0xffff0000u); }
__device__ __forceinline__ float frcp(float x) { return __builtin_amdgcn_rcpf(x); }
__device__ __forceinline__ float silu_f(float x) { return x * frcp(1.f + __expf(-x)); }
__device__ __forceinline__ float sigmoid_f(float x) { return frcp(1.f + __expf(-x)); }
__device__ __forceinline__ float gelu_f(float x) {
  float y = 0.7978845608028654f * (x + 0.044715f * x * x * x);
  float t = 1.f - 2.f * frcp(1.f + __expf(2.f * y));
  return 0.5f * x * (1.f + t);
}
__device__ __forceinline__ f32x16 zero16() {
  f32x16 z;
#pragma unroll
  for (int i = 0; i < 16; ++i) z[i] = 0.f;
  return z;
}
__device__ __forceinline__ float wave_sum(float v) {
#pragma unroll
  for (int o = 32; o > 0; o >>= 1) v += __shfl_xor(v, o);
  return v;
}

__device__ __forceinline__ int otid() {
  int t = threadIdx.x;
  asm volatile("" : "+v"(t));
  return t;
}

struct EvenBufs {
  bf16_t *ug, *vg, *gas, *qb, *gbs, *kb, *vtl, *vtc;
};
__device__ __forceinline__ EvenBufs even_bufs(const Params& p) {
  EvenBufs e;
  e.ug = p.ebuf;
  e.vg = e.ug + (size_t)NR * 512;
  e.gas = e.vg + (size_t)NR * 512;
  e.qb = e.gas + (size_t)NR * 512;
  e.gbs = e.qb + (size_t)NR * 512;
  e.kb = e.gbs + (size_t)NR * 512;
  e.vtl = e.kb + (size_t)NR * 128;
  e.vtc = e.vtl + (size_t)NBATCH * 128 * SEQL;
  return e;
}
struct OddBufs {
  bf16_t *xr, *sg, *sb;
};
__device__ __forceinline__ OddBufs odd_bufs(const Params& p) {
  OddBufs o;
  o.xr = p.ebuf;
  o.sg = o.xr + (size_t)NR * 1024;
  o.sb = o.xr;
  return o;
}

__device__ void transpose_item(const Params& p, int item, char* smem) {
  float* tile = (float*)smem;
  const float* src;
  bf16_t* dst;
  int K, N, local;
  if (item < 1408) { src = p.ab_w_in; dst = p.wt_in_e; K = 1024; N = 2816; local = item; }
  else if (item < 1920) { src = p.ab_w_out; dst = p.wt_out_e; K = 1024; N = 1024; local = item - 1408; }
  else if (item < 2944) { src = p.c_w_in; dst = p.wt_in_o; K = 1024; N = 2048; local = item - 1920; }
  else if (item < 3456) { src = p.c_w_out; dst = p.wt_out_o; K = 1024; N = 1024; local = item - 2944; }
  else if (item < 3712) { src = p.c_w_a; dst = p.wga; K = 256; N = 256; local = item - 3456; }
  else { src = p.c_w_i; dst = p.wgi; K = 256; N = 256; local = item - 3712; }
  const int ntn = N / 64;
  const int tpb = (K / 64) * ntn;
  const int bi = local / tpb;
  const int rem = local % tpb;
  const int k0 = (rem / ntn) * 64, n0 = (rem % ntn) * 64;
  src += (size_t)bi * K * N;
  dst += (size_t)bi * K * N;
  const int tid = otid();
  __syncthreads();
#pragma unroll
  for (int i = 0; i < 16; ++i) {
    int rr = i * 4 + (tid >> 6), cc = tid & 63;
    tile[rr * 65 + cc] = src[(size_t)(k0 + rr) * N + n0 + cc];
  }
  __syncthreads();
#pragma unroll
  for (int i = 0; i < 16; ++i) {
    int n = i * 4 + (tid >> 6), k = tid & 63;
    dst[(size_t)(n0 + n) * K + k0 + k] = f2bf(tile[k * 65 + n]);
  }
}

__device__ void mods_item(const Params& p, int item, char* smem) {
  float* sc = (float*)smem;
  float* red = sc + 9 * 1024;
  const int tid = otid();
  const int l = item / 96, n0 = (item % 96) * 32;
  __syncthreads();
  for (int i = tid; i < 9 * 1024; i += NTHREADS) {
    int j = i >> 10, k = i & 1023;
    float v = (j < 8) ? p.c[j * 1024 + k] : p.c_ctx[k];
    sc[i] = silu_f(v);
  }
  __syncthreads();
  const int col = tid & 31, kg = tid >> 5;
  float acc[9];
#pragma unroll
  for (int j = 0; j < 9; ++j) acc[j] = 0.f;
  const float* w = p.w_mod + ((size_t)l * 1024 + kg * 128) * 3072 + n0 + col;
#pragma unroll 32
  for (int k = 0; k < 128; ++k) {
    float wv = w[(size_t)k * 3072];
#pragma unroll
    for (int j = 0; j < 9; ++j) acc[j] += sc[j * 1024 + kg * 128 + k] * wv;
  }
#pragma unroll
  for (int j = 0; j < 9; ++j) red[(kg * 9 + j) * 32 + col] = acc[j];
  __syncthreads();
  for (int i = tid; i < 9 * 32; i += NTHREADS) {
    int j = i >> 5, cc = i & 31;
    float s = 0.f;
#pragma unroll
    for (int g = 0; g < 8; ++g) s += red[(g * 9 + j) * 32 + cc];
    p.mods[((size_t)l * 9 + j) * 3072 + n0 + cc] = s + p.b_mod[l * 3072 + n0 + cc];
  }
}

__device__ void phase0(const Params& p, char* smem) {
  const int total = 3968 + 384;
  for (int item = blockIdx.x; item < total; item += gridDim.x) {
    if (item < 384) mods_item(p, item, smem);
    else transpose_item(p, item - 384, smem);
  }
}

__device__ void phase_prep(const Params& p, int layer) {
  const int tid = otid();
  const int lane = tid & 63;
  const int gw = blockIdx.x * 4 + (tid >> 6);
  const int nw = gridDim.x * 4;
  const float* ng = p.norm_g + layer * 1024;
  for (int R = gw; R < NR; R += nw) {
    const float* src;
    if (layer == 0) src = (R < NL) ? p.x + (size_t)R * 1024 : p.ctx + (size_t)(R - NL) * 1024;
    else src = p.xbuf + (size_t)R * 1024;
    const int bidx = (R < NL) ? (R >> 12) : 8;
    const float* md = p.mods + ((size_t)layer * 9 + bidx) * 3072;
    float4 v[4];
#pragma unroll
    for (int i = 0; i < 4; ++i) v[i] = ((const float4*)src)[lane + 64 * i];
    float ss = 0.f;
#pragma unroll
    for (int i = 0; i < 4; ++i) ss += v[i].x * v[i].x + v[i].y * v[i].y + v[i].z * v[i].z + v[i].w * v[i].w;
    ss = wave_sum(ss);
    const float rstd = rsqrtf(ss * (1.f / 1024.f) + 1e-6f);
#pragma unroll
    for (int i = 0; i < 4; ++i) {
      const int k4 = lane + 64 * i;
      float4 g = ((const float4*)ng)[k4];
      float4 sh = ((const float4*)md)[k4];
      float4 sc = ((const float4*)(md + 1024))[k4];
      float h0 = v[i].x * rstd * g.x * (1.f + sc.x) + sh.x;
      float h1 = v[i].y * rstd * g.y * (1.f + sc.y) + sh.y;
      float h2 = v[i].z * rstd * g.z * (1.f + sc.z) + sh.z;
      float h3 = v[i].w * rstd * g.w * (1.f + sc.w) + sh.w;
      u32x2 pk;
      pk.x = pack2(h0, h1);
      pk.y = pack2(h2, h3);
      *(u32x2*)(p.hbuf + (size_t)R * 1024 + k4 * 4) = pk;
    }
  }
}

__device__ void phase_final(const Params& p) {
  const int tid = otid();
  const int lane = tid & 63;
  const int gw = blockIdx.x * 4 + (tid >> 6);
  const int nw = gridDim.x * 4;
  for (int R = gw; R < NL; R += nw) {
    const float* src = p.xbuf + (size_t)R * 1024;
    float4 v[4];
#pragma unroll
    for (int i = 0; i < 4; ++i) v[i] = ((const float4*)src)[lane + 64 * i];
    float ss = 0.f;
#pragma unroll
    for (int i = 0; i < 4; ++i) ss += v[i].x * v[i].x + v[i].y * v[i].y + v[i].z * v[i].z + v[i].w * v[i].w;
    ss = wave_sum(ss);
    const float rstd = rsqrtf(ss * (1.f / 1024.f) + 1e-6f);
#pragma unroll
    for (int i = 0; i < 4; ++i) {
      const int k4 = lane + 64 * i;
      float4 g = ((const float4*)p.final_g)[k4];
      float4 o;
      o.x = v[i].x * rstd * g.x;
      o.y = v[i].y * rstd * g.y;
      o.z = v[i].z * rstd * g.z;
      o.w = v[i].w * rstd * g.w;
      ((float4*)(p.out + (size_t)R * 1024))[k4] = o;
    }
  }
}

constexpr int GS = 72;

__device__ __forceinline__ u32x4 add_bf16x8(u32x4 a, u32x4 b) {
  u32x4 r;
  r.x = pack2(lo_bf(a.x) + lo_bf(b.x), hi_bf(a.x) + hi_bf(b.x));
  r.y = pack2(lo_bf(a.y) + lo_bf(b.y), hi_bf(a.y) + hi_bf(b.y));
  r.z = pack2(lo_bf(a.z) + lo_bf(b.z), hi_bf(a.z) + hi_bf(b.z));
  r.w = pack2(lo_bf(a.w) + lo_bf(b.w), hi_bf(a.w) + hi_bf(b.w));
  return r;
}

template <int AMODE, class Epi>
__device__ void gemm_phase(const bf16_t* __restrict__ A0, const bf16_t* __restrict__ A1,
                           const bf16_t* __restrict__ Bt, int Mtiles, int Ntiles, char* smem, Epi epi) {
  constexpr int PD = (AMODE == 1) ? 1 : 2;
  constexpr int BUF = 2 * 128 * GS;
  bf16_t* S0 = (bf16_t*)smem;
  const int tid = otid(), lane = tid & 63, w = __builtin_amdgcn_readfirstlane(tid >> 6);
  const int wm = w >> 1, wn = w & 1;
  const int r = lane & 31, h = lane >> 5;
  const int lrow = tid >> 3, kc = tid & 7;
  const int total = Mtiles * Ntiles;
  const int woff = lrow * GS + kc * 8;
  const int aro = (wm * 64 + r) * GS + h * 8;
  const int bro = 128 * GS + (wn * 64 + r) * GS + h * 8;
  const bool swz = ((gridDim.x & 7) == 0) && ((Mtiles & 7) == 0);
  const int xcd = blockIdx.x & 7;
  const int Mx = Mtiles >> 3;
  const int lstart = swz ? (int)(blockIdx.x >> 3) : (int)blockIdx.x;
  const int lstep = swz ? (int)(gridDim.x >> 3) : (int)gridDim.x;
  const int lend = swz ? Mx * Ntiles : total;
  for (int L = lstart; L < lend; L += lstep) {
    int mt, nt;
    if (swz) {
      const int gfull = 8 * Ntiles;
      const int mg = L / gfull, rem = L - mg * gfull;
      const int gs = min(8, Mx - mg * 8);
      nt = rem / gs;
      mt = xcd * Mx + mg * 8 + (rem - nt * gs);
    } else {
      mt = L / Ntiles;
      nt = L - mt * Ntiles;
    }
    const int m0 = mt * 128, n0 = nt * 128;
    const size_t aoff = (size_t)(m0 + lrow) * 1024 + kc * 8;
    const bf16_t* ap = A0 + aoff;
    const bf16_t* ap1 = (AMODE == 1) ? (A1 + aoff) : A0;
    const bf16_t* bp = Bt + (size_t)(n0 + lrow) * 1024 + kc * 8;
    u32x4 ra[PD][4], ra1[PD][4], rb[PD][4];
#define G_LOAD(S, KT)                                                                              \
    {                                                                                              \
      _Pragma("unroll") for (int i = 0; i < 4; ++i) {                                              \
        ra[S][i] = *(const u32x4*)(ap + (size_t)i * 32 * 1024 + (KT) * 64);                        \
        if (AMODE == 1) ra1[S][i] = *(const u32x4*)(ap1 + (size_t)i * 32 * 1024 + (KT) * 64);     \
        rb[S][i] = *(const u32x4*)(bp + (size_t)i * 32 * 1024 + (KT) * 64);                        \
      }                                                                                            \
    }
#define L_WRITE(S, BUFI)                                                                           \
    {                                                                                              \
      bf16_t* dstA = S0 + (BUFI) * BUF + woff;                                                     \
      _Pragma("unroll") for (int i = 0; i < 4; ++i) {                                              \
        u32x4 av = ra[S][i];                                                                       \
        if (AMODE == 1) av = add_bf16x8(av, ra1[S][i]);                                            \
        *(u32x4*)(dstA + 32 * i * GS) = av;                                                        \
        *(u32x4*)(dstA + 128 * GS + 32 * i * GS) = rb[S][i];                                       \
      }                                                                                            \
    }
    G_LOAD(0, 0);
    L_WRITE(0, 0);
#pragma unroll
    for (int s = 0; s < PD; ++s) G_LOAD(s, 1 + s);
    f32x16 acc[2][2];
#pragma unroll
    for (int mi = 0; mi < 2; ++mi)
#pragma unroll
      for (int ni = 0; ni < 2; ++ni) acc[mi][ni] = zero16();
#pragma unroll 1
    for (int kt0 = 0; kt0 < 16; kt0 += 2) {
#pragma unroll
      for (int u = 0; u < 2; ++u) {
        const int kt = kt0 + u;
        constexpr int dummy = 0; (void)dummy;
        const int s = (PD == 2) ? u : 0;
        __syncthreads();
        L_WRITE(s, (u ^ 1));
        {
          const int ktl = (kt + 1 + PD < 16) ? (kt + 1 + PD) : 15;
          G_LOAD(s, ktl);
        }
        const bf16_t* Aw = S0 + u * BUF + aro;
        const bf16_t* Bw = S0 + u * BUF + bro;
#pragma unroll
        for (int ks = 0; ks < 4; ++ks) {
          bf16x8 a0 = *(const bf16x8*)(Aw + ks * 16);
          bf16x8 a1 = *(const bf16x8*)(Aw + 32 * GS + ks * 16);
          bf16x8 b0 = *(const bf16x8*)(Bw + ks * 16);
          bf16x8 b1 = *(const bf16x8*)(Bw + 32 * GS + ks * 16);
          acc[0][0] = __builtin_amdgcn_mfma_f32_32x32x16_bf16(a0, b0, acc[0][0], 0, 0, 0);
          acc[0][1] = __builtin_amdgcn_mfma_f32_32x32x16_bf16(a0, b1, acc[0][1], 0, 0, 0);
          acc[1][0] = __builtin_amdgcn_mfma_f32_32x32x16_bf16(a1, b0, acc[1][0], 0, 0, 0);
          acc[1][1] = __builtin_amdgcn_mfma_f32_32x32x16_bf16(a1, b1, acc[1][1], 0, 0, 0);
        }
      }
    }
#undef G_LOAD
#undef L_WRITE
    epi(acc, m0 + wm * 64, n0 + wn * 64, lane);
  }
}

template <class Epi>
__device__ void gemm_phase_big(const bf16_t* __restrict__ A0, const bf16_t* __restrict__ Bt, int Mtiles  ,
                               int Ntiles, char* smem, Epi epi) {
  bf16_t* As = (bf16_t*)smem;
  bf16_t* Bs = As + 256 * GS;
  const int tid = otid(), lane = tid & 63, w = __builtin_amdgcn_readfirstlane(tid >> 6);
  const int wm = w >> 1, wn = w & 1;
  const int r = lane & 31, h = lane >> 5;
  const int lrow = tid >> 3, kc = tid & 7;
  const bool swz = ((gridDim.x & 7) == 0) && ((Mtiles & 7) == 0);
  const int xcd = blockIdx.x & 7;
  const int Mx = Mtiles >> 3;
  const int lstart = swz ? (int)(blockIdx.x >> 3) : (int)blockIdx.x;
  const int lstep = swz ? (int)(gridDim.x >> 3) : (int)gridDim.x;
  const int lend = swz ? Mx * Ntiles : Mtiles * Ntiles;
  for (int L = lstart; L < lend; L += lstep) {
    int mt, nt;
    if (swz) {
      const int gfull = 8 * Ntiles;
      const int mg = L / gfull, rem = L - mg * gfull;
      const int gs = min(8, Mx - mg * 8);
      nt = rem / gs;
      mt = xcd * Mx + mg * 8 + (rem - nt * gs);
    } else {
      mt = L / Ntiles;
      nt = L - mt * Ntiles;
    }
    const int m0 = mt * 256, n0 = nt * 128;
    const bf16_t* ap = A0 + (size_t)(m0 + lrow) * 1024 + kc * 8;
    const bf16_t* bp = Bt + (size_t)(n0 + lrow) * 1024 + kc * 8;
    u32x4 ra[8], rb[4];
#pragma unroll
    for (int i = 0; i < 8; ++i) ra[i] = *(const u32x4*)(ap + (size_t)i * 32 * 1024);
#pragma unroll
    for (int i = 0; i < 4; ++i) rb[i] = *(const u32x4*)(bp + (size_t)i * 32 * 1024);
    f32x16 acc[2][2][2];
#pragma unroll
    for (int hf = 0; hf < 2; ++hf)
#pragma unroll
      for (int mi = 0; mi < 2; ++mi)
#pragma unroll
        for (int ni = 0; ni < 2; ++ni) acc[hf][mi][ni] = zero16();
#pragma unroll 1
    for (int kt = 0; kt < 16; ++kt) {
      __syncthreads();
#pragma unroll
      for (int i = 0; i < 8; ++i) *(u32x4*)(As + (lrow + 32 * i) * GS + kc * 8) = ra[i];
#pragma unroll
      for (int i = 0; i < 4; ++i) *(u32x4*)(Bs + (lrow + 32 * i) * GS + kc * 8) = rb[i];
      __syncthreads();
      {
        const int k0 = ((kt + 1 < 16) ? (kt + 1) : 15) * 64;
#pragma unroll
        for (int i = 0; i < 8; ++i) ra[i] = *(const u32x4*)(ap + (size_t)i * 32 * 1024 + k0);
#pragma unroll
        for (int i = 0; i < 4; ++i) rb[i] = *(const u32x4*)(bp + (size_t)i * 32 * 1024 + k0);
      }
      const bf16_t* Aw = As + (wm * 128 + r) * GS + h * 8;
      const bf16_t* Bw = Bs + (wn * 64 + r) * GS + h * 8;
#pragma unroll
      for (int ks = 0; ks < 4; ++ks) {
        bf16x8 b0 = *(const bf16x8*)(Bw + ks * 16);
        bf16x8 b1 = *(const bf16x8*)(Bw + 32 * GS + ks * 16);
#pragma unroll
        for (int hf = 0; hf < 2; ++hf) {
          bf16x8 a0 = *(const bf16x8*)(Aw + (hf * 64) * GS + ks * 16);
          bf16x8 a1 = *(const bf16x8*)(Aw + (hf * 64 + 32) * GS + ks * 16);
          acc[hf][0][0] = __builtin_amdgcn_mfma_f32_32x32x16_bf16(a0, b0, acc[hf][0][0], 0, 0, 0);
          acc[hf][0][1] = __builtin_amdgcn_mfma_f32_32x32x16_bf16(a0, b1, acc[hf][0][1], 0, 0, 0);
          acc[hf][1][0] = __builtin_amdgcn_mfma_f32_32x32x16_bf16(a1, b0, acc[hf][1][0], 0, 0, 0);
          acc[hf][1][1] = __builtin_amdgcn_mfma_f32_32x32x16_bf16(a1, b1, acc[hf][1][1], 0, 0, 0);
        }
      }
    }
    epi(acc[0], m0 + wm * 128, n0 + wn * 64, lane);
    epi(acc[1], m0 + wm * 128 + 64, n0 + wn * 64, lane);
  }
}


struct EpiEvenIn {
  EvenBufs e;
  __device__ void operator()(f32x16 (&acc)[2][2], int rb, int cb, int lane) const {
    const int r = lane & 31, h = lane >> 5;
    if (cb < 1536 || cb >= 2304) {
      bf16_t* dst;
      int c0;
      int mode;
      if (cb < 512) { dst = e.ug; c0 = cb; mode = 0; }
      else if (cb < 1024) { dst = e.vg; c0 = cb - 512; mode = 0; }
      else if (cb < 1536) { dst = e.gas; c0 = cb - 1024; mode = 1; }
      else { dst = e.gbs; c0 = cb - 2304; mode = 1; }
#pragma unroll
      for (int mi = 0; mi < 2; ++mi)
#pragma unroll
        for (int ni = 0; ni < 2; ++ni)
#pragma unroll
          for (int reg = 0; reg < 16; ++reg) {
            const int row = rb + mi * 32 + (reg & 3) + 8 * (reg >> 2) + 4 * h;
            const int col = c0 + ni * 32 + r;
            float v = acc[mi][ni][reg];
            v = (mode == 0) ? gelu_f(v) : silu_f(v);
            dst[(size_t)row * 512 + col] = f2bf(v);
          }
    } else if (cb < 2176) {
      const bool isq = cb < 2048;
      bf16_t* dst = isq ? e.qb : e.kb;
      const int c0 = isq ? (cb - 1536) : (cb - 2048);
      const int ld = isq ? 512 : 128;
      const float scale = isq ? 0.125f : 1.f;
      const bool latent = rb < NL;
      const float inv_freq = exp2f(-(float)(r & 15) * 0.8304820237218406f);
#pragma unroll
      for (int mi = 0; mi < 2; ++mi)
#pragma unroll
        for (int reg = 0; reg < 16; ++reg) {
          const int row = rb + mi * 32 + (reg & 3) + 8 * (reg >> 2) + 4 * h;
          float x1 = acc[mi][0][reg], x2 = acc[mi][1][reg];
          float o1 = x1, o2 = x2;
          if (latent) {
            const int t = row & (SEQL - 1);
            const float pos = (float)((r < 16) ? (t >> 6) : (t & 63));
            const float ang = pos * inv_freq;
            const float cs = __cosf(ang), sn = __sinf(ang);
            o1 = x1 * cs - x2 * sn;
            o2 = x2 * cs + x1 * sn;
          }
          dst[(size_t)row * ld + c0 + r] = f2bf(o1 * scale);
          dst[(size_t)row * ld + c0 + 32 + r] = f2bf(o2 * scale);
        }
    } else {
      const int kvh = (cb - 2176) >> 6;
      const bool latent = rb < NL;
#pragma unroll
      for (int mi = 0; mi < 2; ++mi)
#pragma unroll
        for (int ni = 0; ni < 2; ++ni)
#pragma unroll
          for (int q4 = 0; q4 < 4; ++q4) {
            const int row = rb + mi * 32 + 8 * q4 + 4 * h;
            const int d = ni * 32 + r;
            u32x2 pk;
            pk.x = pack2(acc[mi][ni][q4 * 4 + 0], acc[mi][ni][q4 * 4 + 1]);
            pk.y = pack2(acc[mi][ni][q4 * 4 + 2], acc[mi][ni][q4 * 4 + 3]);
            if (latent) {
              const int b = row >> 12, t = row & (SEQL - 1);
              *(u32x2*)(e.vtl + ((size_t)((b * 2 + kvh) * 64 + d)) * SEQL + t) = pk;
            } else {
              const int rr = row - NL;
              const int b = rr >> 8, t = rr & (LCTX - 1);
              *(u32x2*)(e.vtc + ((size_t)((b * 2 + kvh) * 64 + d)) * LCTX + t) = pk;
            }
          }
    }
  }
};

struct EpiOddIn {
  OddBufs o;
  __device__ void operator()(f32x16 (&acc)[2][2], int rb, int cb, int lane) const {
    const int r = lane & 31, h = lane >> 5;
    const bool isg = cb >= 1024;
    bf16_t* dst = isg ? o.sg : o.xr;
    const int c0 = isg ? cb - 1024 : cb;
#pragma unroll
    for (int mi = 0; mi < 2; ++mi)
#pragma unroll
      for (int ni = 0; ni < 2; ++ni)
#pragma unroll
        for (int reg = 0; reg < 16; ++reg) {
          const int row = rb + mi * 32 + (reg & 3) + 8 * (reg >> 2) + 4 * h;
          const int col = c0 + ni * 32 + r;
          float v = acc[mi][ni][reg];
          if (isg) v = silu_f(v);
          dst[(size_t)row * 1024 + col] = f2bf(v);
        }
  }
};

struct EpiOut {
  float* xbuf;
  const float* xin_lat;
  const float* xin_ctx;
  const float* mods_l;
  __device__ void operator()(f32x16 (&acc)[2][2], int rb, int cb, int lane) const {
    const int r = lane & 31, h = lane >> 5;
    const int bidx = (rb < NL) ? (rb >> 12) : 8;
    const float* gate = mods_l + (size_t)bidx * 3072 + 2048;
    const float* xin = (rb < NL) ? xin_lat : xin_ctx;
    const int rsub = (rb < NL) ? 0 : NL;
#pragma unroll
    for (int ni = 0; ni < 2; ++ni) {
      const int col = cb + ni * 32 + r;
      const float gv = gate[col];
#pragma unroll
      for (int mi = 0; mi < 2; ++mi)
#pragma unroll
        for (int reg = 0; reg < 16; ++reg) {
          const int row = rb + mi * 32 + (reg & 3) + 8 * (reg >> 2) + 4 * h;
          xbuf[(size_t)row * 1024 + col] = xin[(size_t)(row - rsub) * 1024 + col] + gv * acc[mi][ni][reg];
        }
    }
  }
};

constexpr int AS = 72;

__device__ void attn_item(const Params& p, const EvenBufs& e, int item, char* smem, int ei) {
  bf16_t* Ks = (bf16_t*)smem;
  bf16_t* Vs = Ks + 64 * AS;
  const int tid = otid(), lane = tid & 63, w = __builtin_amdgcn_readfirstlane(tid >> 6);
  const int r = lane & 31, h = lane >> 5;
  int b, hq, start, R0;
  bool isctx;
  if (item < 2048) {
    b = item >> 8;
    hq = (item >> 5) & 7;
    const int qblk = item & 31;
    start = qblk * 128;
    R0 = b * SEQL + start;
    isctx = false;
  } else {
    const int it = item - 2048;
    b = it >> 4;
    hq = (it >> 1) & 7;
    start = (it & 1) * 128;
    R0 = NL + b * LCTX + start;
    isctx = true;
  }
  const int kvh = hq >> 2;
  const int qrow = R0 + w * 32 + r;
  bf16x8 qf[4];
#pragma unroll
  for (int s = 0; s < 4; ++s) qf[s] = *(const bf16x8*)(e.qb + (size_t)qrow * 512 + hq * 64 + s * 16 + h * 8);
  float m = p.b_sink[ei * 8 + hq], l = 1.f;
  f32x16 o[2];
  o[0] = zero16();
  o[1] = zero16();
  const int nblk = isctx ? 4 : 10;
  auto kb_desc = [&](int kb, const bf16_t*& kp, const bf16_t*& vp, int& vstride, int& kpos0, bool& local) -> bool {
    if (kb < 4) {
      kp = e.kb + (size_t)(NL + b * LCTX + kb * 64) * 128 + kvh * 64;
      vp = e.vtc + (size_t)((b * 2 + kvh) * 64) * LCTX + kb * 64;
      vstride = LCTX; kpos0 = 0; local = false;
      return true;
    }
    kpos0 = start - 128 + (kb - 4) * 64;
    local = true;
    if (kpos0 < 0 || kpos0 >= SEQL) return false;
    kp = e.kb + (size_t)(b * SEQL + kpos0) * 128 + kvh * 64;
    vp = e.vtl + (size_t)((b * 2 + kvh) * 64) * SEQL + kpos0;
    vstride = SEQL;
    return true;
  };
  const int lr0 = tid >> 3, lc0 = tid & 7;
  u32x4 pk0, pk1, pv0, pv1;
  int kbn = 0;
  {
    const bf16_t *kp, *vp; int vs, kp0; bool lc;
    while (!kb_desc(kbn, kp, vp, vs, kp0, lc)) ++kbn;
    pk0 = *(const u32x4*)(kp + (size_t)lr0 * 128 + lc0 * 8);
    pk1 = *(const u32x4*)(kp + (size_t)(lr0 + 32) * 128 + lc0 * 8);
    pv0 = *(const u32x4*)(vp + (size_t)lr0 * vs + lc0 * 8);
    pv1 = *(const u32x4*)(vp + (size_t)(lr0 + 32) * vs + lc0 * 8);
  }
  while (kbn < nblk) {
    const int kb = kbn;
    int kpos0 = 0;
    bool local = false;
    {
      const bf16_t *kp, *vp; int vs;
      kb_desc(kb, kp, vp, vs, kpos0, local);
    }
    __syncthreads();
    *(u32x4*)(Ks + lr0 * AS + lc0 * 8) = pk0;
    *(u32x4*)(Ks + (lr0 + 32) * AS + lc0 * 8) = pk1;
    *(u32x4*)(Vs + lr0 * AS + lc0 * 8) = pv0;
    *(u32x4*)(Vs + (lr0 + 32) * AS + lc0 * 8) = pv1;
    __syncthreads();
    {
      const bf16_t *kp = nullptr, *vp = nullptr; int vs = 0, kp0; bool lc;
      ++kbn;
      while (kbn < nblk && !kb_desc(kbn, kp, vp, vs, kp0, lc)) ++kbn;
      if (kbn < nblk) {
        pk0 = *(const u32x4*)(kp + (size_t)lr0 * 128 + lc0 * 8);
        pk1 = *(const u32x4*)(kp + (size_t)(lr0 + 32) * 128 + lc0 * 8);
        pv0 = *(const u32x4*)(vp + (size_t)lr0 * vs + lc0 * 8);
        pv1 = *(const u32x4*)(vp + (size_t)(lr0 + 32) * vs + lc0 * 8);
      }
    }
    if (local) {
      const int qmin = start + w * 32;
      if (kpos0 > qmin + 31 + 128 || kpos0 + 63 < qmin - 128) continue;
    }
    f32x16 s[2];
#pragma unroll
    for (int kt = 0; kt < 2; ++kt) {
      s[kt] = zero16();
#pragma unroll
      for (int ks = 0; ks < 4; ++ks) {
        bf16x8 a = *(const bf16x8*)(Ks + (kt * 32 + r) * AS + ks * 16 + h * 8);
        s[kt] = __builtin_amdgcn_mfma_f32_32x32x16_bf16(a, qf[ks], s[kt], 0, 0, 0);
      }
    }
    if (local) {
      const int qpos = start + w * 32 + r;
#pragma unroll
      for (int kt = 0; kt < 2; ++kt)
#pragma unroll
        for (int reg = 0; reg < 16; ++reg) {
          const int kpos = kpos0 + kt * 32 + (reg & 3) + 8 * (reg >> 2) + 4 * h;
          const int diff = qpos - kpos;
          if (diff > 128 || diff < -128) s[kt][reg] = -1e30f;
        }
    }
    float mx = m;
#pragma unroll
    for (int kt = 0; kt < 2; ++kt)
#pragma unroll
      for (int reg = 0; reg < 16; ++reg) mx = fmaxf(mx, s[kt][reg]);
    mx = fmaxf(mx, __shfl_xor(mx, 32));
    const float alpha = __expf(m - mx);
    m = mx;
    float rs = 0.f;
#pragma unroll
    for (int kt = 0; kt < 2; ++kt)
#pragma unroll
      for (int reg = 0; reg < 16; ++reg) {
        const float pv = __expf(s[kt][reg] - mx);
        rs += pv;
        s[kt][reg] = pv;
      }
    rs += __shfl_xor(rs, 32);
    l = l * alpha + rs;
#pragma unroll
    for (int dt = 0; dt < 2; ++dt)
#pragma unroll
      for (int reg = 0; reg < 16; ++reg) o[dt][reg] *= alpha;
#pragma unroll
    for (int kt = 0; kt < 2; ++kt)
#pragma unroll
      for (int sp = 0; sp < 2; ++sp) {
        union { bf16x8 v; uint32_t u[4]; } pf;
#pragma unroll
        for (int j = 0; j < 4; ++j) pf.u[j] = pack2(s[kt][8 * sp + 2 * j], s[kt][8 * sp + 2 * j + 1]);
#pragma unroll
        for (int dt = 0; dt < 2; ++dt) {
          const bf16_t* vp = Vs + (dt * 32 + r) * AS + kt * 32 + sp * 16 + 4 * h;
          union { bf16x8 v; u32x2 u[2]; } af;
          af.u[0] = *(const u32x2*)(vp);
          af.u[1] = *(const u32x2*)(vp + 8);
          o[dt] = __builtin_amdgcn_mfma_f32_32x32x16_bf16(af.v, pf.v, o[dt], 0, 0, 0);
        }
      }
  }
  const float inv = 1.f / l;
  bf16_t* ymix = p.hbuf;
#pragma unroll
  for (int dt = 0; dt < 2; ++dt)
#pragma unroll
    for (int q4 = 0; q4 < 4; ++q4) {
      const int d0 = dt * 32 + 8 * q4 + 4 * h;
      const u32x2 g = *(const u32x2*)(e.gbs + (size_t)qrow * 512 + hq * 64 + d0);
      u32x2 pk;
      pk.x = pack2(o[dt][q4 * 4 + 0] * inv * lo_bf(g.x), o[dt][q4 * 4 + 1] * inv * hi_bf(g.x));
      pk.y = pack2(o[dt][q4 * 4 + 2] * inv * lo_bf(g.y), o[dt][q4 * 4 + 3] * inv * hi_bf(g.y));
      *(u32x2*)(ymix + (size_t)qrow * 1024 + 512 + hq * 64 + d0) = pk;
    }
}

constexpr int MS = 136;

__device__ void gmlp_item(const Params& p, const EvenBufs& e, int item, char* smem, int ei) {
  bf16_t* Ws = (bf16_t*)smem;
  bf16_t* VT = Ws + 128 * MS;
  const int tid = otid(), lane = tid & 63, w = __builtin_amdgcn_readfirstlane(tid >> 6);
  const int r = lane & 31, h = lane >> 5;
  const int wm = w >> 1, wn = w & 1;
  const int rt = item >> 2, g = item & 3;
  const int R0 = rt * 128;
  __syncthreads();
  {
    const float4* wsrc = (const float4*)(p.a_w_s + (size_t)(ei * 4 + g) * 128 * 128);
#pragma unroll
    for (int i = 0; i < 16; ++i) {
      const int idx = tid + 256 * i;
      const int pp = idx >> 5, q4 = idx & 31;
      float4 v = wsrc[idx];
      u32x2 pk;
      pk.x = pack2(v.x, v.y);
      pk.y = pack2(v.z, v.w);
      *(u32x2*)(Ws + pp * MS + q4 * 4) = pk;
    }
  }
#pragma unroll 1
  for (int hp = 0; hp < 2; ++hp) {
    const int q = hp * 64 + (tid >> 2), qt = tid & 3;
    const bf16_t* vsrc = e.vg + (size_t)(R0 + q) * 512 + g * 128 + qt * 32;
    float xv[32];
#pragma unroll
    for (int i = 0; i < 4; ++i) {
      u32x4 u = *(const u32x4*)(vsrc + i * 8);
      xv[i * 8 + 0] = lo_bf(u.x); xv[i * 8 + 1] = hi_bf(u.x);
      xv[i * 8 + 2] = lo_bf(u.y); xv[i * 8 + 3] = hi_bf(u.y);
      xv[i * 8 + 4] = lo_bf(u.z); xv[i * 8 + 5] = hi_bf(u.z);
      xv[i * 8 + 6] = lo_bf(u.w); xv[i * 8 + 7] = hi_bf(u.w);
    }
    float sm = 0.f;
#pragma unroll
    for (int j = 0; j < 32; ++j) sm += xv[j];
    sm += __shfl_xor(sm, 1);
    sm += __shfl_xor(sm, 2);
    const float mean = sm * (1.f / 128.f);
    float sq = 0.f;
#pragma unroll
    for (int j = 0; j < 32; ++j) { float dlt = xv[j] - mean; sq += dlt * dlt; }
    sq += __shfl_xor(sq, 1);
    sq += __shfl_xor(sq, 2);
    const float rstd = rsqrtf(sq * (1.f / 128.f) + 1e-6f);
    const float* lg = p.a_ln_g + ei * 512 + g * 128 + qt * 32;
    const float* lb = p.a_ln_b + ei * 512 + g * 128 + qt * 32;
#pragma unroll
    for (int j = 0; j < 32; ++j) {
      const float val = (xv[j] - mean) * rstd * lg[j] + lb[j];
      VT[(qt * 32 + j) * MS + q] = f2bf(val);
    }
  }
  __syncthreads();
  f32x16 acc[2][2];
#pragma unroll
  for (int mi = 0; mi < 2; ++mi)
#pragma unroll
    for (int ni = 0; ni < 2; ++ni) acc[mi][ni] = zero16();
  const bf16_t* Aw = Ws + (wm * 64 + r) * MS + h * 8;
  const bf16_t* Bw = VT + (wn * 64 + r) * MS + h * 8;
#pragma unroll
  for (int ks = 0; ks < 8; ++ks) {
    bf16x8 a0 = *(const bf16x8*)(Aw + ks * 16);
    bf16x8 a1 = *(const bf16x8*)(Aw + 32 * MS + ks * 16);
    bf16x8 b0 = *(const bf16x8*)(Bw + ks * 16);
    bf16x8 b1 = *(const bf16x8*)(Bw + 32 * MS + ks * 16);
    acc[0][0] = __builtin_amdgcn_mfma_f32_32x32x16_bf16(a0, b0, acc[0][0], 0, 0, 0);
    acc[0][1] = __builtin_amdgcn_mfma_f32_32x32x16_bf16(a0, b1, acc[0][1], 0, 0, 0);
    acc[1][0] = __builtin_amdgcn_mfma_f32_32x32x16_bf16(a1, b0, acc[1][0], 0, 0, 0);
    acc[1][1] = __builtin_amdgcn_mfma_f32_32x32x16_bf16(a1, b1, acc[1][1], 0, 0, 0);
  }
  bf16_t* ymix = p.hbuf;
  const float* bs = p.a_b_s + (ei * 4 + g) * 128;
#pragma unroll
  for (int mi = 0; mi < 2; ++mi)
#pragma unroll
    for (int reg = 0; reg < 16; ++reg) {
      const int prow = wm * 64 + mi * 32 + (reg & 3) + 8 * (reg >> 2) + 4 * h;
      const float bsv = bs[prow];
      const size_t row = (size_t)(R0 + prow);
#pragma unroll
      for (int ni = 0; ni < 2; ++ni) {
        const int col = g * 128 + wn * 64 + ni * 32 + r;
        const float sv = acc[mi][ni][reg] + bsv;
        const float y = bf2f(e.ug[row * 512 + col]) * sv * bf2f(e.gas[row * 512 + col]);
        ymix[row * 1024 + col] = f2bf(y);
      }
    }
}

__device__ void phase_even_mix(const Params& p, char* smem, int ei) {
  const EvenBufs e = even_bufs(p);
  const int n_attn = 2048 + 128, n_gmlp = 1088;
  for (int item = blockIdx.x; item < n_attn + n_gmlp; item += gridDim.x) {
    if (item < n_attn) attn_item(p, e, item, smem, ei);
    else gmlp_item(p, e, item - n_attn, smem, ei);
  }
}

__device__ void phase_conv(const Params& p, int oi) {
  const OddBufs ob = odd_bufs(p);
  const bf16_t* xr = ob.xr;
  bf16_t* zb = ob.sg + (size_t)NR * 1024;
  const int tid = otid();
  const int total = (NR / 8) * 128;
  for (int id = blockIdx.x * NTHREADS + tid; id < total; id += gridDim.x * NTHREADS) {
    const int chunk = id & 127, rg = id >> 7;
    const int R0 = rg * 8;
    int t0, Ls;
    if (R0 < NL) { t0 = R0 & (SEQL - 1); Ls = SEQL; } else { t0 = (R0 - NL) & (LCTX - 1); Ls = LCTX; }
    const int chb = chunk * 8;
    float cw[4][8], cbias[8];
#pragma unroll
    for (int j = 0; j < 4; ++j) {
      const float4 w0 = *(const float4*)(p.c_conv_w + ((size_t)oi * 4 + j) * 1024 + chb);
      const float4 w1 = *(const float4*)(p.c_conv_w + ((size_t)oi * 4 + j) * 1024 + chb + 4);
      cw[j][0] = w0.x; cw[j][1] = w0.y; cw[j][2] = w0.z; cw[j][3] = w0.w;
      cw[j][4] = w1.x; cw[j][5] = w1.y; cw[j][6] = w1.z; cw[j][7] = w1.w;
    }
    {
      const float4 b0 = *(const float4*)(p.c_conv_b + oi * 1024 + chb);
      const float4 b1 = *(const float4*)(p.c_conv_b + oi * 1024 + chb + 4);
      cbias[0] = b0.x; cbias[1] = b0.y; cbias[2] = b0.z; cbias[3] = b0.w;
      cbias[4] = b1.x; cbias[5] = b1.y; cbias[6] = b1.z; cbias[7] = b1.w;
    }
    float xw[11][8];
#pragma unroll
    for (int jj = 0; jj < 11; ++jj) {
      const int t = t0 - 2 + jj;
      u32x4 u = (u32x4){0u, 0u, 0u, 0u};
      if (t >= 0 && t < Ls) u = *(const u32x4*)(xr + (size_t)(R0 - 2 + jj) * 1024 + chb);
      xw[jj][0] = lo_bf(u.x); xw[jj][1] = hi_bf(u.x);
      xw[jj][2] = lo_bf(u.y); xw[jj][3] = hi_bf(u.y);
      xw[jj][4] = lo_bf(u.z); xw[jj][5] = hi_bf(u.z);
      xw[jj][6] = lo_bf(u.w); xw[jj][7] = hi_bf(u.w);
    }
#pragma unroll
    for (int i = 0; i < 8; ++i) {
      float z[8];
#pragma unroll
      for (int e2 = 0; e2 < 8; ++e2) {
        float a = cbias[e2];
#pragma unroll
        for (int j = 0; j < 4; ++j) a += cw[j][e2] * xw[i + j][e2];
        z[e2] = a;
      }
      u32x4 pk;
      pk.x = pack2(z[0], z[1]); pk.y = pack2(z[2], z[3]);
      pk.z = pack2(z[4], z[5]); pk.w = pack2(z[6], z[7]);
      *(u32x4*)(zb + (size_t)(R0 + i) * 1024 + chb) = pk;
    }
  }
}

constexpr int ZS = 264;

template <int DIR>
__device__ void rglru_item(const Params& p, const OddBufs& ob, int item, char* smem, int oi, bool need_ctx) {
  bf16_t* Zs = (bf16_t*)smem;
  float* segA = (float*)(Zs + 128 * ZS);
  float* segB = segA + 256;
  float* carry = segB + 256;
  float* La = (float*)Zs;
  float* Gz = La + 4096;
  const int tid = otid(), lane = tid & 63, w = __builtin_amdgcn_readfirstlane(tid >> 6);
  const int r = lane & 31, h = lane >> 5;
  const int wm = w >> 1, wn = w & 1;
  const int b = item >> 6, cs = item & 31;
  constexpr int dir = DIR;
  const int hd = cs >> 3, j0 = (cs & 7) * 32, c0 = cs * 32;
  bf16_t* sout = dir ? ob.sb : p.hbuf;
  const bf16_t* zb = ob.sg + (size_t)NR * 1024;
  __syncthreads();
  if (tid < 32) carry[tid] = 0.f;
  bf16x8 bfr[16];
  {
    const size_t mo = ((size_t)((oi * 2 + dir) * 4 + hd)) * 65536 + (size_t)(j0 + r) * 256 + h * 8;
    const bf16_t* wsrc = (wn ? p.wgi : p.wga) + mo;
#pragma unroll
    for (int ks = 0; ks < 16; ++ks) bfr[ks] = *(const bf16x8*)(wsrc + ks * 16);
  }
  const int gch = (oi * 2 + dir) * 1024 + c0 + r;
  const float gbias = wn ? p.c_b_i[gch] : p.c_b_a[gch];
  const float spl = log1pf(__expf(-p.c_lam[gch]));
  const int sc_c = tid & 31, sc_sg = tid >> 5;
  const int lrow = tid >> 5, kc = tid & 31;

  u32x4 zt[4];
  {
    const int Rs0 = NL + b * LCTX;
    const int ti0 = dir ? 1 : 0;
    const bf16_t* src = zb + (size_t)(Rs0 + ti0 * 128 + lrow) * 1024 + hd * 256 + kc * 8;
#pragma unroll
    for (int i = 0; i < 4; ++i) zt[i] = *(const u32x4*)(src + (size_t)i * 8 * 1024);
  }
  const int sbase = DIR ? (7 - sc_sg) * 16 : sc_sg * 16;
  const unsigned voff = (unsigned)(sbase * 1024 + c0 + sc_c);
  for (int step = 0; step < 34; ++step) {
    int Rs, ti;
    bool wr;
    if (step < 2) { Rs = NL + b * LCTX; ti = dir ? 1 - step : step; wr = need_ctx; }
    else { Rs = b * SEQL; ti = dir ? 31 - (step - 2) : (step - 2); wr = true; }
    const int t0 = ti * 128;
    __syncthreads();
    {
      const bf16_t* src2 = zb + (size_t)(Rs + t0 + lrow + 32) * 1024 + hd * 256 + kc * 8;
      u32x4 z2[12];
#pragma unroll
      for (int i = 0; i < 12; ++i) z2[i] = *(const u32x4*)(src2 + (size_t)i * 8 * 1024);
#pragma unroll
      for (int i = 0; i < 4; ++i) *(u32x4*)(Zs + (lrow + 8 * i) * ZS + kc * 8) = zt[i];
#pragma unroll
      for (int i = 0; i < 12; ++i) *(u32x4*)(Zs + (lrow + 32 + 8 * i) * ZS + kc * 8) = z2[i];
    }
    const bf16_t* sgp = ob.sg + (size_t)(Rs + t0) * 1024;
    bf16_t sgv[16];
    if (wr) {
#pragma unroll
      for (int i = 0; i < 16; ++i) sgv[i] = sgp[voff + (DIR ? 15 - i : i) * 1024];
    }
    __syncthreads();
    f32x16 acc[2];
    acc[0] = zero16();
    acc[1] = zero16();
    {
      const bf16_t* Aw = Zs + (wm * 64 + r) * ZS + h * 8;
#pragma unroll
      for (int ks = 0; ks < 16; ++ks) {
        bf16x8 a0 = *(const bf16x8*)(Aw + ks * 16);
        bf16x8 a1 = *(const bf16x8*)(Aw + 32 * ZS + ks * 16);
        acc[0] = __builtin_amdgcn_mfma_f32_32x32x16_bf16(a0, bfr[ks], acc[0], 0, 0, 0);
        acc[1] = __builtin_amdgcn_mfma_f32_32x32x16_bf16(a1, bfr[ks], acc[1], 0, 0, 0);
      }
    }
    if (wn == 0) {
#pragma unroll
      for (int mi = 0; mi < 2; ++mi)
#pragma unroll
        for (int reg = 0; reg < 16; ++reg) acc[mi][reg] = -8.f * spl * sigmoid_f(acc[mi][reg] + gbias);
    } else {
#pragma unroll
      for (int mi = 0; mi < 2; ++mi) {
        float zv[16];
#pragma unroll
        for (int reg = 0; reg < 16; ++reg) {
          const int row = wm * 64 + mi * 32 + (reg & 3) + 8 * (reg >> 2) + 4 * h;
          zv[reg] = bf2f(Zs[row * ZS + j0 + r]);
        }
#pragma unroll
        for (int reg = 0; reg < 16; ++reg) acc[mi][reg] = zv[reg] * sigmoid_f(acc[mi][reg] + gbias);
        asm volatile("" ::: "memory");
      }
    }
    __syncthreads();
    {
      float* dstb = wn ? Gz : La;
#pragma unroll
      for (int mi = 0; mi < 2; ++mi)
#pragma unroll
        for (int reg = 0; reg < 16; ++reg) {
          const int row = wm * 64 + mi * 32 + (reg & 3) + 8 * (reg >> 2) + 4 * h;
          dstb[row * 32 + r] = acc[mi][reg];
        }
    }
    __syncthreads();
    if (step + 1 < 34) {
      const int ns = step + 1;
      int nRs, nti;
      if (ns < 2) { nRs = NL + b * LCTX; nti = dir ? 1 - ns : ns; }
      else { nRs = b * SEQL; nti = dir ? 31 - (ns - 2) : (ns - 2); }
      const bf16_t* src = zb + (size_t)(nRs + nti * 128 + lrow) * 1024 + hd * 256 + kc * 8;
#pragma unroll
      for (int i = 0; i < 4; ++i) zt[i] = *(const u32x4*)(src + (size_t)i * 8 * 1024);
    }
    bf16_t* sop = sout + (size_t)(Rs + t0) * 1024;
    const float* Lap = La + sbase * 32 + sc_c;
    const float* Gzp = Gz + sbase * 32 + sc_c;
    {
      float A = 1.f, Bv = 0.f;
      float* Law = La + sbase * 32 + sc_c;
      float* Gzw = Gz + sbase * 32 + sc_c;
#pragma unroll
      for (int i = 0; i < 16; ++i) {
        const int ro = (DIR ? 15 - i : i) * 32;
        const float la = Lap[ro];
        const float a = __expf(la);
        const float mult = __builtin_amdgcn_sqrtf(fmaf(-a, a, 1.f));
        const float bx = mult * Gzp[ro];
        Law[ro] = a;
        Gzw[ro] = bx;
        Bv = a * Bv + bx;
        A *= a;
      }
      segA[sc_sg * 32 + sc_c] = A;
      segB[sc_sg * 32 + sc_c] = Bv;
    }
    __syncthreads();
    {
      float hh = carry[(step & 1) * 32 + sc_c];
      {
        float sa[7], sbv[7];
#pragma unroll
        for (int s2 = 0; s2 < 7; ++s2) { sa[s2] = segA[s2 * 32 + sc_c]; sbv[s2] = segB[s2 * 32 + sc_c]; }
#pragma unroll
        for (int s2 = 0; s2 < 7; ++s2) hh = (s2 < sc_sg) ? (sa[s2] * hh + sbv[s2]) : hh;
      }
#pragma unroll
      for (int i = 0; i < 16; ++i) {
        const int ro = (DIR ? 15 - i : i);
        hh = Lap[ro * 32] * hh + Gzp[ro * 32];
        if (wr) sop[voff + ro * 1024] = f2bf(hh * bf2f(sgv[i]));
      }
      if (sc_sg == 7) carry[((step + 1) & 1) * 32 + sc_c] = hh;
    }
  }
}

__device__ void phase_rglru(const Params& p, char* smem, int oi, bool need_ctx) {
  const OddBufs ob = odd_bufs(p);
  for (int it0 = blockIdx.x; it0 < 512; it0 += gridDim.x) {
    const int xcd = it0 & 7, slot = it0 >> 3;
    const int grp = xcd * 4 + (slot >> 4), j = slot & 15;
    const int item = ((grp >> 2) << 6) | ((j >> 3) << 5) | ((grp & 3) << 3) | (j & 7);
    if ((item >> 5) & 1) rglru_item<1>(p, ob, item, smem, oi, need_ctx);
    else rglru_item<0>(p, ob, item, smem, oi, need_ctx);
  }
}

#define XB_TMO      128
#define XB_XCNT(j)  (256  + 64 * (j))
#define XB_XSUB(j)  (1280 + 64 * (j))
#define XB_XGEN(j)  (2304 + 64 * (j))
#define XB_TOP      3328
#define XB_TOPGEN   3392
#define XCD_BAR_WORDS 3456
#define XB_SPIN_CAP (1u << 18)
#define LAS __attribute__((address_space(3)))

__device__ __forceinline__ unsigned xb_ld(unsigned* p)              { return __hip_atomic_load(p, __ATOMIC_RELAXED, __HIP_MEMORY_SCOPE_AGENT); }
__device__ __forceinline__ unsigned xb_add(unsigned* p, unsigned v) { return __hip_atomic_fetch_add(p, v, __ATOMIC_RELAXED, __HIP_MEMORY_SCOPE_AGENT); }
__device__ __forceinline__ unsigned xb_xcc_id() { return (unsigned)__builtin_amdgcn_s_getreg((3 << 11) | 20) & 0xFu; }
#define XB_SPIN(cond, bar) do { unsigned _sp = 0; while (cond) { __builtin_amdgcn_s_sleep(1); \
    if ((++_sp & 255u) == 0u) { if (xb_ld(&(bar)[XB_TMO])) break; if (_sp > XB_SPIN_CAP) { atomicAdd(&(bar)[XB_TMO], 1u); break; } } } } while (0)

struct XcdBarrier {
    unsigned* bar; unsigned x;
    volatile LAS unsigned* st;
};

__device__ __forceinline__ XcdBarrier xcd_barrier_post(unsigned* bar, volatile LAS unsigned* st) {
    XcdBarrier b; b.bar = bar; b.x = xb_xcc_id(); b.st = st;
    if (threadIdx.x == 0) (void)xb_add(&bar[XB_XCNT(b.x)], 1u);
    return b;
}
__device__ __forceinline__ void xcd_barrier_complete(unsigned* bar, unsigned x, unsigned& nloc, unsigned& nx) {
    const unsigned G = gridDim.x * gridDim.y * gridDim.z;
    unsigned sum, cnt, mine, sp = 0u;
    for (;;) {
        sum = 0u; cnt = 0u; mine = 0u;
#pragma unroll
        for (unsigned j = 0; j < 16; ++j) { const unsigned c = xb_ld(&bar[XB_XCNT(j)]); sum += c; cnt += (c > 0u) ? 1u : 0u; mine = (j == x) ? c : mine; }
        if (sum == G) break;
        __builtin_amdgcn_s_sleep(1);
        if ((++sp & 255u) == 0u) { if (xb_ld(&bar[XB_TMO])) break; if (sp > XB_SPIN_CAP) { atomicAdd(&bar[XB_TMO], 1u); break; } }
    }
    nloc = mine > 0u ? mine : 1u; nx = cnt > 0u ? cnt : 1u;
}

__device__ __forceinline__ void xcd_barrier(const XcdBarrier& b) {
    asm volatile("s_waitcnt vmcnt(0)" ::: "memory");
    __syncthreads();
    if (threadIdx.x == 0) {
        unsigned* bar = b.bar;
        __builtin_amdgcn_s_waitcnt(0);
        unsigned nloc = b.st[0], nx = b.st[1];
        if (nloc == 0u) { xcd_barrier_complete(bar, b.x, nloc, nx); b.st[0] = nloc; b.st[1] = nx; }
        const unsigned old = xb_add(&bar[XB_XSUB(b.x)], 1u);
        const unsigned gen = old / nloc;
        if (old + 1u == (gen + 1u) * nloc) {
            __builtin_amdgcn_fence(__ATOMIC_RELEASE, "agent");
            asm volatile("s_waitcnt vmcnt(0)" ::: "memory");
            const unsigned og = xb_add(&bar[XB_TOP], 1u);
            const unsigned tg = og / nx;
            if (og + 1u == (tg + 1u) * nx) xb_add(&bar[XB_TOPGEN], 1u);
            else XB_SPIN(xb_ld(&bar[XB_TOPGEN]) == tg, bar);
            __builtin_amdgcn_fence(__ATOMIC_ACQUIRE, "agent");
            xb_add(&bar[XB_XGEN(b.x)], 1u);
            asm volatile("s_waitcnt vmcnt(0)" ::: "memory");
        } else {
            XB_SPIN(xb_ld(&bar[XB_XGEN(b.x)]) == gen, bar);
            __builtin_amdgcn_fence(__ATOMIC_ACQUIRE, "agent");
            asm volatile("s_waitcnt vmcnt(0)" ::: "memory");
        }
    }
    __syncthreads();
}


#define LAUNDER(f) q.f = p.f + z
__device__ __forceinline__ void launder(Params& q, const Params& p) {
  long z;
  asm volatile("s_mov_b64 %0, 0" : "=s"(z));
  LAUNDER(x); LAUNDER(c); LAUNDER(ctx); LAUNDER(c_ctx); LAUNDER(norm_g); LAUNDER(w_mod); LAUNDER(b_mod);
  LAUNDER(ab_w_in); LAUNDER(a_ln_g); LAUNDER(a_ln_b); LAUNDER(a_w_s); LAUNDER(a_b_s); LAUNDER(b_sink);
  LAUNDER(ab_w_out); LAUNDER(c_w_in); LAUNDER(c_conv_w); LAUNDER(c_conv_b); LAUNDER(c_w_a); LAUNDER(c_b_a);
  LAUNDER(c_w_i); LAUNDER(c_b_i); LAUNDER(c_lam); LAUNDER(c_w_out); LAUNDER(final_g); LAUNDER(out);
  LAUNDER(xbuf); LAUNDER(mods); LAUNDER(hbuf); LAUNDER(ebuf); LAUNDER(wt_in_e); LAUNDER(wt_out_e);
  LAUNDER(wt_in_o); LAUNDER(wt_out_o); LAUNDER(wga); LAUNDER(wgi);
}

constexpr int NPHASES = 20;

__device__ void run_phase(const Params& p0, int ph, char* smem) {
  if (ph == 0) { Params p; launder(p, p0); phase0(p, smem); return; }
  if (ph == 19) { Params p; launder(p, p0); phase_final(p); return; }
  int layer, sub;
  if (ph < 5) { layer = 0; sub = ph - 1; }
  else if (ph < 10) { layer = 1; sub = ph - 5; }
  else if (ph < 14) { layer = 2; sub = ph - 10; }
  else { layer = 3; sub = ph - 14; }
  const int idx = layer >> 1;
  const bool even = (layer & 1) == 0;
  const bool need_ctx = layer < 3;
  if (sub == 0) { Params p; launder(p, p0); phase_prep(p, layer); return; }
  if (even) {
    if (sub == 1) {
      Params p; launder(p, p0);
      EpiEvenIn epi; epi.e = even_bufs(p);
      gemm_phase_big(p.hbuf, p.wt_in_e + (size_t)idx * 2816 * 1024, NR / 256, 22, smem, epi);
    } else if (sub == 2) {
      Params p; launder(p, p0);
      phase_even_mix(p, smem, idx);
    } else {
      Params p; launder(p, p0);
      EpiOut epi; epi.xbuf = p.xbuf; epi.mods_l = p.mods + (size_t)layer * 9 * 3072;
      epi.xin_lat = (layer == 0) ? p.x : p.xbuf;
      epi.xin_ctx = (layer == 0) ? p.ctx : p.xbuf + (size_t)NL * 1024;
      gemm_phase<0>(p.hbuf, nullptr, p.wt_out_e + (size_t)idx * 1024 * 1024, NR / 128, 8, smem, epi);
    }
  } else {
    if (sub == 1) {
      Params p; launder(p, p0);
      EpiOddIn epi; epi.o = odd_bufs(p);
      gemm_phase_big(p.hbuf, p.wt_in_o + (size_t)idx * 2048 * 1024, NR / 256, 16, smem, epi);
    } else if (sub == 2) {
      Params p; launder(p, p0);
      phase_conv(p, idx);
    } else if (sub == 3) {
      Params p; launder(p, p0);
      phase_rglru(p, smem, idx, need_ctx);
    } else {
      Params p; launder(p, p0);
      EpiOut epi; epi.xbuf = p.xbuf; epi.mods_l = p.mods + (size_t)layer * 9 * 3072;
      epi.xin_lat = (layer == 0) ? p.x : p.xbuf;
      epi.xin_ctx = (layer == 0) ? p.ctx : p.xbuf + (size_t)NL * 1024;
      const OddBufs ob = odd_bufs(p);
      gemm_phase<1>(p.hbuf, ob.sb, p.wt_out_o + (size_t)idx * 1024 * 1024, (need_ctx ? NR : NL) / 128, 8, smem, epi);
    }
  }
}

__global__ void __launch_bounds__(NTHREADS, 2) mega_kernel(Params p, int ph_lo, int ph_hi, int use_bar) {
  __shared__ __attribute__((aligned(16))) char smem[SMEM_BYTES];
  __shared__ uint4 xb_words;
  if (threadIdx.x == 0) xb_words = make_uint4(0u, 0u, 0u, 0u);
  __syncthreads();
  if (use_bar == 1) (void)xcd_barrier_post(p.bar, (volatile LAS unsigned*)&xb_words);
  for (int ph = ph_lo; ph < ph_hi; ++ph) {
    run_phase(p, ph, smem);
    if (ph + 1 < ph_hi) {
      if (use_bar == 1) {
        XcdBarrier xb;
        xb.bar = p.bar; xb.x = xb_xcc_id(); xb.st = (volatile LAS unsigned*)&xb_words;
        xcd_barrier(xb);
      } else if (use_bar == 2) cg::this_grid().sync();
    }
  }
}

extern "C" void kernel_launch(void* const* d_in, const int* in_sizes, int n_in, void* d_out, int out_size,
                              void* d_ws, size_t ws_size, hipStream_t stream) {
  static int grid_blocks = 0;
  if (!grid_blocks) {
    int dev = 0, cus = 0, per_cu = 0;
    hipGetDevice(&dev);
    hipDeviceGetAttribute(&cus, hipDeviceAttributeMultiprocessorCount, dev);
    hipOccupancyMaxActiveBlocksPerMultiprocessor(&per_cu, mega_kernel, NTHREADS, 0);
    if (per_cu < 1) per_cu = 1;
    if (per_cu > 2) per_cu = 2;
    grid_blocks = cus * per_cu;
  }
  Params p{};
  const float** fp = (const float**)&p;
  for (int i = 0; i < 24; ++i) fp[i] = (const float*)d_in[i];
  p.out = (float*)d_out;
  char* ws = (char*)d_ws;
  size_t off = 0;
  auto take = [&](size_t bytes) { char* q = ws + off; off += (bytes + 255) & ~(size_t)255; return q; };
  p.xbuf = (float*)take((size_t)NR * 1024 * 4);
  p.mods = (float*)take((size_t)4 * 9 * 3072 * 4);
  p.hbuf = (bf16_t*)take((size_t)NR * 1024 * 2);
  p.ebuf = (bf16_t*)take((size_t)NR * 3072 * 2);
  p.wt_in_e = (bf16_t*)take((size_t)2 * 2816 * 1024 * 2);
  p.wt_out_e = (bf16_t*)take((size_t)2 * 1024 * 1024 * 2);
  p.wt_in_o = (bf16_t*)take((size_t)2 * 2048 * 1024 * 2);
  p.wt_out_o = (bf16_t*)take((size_t)2 * 1024 * 1024 * 2);
  p.wga = (bf16_t*)take((size_t)16 * 65536 * 2);
  p.wgi = (bf16_t*)take((size_t)16 * 65536 * 2);
  p.bar = (unsigned*)take((size_t)XCD_BAR_WORDS * 4);
  if (off > ws_size) fprintf(stderr, "workspace too small: need %zu have %zu\n", off, ws_size);
#if COOP
  hipMemsetAsync(p.bar, 0, (size_t)XCD_BAR_WORDS * 4, stream);
  int lo = 0, hi = NPHASES, ub = 1;
  void* args[] = {&p, &lo, &hi, &ub};
  hipError_t e = hipLaunchCooperativeKernel((void*)mega_kernel, dim3(grid_blocks), dim3(NTHREADS), args, 0, stream);
  if (e != hipSuccess) fprintf(stderr, "cooperative launch failed: %s (grid %d)\n", hipGetErrorString(e), grid_blocks);
#else
  for (int ph = 0; ph < NPHASES; ++ph) mega_kernel<<<grid_blocks, NTHREADS, 0, stream>>>(p, ph, ph + 1, 0);
#endif
}
```

```cpp
#include <hip/hip_runtime.h>
#include <hip/hip_cooperative_groups.h>
#include <stdint.h>
#include <stdio.h>
namespace cg = cooperative_groups;

#ifndef COOP
#define COOP 1
#endif

typedef unsigned short bf16_t;
typedef __attribute__((ext_vector_type(8))) short bf16x8;
typedef __attribute__((ext_vector_type(16))) float f32x16;
typedef __attribute__((ext_vector_type(4))) unsigned int u32x4;
typedef __attribute__((ext_vector_type(2))) unsigned int u32x2;

constexpr int DM = 1024;
constexpr int NBATCH = 8;
constexpr int SEQL = 4096;
constexpr int LCTX = 256;
constexpr int NL = NBATCH * SEQL;
constexpr int NC = NBATCH * LCTX;
constexpr int NR = NL + NC;
constexpr int VSMEM = 72 * 1024;
constexpr int NTHREADS = 512;
constexpr int VTH = 256;
constexpr int DSM_BYTES = 2 * VSMEM + 256;

struct Params {
  const float *x, *c, *ctx, *c_ctx, *norm_g, *w_mod, *b_mod, *ab_w_in, *a_ln_g, *a_ln_b, *a_w_s, *a_b_s,
      *b_sink, *ab_w_out, *c_w_in, *c_conv_w, *c_conv_b, *c_w_a, *c_b_a, *c_w_i, *c_b_i, *c_lam, *c_w_out,
      *final_g;
  float* out;
  float* xbuf;
  float* mods;
  bf16_t* hbuf;
  bf16_t* ebuf;
  bf16_t *wt_in_e, *wt_out_e, *wt_in_o, *wt_out_o, *wga, *wgi;
  bf16_t* wsb;
  float* wsum;
  float* part;
  unsigned* bar;
};

typedef __bf16 hwbf16x2 __attribute__((ext_vector_type(2)));
typedef float f32x2v __attribute__((ext_vector_type(2)));
__device__ __forceinline__ uint32_t pack2(float a, float b) {
  f32x2v v = {a, b};
  hwbf16x2 r = __builtin_convertvector(v, hwbf16x2);
  return __builtin_bit_cast(uint32_t, r);
}
__device__ __forceinline__ bf16_t f2bf(float f) { return (bf16_t)(pack2(f, f) & 0xffffu); }
__device__ __forceinline__ float bf2f(bf16_t b) { return __uint_as_float(((uint32_t)b) << 16); }
__device__ __forceinline__ float lo_bf(uint32_t u) { return __uint_as_float(u << 16); }
__device__ __forceinline__ float hi_bf(uint32_t u) { return __uint_as_float(u & 0xffff0000u); }
__device__ __forceinline__ float frcp(float x) { return __builtin_amdgcn_rcpf(x); }
__device__ __forceinline__ float silu_f(float x) { return x * frcp(1.f + __expf(-x)); }
__device__ __forceinline__ float sigmoid_f(float x) { return frcp(1.f + __expf(-x)); }
__device__ __forceinline__ float gelu_f(float x) {
  float y = 0.7978845608028654f * (x + 0.044715f * x * x * x);
  float t = 1.f - 2.f * frcp(1.f + __expf(2.f * y));
  return 0.5f * x * (1.f + t);
}
typedef float f32x2p __attribute__((ext_vector_type(2)));
__device__ __forceinline__ f32x2p silu_pk(f32x2p x) {
  const f32x2p t = x * (-1.4426950408889634f);
  f32x2p e; e.x = __builtin_amdgcn_exp2f(t.x); e.y = __builtin_amdgcn_exp2f(t.y);
  const f32x2p d = e + 1.0f;
  f32x2p r; r.x = __builtin_amdgcn_rcpf(d.x); r.y = __builtin_amdgcn_rcpf(d.y);
  return x * r;
}
__device__ __forceinline__ f32x2p gelu_pk(f32x2p x) {
  const f32x2p x2 = x * x;
  const f32x2p pz = x2 * (0.044715f * 2.3022082003f) + 2.3022082003f;
  const f32x2p u = x * pz;
  f32x2p e; e.x = __builtin_amdgcn_exp2f(u.x); e.y = __builtin_amdgcn_exp2f(u.y);
  const f32x2p d = e + 1.0f;
  f32x2p r; r.x = __builtin_amdgcn_rcpf(d.x); r.y = __builtin_amdgcn_rcpf(d.y);
  return x - x * r;
}
__device__ __forceinline__ f32x16 zero16() {
  f32x16 z;
#pragma unroll
  for (int i = 0; i < 16; ++i) z[i] = 0.f;
  return z;
}
__device__ __forceinline__ float wave_sum(float v) {
#pragma unroll
  for (int o = 32; o > 0; o >>= 1) v += __shfl_xor(v, o);
  return v;
}

__device__ __forceinline__ int ofull() {
  int t = threadIdx.x;
  asm volatile("" : "+v"(t));
  return t;
}
__device__ __forceinline__ int otid() { return ofull() & (VTH - 1); }
__device__ __forceinline__ int vbid() { return __builtin_amdgcn_readfirstlane(ofull() >> 8); }
__device__ __forceinline__ int vblk() { return (int)blockIdx.x * 2 + vbid(); }
__device__ __forceinline__ int nvblk() { return (int)gridDim.x * 2; }

struct EvenBufs {
  bf16_t *ug, *vg, *gas, *qb, *gbs, *kb, *vtl, *vtc;
};
__device__ __forceinline__ EvenBufs even_bufs(const Params& p) {
  EvenBufs e;
  e.ug = p.ebuf;
  e.vg = e.ug + (size_t)NR * 512;
  e.gas = e.vg + (size_t)NR * 512;
  e.qb = e.gas + (size_t)NR * 512;
  e.gbs = e.qb + (size_t)NR * 512;
  e.kb = e.gbs + (size_t)NR * 512;
  e.vtl = e.kb + (size_t)NR * 128;
  e.vtc = e.vtl + (size_t)NBATCH * 128 * SEQL;
  return e;
}
struct OddBufs {
  bf16_t *xr, *sg, *sb;
};
__device__ __forceinline__ OddBufs odd_bufs(const Params& p) {
  OddBufs o;
  o.xr = p.ebuf;
  o.sg = o.xr + (size_t)NR * 1024;
  o.sb = o.xr;
  return o;
}

__device__ void transpose_item(const Params& p, int item, char* smem) {
  float* tile = (float*)smem;
  const float* src;
  bf16_t* dst;
  int K, N, local;
  if (item < 1408) { src = p.ab_w_in; dst = p.wt_in_e; K = 1024; N = 2816; local = item; }
  else if (item < 1920) { src = p.ab_w_out; dst = p.wt_out_e; K = 1024; N = 1024; local = item - 1408; }
  else if (item < 2944) { src = p.c_w_in; dst = p.wt_in_o; K = 1024; N = 2048; local = item - 1920; }
  else if (item < 3456) { src = p.c_w_out; dst = p.wt_out_o; K = 1024; N = 1024; local = item - 2944; }
  else if (item < 3712) { src = p.c_w_a; dst = p.wga; K = 256; N = 256; local = item - 3456; }
  else { src = p.c_w_i; dst = p.wgi; K = 256; N = 256; local = item - 3712; }
  const int ntn = N / 64;
  const int tpb = (K / 64) * ntn;
  const int bi = local / tpb;
  const int rem = local % tpb;
  const int k0 = (rem / ntn) * 64, n0 = (rem % ntn) * 64;
  src += (size_t)bi * K * N;
  dst += (size_t)bi * K * N;
  const int tid = otid();
  __syncthreads();
#pragma unroll
  for (int i = 0; i < 16; ++i) {
    int rr = i * 4 + (tid >> 6), cc = tid & 63;
    tile[rr * 65 + cc] = src[(size_t)(k0 + rr) * N + n0 + cc];
  }
  __syncthreads();
  const bool qk = (item < 1408) && n0 >= 1536 && n0 < 2176;
#pragma unroll
  for (int i = 0; i < 16; ++i) {
    int n = i * 4 + (tid >> 6), k = tid & 63;
    const int ns = qk ? (((n >> 3) << 2) + (n & 3) + (((n >> 2) & 1) << 5)) : n;
    dst[(size_t)(n0 + n) * K + k0 + k] = f2bf(tile[k * 65 + ns]);
  }
}

__device__ void mods_item(const Params& p, int item, char* smem) {
  float* sc = (float*)smem;
  float* red = sc + 9 * 1024;
  const int tid = otid();
  const int l = item / 96, n0 = (item % 96) * 32;
  __syncthreads();
  {
    float cv[36];
#pragma unroll
    for (int it = 0; it < 36; ++it) {
      const int j = it >> 2, k = tid + 256 * (it & 3);
      cv[it] = (j < 8) ? p.c[j * 1024 + k] : p.c_ctx[k];
    }
#pragma unroll
    for (int it = 0; it < 36; ++it) sc[tid + 256 * it] = silu_f(cv[it]);
  }
  __syncthreads();
  const int col = tid & 31, kg = tid >> 5;
  float acc[9];
#pragma unroll
  for (int j = 0; j < 9; ++j) acc[j] = 0.f;
  const float* w = p.w_mod + ((size_t)l * 1024 + kg * 128) * 3072 + n0 + col;
#pragma unroll 64
  for (int k = 0; k < 128; ++k) {
    float wv = w[(size_t)k * 3072];
#pragma unroll
    for (int j = 0; j < 9; ++j) acc[j] += sc[j * 1024 + kg * 128 + k] * wv;
  }
#pragma unroll
  for (int j = 0; j < 9; ++j) red[(kg * 9 + j) * 32 + col] = acc[j];
  __syncthreads();
  for (int i = tid; i < 9 * 32; i += VTH) {
    int j = i >> 5, cc = i & 31;
    float s = 0.f;
#pragma unroll
    for (int g = 0; g < 8; ++g) s += red[(g * 9 + j) * 32 + cc];
    p.mods[((size_t)l * 9 + j) * 3072 + n0 + cc] = s + p.b_mod[l * 3072 + n0 + cc];
  }
}

__device__ void phase0(const Params& p, char* smem) {
  for (int row = blockIdx.x * NTHREADS + ofull(); row < 8 * 128; row += gridDim.x * NTHREADS) {
    const float4* src = (const float4*)(p.a_w_s + (size_t)row * 128);
    float sm = 0.f;
#pragma unroll 8
    for (int i = 0; i < 32; ++i) {
      const float4 v = src[i];
      sm += (v.x + v.y) + (v.z + v.w);
      u32x2 pk;
      pk.x = pack2(v.x, v.y);
      pk.y = pack2(v.z, v.w);
      *(u32x2*)(p.wsb + (size_t)row * 128 + i * 4) = pk;
    }
    p.wsum[row] = sm;
  }
  for (int item = vblk(); item < 384; item += nvblk()) mods_item(p, item, smem);
}
__device__ void phase0_transposes(const Params& p, char* smem) {
  for (int item = vblk(); item < 3968; item += nvblk()) transpose_item(p, item, smem);
}

__device__ void phase_prep(const Params& p, int layer) {
  const int tid = ofull();
  const int lane = tid & 63;
  const int gw = blockIdx.x * 8 + (tid >> 6);
  const int nw = gridDim.x * 8;
  const float* ng = p.norm_g + layer * 1024;
  float4 gpre[4];
#pragma unroll
  for (int i = 0; i < 4; ++i) gpre[i] = ((const float4*)ng)[lane + 64 * i];
  for (int R = gw; R < NR; R += nw) {
    const float* src;
    if (layer == 0) src = (R < NL) ? p.x + (size_t)R * 1024 : p.ctx + (size_t)(R - NL) * 1024;
    else if (layer == 1 && R >= NL) src = p.ctx + (size_t)(R - NL) * 1024;
    else src = p.xbuf + (size_t)R * 1024;
    const int bidx = (R < NL) ? (R >> 12) : 8;
    const float* md = p.mods + ((size_t)layer * 9 + bidx) * 3072;
    float4 v[4], shp[4], scp[4];
#pragma unroll
    for (int i = 0; i < 4; ++i) v[i] = ((const float4*)src)[lane + 64 * i];
#pragma unroll
    for (int i = 0; i < 4; ++i) {
      shp[i] = ((const float4*)md)[lane + 64 * i];
      scp[i] = ((const float4*)(md + 1024))[lane + 64 * i];
    }
    if (layer >= 1 && R >= NL) {
      const float* gp = p.mods + ((size_t)(layer - 1) * 9 + 8) * 3072 + 2048;
      const float* pp = p.part + (size_t)(R - NL) * 1024;
#pragma unroll
      for (int i = 0; i < 4; ++i) {
        const int k4 = lane + 64 * i;
        const float4 g = ((const float4*)gp)[k4];
        const float4 a0 = ((const float4*)pp)[k4];
        const float4 a1 = ((const float4*)(pp + (size_t)NC * 1024))[k4];
        const float4 a2 = ((const float4*)(pp + (size_t)2 * NC * 1024))[k4];
        const float4 a3 = ((const float4*)(pp + (size_t)3 * NC * 1024))[k4];
        v[i].x += g.x * ((a0.x + a1.x) + (a2.x + a3.x));
        v[i].y += g.y * ((a0.y + a1.y) + (a2.y + a3.y));
        v[i].z += g.z * ((a0.z + a1.z) + (a2.z + a3.z));
        v[i].w += g.w * ((a0.w + a1.w) + (a2.w + a3.w));
        ((float4*)(p.xbuf + (size_t)R * 1024))[k4] = v[i];
      }
    }
    float ss = 0.f;
#pragma unroll
    for (int i = 0; i < 4; ++i) ss += v[i].x * v[i].x + v[i].y * v[i].y + v[i].z * v[i].z + v[i].w * v[i].w;
    ss = wave_sum(ss);
    const float rstd = rsqrtf(ss * (1.f / 1024.f) + 1e-6f);
#pragma unroll
    for (int i = 0; i < 4; ++i) {
      const int k4 = lane + 64 * i;
      const float4 g = gpre[i];
      const float4 sh = shp[i];
      const float4 sc = scp[i];
      float h0 = v[i].x * rstd * g.x * (1.f + sc.x) + sh.x;
      float h1 = v[i].y * rstd * g.y * (1.f + sc.y) + sh.y;
      float h2 = v[i].z * rstd * g.z * (1.f + sc.z) + sh.z;
      float h3 = v[i].w * rstd * g.w * (1.f + sc.w) + sh.w;
      u32x2 pk;
      pk.x = pack2(h0, h1);
      pk.y = pack2(h2, h3);
      *(u32x2*)(p.hbuf + (size_t)R * 1024 + k4 * 4) = pk;
    }
  }
}

__device__ void phase_final(const Params& p) {
  const int tid = ofull();
  const int lane = tid & 63;
  const int gw = blockIdx.x * 8 + (tid >> 6);
  const int nw = gridDim.x * 8;
  float4 fg[4];
#pragma unroll
  for (int i = 0; i < 4; ++i) fg[i] = ((const float4*)p.final_g)[lane + 64 * i];
  for (int R = gw; R < NL; R += nw) {
    const float* src = p.xbuf + (size_t)R * 1024;
    float4 v[4];
#pragma unroll
    for (int i = 0; i < 4; ++i) v[i] = ((const float4*)src)[lane + 64 * i];
    float ss = 0.f;
#pragma unroll
    for (int i = 0; i < 4; ++i) ss += v[i].x * v[i].x + v[i].y * v[i].y + v[i].z * v[i].z + v[i].w * v[i].w;
    ss = wave_sum(ss);
    const float rstd = rsqrtf(ss * (1.f / 1024.f) + 1e-6f);
#pragma unroll
    for (int i = 0; i < 4; ++i) {
      const int k4 = lane + 64 * i;
      const float4 g = fg[i];
      float4 o;
      o.x = v[i].x * rstd * g.x;
      o.y = v[i].y * rstd * g.y;
      o.z = v[i].z * rstd * g.z;
      o.w = v[i].w * rstd * g.w;
      ((float4*)(p.out + (size_t)R * 1024))[k4] = o;
    }
  }
}

constexpr int GS = 72;

__device__ __forceinline__ u32x4 add_bf16x8(u32x4 a, u32x4 b) {
  u32x4 r;
  r.x = pack2(lo_bf(a.x) + lo_bf(b.x), hi_bf(a.x) + hi_bf(b.x));
  r.y = pack2(lo_bf(a.y) + lo_bf(b.y), hi_bf(a.y) + hi_bf(b.y));
  r.z = pack2(lo_bf(a.z) + lo_bf(b.z), hi_bf(a.z) + hi_bf(b.z));
  r.w = pack2(lo_bf(a.w) + lo_bf(b.w), hi_bf(a.w) + hi_bf(b.w));
  return r;
}

template <int AMODE, class Epi>
__device__ void gemm_phase(const bf16_t* __restrict__ A0, const bf16_t* __restrict__ A1,
                           const bf16_t* __restrict__ Bt, int Mtiles, int Ntiles, char* smem, Epi epi) {
  constexpr int PD = (AMODE == 1) ? 1 : 2;
  constexpr int BUF = 2 * 128 * GS;
  bf16_t* S0 = (bf16_t*)smem;
  const int tid = otid(), lane = tid & 63, w = __builtin_amdgcn_readfirstlane(tid >> 6);
  const int wm = w >> 1, wn = w & 1;
  const int r = lane & 31, h = lane >> 5;
  const int lrow = tid >> 3, kc = tid & 7;
  const int total = Mtiles * Ntiles;
  const int woff = lrow * GS + kc * 8;
  const int aro = (wm * 64 + r) * GS + h * 8;
  const int bro = 128 * GS + (wn * 64 + r) * GS + h * 8;
  const bool swz = ((gridDim.x & 7) == 0) && ((Mtiles & 7) == 0);
  const int xcd = blockIdx.x & 7;
  const int Mx = Mtiles >> 3;
  const int lstart = swz ? (int)(blockIdx.x >> 3) * 2 + vbid() : vblk();
  const int lstep = swz ? (int)(gridDim.x >> 3) * 2 : nvblk();
  const int lend = swz ? Mx * Ntiles : total;
  for (int L0 = 0; L0 < lend; L0 += lstep) {
    const bool tvalid = L0 + lstart < lend;
    const int L = tvalid ? L0 + lstart : lend - 1;
    int mt, nt;
    if (swz) {
      const int gfull = 8 * Ntiles;
      const int mg = L / gfull, rem = L - mg * gfull;
      const int gs = min(8, Mx - mg * 8);
      nt = rem / gs;
      mt = xcd * Mx + mg * 8 + (rem - nt * gs);
    } else {
      mt = L / Ntiles;
      nt = L - mt * Ntiles;
    }
    const int m0 = mt * 128, n0 = nt * 128;
    const size_t aoff = (size_t)(m0 + lrow) * 1024 + kc * 8;
    const bf16_t* ap = A0 + aoff;
    const bf16_t* ap1 = (AMODE == 1) ? (A1 + aoff) : A0;
    const bf16_t* bp = Bt + (size_t)(n0 + lrow) * 1024 + kc * 8;
    u32x4 ra[PD][4], ra1[PD][4], rb[PD][4];
#define G_LOAD(S, KT)                                                                              \
    {                                                                                              \
      _Pragma("unroll") for (int i = 0; i < 4; ++i) {                                              \
        ra[S][i] = *(const u32x4*)(ap + (size_t)i * 32 * 1024 + (KT) * 64);                        \
        if (AMODE == 1) ra1[S][i] = *(const u32x4*)(ap1 + (size_t)i * 32 * 1024 + (KT) * 64);     \
        rb[S][i] = *(const u32x4*)(bp + (size_t)i * 32 * 1024 + (KT) * 64);                        \
      }                                                                                            \
    }
#define L_WRITE(S, BUFI)                                                                           \
    {                                                                                              \
      bf16_t* dstA = S0 + (BUFI) * BUF + woff;                                                     \
      _Pragma("unroll") for (int i = 0; i < 4; ++i) {                                              \
        u32x4 av = ra[S][i];                                                                       \
        if (AMODE == 1) av = add_bf16x8(av, ra1[S][i]);                                            \
        *(u32x4*)(dstA + 32 * i * GS) = av;                                                        \
        *(u32x4*)(dstA + 128 * GS + 32 * i * GS) = rb[S][i];                                       \
      }                                                                                            \
    }
    G_LOAD(0, 0);
    L_WRITE(0, 0);
#pragma unroll
    for (int s = 0; s < PD; ++s) G_LOAD(s, 1 + s);
    f32x16 acc[2][2];
#pragma unroll
    for (int mi = 0; mi < 2; ++mi)
#pragma unroll
      for (int ni = 0; ni < 2; ++ni) acc[mi][ni] = zero16();
#pragma unroll 1
    for (int kt0 = 0; kt0 < 16; kt0 += 2) {
#pragma unroll
      for (int u = 0; u < 2; ++u) {
        const int kt = kt0 + u;
        constexpr int dummy = 0; (void)dummy;
        const int s = (PD == 2) ? u : 0;
        __syncthreads();
        L_WRITE(s, (u ^ 1));
        {
          const int ktl = (kt + 1 + PD < 16) ? (kt + 1 + PD) : 15;
          G_LOAD(s, ktl);
        }
        const bf16_t* Aw = S0 + u * BUF + aro;
        const bf16_t* Bw = S0 + u * BUF + bro;
#pragma unroll
        for (int ks = 0; ks < 4; ++ks) {
          bf16x8 a0 = *(const bf16x8*)(Aw + ks * 16);
          bf16x8 a1 = *(const bf16x8*)(Aw + 32 * GS + ks * 16);
          bf16x8 b0 = *(const bf16x8*)(Bw + ks * 16);
          bf16x8 b1 = *(const bf16x8*)(Bw + 32 * GS + ks * 16);
          acc[0][0] = __builtin_amdgcn_mfma_f32_32x32x16_bf16(a0, b0, acc[0][0], 0, 0, 0);
          acc[0][1] = __builtin_amdgcn_mfma_f32_32x32x16_bf16(a0, b1, acc[0][1], 0, 0, 0);
          acc[1][0] = __builtin_amdgcn_mfma_f32_32x32x16_bf16(a1, b0, acc[1][0], 0, 0, 0);
          acc[1][1] = __builtin_amdgcn_mfma_f32_32x32x16_bf16(a1, b1, acc[1][1], 0, 0, 0);
        }
      }
    }
#undef G_LOAD
#undef L_WRITE
    if (tvalid) epi(acc, m0 + wm * 64, n0 + wn * 64, lane);
  }
}

template <class Epi>
__device__ void gemm_phase_big(const bf16_t* __restrict__ A0, const bf16_t* __restrict__ Bt, int Mtiles  ,
                               int Ntiles, char* smem, Epi epi) {
  bf16_t* As = (bf16_t*)smem;
  bf16_t* Bs = As + 256 * GS;
  const int tid = otid(), lane = tid & 63, w = __builtin_amdgcn_readfirstlane(tid >> 6);
  const int wm = w >> 1, wn = w & 1;
  const int r = lane & 31, h = lane >> 5;
  const int lrow = tid >> 3, kc = tid & 7;
  const bool swz = ((gridDim.x & 7) == 0) && ((Mtiles & 7) == 0);
  const int xcd = blockIdx.x & 7;
  const int Mx = Mtiles >> 3;
  const int lstart = swz ? (int)(blockIdx.x >> 3) * 2 + vbid() : vblk();
  const int lstep = swz ? (int)(gridDim.x >> 3) * 2 : nvblk();
  const int lend = swz ? Mx * Ntiles : Mtiles * Ntiles;
  for (int L0 = 0; L0 < lend; L0 += lstep) {
    const bool tvalid = L0 + lstart < lend;
    const int L = tvalid ? L0 + lstart : lend - 1;
    int mt, nt;
    if (swz) {
      const int gfull = 8 * Ntiles;
      const int mg = L / gfull, rem = L - mg * gfull;
      const int gs = min(8, Mx - mg * 8);
      nt = rem / gs;
      mt = xcd * Mx + mg * 8 + (rem - nt * gs);
    } else {
      mt = L / Ntiles;
      nt = L - mt * Ntiles;
    }
    const int m0 = mt * 256, n0 = nt * 128;
    const bf16_t* ap = A0 + (size_t)(m0 + lrow) * 1024 + kc * 8;
    const bf16_t* bp = Bt + (size_t)(n0 + lrow) * 1024 + kc * 8;
    u32x4 ra[8], rb[4];
#pragma unroll
    for (int i = 0; i < 8; ++i) ra[i] = *(const u32x4*)(ap + (size_t)i * 32 * 1024);
#pragma unroll
    for (int i = 0; i < 4; ++i) rb[i] = *(const u32x4*)(bp + (size_t)i * 32 * 1024);
    f32x16 acc[2][2][2];
#pragma unroll
    for (int hf = 0; hf < 2; ++hf)
#pragma unroll
      for (int mi = 0; mi < 2; ++mi)
#pragma unroll
        for (int ni = 0; ni < 2; ++ni) acc[hf][mi][ni] = zero16();
#pragma unroll 1
    for (int kt = 0; kt < 16; ++kt) {
      __syncthreads();
#pragma unroll
      for (int i = 0; i < 8; ++i) *(u32x4*)(As + (lrow + 32 * i) * GS + kc * 8) = ra[i];
#pragma unroll
      for (int i = 0; i < 4; ++i) *(u32x4*)(Bs + (lrow + 32 * i) * GS + kc * 8) = rb[i];
      __syncthreads();
      {
        const int k0 = ((kt + 1 < 16) ? (kt + 1) : 15) * 64;
#pragma unroll
        for (int i = 0; i < 8; ++i) ra[i] = *(const u32x4*)(ap + (size_t)i * 32 * 1024 + k0);
#pragma unroll
        for (int i = 0; i < 4; ++i) rb[i] = *(const u32x4*)(bp + (size_t)i * 32 * 1024 + k0);
      }
      const bf16_t* Aw = As + (wm * 128 + r) * GS + h * 8;
      const bf16_t* Bw = Bs + (wn * 64 + r) * GS + h * 8;
#pragma unroll
      for (int ks = 0; ks < 4; ++ks) {
        bf16x8 b0 = *(const bf16x8*)(Bw + ks * 16);
        bf16x8 b1 = *(const bf16x8*)(Bw + 32 * GS + ks * 16);
#pragma unroll
        for (int hf = 0; hf < 2; ++hf) {
          bf16x8 a0 = *(const bf16x8*)(Aw + (hf * 64) * GS + ks * 16);
          bf16x8 a1 = *(const bf16x8*)(Aw + (hf * 64 + 32) * GS + ks * 16);
          acc[hf][0][0] = __builtin_amdgcn_mfma_f32_32x32x16_bf16(a0, b0, acc[hf][0][0], 0, 0, 0);
          acc[hf][0][1] = __builtin_amdgcn_mfma_f32_32x32x16_bf16(a0, b1, acc[hf][0][1], 0, 0, 0);
          acc[hf][1][0] = __builtin_amdgcn_mfma_f32_32x32x16_bf16(a1, b0, acc[hf][1][0], 0, 0, 0);
          acc[hf][1][1] = __builtin_amdgcn_mfma_f32_32x32x16_bf16(a1, b1, acc[hf][1][1], 0, 0, 0);
        }
      }
    }
    if (tvalid) {
      epi(acc[0], m0 + wm * 128, n0 + wn * 64, lane);
      epi(acc[1], m0 + wm * 128 + 64, n0 + wn * 64, lane);
    }
  }
}


struct EpiEvenIn {
  EvenBufs e;
  __device__ void operator()(f32x16 (&acc)[2][2], int rb, int cb, int lane) const {
    const int r = lane & 31, h = lane >> 5;
    if (cb < 1536 || cb >= 2304) {
      bf16_t* dst;
      int c0;
      int mode;
      if (cb < 512) { dst = e.ug; c0 = cb; mode = 0; }
      else if (cb < 1024) { dst = e.vg; c0 = cb - 512; mode = 0; }
      else if (cb < 1536) { dst = e.gas; c0 = cb - 1024; mode = 1; }
      else { dst = e.gbs; c0 = cb - 2304; mode = 1; }
#pragma unroll
      for (int mi = 0; mi < 2; ++mi)
#pragma unroll
        for (int ni = 0; ni < 2; ++ni)
#pragma unroll
          for (int reg = 0; reg < 16; ++reg) {
            const int row = rb + mi * 32 + (reg & 3) + 8 * (reg >> 2) + 4 * h;
            const int col = c0 + ni * 32 + r;
            float v = acc[mi][ni][reg];
            v = (mode == 0) ? gelu_f(v) : silu_f(v);
            dst[(size_t)row * 512 + col] = f2bf(v);
          }
    } else if (cb < 2176) {
      const bool isq = cb < 2048;
      bf16_t* dst = isq ? e.qb : e.kb;
      const int c0 = isq ? (cb - 1536) : (cb - 2048);
      const int ld = isq ? 512 : 128;
      const float scale = isq ? 0.125f : 1.f;
      const bool latent = rb < NL;
      const float inv_freq = exp2f(-(float)(r & 15) * 0.8304820237218406f);
#pragma unroll
      for (int mi = 0; mi < 2; ++mi)
#pragma unroll
        for (int reg = 0; reg < 16; ++reg) {
          const int row = rb + mi * 32 + (reg & 3) + 8 * (reg >> 2) + 4 * h;
          float x1 = acc[mi][0][reg], x2 = acc[mi][1][reg];
          float o1 = x1, o2 = x2;
          if (latent) {
            const int t = row & (SEQL - 1);
            const float pos = (float)((r < 16) ? (t >> 6) : (t & 63));
            const float ang = pos * inv_freq;
            const float cs = __cosf(ang), sn = __sinf(ang);
            o1 = x1 * cs - x2 * sn;
            o2 = x2 * cs + x1 * sn;
          }
          dst[(size_t)row * ld + c0 + r] = f2bf(o1 * scale);
          dst[(size_t)row * ld + c0 + 32 + r] = f2bf(o2 * scale);
        }
    } else {
      const int kvh = (cb - 2176) >> 6;
      const bool latent = rb < NL;
#pragma unroll
      for (int mi = 0; mi < 2; ++mi)
#pragma unroll
        for (int ni = 0; ni < 2; ++ni)
#pragma unroll
          for (int q4 = 0; q4 < 4; ++q4) {
            const int row = rb + mi * 32 + 8 * q4 + 4 * h;
            const int d = ni * 32 + r;
            u32x2 pk;
            pk.x = pack2(acc[mi][ni][q4 * 4 + 0], acc[mi][ni][q4 * 4 + 1]);
            pk.y = pack2(acc[mi][ni][q4 * 4 + 2], acc[mi][ni][q4 * 4 + 3]);
            if (latent) {
              const int b = row >> 12, t = row & (SEQL - 1);
              *(u32x2*)(e.vtl + ((size_t)((b * 2 + kvh) * 64 + d)) * SEQL + t) = pk;
            } else {
              const int rr = row - NL;
              const int b = rr >> 8, t = rr & (LCTX - 1);
              *(u32x2*)(e.vtc + ((size_t)((b * 2 + kvh) * 64 + d)) * LCTX + t) = pk;
            }
          }
    }
  }
};

struct EpiOddIn {
  OddBufs o;
  __device__ void operator()(f32x16 (&acc)[2][2], int rb, int cb, int lane) const {
    const int r = lane & 31, h = lane >> 5;
    const bool isg = cb >= 1024;
    bf16_t* dst = isg ? o.sg : o.xr;
    const int c0 = isg ? cb - 1024 : cb;
#pragma unroll
    for (int mi = 0; mi < 2; ++mi)
#pragma unroll
      for (int ni = 0; ni < 2; ++ni)
#pragma unroll
        for (int reg = 0; reg < 16; ++reg) {
          const int row = rb + mi * 32 + (reg & 3) + 8 * (reg >> 2) + 4 * h;
          const int col = c0 + ni * 32 + r;
          float v = acc[mi][ni][reg];
          if (isg) v = silu_f(v);
          dst[(size_t)row * 1024 + col] = f2bf(v);
        }
  }
};

struct EpiOut {
  float* xbuf;
  const float* xin_lat;
  const float* xin_ctx;
  const float* mods_l;
  __device__ void operator()(f32x16 (&acc)[2][2], int rb, int cb, int lane) const {
    const int r = lane & 31, h = lane >> 5;
    const int bidx = (rb < NL) ? (rb >> 12) : 8;
    const float* gate = mods_l + (size_t)bidx * 3072 + 2048;
    const float* xin = (rb < NL) ? xin_lat : xin_ctx;
    const int rsub = (rb < NL) ? 0 : NL;
#pragma unroll
    for (int ni = 0; ni < 2; ++ni) {
      const int col = cb + ni * 32 + r;
      const float gv = gate[col];
#pragma unroll
      for (int mi = 0; mi < 2; ++mi)
#pragma unroll
        for (int reg = 0; reg < 16; ++reg) {
          const int row = rb + mi * 32 + (reg & 3) + 8 * (reg >> 2) + 4 * h;
          xbuf[(size_t)row * 1024 + col] = xin[(size_t)(row - rsub) * 1024 + col] + gv * acc[mi][ni][reg];
        }
    }
  }
};


namespace pg8 {
#define PG8_LAS __attribute__((address_space(3)))
typedef float f32x4 __attribute__((ext_vector_type(4)));
constexpr int BM = 256, BK = 64, HALF = 128, HTB = HALF * BK * 2, STAGE_BYTES = 8 * HTB, NXCD = 8, WGM = 8;
__device__ __forceinline__ int lds_byte(int r, int c) { const int st = (r >> 4) * 2 + (c >> 5), rr = r & 15, cc = c & 31, ob = rr * 64 + cc * 2; return st * 1024 + (ob ^ (((ob >> 9) & 1) << 5)); }
__device__ __forceinline__ void stage_rc(int b, int& R, int& C) { const int st = b / 1024, sb = b % 1024, swz = sb ^ (((sb >> 9) & 1) << 5); R = (st >> 1) * 16 + swz / 64; C = (st & 1) * 32 + (swz % 64) / 2; }
__device__ __forceinline__ int perm32(int rho) { const int n = rho >> 4, i = rho & 15; return 8 * (i >> 2) + 4 * n + (i & 3); }
struct Unit { int pm, pn, ko; };
struct Gemm { const bf16_t* A; const bf16_t* Bt; int M, N, K; };
struct StaticOrder {
    int nM, nN, nwg, G, c;
    __device__ void init(int M, int N, int G_, int c_) { nM = M / BM; nN = N / BM; nwg = nM * nN; G = G_; c = c_; }
    __device__ bool next(int i, Unit& u) const {
        const long L = (long)i * G + c; if (L >= nwg) return false;
        int wgid = (int)L; { const int q = nwg / NXCD, r = nwg % NXCD, xcd = wgid % NXCD, off = wgid / NXCD; wgid = (xcd < r ? xcd * (q + 1) : r * (q + 1) + (xcd - r) * q) + off; }
        const int nig = WGM * nN, gid = wgid / nig, fm = gid * WGM, gsz = (nM - fm) < WGM ? (nM - fm) : WGM;
        u.pm = fm + ((wgid % nig) % gsz); u.pn = (wgid % nig) / gsz; u.ko = 0; return true;
    }
    __device__ __forceinline__ void a_ready(const Unit&) const {}
    __device__ __forceinline__ void done(const Unit&) const {}
};
struct CtxSplitOrder {
    int G, c;
    __device__ void init(int G_, int c_) { G = G_; c = c_; }
    __device__ bool next(int i, Unit& u) const {
        const int L = i * G + c; if (L >= 128) return false;
        const int unit = L >> 2; u.pm = (NL / 256) + (unit >> 2); u.pn = unit & 3; u.ko = (L & 3) * 256; return true;
    }
};
struct OutOrder {
    StaticOrder so; CtxSplitOrder cs; int mode;
    __device__ bool next(int i, Unit& u) const { return mode ? cs.next(i, u) : so.next(i, u); }
    __device__ __forceinline__ void a_ready(const Unit&) const {}
    __device__ __forceinline__ void done(const Unit&) const {}
};
template <class Epi, class Sched>
__device__ __forceinline__ void gemm_phase(PG8_LAS unsigned char* lds, const Gemm g, const Sched& S, const Epi& E) {
    const int tid = ofull(), wid = __builtin_amdgcn_readfirstlane(tid >> 6), lane = tid & 63, wr = wid >> 2, wc = wid & 3, fr = lane & 15, fq = lane >> 4;
    const int K = g.K, nt = K / BK;
    unsigned voffA[2], voffB[2];
#pragma unroll
    for (int i = 0; i < 2; ++i) { int R, C; stage_rc(tid * 16 + i * 8192, R, C); const int Rb = Epi::PERM ? ((R & ~31) + perm32(R & 31)) : R;
        voffA[i] = (unsigned)(R * 1024 + C) * 2u; voffB[i] = (unsigned)(Rb * 1024 + C) * 2u; }
    const size_t kstep = (size_t)(BK * 2);
    const size_t hstep = (size_t)HALF * 1024 * 2;
    const size_t tstep = 2 * hstep;
    const unsigned ldsw = (unsigned)wid * 1024u;
    const int aoff = lds_byte(wr * 64 + fr, fq * 8), boff = lds_byte(wc * 32 + fr, fq * 8);
#define PG8_SA(b, h) (((b) * 2 + (h)) * HTB)
#define PG8_SB(b, h) ((4 + (b) * 2 + (h)) * HTB)
#define PG8_STAGE(bufoff, gbase, voff) do { _Pragma("unroll") for (int _i = 0; _i < 2; ++_i) \
        __builtin_amdgcn_global_load_lds((const unsigned*)((const char*)(gbase) + (voff)[_i]), (PG8_LAS unsigned*)(lds + (bufoff) + ldsw + _i * 8192), 16, 0, 0); } while (0)
#define PG8_LDA(dst, b, h) do { _Pragma("unroll") for (int m = 0; m < 4; ++m) _Pragma("unroll") for (int k = 0; k < 2; ++k) dst[m][k] = *(const PG8_LAS bf16x8*)(lds + PG8_SA(b, h) + aoff + m * 2048 + k * 1024); } while (0)
#define PG8_LDB(dst, b, h) do { _Pragma("unroll") for (int n = 0; n < 2; ++n) _Pragma("unroll") for (int k = 0; k < 2; ++k) dst[n][k] = *(const PG8_LAS bf16x8*)(lds + PG8_SB(b, h) + boff + n * 2048 + k * 1024); } while (0)
#define PG8_MMA(ai, bj, At, Bt) do { __builtin_amdgcn_s_setprio(1); _Pragma("unroll") for (int m = 0; m < 4; ++m) _Pragma("unroll") for (int n = 0; n < 2; ++n) _Pragma("unroll") for (int k = 0; k < 2; ++k) \
        acc[ai][bj][m][n] = __builtin_amdgcn_mfma_f32_16x16x32_bf16(Bt[n][k], At[m][k], acc[ai][bj][m][n], 0, 0, 0); __builtin_amdgcn_s_setprio(0); } while (0)
#define PG8_WAIT_V(n) asm volatile("s_waitcnt vmcnt(" #n ")" ::: "memory")
#define PG8_WAIT_L(n) asm volatile("s_waitcnt lgkmcnt(" #n ")" ::: "memory")
#define PG8_BAR __builtin_amdgcn_s_barrier()
#define PG8_SCHED __builtin_amdgcn_sched_barrier(0)
    Unit cur, nxt; int ui = 0;
    if (!S.next(0, cur)) return;
    f32x4 acc[2][2][4][2];
#pragma unroll
    for (int a = 0; a < 2; ++a)
#pragma unroll
        for (int b = 0; b < 2; ++b)
#pragma unroll
            for (int m = 0; m < 4; ++m)
#pragma unroll
                for (int n = 0; n < 2; ++n) acc[a][b][m][n] = (f32x4){0.f, 0.f, 0.f, 0.f};
    bf16x8 At[4][2], B0[2][2], B1[2][2];
    const char* cA = (const char*)g.A + (size_t)cur.pm * tstep + (size_t)cur.ko * 2; const char* cB = (const char*)g.Bt + (size_t)cur.pn * tstep + (size_t)cur.ko * 2;
    S.a_ready(cur);
    PG8_STAGE(PG8_SB(0, 0), cB, voffB); PG8_STAGE(PG8_SA(0, 0), cA, voffA); PG8_STAGE(PG8_SB(0, 1), cB + hstep, voffB); PG8_STAGE(PG8_SA(0, 1), cA + hstep, voffA);
    if (wr == 1) PG8_BAR;
    PG8_WAIT_V(4); PG8_BAR;
    PG8_STAGE(PG8_SB(1, 0), cB + kstep, voffB); PG8_STAGE(PG8_SA(1, 0), cA + kstep, voffA); PG8_STAGE(PG8_SB(1, 1), cB + hstep + kstep, voffB);
    PG8_WAIT_V(6); PG8_BAR;
    for (;;) {
        const bool has_next = S.next(ui + 1, nxt);
        const char* nA = has_next ? (const char*)g.A + (size_t)nxt.pm * tstep + (size_t)nxt.ko * 2 : cA; const char* nB = has_next ? (const char*)g.Bt + (size_t)nxt.pn * tstep + (size_t)nxt.ko * 2 : cB;
        for (int t = 0; t < nt; t += 2) {
            const bool last = (t == nt - 2);
            const char* a1 = cA + (size_t)(t + 1) * kstep;
            const char* a2 = last ? nA : cA + (size_t)(t + 2) * kstep; const char* b2 = last ? nB : cB + (size_t)(t + 2) * kstep;
            const char* a3 = a2 + kstep; const char* b3 = b2 + kstep;
            if (last && has_next) S.a_ready(nxt);
            PG8_LDB(B0, 0, 0); PG8_SCHED; PG8_LDA(At, 0, 0); PG8_STAGE(PG8_SA(1, 1), a1 + hstep, voffA);
            PG8_WAIT_L(8); PG8_BAR; PG8_WAIT_L(0); PG8_MMA(0, 0, At, B0); PG8_BAR; PG8_SCHED;
            PG8_LDB(B1, 0, 1); PG8_STAGE(PG8_SB(0, 0), b2, voffB);
            PG8_BAR; PG8_WAIT_L(0); PG8_MMA(0, 1, At, B1); PG8_BAR;
            PG8_LDA(At, 0, 1); PG8_STAGE(PG8_SA(0, 0), a2, voffA);
            PG8_BAR; PG8_WAIT_L(0); PG8_MMA(1, 0, At, B0); PG8_BAR; PG8_SCHED;
            PG8_STAGE(PG8_SB(0, 1), b2 + hstep, voffB);
            PG8_WAIT_V(6); PG8_BAR; PG8_MMA(1, 1, At, B1); PG8_BAR;
            PG8_LDB(B0, 1, 0); PG8_SCHED; PG8_LDA(At, 1, 0); PG8_STAGE(PG8_SA(0, 1), a2 + hstep, voffA);
            PG8_WAIT_L(8); PG8_BAR; PG8_WAIT_L(0); PG8_MMA(0, 0, At, B0); PG8_BAR; PG8_SCHED;
            PG8_LDB(B1, 1, 1); PG8_STAGE(PG8_SB(1, 0), b3, voffB);
            PG8_BAR; PG8_WAIT_L(0); PG8_MMA(0, 1, At, B1); PG8_BAR;
            PG8_LDA(At, 1, 1); PG8_STAGE(PG8_SA(1, 0), a3, voffA);
            PG8_BAR; PG8_WAIT_L(0); PG8_MMA(1, 0, At, B0); PG8_BAR; PG8_SCHED;
            PG8_STAGE(PG8_SB(1, 1), b3 + hstep, voffB);
            PG8_WAIT_V(6); PG8_BAR; PG8_MMA(1, 1, At, B1); PG8_BAR;
        }
        if constexpr (!Epi::AFTER_DRAIN) { E(acc, cur, wr, wc, fr, fq); S.done(cur); }
        if (!has_next) break;
#pragma unroll
        for (int a = 0; a < 2; ++a)
#pragma unroll
            for (int b = 0; b < 2; ++b)
#pragma unroll
                for (int m = 0; m < 4; ++m)
#pragma unroll
                    for (int n = 0; n < 2; ++n) acc[a][b][m][n] = (f32x4){0.f, 0.f, 0.f, 0.f};
        cur = nxt; cA = nA; cB = nB; ++ui;
    }
    PG8_WAIT_V(0);
    if (wr == 0) PG8_BAR;
    PG8_BAR;
    if constexpr (Epi::AFTER_DRAIN) { E.fused(acc, cur, wr, wc, fr, fq, lds, wid, lane); S.done(cur); }
#undef PG8_SA
#undef PG8_SB
#undef PG8_STAGE
#undef PG8_LDA
#undef PG8_LDB
#undef PG8_MMA
#undef PG8_WAIT_V
#undef PG8_WAIT_L
#undef PG8_BAR
#undef PG8_SCHED
}
}


struct PEpiOddIn {
  static constexpr bool PERM = true, AFTER_DRAIN = false;
  OddBufs o;
  __device__ __forceinline__ void operator()(const pg8::f32x4 (&acc)[2][2][4][2], const pg8::Unit& u, int wr, int wc, int fr, int fq) const {
    const bool isg = u.pn >= 4;
    bf16_t* dst = isg ? o.sg : o.xr;
    const int colt = (u.pn & 3) * 256 + wc * 32 + 8 * fq;
    const int row0 = u.pm * 256 + wr * 64 + fr;
#pragma unroll
    for (int ai = 0; ai < 2; ++ai)
#pragma unroll
      for (int m = 0; m < 4; ++m) {
        bf16_t* rowp = dst + (size_t)(row0 + ai * 128 + m * 16) * 1024 + colt;
#pragma unroll
        for (int bj = 0; bj < 2; ++bj) {
          pg8::f32x4 v0 = acc[ai][bj][m][0], v1 = acc[ai][bj][m][1];
          if (isg) {
            const f32x2p a0 = silu_pk((f32x2p){v0[0], v0[1]}), a1 = silu_pk((f32x2p){v0[2], v0[3]});
            const f32x2p b0 = silu_pk((f32x2p){v1[0], v1[1]}), b1 = silu_pk((f32x2p){v1[2], v1[3]});
            v0[0] = a0.x; v0[1] = a0.y; v0[2] = a1.x; v0[3] = a1.y;
            v1[0] = b0.x; v1[1] = b0.y; v1[2] = b1.x; v1[3] = b1.y;
          }
          u32x4 pk;
          pk.x = pack2(v0[0], v0[1]); pk.y = pack2(v0[2], v0[3]);
          pk.z = pack2(v1[0], v1[1]); pk.w = pack2(v1[2], v1[3]);
          *(u32x4*)(rowp + bj * 128) = pk;
        }
      }
  }
};

struct PEpiOut {
  static constexpr bool PERM = false, AFTER_DRAIN = false;
  float* xbuf;
  const float* xin_lat;
  const float* xin_ctx;
  const float* mods_l;
  float* part;
  int split;
  __device__ __forceinline__ void operator()(const pg8::f32x4 (&acc)[2][2][4][2], const pg8::Unit& u, int wr, int wc, int fr, int fq) const {
    if (split) {
      float* pb = part + ((size_t)(u.ko >> 8) * NC + (size_t)(u.pm * 256 - NL + wr * 64 + fr)) * 1024 + u.pn * 256 + wc * 32 + 4 * fq;
#pragma unroll
      for (int ai = 0; ai < 2; ++ai)
#pragma unroll
        for (int m = 0; m < 4; ++m)
#pragma unroll
          for (int bj = 0; bj < 2; ++bj)
#pragma unroll
            for (int n = 0; n < 2; ++n) *(pg8::f32x4*)(pb + (size_t)(ai * 128 + m * 16) * 1024 + bj * 128 + n * 16) = acc[ai][bj][m][n];
      return;
    }
    const bool lat = u.pm < (NL / 256);
    const int bidx = lat ? (u.pm >> 4) : 8;
    const float* gate = mods_l + (size_t)bidx * 3072 + 2048;
    const float* xin = lat ? xin_lat : xin_ctx;
    const int rsub = lat ? 0 : NL;
    const int row0 = u.pm * 256 + wr * 64 + fr, col0 = u.pn * 256 + wc * 32 + 4 * fq;
    pg8::f32x4 gv[2][2];
#pragma unroll
    for (int bj = 0; bj < 2; ++bj)
#pragma unroll
      for (int n = 0; n < 2; ++n) gv[bj][n] = *(const pg8::f32x4*)(gate + col0 + bj * 128 + n * 16);
#pragma unroll
    for (int ai = 0; ai < 2; ++ai)
#pragma unroll
      for (int m = 0; m < 4; ++m) {
        const int row = row0 + ai * 128 + m * 16;
        const float* xr = xin + (size_t)(row - rsub) * 1024 + col0;
        float* xo = xbuf + (size_t)row * 1024 + col0;
#pragma unroll
        for (int bj = 0; bj < 2; ++bj)
#pragma unroll
          for (int n = 0; n < 2; ++n) {
            const pg8::f32x4 xv = *(const pg8::f32x4*)(xr + bj * 128 + n * 16);
            *(pg8::f32x4*)(xo + bj * 128 + n * 16) = xv + gv[bj][n] * acc[ai][bj][m][n];
          }
      }
  }
};

struct PEpiEvenIn {
  static constexpr bool PERM = true, AFTER_DRAIN = false;
  EvenBufs e;
  __device__ __forceinline__ void operator()(const pg8::f32x4 (&acc)[2][2][4][2], const pg8::Unit& u, int wr, int wc, int fr, int fq) const {
    const int row0 = u.pm * 256 + wr * 64 + fr;
    const bool latent = u.pm < (NL / 256);
    const int cw = wc * 32 + 8 * fq;
#pragma unroll
    for (int bj = 0; bj < 2; ++bj) {
      const int cbase = u.pn * 256 + bj * 128;
      if (cbase < 1536 || cbase >= 2304) {
        bf16_t* dst;
        int c0, mode;
        if (cbase < 512) { dst = e.ug; c0 = cbase; mode = 0; }
        else if (cbase < 1024) { dst = e.vg; c0 = cbase - 512; mode = 0; }
        else if (cbase < 1536) { dst = e.gas; c0 = cbase - 1024; mode = 1; }
        else { dst = e.gbs; c0 = cbase - 2304; mode = 1; }
#pragma unroll
        for (int ai = 0; ai < 2; ++ai)
#pragma unroll
          for (int m = 0; m < 4; ++m) {
            const int row = row0 + ai * 128 + m * 16;
            pg8::f32x4 v0 = acc[ai][bj][m][0], v1 = acc[ai][bj][m][1];
            {
              f32x2p a0 = {v0[0], v0[1]}, a1 = {v0[2], v0[3]}, b0 = {v1[0], v1[1]}, b1 = {v1[2], v1[3]};
              if (mode) { a0 = silu_pk(a0); a1 = silu_pk(a1); b0 = silu_pk(b0); b1 = silu_pk(b1); }
              else { a0 = gelu_pk(a0); a1 = gelu_pk(a1); b0 = gelu_pk(b0); b1 = gelu_pk(b1); }
              v0[0] = a0.x; v0[1] = a0.y; v0[2] = a1.x; v0[3] = a1.y;
              v1[0] = b0.x; v1[1] = b0.y; v1[2] = b1.x; v1[3] = b1.y;
            }
            u32x4 pk;
            pk.x = pack2(v0[0], v0[1]); pk.y = pack2(v0[2], v0[3]);
            pk.z = pack2(v1[0], v1[1]); pk.w = pack2(v1[2], v1[3]);
            *(u32x4*)(dst + (size_t)row * 512 + c0 + cw) = pk;
          }
      } else if (cbase < 2176) {
        const bool isq = cbase < 2048;
        bf16_t* dst = isq ? e.qb : e.kb;
        const int ld = isq ? 512 : 128;
        const int hb = (isq ? cbase - 1536 : cbase - 2048) + (cw & 64);
        const float scale = isq ? (0.125f * 1.4426950408889634f) : 1.f;
        const int i4 = ((cw & 63) >> 3) * 4;
        const bool rowaxis = i4 < 16;
        float invf[4];
#pragma unroll
        for (int q = 0; q < 4; ++q) invf[q] = exp2f(-(float)((i4 + q) & 15) * 0.8304820237218406f);
#pragma unroll
        for (int ai = 0; ai < 2; ++ai)
#pragma unroll
          for (int m = 0; m < 4; ++m) {
            const int row = row0 + ai * 128 + m * 16;
            const pg8::f32x4 x1 = acc[ai][bj][m][0], x2 = acc[ai][bj][m][1];
            float o1[4], o2[4];
            const int t = row & (SEQL - 1);
            const float pos = (float)(rowaxis ? (t >> 6) : (t & 63));
#pragma unroll
            for (int q = 0; q < 4; ++q) {
              float a = x1[q], bq = x2[q];
              if (latent) {
                const float ang = pos * invf[q];
                const float cs = __cosf(ang), sn = __sinf(ang);
                a = x1[q] * cs - x2[q] * sn;
                bq = x2[q] * cs + x1[q] * sn;
              }
              o1[q] = a * scale;
              o2[q] = bq * scale;
            }
            u32x2 p1, p2;
            p1.x = pack2(o1[0], o1[1]); p1.y = pack2(o1[2], o1[3]);
            p2.x = pack2(o2[0], o2[1]); p2.y = pack2(o2[2], o2[3]);
            bf16_t* rp = dst + (size_t)row * ld + hb + i4;
            *(u32x2*)(rp) = p1;
            *(u32x2*)(rp + 32) = p2;
          }
      } else {
        const int kvh = cw >> 6, dd0 = cw & 63;
#pragma unroll
        for (int ai = 0; ai < 2; ++ai)
#pragma unroll
          for (int m = 0; m < 4; ++m) {
            const int row = row0 + ai * 128 + m * 16;
            bf16_t* base;
            int ldt;
            if (latent) {
              const int b = row >> 12, t = row & (SEQL - 1);
              base = e.vtl + ((size_t)((b * 2 + kvh) * 64 + dd0)) * SEQL + t;
              ldt = SEQL;
            } else {
              const int rr = row - NL;
              const int b = rr >> 8, t = rr & (LCTX - 1);
              base = e.vtc + ((size_t)((b * 2 + kvh) * 64 + dd0)) * LCTX + t;
              ldt = LCTX;
            }
#pragma unroll
            for (int n = 0; n < 2; ++n)
#pragma unroll
              for (int q = 0; q < 4; ++q) base[(size_t)(4 * n + q) * ldt] = f2bf(acc[ai][bj][m][n][q]);
          }
      }
    }
  }
};
constexpr int AS = 72;

__device__ void attn_item(const Params& p, const EvenBufs& e, int item, char* smem, int ei) {
  bf16_t* Ks = (bf16_t*)smem;
  bf16_t* Vs = Ks + 64 * AS;
  const int tid = otid(), lane = tid & 63, w = __builtin_amdgcn_readfirstlane(tid >> 6);
  const int r = lane & 31, h = lane >> 5;
  int b, hq, start, R0;
  bool isctx;
  if (item < 2048) {
    b = item >> 8;
    hq = (item >> 5) & 7;
    const int qblk = item & 31;
    start = qblk * 128;
    R0 = b * SEQL + start;
    isctx = false;
  } else {
    const int it = item - 2048;
    b = it >> 4;
    hq = (it >> 1) & 7;
    start = (it & 1) * 128;
    R0 = NL + b * LCTX + start;
    isctx = true;
  }
  const int kvh = hq >> 2;
  const int qrow = R0 + w * 32 + r;
  bf16x8 qf[4];
#pragma unroll
  for (int s = 0; s < 4; ++s) qf[s] = *(const bf16x8*)(e.qb + (size_t)qrow * 512 + hq * 64 + s * 16 + h * 8);
  float m = p.b_sink[ei * 8 + hq] * 1.4426950408889634f, l = 1.f;
  u32x2 gpre[2][4];
#pragma unroll
  for (int dt = 0; dt < 2; ++dt)
#pragma unroll
    for (int q4 = 0; q4 < 4; ++q4) gpre[dt][q4] = *(const u32x2*)(e.gbs + (size_t)qrow * 512 + hq * 64 + dt * 32 + 8 * q4 + 4 * h);
  f32x16 o[2];
  o[0] = zero16();
  o[1] = zero16();
  const int nblk = isctx ? 4 : 10;
  auto kb_desc = [&](int kb, const bf16_t*& kp, const bf16_t*& vp, int& vstride, int& kpos0, bool& local) -> bool {
    if (kb < 4) {
      kp = e.kb + (size_t)(NL + b * LCTX + kb * 64) * 128 + kvh * 64;
      vp = e.vtc + (size_t)((b * 2 + kvh) * 64) * LCTX + kb * 64;
      vstride = LCTX; kpos0 = 0; local = false;
      return true;
    }
    kpos0 = start - 128 + (kb - 4) * 64;
    local = true;
    if (kpos0 < 0 || kpos0 >= SEQL) return false;
    kp = e.kb + (size_t)(b * SEQL + kpos0) * 128 + kvh * 64;
    vp = e.vtl + (size_t)((b * 2 + kvh) * 64) * SEQL + kpos0;
    vstride = SEQL;
    return true;
  };
  const int lr0 = tid >> 3, lc0 = tid & 7;
  u32x4 pk0, pk1, pv0, pv1;
  {
    const bf16_t *kp, *vp; int vs, kp0; bool lc;
    kb_desc(0, kp, vp, vs, kp0, lc);
    pk0 = *(const u32x4*)(kp + (size_t)lr0 * 128 + lc0 * 8);
    pk1 = *(const u32x4*)(kp + (size_t)(lr0 + 32) * 128 + lc0 * 8);
    pv0 = *(const u32x4*)(vp + (size_t)lr0 * vs + lc0 * 8);
    pv1 = *(const u32x4*)(vp + (size_t)(lr0 + 32) * vs + lc0 * 8);
  }
  for (int kb = 0; kb < nblk; ++kb) {
    int kpos0 = 0;
    bool local = false;
    bool valid;
    {
      const bf16_t *kp, *vp; int vs;
      valid = kb_desc(kb, kp, vp, vs, kpos0, local);
    }
    __syncthreads();
    if (valid) {
      *(u32x4*)(Ks + lr0 * AS + lc0 * 8) = pk0;
      *(u32x4*)(Ks + (lr0 + 32) * AS + lc0 * 8) = pk1;
      *(u32x4*)(Vs + lr0 * AS + lc0 * 8) = pv0;
      *(u32x4*)(Vs + (lr0 + 32) * AS + lc0 * 8) = pv1;
    }
    __syncthreads();
    if (kb + 1 < nblk) {
      const bf16_t *kp = nullptr, *vp = nullptr; int vs = 0, kp0; bool lc;
      if (kb_desc(kb + 1, kp, vp, vs, kp0, lc)) {
        pk0 = *(const u32x4*)(kp + (size_t)lr0 * 128 + lc0 * 8);
        pk1 = *(const u32x4*)(kp + (size_t)(lr0 + 32) * 128 + lc0 * 8);
        pv0 = *(const u32x4*)(vp + (size_t)lr0 * vs + lc0 * 8);
        pv1 = *(const u32x4*)(vp + (size_t)(lr0 + 32) * vs + lc0 * 8);
      }
    }
    if (!valid) continue;
    if (local) {
      const int qmin = start + w * 32;
      if (kpos0 > qmin + 31 + 128 || kpos0 + 63 < qmin - 128) continue;
    }
    f32x16 s[2];
#pragma unroll
    for (int kt = 0; kt < 2; ++kt) {
      s[kt] = zero16();
#pragma unroll
      for (int ks = 0; ks < 4; ++ks) {
        bf16x8 a = *(const bf16x8*)(Ks + (kt * 32 + r) * AS + ks * 16 + h * 8);
        s[kt] = __builtin_amdgcn_mfma_f32_32x32x16_bf16(a, qf[ks], s[kt], 0, 0, 0);
      }
    }
    if (local) {
      const int qmin = start + w * 32;
      const bool interior = (kpos0 >= qmin + 31 - 128) && (kpos0 + 63 <= qmin + 128);
      if (!interior) {
        const int dqp = (start + w * 32 + r) - kpos0 - 4 * h + 128;
#pragma unroll
        for (int kt = 0; kt < 2; ++kt)
#pragma unroll
          for (int reg = 0; reg < 16; ++reg) {
            const int d = dqp - (kt * 32 + (reg & 3) + 8 * (reg >> 2));
            if ((unsigned)d > 256u) s[kt][reg] = -1e30f;
          }
      }
    }
    float mx = m;
#pragma unroll
    for (int kt = 0; kt < 2; ++kt)
#pragma unroll
      for (int reg = 0; reg < 16; reg += 2) mx = fmaxf(fmaxf(mx, s[kt][reg]), s[kt][reg + 1]);
    mx = fmaxf(mx, __shfl_xor(mx, 32));
    const bool grew = __any(mx > m) != 0;
    float rs = 0.f;
#pragma unroll
    for (int kt = 0; kt < 2; ++kt)
#pragma unroll
      for (int reg = 0; reg < 16; ++reg) {
        const float pv = __builtin_amdgcn_exp2f(s[kt][reg] - mx);
        rs += pv;
        s[kt][reg] = pv;
      }
    rs += __shfl_xor(rs, 32);
    if (grew) {
      const float alpha = __builtin_amdgcn_exp2f(m - mx);
      m = mx;
      l = l * alpha + rs;
#pragma unroll
      for (int dt = 0; dt < 2; ++dt)
#pragma unroll
        for (int reg = 0; reg < 16; ++reg) o[dt][reg] *= alpha;
    } else {
      l += rs;
    }
#pragma unroll
    for (int kt = 0; kt < 2; ++kt)
#pragma unroll
      for (int sp = 0; sp < 2; ++sp) {
        union { bf16x8 v; uint32_t u[4]; } pf;
#pragma unroll
        for (int j = 0; j < 4; ++j) pf.u[j] = pack2(s[kt][8 * sp + 2 * j], s[kt][8 * sp + 2 * j + 1]);
#pragma unroll
        for (int dt = 0; dt < 2; ++dt) {
          const bf16_t* vp = Vs + (dt * 32 + r) * AS + kt * 32 + sp * 16 + 4 * h;
          union { bf16x8 v; u32x2 u[2]; } af;
          af.u[0] = *(const u32x2*)(vp);
          af.u[1] = *(const u32x2*)(vp + 8);
          o[dt] = __builtin_amdgcn_mfma_f32_32x32x16_bf16(af.v, pf.v, o[dt], 0, 0, 0);
        }
      }
  }
  const float inv = 1.f / l;
  bf16_t* ymix = p.hbuf;
#pragma unroll
  for (int dt = 0; dt < 2; ++dt)
#pragma unroll
    for (int q4 = 0; q4 < 4; ++q4) {
      const int d0 = dt * 32 + 8 * q4 + 4 * h;
      const u32x2 g = gpre[dt][q4];
      u32x2 pk;
      pk.x = pack2(o[dt][q4 * 4 + 0] * inv * lo_bf(g.x), o[dt][q4 * 4 + 1] * inv * hi_bf(g.x));
      pk.y = pack2(o[dt][q4 * 4 + 2] * inv * lo_bf(g.y), o[dt][q4 * 4 + 3] * inv * hi_bf(g.y));
      *(u32x2*)(ymix + (size_t)qrow * 1024 + 512 + hq * 64 + d0) = pk;
    }
}

constexpr int MS = 136;

__device__ void gmlp_item(const Params& p, const EvenBufs& e, int item, char* smem, int ei) {
  bf16_t* Ws = (bf16_t*)smem;
  bf16_t* VT = Ws + 128 * MS;
  const int tid = otid(), lane = tid & 63, w = __builtin_amdgcn_readfirstlane(tid >> 6);
  const int r = lane & 31, h = lane >> 5;
  const int wm = w >> 1, wn = w & 1;
  const int rt = item >> 2, g = item & 3;
  const int R0 = rt * 128;
  u32x4 wreg[8], vreg[2][4];
  {
    const bf16_t* wsrc = p.wsb + (size_t)(ei * 4 + g) * 128 * 128;
#pragma unroll
    for (int i = 0; i < 8; ++i) {
      const int idx = tid + 256 * i;
      wreg[i] = *(const u32x4*)(wsrc + (idx >> 4) * 128 + (idx & 15) * 8);
    }
#pragma unroll
    for (int hp = 0; hp < 2; ++hp) {
      const bf16_t* vsrc = e.vg + (size_t)(R0 + hp * 64 + (tid >> 2)) * 512 + g * 128 + (tid & 3) * 32;
#pragma unroll
      for (int i = 0; i < 4; ++i) vreg[hp][i] = *(const u32x4*)(vsrc + i * 8);
    }
  }
  __syncthreads();
#pragma unroll
  for (int i = 0; i < 8; ++i) {
    const int idx = tid + 256 * i;
    *(u32x4*)(Ws + (idx >> 4) * MS + (idx & 15) * 8) = wreg[i];
  }
#pragma unroll
  for (int hp = 0; hp < 2; ++hp) {
    const int q = hp * 64 + (tid >> 2), qt = tid & 3;
    float xv[32];
#pragma unroll
    for (int i = 0; i < 4; ++i) {
      const u32x4 u = vreg[hp][i];
      xv[i * 8 + 0] = lo_bf(u.x); xv[i * 8 + 1] = hi_bf(u.x);
      xv[i * 8 + 2] = lo_bf(u.y); xv[i * 8 + 3] = hi_bf(u.y);
      xv[i * 8 + 4] = lo_bf(u.z); xv[i * 8 + 5] = hi_bf(u.z);
      xv[i * 8 + 6] = lo_bf(u.w); xv[i * 8 + 7] = hi_bf(u.w);
    }
    float sm = 0.f;
#pragma unroll
    for (int j = 0; j < 32; ++j) sm += xv[j];
    sm += __shfl_xor(sm, 1);
    sm += __shfl_xor(sm, 2);
    const float mean = sm * (1.f / 128.f);
    float sq = 0.f;
#pragma unroll
    for (int j = 0; j < 32; ++j) { float dlt = xv[j] - mean; sq += dlt * dlt; }
    sq += __shfl_xor(sq, 1);
    sq += __shfl_xor(sq, 2);
    const float rstd = rsqrtf(sq * (1.f / 128.f) + 1e-6f);
    bf16_t* vdst = VT + (qt * 32) * MS + (q ^ (16 * qt));
#pragma unroll
    for (int j = 0; j < 32; ++j) vdst[j * MS] = f2bf((xv[j] - mean) * rstd);
  }
  __syncthreads();
  u32x2 upre[2][2][4], gapre[2][2][4];
#pragma unroll
  for (int mi = 0; mi < 2; ++mi)
#pragma unroll
    for (int ni = 0; ni < 2; ++ni)
#pragma unroll
      for (int q4 = 0; q4 < 4; ++q4) {
        const size_t off = (size_t)(R0 + wm * 64 + mi * 32 + r) * 512 + g * 128 + wn * 64 + ni * 32 + 8 * q4 + 4 * h;
        upre[mi][ni][q4] = *(const u32x2*)(e.ug + off);
        gapre[mi][ni][q4] = *(const u32x2*)(e.gas + off);
      }
  float4 lgpre[2][4], lbpre[2][4];
  float bspre[2], wspre[2];
#pragma unroll
  for (int ni = 0; ni < 2; ++ni)
#pragma unroll
    for (int q4 = 0; q4 < 4; ++q4) {
      const int d0p = wn * 64 + ni * 32 + 8 * q4 + 4 * h;
      lgpre[ni][q4] = *(const float4*)(p.a_ln_g + ei * 512 + g * 128 + d0p);
      lbpre[ni][q4] = *(const float4*)(p.a_ln_b + ei * 512 + g * 128 + d0p);
    }
#pragma unroll
  for (int mi = 0; mi < 2; ++mi) {
    bspre[mi] = p.a_b_s[(ei * 4 + g) * 128 + wm * 64 + mi * 32 + r];
    wspre[mi] = p.wsum[(ei * 4 + g) * 128 + wm * 64 + mi * 32 + r];
  }
  f32x16 acc[2][2];
#pragma unroll
  for (int ni = 0; ni < 2; ++ni)
#pragma unroll
    for (int mi = 0; mi < 2; ++mi) acc[ni][mi] = zero16();
  const bf16_t* Aw = Ws + (wm * 64 + r) * MS + h * 8;
  const bf16_t* Bw = VT + (wn * 64 + r) * MS;
  const int sw0 = 16 * ((wn * 2) & 3), sw1 = 16 * ((wn * 2 + 1) & 3);
#pragma unroll
  for (int ks = 0; ks < 8; ++ks) {
    bf16x8 a0 = *(const bf16x8*)(Aw + ks * 16);
    bf16x8 a1 = *(const bf16x8*)(Aw + 32 * MS + ks * 16);
    bf16x8 b0 = *(const bf16x8*)(Bw + ((ks * 16 + h * 8) ^ sw0));
    bf16x8 b1 = *(const bf16x8*)(Bw + 32 * MS + ((ks * 16 + h * 8) ^ sw1));
    acc[0][0] = __builtin_amdgcn_mfma_f32_32x32x16_bf16(b0, a0, acc[0][0], 0, 0, 0);
    acc[0][1] = __builtin_amdgcn_mfma_f32_32x32x16_bf16(b0, a1, acc[0][1], 0, 0, 0);
    acc[1][0] = __builtin_amdgcn_mfma_f32_32x32x16_bf16(b1, a0, acc[1][0], 0, 0, 0);
    acc[1][1] = __builtin_amdgcn_mfma_f32_32x32x16_bf16(b1, a1, acc[1][1], 0, 0, 0);
  }
  bf16_t* ymix = p.hbuf;
  const float* bs = p.a_b_s + (ei * 4 + g) * 128;
  const float* wsm = p.wsum + (ei * 4 + g) * 128;
  const float* lgp = p.a_ln_g + ei * 512 + g * 128;
  const float* lbp = p.a_ln_b + ei * 512 + g * 128;
#pragma unroll
  for (int mi = 0; mi < 2; ++mi) {
    const int prow = wm * 64 + mi * 32 + r;
    const float bsv = bspre[mi], wsv = wspre[mi];
    const size_t row = (size_t)(R0 + prow);
#pragma unroll
    for (int ni = 0; ni < 2; ++ni)
#pragma unroll
      for (int q4 = 0; q4 < 4; ++q4) {
        const int d0 = wn * 64 + ni * 32 + 8 * q4 + 4 * h;
        const float4 lg = lgpre[ni][q4];
        const float4 lb = lbpre[ni][q4];
        const u32x2 uu = upre[mi][ni][q4];
        const u32x2 gg = gapre[mi][ni][q4];
        const float s0 = lg.x * acc[ni][mi][q4 * 4 + 0] + (lb.x * wsv + bsv);
        const float s1 = lg.y * acc[ni][mi][q4 * 4 + 1] + (lb.y * wsv + bsv);
        const float s2 = lg.z * acc[ni][mi][q4 * 4 + 2] + (lb.z * wsv + bsv);
        const float s3 = lg.w * acc[ni][mi][q4 * 4 + 3] + (lb.w * wsv + bsv);
        u32x2 pk;
        pk.x = pack2(lo_bf(uu.x) * s0 * lo_bf(gg.x), hi_bf(uu.x) * s1 * hi_bf(gg.x));
        pk.y = pack2(lo_bf(uu.y) * s2 * lo_bf(gg.y), hi_bf(uu.y) * s3 * hi_bf(gg.y));
        *(u32x2*)(ymix + row * 1024 + g * 128 + d0) = pk;
      }
  }
}

__device__ void phase_even_mix(const Params& p, char* smem, int ei) {
  const EvenBufs e = even_bufs(p);
  const int n_attn = 2048 + 128, n_gmlp = 1088;
  for (int item = vblk(); item < n_attn + n_gmlp; item += nvblk()) {
    if (item < n_attn) attn_item(p, e, item, smem, ei);
    else gmlp_item(p, e, item - n_attn, smem, ei);
  }
}

__device__ void phase_conv(const Params& p, int oi) {
  const OddBufs ob = odd_bufs(p);
  const bf16_t* xr = ob.xr;
  bf16_t* zb = ob.sg + (size_t)NR * 1024;
  const int tid = ofull();
  const int total = (NR / 8) * 128;
  const int chb = ((blockIdx.x * NTHREADS + tid) & 127) * 8;
    float cw[4][8], cbias[8];
#pragma unroll
    for (int j = 0; j < 4; ++j) {
      const float4 w0 = *(const float4*)(p.c_conv_w + ((size_t)oi * 4 + j) * 1024 + chb);
      const float4 w1 = *(const float4*)(p.c_conv_w + ((size_t)oi * 4 + j) * 1024 + chb + 4);
      cw[j][0] = w0.x; cw[j][1] = w0.y; cw[j][2] = w0.z; cw[j][3] = w0.w;
      cw[j][4] = w1.x; cw[j][5] = w1.y; cw[j][6] = w1.z; cw[j][7] = w1.w;
    }
    {
      const float4 b0 = *(const float4*)(p.c_conv_b + oi * 1024 + chb);
      const float4 b1 = *(const float4*)(p.c_conv_b + oi * 1024 + chb + 4);
      cbias[0] = b0.x; cbias[1] = b0.y; cbias[2] = b0.z; cbias[3] = b0.w;
      cbias[4] = b1.x; cbias[5] = b1.y; cbias[6] = b1.z; cbias[7] = b1.w;
    }
  auto load_rows = [&](int id, u32x4 (&raw)[11]) {
    const int R0 = (id >> 7) * 8;
    int t0, Ls;
    if (R0 < NL) { t0 = R0 & (SEQL - 1); Ls = SEQL; } else { t0 = (R0 - NL) & (LCTX - 1); Ls = LCTX; }
#pragma unroll
    for (int jj = 0; jj < 11; ++jj) {
      const int t = t0 - 2 + jj;
      raw[jj] = (u32x4){0u, 0u, 0u, 0u};
      if (t >= 0 && t < Ls) raw[jj] = *(const u32x4*)(xr + (size_t)(R0 - 2 + jj) * 1024 + chb);
    }
  };
  const int id0 = blockIdx.x * NTHREADS + tid, idstep = gridDim.x * NTHREADS;
  u32x4 cur[11];
  if (id0 < total) load_rows(id0, cur);
  for (int id = id0; id < total; id += idstep) {
    const int R0 = (id >> 7) * 8;
    u32x4 nxt[11];
    const bool more = id + idstep < total;
    if (more) load_rows(id + idstep, nxt);
    float xw[11][8];
#pragma unroll
    for (int jj = 0; jj < 11; ++jj) {
      const u32x4 u = cur[jj];
      xw[jj][0] = lo_bf(u.x); xw[jj][1] = hi_bf(u.x);
      xw[jj][2] = lo_bf(u.y); xw[jj][3] = hi_bf(u.y);
      xw[jj][4] = lo_bf(u.z); xw[jj][5] = hi_bf(u.z);
      xw[jj][6] = lo_bf(u.w); xw[jj][7] = hi_bf(u.w);
    }
#pragma unroll
    for (int i = 0; i < 8; ++i) {
      float z[8];
#pragma unroll
      for (int e2 = 0; e2 < 8; ++e2) {
        float a = cbias[e2];
#pragma unroll
        for (int j = 0; j < 4; ++j) a += cw[j][e2] * xw[i + j][e2];
        z[e2] = a;
      }
      u32x4 pk;
      pk.x = pack2(z[0], z[1]); pk.y = pack2(z[2], z[3]);
      pk.z = pack2(z[4], z[5]); pk.w = pack2(z[6], z[7]);
      *(u32x4*)(zb + (size_t)(R0 + i) * 1024 + chb) = pk;
    }
    if (more) {
#pragma unroll
      for (int jj = 0; jj < 11; ++jj) cur[jj] = nxt[jj];
    }
  }
}

constexpr int ZS = 264;

template <int DIR>
__device__ void rglru_item(const Params& p, const OddBufs& ob, int item, char* smem, int oi, bool need_ctx) {
  bf16_t* Zs = (bf16_t*)smem;
  float* segA = (float*)(Zs + 128 * ZS);
  float* segB = segA + 256;
  float* carry = segB + 256;
  constexpr int LT = 132;
  float* La = (float*)Zs;
  float* Gz = La + 32 * LT;
  const int tid = otid(), lane = tid & 63, w = __builtin_amdgcn_readfirstlane(tid >> 6);
  const int r = lane & 31, h = lane >> 5;
  const int wm = w >> 1, wn = w & 1;
  const int b = item >> 6, cs = item & 31;
  constexpr int dir = DIR;
  const int hd = cs >> 3, j0 = (cs & 7) * 32, c0 = cs * 32;
  bf16_t* sout = p.hbuf;
  const bf16_t* zb = ob.sg + (size_t)NR * 1024;
  __syncthreads();
  if (tid < 32) carry[tid] = 0.f;
  bf16x8 bfr[16];
  {
    const size_t mo = ((size_t)((oi * 2 + dir) * 4 + hd)) * 65536 + (size_t)(j0 + r) * 256 + h * 8;
    const bf16_t* wsrc = (wn ? p.wgi : p.wga) + mo;
#pragma unroll
    for (int ks = 0; ks < 16; ++ks) bfr[ks] = *(const bf16x8*)(wsrc + ks * 16);
  }
  const int gch = (oi * 2 + dir) * 1024 + c0 + r;
  const float gbias = wn ? p.c_b_i[gch] : p.c_b_a[gch];
  const float spl = log1pf(__expf(-p.c_lam[gch]));
  const int sc_c = tid & 31, sc_sg = tid >> 5;
  const int lrow = tid >> 5, kc = tid & 31;

  u32x4 zt[4];
  {
    const int Rs0 = NL + b * LCTX;
    const int ti0 = dir ? 1 : 0;
    const bf16_t* src = zb + (size_t)(Rs0 + ti0 * 128 + lrow) * 1024 + hd * 256 + kc * 8;
#pragma unroll
    for (int i = 0; i < 4; ++i) zt[i] = *(const u32x4*)(src + (size_t)i * 8 * 1024);
  }
  const int sbase = DIR ? (7 - sc_sg) * 16 : sc_sg * 16;
  const unsigned voff = (unsigned)(sbase * 1024 + c0 + sc_c);
  for (int step = 0; step < 34; ++step) {
    int Rs, ti;
    bool wr;
    if (step < 2) { Rs = NL + b * LCTX; ti = dir ? 1 - step : step; wr = need_ctx; }
    else { Rs = b * SEQL; ti = dir ? 31 - (step - 2) : (step - 2); wr = true; }
    const int t0 = ti * 128;
    __syncthreads();
    {
      const bf16_t* src2 = zb + (size_t)(Rs + t0 + lrow + 32) * 1024 + hd * 256 + kc * 8;
      u32x4 z2[12];
#pragma unroll
      for (int i = 0; i < 12; ++i) z2[i] = *(const u32x4*)(src2 + (size_t)i * 8 * 1024);
#pragma unroll
      for (int i = 0; i < 4; ++i) *(u32x4*)(Zs + (lrow + 8 * i) * ZS + kc * 8) = zt[i];
#pragma unroll
      for (int i = 0; i < 12; ++i) *(u32x4*)(Zs + (lrow + 32 + 8 * i) * ZS + kc * 8) = z2[i];
    }
    const bf16_t* sgp = ob.sg + (size_t)(Rs + t0) * 1024;
    bf16_t sgv[16];
    const bool later = (step < 2) ? (step == 1) : (DIR ? (ti <= 15) : (ti >= 16));
    const bf16_t* sip = sout + (size_t)(Rs + t0) * 1024;
    bf16_t prv[16];
    if (wr) {
#pragma unroll
      for (int i = 0; i < 16; ++i) sgv[i] = sgp[voff + (DIR ? 15 - i : i) * 1024];
      if (later) {
#pragma unroll
        for (int i = 0; i < 16; ++i) prv[i] = sip[voff + (DIR ? 15 - i : i) * 1024];
      }
    }
    __syncthreads();
    f32x16 acc[2];
    acc[0] = zero16();
    acc[1] = zero16();
    {
      const bf16_t* Aw = Zs + (wm * 64 + r) * ZS + h * 8;
#pragma unroll
      for (int ks = 0; ks < 16; ++ks) {
        bf16x8 a0 = *(const bf16x8*)(Aw + ks * 16);
        bf16x8 a1 = *(const bf16x8*)(Aw + 32 * ZS + ks * 16);
        acc[0] = __builtin_amdgcn_mfma_f32_32x32x16_bf16(a0, bfr[ks], acc[0], 0, 0, 0);
        acc[1] = __builtin_amdgcn_mfma_f32_32x32x16_bf16(a1, bfr[ks], acc[1], 0, 0, 0);
      }
    }
    if (wn == 0) {
#pragma unroll
      for (int mi = 0; mi < 2; ++mi)
#pragma unroll
        for (int reg = 0; reg < 16; ++reg) acc[mi][reg] = -8.f * spl * sigmoid_f(acc[mi][reg] + gbias);
    } else {
#pragma unroll
      for (int mi = 0; mi < 2; ++mi) {
        float zv[16];
#pragma unroll
        for (int reg = 0; reg < 16; ++reg) {
          const int row = wm * 64 + mi * 32 + (reg & 3) + 8 * (reg >> 2) + 4 * h;
          zv[reg] = bf2f(Zs[row * ZS + j0 + r]);
        }
#pragma unroll
        for (int reg = 0; reg < 16; ++reg) acc[mi][reg] = zv[reg] * sigmoid_f(acc[mi][reg] + gbias);
        asm volatile("" ::: "memory");
      }
    }
    __syncthreads();
    {
      float* dstb = (wn ? Gz : La) + r * LT + wm * 64 + 4 * h;
#pragma unroll
      for (int mi = 0; mi < 2; ++mi)
#pragma unroll
        for (int q4 = 0; q4 < 4; ++q4) {
          pg8::f32x4 v4 = {acc[mi][q4 * 4 + 0], acc[mi][q4 * 4 + 1], acc[mi][q4 * 4 + 2], acc[mi][q4 * 4 + 3]};
          *(pg8::f32x4*)(dstb + mi * 32 + 8 * q4) = v4;
        }
    }
    __syncthreads();
    if (step + 1 < 34) {
      const int ns = step + 1;
      int nRs, nti;
      if (ns < 2) { nRs = NL + b * LCTX; nti = dir ? 1 - ns : ns; }
      else { nRs = b * SEQL; nti = dir ? 31 - (ns - 2) : (ns - 2); }
      const bf16_t* src = zb + (size_t)(nRs + nti * 128 + lrow) * 1024 + hd * 256 + kc * 8;
#pragma unroll
      for (int i = 0; i < 4; ++i) zt[i] = *(const u32x4*)(src + (size_t)i * 8 * 1024);
    }
    bf16_t* sop = sout + (size_t)(Rs + t0) * 1024;
    float* Lap = La + sc_c * LT + sbase;
    float* Gzp = Gz + sc_c * LT + sbase;
    {
      pg8::f32x4 va[4], vg[4];
#pragma unroll
      for (int k = 0; k < 4; ++k) { va[k] = *(const pg8::f32x4*)(Lap + 4 * k); vg[k] = *(const pg8::f32x4*)(Gzp + 4 * k); }
      float A = 1.f, Bv = 0.f;
#pragma unroll
      for (int i = 0; i < 16; ++i) {
        const int ro = DIR ? 15 - i : i;
        const float la = va[ro >> 2][ro & 3];
        const float a = __expf(la);
        const float mult = __builtin_amdgcn_sqrtf(fmaf(-a, a, 1.f));
        const float bx = mult * vg[ro >> 2][ro & 3];
        va[ro >> 2][ro & 3] = a;
        vg[ro >> 2][ro & 3] = bx;
        Bv = a * Bv + bx;
        A *= a;
      }
#pragma unroll
      for (int k = 0; k < 4; ++k) { *(pg8::f32x4*)(Lap + 4 * k) = va[k]; *(pg8::f32x4*)(Gzp + 4 * k) = vg[k]; }
      segA[sc_sg * 32 + sc_c] = A;
      segB[sc_sg * 32 + sc_c] = Bv;
    }
    __syncthreads();
    {
      float hh = carry[(step & 1) * 32 + sc_c];
      {
        float sa[7], sbv[7];
#pragma unroll
        for (int s2 = 0; s2 < 7; ++s2) { sa[s2] = segA[s2 * 32 + sc_c]; sbv[s2] = segB[s2 * 32 + sc_c]; }
#pragma unroll
        for (int s2 = 0; s2 < 7; ++s2) hh = (s2 < sc_sg) ? (sa[s2] * hh + sbv[s2]) : hh;
      }
      pg8::f32x4 va[4], vg[4];
#pragma unroll
      for (int k = 0; k < 4; ++k) { va[k] = *(const pg8::f32x4*)(Lap + 4 * k); vg[k] = *(const pg8::f32x4*)(Gzp + 4 * k); }
#pragma unroll
      for (int i = 0; i < 16; ++i) {
        const int ro = (DIR ? 15 - i : i);
        hh = va[ro >> 2][ro & 3] * hh + vg[ro >> 2][ro & 3];
        if (wr) {
          float ov = hh * bf2f(sgv[i]);
          if (later) ov += bf2f(prv[i]);
          sop[voff + ro * 1024] = f2bf(ov);
        }
      }
      if (sc_sg == 7) carry[((step + 1) & 1) * 32 + sc_c] = hh;
    }
  }
}

__device__ void phase_rglru(const Params& p, char* smem, int oi, bool need_ctx) {
  const OddBufs ob = odd_bufs(p);
  const int vb = vbid();
  for (int P0 = blockIdx.x; P0 < 256; P0 += gridDim.x) {
    const int xcd = P0 & 7, slot = P0 >> 3;
    const int grp = xcd * 4 + (slot >> 3), j = slot & 7;
    const int item = ((grp >> 2) << 6) | ((grp & 3) << 3) | j;
    if (vb) rglru_item<1>(p, ob, item, smem, oi, need_ctx);
    else rglru_item<0>(p, ob, item, smem, oi, need_ctx);
  }
}

#define XB_TMO      128
#define XB_XCNT(j)  (256  + 64 * (j))
#define XB_XSUB(j)  (1280 + 64 * (j))
#define XB_XGEN(j)  (2304 + 64 * (j))
#define XB_TOP      3328
#define XB_TOPGEN   3392
#define XCD_BAR_WORDS 3456
#define XB_SPIN_CAP (1u << 18)
#define LAS __attribute__((address_space(3)))

__device__ __forceinline__ unsigned xb_ld(unsigned* p)              { return __hip_atomic_load(p, __ATOMIC_RELAXED, __HIP_MEMORY_SCOPE_AGENT); }
__device__ __forceinline__ unsigned xb_add(unsigned* p, unsigned v) { return __hip_atomic_fetch_add(p, v, __ATOMIC_RELAXED, __HIP_MEMORY_SCOPE_AGENT); }
__device__ __forceinline__ unsigned xb_xcc_id() { return (unsigned)__builtin_amdgcn_s_getreg((3 << 11) | 20) & 0xFu; }
#define XB_SPIN(cond, bar) do { unsigned _sp = 0; while (cond) { __builtin_amdgcn_s_sleep(1); \
    if ((++_sp & 255u) == 0u) { if (xb_ld(&(bar)[XB_TMO])) break; if (_sp > XB_SPIN_CAP) { atomicAdd(&(bar)[XB_TMO], 1u); break; } } } } while (0)

struct XcdBarrier {
    unsigned* bar; unsigned x;
    volatile LAS unsigned* st;
};

__device__ __forceinline__ XcdBarrier xcd_barrier_post(unsigned* bar, volatile LAS unsigned* st) {
    XcdBarrier b; b.bar = bar; b.x = xb_xcc_id(); b.st = st;
    if (threadIdx.x == 0) (void)xb_add(&bar[XB_XCNT(b.x)], 1u);
    return b;
}
__device__ __forceinline__ void xcd_barrier_complete(unsigned* bar, unsigned x, unsigned& nloc, unsigned& nx) {
    const unsigned G = gridDim.x * gridDim.y * gridDim.z;
    unsigned sum, cnt, mine, sp = 0u;
    for (;;) {
        sum = 0u; cnt = 0u; mine = 0u;
#pragma unroll
        for (unsigned j = 0; j < 16; ++j) { const unsigned c = xb_ld(&bar[XB_XCNT(j)]); sum += c; cnt += (c > 0u) ? 1u : 0u; mine = (j == x) ? c : mine; }
        if (sum == G) break;
        __builtin_amdgcn_s_sleep(1);
        if ((++sp & 255u) == 0u) { if (xb_ld(&bar[XB_TMO])) break; if (sp > XB_SPIN_CAP) { atomicAdd(&bar[XB_TMO], 1u); break; } }
    }
    nloc = mine > 0u ? mine : 1u; nx = cnt > 0u ? cnt : 1u;
}

__device__ __forceinline__ void xcd_barrier(const XcdBarrier& b) {
    asm volatile("s_waitcnt vmcnt(0)" ::: "memory");
    __syncthreads();
    if (threadIdx.x == 0) {
        unsigned* bar = b.bar;
        __builtin_amdgcn_s_waitcnt(0);
        unsigned nloc = b.st[0], nx = b.st[1];
        if (nloc == 0u) { xcd_barrier_complete(bar, b.x, nloc, nx); b.st[0] = nloc; b.st[1] = nx; }
        const unsigned old = xb_add(&bar[XB_XSUB(b.x)], 1u);
        const unsigned gen = old / nloc;
        if (old + 1u == (gen + 1u) * nloc) {
            __builtin_amdgcn_fence(__ATOMIC_RELEASE, "agent");
            asm volatile("s_waitcnt vmcnt(0)" ::: "memory");
            const unsigned og = xb_add(&bar[XB_TOP], 1u);
            const unsigned tg = og / nx;
            if (og + 1u == (tg + 1u) * nx) xb_add(&bar[XB_TOPGEN], 1u);
            else XB_SPIN(xb_ld(&bar[XB_TOPGEN]) == tg, bar);
            __builtin_amdgcn_fence(__ATOMIC_ACQUIRE, "agent");
            xb_add(&bar[XB_XGEN(b.x)], 1u);
            asm volatile("s_waitcnt vmcnt(0)" ::: "memory");
        } else {
            XB_SPIN(xb_ld(&bar[XB_XGEN(b.x)]) == gen, bar);
            __builtin_amdgcn_fence(__ATOMIC_ACQUIRE, "agent");
            asm volatile("s_waitcnt vmcnt(0)" ::: "memory");
        }
    }
    __syncthreads();
}


#define LAUNDER(f) q.f = p.f + z
__device__ __forceinline__ void launder(Params& q, const Params& p) {
  long z;
  asm volatile("s_mov_b64 %0, 0" : "=s"(z));
  LAUNDER(x); LAUNDER(c); LAUNDER(ctx); LAUNDER(c_ctx); LAUNDER(norm_g); LAUNDER(w_mod); LAUNDER(b_mod);
  LAUNDER(ab_w_in); LAUNDER(a_ln_g); LAUNDER(a_ln_b); LAUNDER(a_w_s); LAUNDER(a_b_s); LAUNDER(b_sink);
  LAUNDER(ab_w_out); LAUNDER(c_w_in); LAUNDER(c_conv_w); LAUNDER(c_conv_b); LAUNDER(c_w_a); LAUNDER(c_b_a);
  LAUNDER(c_w_i); LAUNDER(c_b_i); LAUNDER(c_lam); LAUNDER(c_w_out); LAUNDER(final_g); LAUNDER(out);
  LAUNDER(xbuf); LAUNDER(mods); LAUNDER(hbuf); LAUNDER(ebuf); LAUNDER(wt_in_e); LAUNDER(wt_out_e);
  LAUNDER(wt_in_o); LAUNDER(wt_out_o); LAUNDER(wga); LAUNDER(wgi); LAUNDER(wsb); LAUNDER(wsum); LAUNDER(part);
}

constexpr int NPHASES = 20;

__device__ void run_phase(const Params& p0, int ph, char* smem, char* dsm) {
  if (ph == 0) { Params p; launder(p, p0); phase0(p, smem); return; }
  if (ph == 19) { Params p; launder(p, p0); phase_final(p); return; }
  int layer, sub;
  if (ph < 5) { layer = 0; sub = ph - 1; }
  else if (ph < 10) { layer = 1; sub = ph - 5; }
  else if (ph < 14) { layer = 2; sub = ph - 10; }
  else { layer = 3; sub = ph - 14; }
  const int idx = layer >> 1;
  const bool even = (layer & 1) == 0;
  const bool need_ctx = layer < 3;
  if (sub == 0) { Params p; launder(p, p0); phase_prep(p, layer); if (layer == 0) phase0_transposes(p, smem); return; }
  if (even) {
    if (sub == 1) {
      Params p; launder(p, p0);
      EpiEvenIn epi; epi.e = even_bufs(p);
      (void)epi;
      PEpiEvenIn pe; pe.e = even_bufs(p);
      pg8::Gemm g; g.A = p.hbuf; g.Bt = p.wt_in_e + (size_t)idx * 2816 * 1024; g.M = NR; g.N = 2816; g.K = 1024;
      pg8::StaticOrder so; so.init(g.M, g.N, (int)gridDim.x, (int)blockIdx.x);
      pg8::gemm_phase((PG8_LAS unsigned char*)dsm, g, so, pe);
    } else if (sub == 2) {
      Params p; launder(p, p0);
      phase_even_mix(p, smem, idx);
    } else {
      Params p; launder(p, p0);
      EpiOut epi; epi.xbuf = p.xbuf; epi.mods_l = p.mods + (size_t)layer * 9 * 3072;
      epi.xin_lat = (layer == 0) ? p.x : p.xbuf;
      epi.xin_ctx = (layer == 0) ? p.ctx : p.xbuf + (size_t)NL * 1024;
      PEpiOut pe; pe.xbuf = epi.xbuf; pe.xin_lat = epi.xin_lat; pe.xin_ctx = epi.xin_ctx; pe.mods_l = epi.mods_l;
      pe.part = p.part;
      pg8::OutOrder oo;
#pragma unroll 1
      for (int pass = 0; pass < 2; ++pass) {
        pg8::Gemm g; g.A = p.hbuf; g.Bt = p.wt_out_e + (size_t)idx * 1024 * 1024; g.M = pass ? NR : NL; g.N = 1024; g.K = pass ? 256 : 1024;
        oo.so.init(NL, 1024, (int)gridDim.x, (int)blockIdx.x); oo.cs.init((int)gridDim.x, (int)blockIdx.x); oo.mode = pass;
        pe.split = pass;
        pg8::gemm_phase((PG8_LAS unsigned char*)dsm, g, oo, pe);
      }
    }
  } else {
    if (sub == 1) {
      Params p; launder(p, p0);
      EpiOddIn epi; epi.o = odd_bufs(p);
      (void)epi;
      PEpiOddIn pe; pe.o = odd_bufs(p);
      pg8::Gemm g; g.A = p.hbuf; g.Bt = p.wt_in_o + (size_t)idx * 2048 * 1024; g.M = NR; g.N = 2048; g.K = 1024;
      pg8::StaticOrder so; so.init(g.M, g.N, (int)gridDim.x, (int)blockIdx.x);
      pg8::gemm_phase((PG8_LAS unsigned char*)dsm, g, so, pe);
    } else if (sub == 2) {
      Params p; launder(p, p0);
      phase_conv(p, idx);
    } else if (sub == 3) {
      Params p; launder(p, p0);
      phase_rglru(p, smem, idx, need_ctx);
    } else {
      Params p; launder(p, p0);
      EpiOut epi; epi.xbuf = p.xbuf; epi.mods_l = p.mods + (size_t)layer * 9 * 3072;
      epi.xin_lat = (layer == 0) ? p.x : p.xbuf;
      epi.xin_ctx = (layer == 0) ? p.ctx : p.xbuf + (size_t)NL * 1024;
      PEpiOut pe; pe.xbuf = epi.xbuf; pe.xin_lat = epi.xin_lat; pe.xin_ctx = epi.xin_ctx; pe.mods_l = epi.mods_l;
      pe.part = p.part;
      pg8::OutOrder oo;
      const int npass = need_ctx ? 2 : 1;
#pragma unroll 1
      for (int pass = 0; pass < npass; ++pass) {
        pg8::Gemm g; g.A = p.hbuf; g.Bt = p.wt_out_o + (size_t)idx * 1024 * 1024; g.M = pass ? NR : NL; g.N = 1024; g.K = pass ? 256 : 1024;
        oo.so.init(NL, 1024, (int)gridDim.x, (int)blockIdx.x); oo.cs.init((int)gridDim.x, (int)blockIdx.x); oo.mode = pass;
        pe.split = pass;
        pg8::gemm_phase((PG8_LAS unsigned char*)dsm, g, oo, pe);
      }
    }
  }
}

__global__ void __launch_bounds__(NTHREADS, 2) mega_kernel(Params p, int ph_lo, int ph_hi, int use_bar) {
  extern __shared__ __attribute__((aligned(16))) char dsm[];
  uint4* xbw = (uint4*)(dsm + 2 * VSMEM);
  if (threadIdx.x == 0) *xbw = make_uint4(0u, 0u, 0u, 0u);
  __syncthreads();
  if (use_bar == 1) (void)xcd_barrier_post(p.bar, (volatile LAS unsigned*)xbw);
  char* smem = dsm + (threadIdx.x >> 8) * VSMEM;
  for (int ph = ph_lo; ph < ph_hi; ++ph) {
    run_phase(p, ph, smem, dsm);
    if (ph + 1 < ph_hi) {
      if (use_bar == 1) {
        XcdBarrier xb;
        xb.bar = p.bar; xb.x = xb_xcc_id(); xb.st = (volatile LAS unsigned*)xbw;
        xcd_barrier(xb);
      } else if (use_bar == 2) cg::this_grid().sync();
    }
  }
}

extern "C" void kernel_launch(void* const* d_in, const int* in_sizes, int n_in, void* d_out, int out_size,
                              void* d_ws, size_t ws_size, hipStream_t stream) {
  static int grid_blocks = 0;
  if (!grid_blocks) {
    int dev = 0, cus = 0, per_cu = 0;
    hipGetDevice(&dev);
    hipDeviceGetAttribute(&cus, hipDeviceAttributeMultiprocessorCount, dev);
    hipFuncSetAttribute((const void*)mega_kernel, hipFuncAttributeMaxDynamicSharedMemorySize, DSM_BYTES);
    hipOccupancyMaxActiveBlocksPerMultiprocessor(&per_cu, mega_kernel, NTHREADS, DSM_BYTES);
    if (per_cu < 1) per_cu = 1;
    if (per_cu > 1) per_cu = 1;
    grid_blocks = cus * per_cu;
  }
  Params p{};
  const float** fp = (const float**)&p;
  for (int i = 0; i < 24; ++i) fp[i] = (const float*)d_in[i];
  p.out = (float*)d_out;
  char* ws = (char*)d_ws;
  size_t off = 0;
  auto take = [&](size_t bytes) { char* q = ws + off; off += (bytes + 255) & ~(size_t)255; return q; };
  p.xbuf = (float*)take((size_t)NR * 1024 * 4);
  p.mods = (float*)take((size_t)4 * 9 * 3072 * 4);
  p.hbuf = (bf16_t*)take((size_t)NR * 1024 * 2);
  p.ebuf = (bf16_t*)take((size_t)NR * 3072 * 2);
  p.wt_in_e = (bf16_t*)take((size_t)2 * 2816 * 1024 * 2);
  p.wt_out_e = (bf16_t*)take((size_t)2 * 1024 * 1024 * 2);
  p.wt_in_o = (bf16_t*)take((size_t)2 * 2048 * 1024 * 2);
  p.wt_out_o = (bf16_t*)take((size_t)2 * 1024 * 1024 * 2);
  p.wga = (bf16_t*)take((size_t)16 * 65536 * 2);
  p.wgi = (bf16_t*)take((size_t)16 * 65536 * 2);
  p.wsb = (bf16_t*)take((size_t)8 * 16384 * 2);
  p.wsum = (float*)take((size_t)8 * 128 * 4);
  p.part = (float*)take((size_t)4 * NC * 1024 * 4);
  p.bar = (unsigned*)take((size_t)XCD_BAR_WORDS * 4);
  if (off > ws_size) fprintf(stderr, "workspace too small: need %zu have %zu\n", off, ws_size);
#if COOP
  hipMemsetAsync(p.bar, 0, (size_t)XCD_BAR_WORDS * 4, stream);
  int lo = 0, hi = NPHASES, ub = 1;
  void* args[] = {&p, &lo, &hi, &ub};
  hipError_t e = hipLaunchCooperativeKernel((void*)mega_kernel, dim3(grid_blocks), dim3(NTHREADS), args, DSM_BYTES, stream);
  if (e != hipSuccess) fprintf(stderr, "cooperative launch failed: %s (grid %d)\n", hipGetErrorString(e), grid_blocks);
#else
  for (int ph = 0; ph < NPHASES; ++ph) mega_kernel<<<grid_blocks, NTHREADS, DSM_BYTES, stream>>>(p, ph, ph + 1, 0);
#endif
}
```

```cpp
#include <hip/hip_runtime.h>
#include <hip/hip_cooperative_groups.h>
#include <stdint.h>
#include <stdio.h>
namespace cg = cooperative_groups;

#ifndef COOP
#define COOP 1
#endif

typedef unsigned short bf16_t;
typedef __attribute__((ext_vector_type(8))) short bf16x8;
typedef __attribute__((ext_vector_type(16))) float f32x16;
typedef __attribute__((ext_vector_type(4))) unsigned int u32x4;
typedef __attribute__((ext_vector_type(2))) unsigned int u32x2;

constexpr int DM = 1024;
constexpr int NBATCH = 8;
constexpr int SEQL = 4096;
constexpr int LCTX = 256;
constexpr int NL = NBATCH * SEQL;
constexpr int NC = NBATCH * LCTX;
constexpr int NR = NL + NC;
constexpr int VSMEM = 72 * 1024;
constexpr int NTHREADS = 512;
constexpr int VTH = 256;
constexpr int DSM_BYTES = 2 * VSMEM + 256;

struct Params {
  const float *x, *c, *ctx, *c_ctx, *norm_g, *w_mod, *b_mod, *ab_w_in, *a_ln_g, *a_ln_b, *a_w_s, *a_b_s,
      *b_sink, *ab_w_out, *c_w_in, *c_conv_w, *c_conv_b, *c_w_a, *c_b_a, *c_w_i, *c_b_i, *c_lam, *c_w_out,
      *final_g;
  float* out;
  float* xbuf;
  float* mods;
  bf16_t* hbuf;
  bf16_t* ebuf;
  bf16_t *wt_in_e, *wt_out_e, *wt_in_o, *wt_out_o, *wga, *wgi;
  bf16_t* wsb;
  float* wsum;
  float* part;
  unsigned* bar;
};

typedef __bf16 hwbf16x2 __attribute__((ext_vector_type(2)));
typedef float f32x2v __attribute__((ext_vector_type(2)));
__device__ __forceinline__ uint32_t pack2(float a, float b) {
  f32x2v v = {a, b};
  hwbf16x2 r = __builtin_convertvector(v, hwbf16x2);
  return __builtin_bit_cast(uint32_t, r);
}
__device__ __forceinline__ bf16_t f2bf(float f) { return (bf16_t)(pack2(f, f) & 0xffffu); }
__device__ __forceinline__ float bf2f(bf16_t b) { return __uint_as_float(((uint32_t)b) << 16); }
__device__ __forceinline__ float lo_bf(uint32_t u) { return __uint_as_float(u << 16); }
__device__ __forceinline__ float hi_bf(uint32_t u) { return __uint_as_float(u & 0xffff0000u); }
__device__ __forceinline__ float frcp(float x) { return __builtin_amdgcn_rcpf(x); }
__device__ __forceinline__ float silu_f(float x) { return x * frcp(1.f + __expf(-x)); }
__device__ __forceinline__ float sigmoid_f(float x) { return frcp(1.f + __expf(-x)); }
__device__ __forceinline__ float gelu_f(float x) {
  float y = 0.7978845608028654f * (x + 0.044715f * x * x * x);
  float t = 1.f - 2.f * frcp(1.f + __expf(2.f * y));
  return 0.5f * x * (1.f + t);
}
typedef float f32x2p __attribute__((ext_vector_type(2)));
__device__ __forceinline__ f32x2p silu_pk(f32x2p x) {
  const f32x2p t = x * (-1.4426950408889634f);
  f32x2p e; e.x = __builtin_amdgcn_exp2f(t.x); e.y = __builtin_amdgcn_exp2f(t.y);
  const f32x2p d = e + 1.0f;
  f32x2p r; r.x = __builtin_amdgcn_rcpf(d.x); r.y = __builtin_amdgcn_rcpf(d.y);
  return x * r;
}
__device__ __forceinline__ f32x2p gelu_pk(f32x2p x) {
  const f32x2p x2 = x * x;
  const f32x2p pz = x2 * (0.044715f * 2.3022082003f) + 2.3022082003f;
  const f32x2p u = x * pz;
  f32x2p e; e.x = __builtin_amdgcn_exp2f(u.x); e.y = __builtin_amdgcn_exp2f(u.y);
  const f32x2p d = e + 1.0f;
  f32x2p r; r.x = __builtin_amdgcn_rcpf(d.x); r.y = __builtin_amdgcn_rcpf(d.y);
  return x - x * r;
}
__device__ __forceinline__ f32x16 zero16() {
  f32x16 z;
#pragma unroll
  for (int i = 0; i < 16; ++i) z[i] = 0.f;
  return z;
}
__device__ __forceinline__ float wave_sum(float v) {
#pragma unroll
  for (int o = 32; o > 0; o >>= 1) v += __shfl_xor(v, o);
  return v;
}

__device__ __forceinline__ int ofull() {
  int t = threadIdx.x;
  asm volatile("" : "+v"(t));
  return t;
}
__device__ __forceinline__ int otid() { return ofull() & (VTH - 1); }
__device__ __forceinline__ int vbid() { return __builtin_amdgcn_readfirstlane(ofull() >> 8); }
__device__ __forceinline__ int vblk() { return (int)blockIdx.x * 2 + vbid(); }
__device__ __forceinline__ int nvblk() { return (int)gridDim.x * 2; }

struct EvenBufs {
  bf16_t *ug, *vg, *gas, *qb, *gbs, *kb, *vtl, *vtc;
};
__device__ __forceinline__ EvenBufs even_bufs(const Params& p) {
  EvenBufs e;
  e.ug = p.ebuf;
  e.vg = e.ug + (size_t)NR * 512;
  e.gas = e.vg + (size_t)NR * 512;
  e.qb = e.gas + (size_t)NR * 512;
  e.gbs = e.qb + (size_t)NR * 512;
  e.kb = e.gbs + (size_t)NR * 512;
  e.vtl = e.kb + (size_t)NR * 128;
  e.vtc = e.vtl + (size_t)NBATCH * 128 * SEQL;
  return e;
}
struct OddBufs {
  bf16_t *xr, *sg, *sb;
};
__device__ __forceinline__ OddBufs odd_bufs(const Params& p) {
  OddBufs o;
  o.xr = p.ebuf;
  o.sg = o.xr + (size_t)NR * 1024;
  o.sb = o.xr;
  return o;
}

struct TrDesc { const float* src; bf16_t* dst; int K, N, k0, n0; bool qk; };
__device__ __forceinline__ TrDesc transpose_desc(const Params& p, int item) {
  TrDesc d;
  int local;
  if (item < 1408) { d.src = p.ab_w_in; d.dst = p.wt_in_e; d.K = 1024; d.N = 2816; local = item; }
  else if (item < 1920) { d.src = p.ab_w_out; d.dst = p.wt_out_e; d.K = 1024; d.N = 1024; local = item - 1408; }
  else if (item < 2944) { d.src = p.c_w_in; d.dst = p.wt_in_o; d.K = 1024; d.N = 2048; local = item - 1920; }
  else if (item < 3456) { d.src = p.c_w_out; d.dst = p.wt_out_o; d.K = 1024; d.N = 1024; local = item - 2944; }
  else if (item < 3712) { d.src = p.c_w_a; d.dst = p.wga; d.K = 256; d.N = 256; local = item - 3456; }
  else { d.src = p.c_w_i; d.dst = p.wgi; d.K = 256; d.N = 256; local = item - 3712; }
  const int ntn = d.N / 64;
  const int tpb = (d.K / 64) * ntn;
  const int bi = local / tpb;
  const int rem = local % tpb;
  d.k0 = (rem / ntn) * 64; d.n0 = (rem % ntn) * 64;
  d.src += (size_t)bi * d.K * d.N;
  d.dst += (size_t)bi * d.K * d.N;
  d.qk = (item < 1408) && d.n0 >= 1536 && d.n0 < 2176;
  return d;
}
__device__ __forceinline__ void transpose_load(const TrDesc& d, int tid, float (&v)[16]) {
#pragma unroll
  for (int i = 0; i < 16; ++i) {
    const int rr = i * 4 + (tid >> 6), cc = tid & 63;
    v[i] = d.src[(size_t)(d.k0 + rr) * d.N + d.n0 + cc];
  }
}
__device__ void transpose_items(const Params& p, int item0, int istep, int iend, char* smem) {
  float* tile = (float*)smem;
  const int tid = otid();
  float cur[16];
  if (item0 < iend) { const TrDesc d0 = transpose_desc(p, item0); transpose_load(d0, tid, cur); }
  for (int item = item0; item < iend; item += istep) {
    const bool more = item + istep < iend;
    float nxt[16];
    if (more) { const TrDesc dn = transpose_desc(p, item + istep); transpose_load(dn, tid, nxt); }
    const TrDesc d = transpose_desc(p, item);
    __syncthreads();
#pragma unroll
    for (int i = 0; i < 16; ++i) tile[(i * 4 + (tid >> 6)) * 65 + (tid & 63)] = cur[i];
    __syncthreads();
#pragma unroll
    for (int i = 0; i < 16; ++i) {
      const int n = i * 4 + (tid >> 6), k = tid & 63;
      const int ns = d.qk ? (((n >> 3) << 2) + (n & 3) + (((n >> 2) & 1) << 5)) : n;
      d.dst[(size_t)(d.n0 + n) * d.K + d.k0 + k] = f2bf(tile[k * 65 + ns]);
    }
    if (more) {
#pragma unroll
      for (int i = 0; i < 16; ++i) cur[i] = nxt[i];
    }
  }
}

__device__ void mods_item(const Params& p, int item, char* smem) {
  float* sc = (float*)smem;
  float* red = sc + 9 * 1024;
  const int tid = otid();
  const int l = item / 96, n0 = (item % 96) * 32;
  __syncthreads();
  {
    float cv[36];
#pragma unroll
    for (int it = 0; it < 36; ++it) {
      const int j = it >> 2, k = tid + 256 * (it & 3);
      cv[it] = (j < 8) ? p.c[j * 1024 + k] : p.c_ctx[k];
    }
#pragma unroll
    for (int it = 0; it < 36; ++it) sc[tid + 256 * it] = silu_f(cv[it]);
  }
  __syncthreads();
  const int col = tid & 31, kg = tid >> 5;
  float acc[9];
#pragma unroll
  for (int j = 0; j < 9; ++j) acc[j] = 0.f;
  const float* w = p.w_mod + ((size_t)l * 1024 + kg * 128) * 3072 + n0 + col;
#pragma unroll 64
  for (int k = 0; k < 128; ++k) {
    float wv = w[(size_t)k * 3072];
#pragma unroll
    for (int j = 0; j < 9; ++j) acc[j] += sc[j * 1024 + kg * 128 + k] * wv;
  }
#pragma unroll
  for (int j = 0; j < 9; ++j) red[(kg * 9 + j) * 32 + col] = acc[j];
  __syncthreads();
  for (int i = tid; i < 9 * 32; i += VTH) {
    int j = i >> 5, cc = i & 31;
    float s = 0.f;
#pragma unroll
    for (int g = 0; g < 8; ++g) s += red[(g * 9 + j) * 32 + cc];
    p.mods[((size_t)l * 9 + j) * 3072 + n0 + cc] = s + p.b_mod[l * 3072 + n0 + cc];
  }
}

__device__ void phase0(const Params& p, char* smem) {
  for (int row = blockIdx.x * NTHREADS + ofull(); row < 8 * 128; row += gridDim.x * NTHREADS) {
    const float4* src = (const float4*)(p.a_w_s + (size_t)row * 128);
    float sm = 0.f;
#pragma unroll 8
    for (int i = 0; i < 32; ++i) {
      const float4 v = src[i];
      sm += (v.x + v.y) + (v.z + v.w);
      u32x2 pk;
      pk.x = pack2(v.x, v.y);
      pk.y = pack2(v.z, v.w);
      *(u32x2*)(p.wsb + (size_t)row * 128 + i * 4) = pk;
    }
    p.wsum[row] = sm;
  }
  for (int item = vblk(); item < 384; item += nvblk()) mods_item(p, item, smem);
}
__device__ void phase0_transposes(const Params& p, char* smem) {
  transpose_items(p, vblk(), nvblk(), 3968, smem);
}

__device__ void phase_prep(const Params& p, int layer) {
  const int tid = ofull();
  const int lane = tid & 63;
  const int gw = blockIdx.x * 8 + (tid >> 6);
  const int nw = gridDim.x * 8;
  const float* ng = p.norm_g + layer * 1024;
  float4 gpre[4];
#pragma unroll
  for (int i = 0; i < 4; ++i) gpre[i] = ((const float4*)ng)[lane + 64 * i];
  for (int R = gw; R < NR; R += nw) {
    const float* src;
    if (layer == 0) src = (R < NL) ? p.x + (size_t)R * 1024 : p.ctx + (size_t)(R - NL) * 1024;
    else if (layer == 1 && R >= NL) src = p.ctx + (size_t)(R - NL) * 1024;
    else src = p.xbuf + (size_t)R * 1024;
    const int bidx = (R < NL) ? (R >> 12) : 8;
    const float* md = p.mods + ((size_t)layer * 9 + bidx) * 3072;
    float4 v[4], shp[4], scp[4];
#pragma unroll
    for (int i = 0; i < 4; ++i) v[i] = ((const float4*)src)[lane + 64 * i];
#pragma unroll
    for (int i = 0; i < 4; ++i) {
      shp[i] = ((const float4*)md)[lane + 64 * i];
      scp[i] = ((const float4*)(md + 1024))[lane + 64 * i];
    }
    if (layer >= 1 && R >= NL) {
      const float* gp = p.mods + ((size_t)(layer - 1) * 9 + 8) * 3072 + 2048;
      const float* pp = p.part + (size_t)(R - NL) * 1024;
#pragma unroll
      for (int i = 0; i < 4; ++i) {
        const int k4 = lane + 64 * i;
        const float4 g = ((const float4*)gp)[k4];
        const float4 a0 = ((const float4*)pp)[k4];
        const float4 a1 = ((const float4*)(pp + (size_t)NC * 1024))[k4];
        const float4 a2 = ((const float4*)(pp + (size_t)2 * NC * 1024))[k4];
        const float4 a3 = ((const float4*)(pp + (size_t)3 * NC * 1024))[k4];
        v[i].x += g.x * ((a0.x + a1.x) + (a2.x + a3.x));
        v[i].y += g.y * ((a0.y + a1.y) + (a2.y + a3.y));
        v[i].z += g.z * ((a0.z + a1.z) + (a2.z + a3.z));
        v[i].w += g.w * ((a0.w + a1.w) + (a2.w + a3.w));
        ((float4*)(p.xbuf + (size_t)R * 1024))[k4] = v[i];
      }
    }
    float ss = 0.f;
#pragma unroll
    for (int i = 0; i < 4; ++i) ss += v[i].x * v[i].x + v[i].y * v[i].y + v[i].z * v[i].z + v[i].w * v[i].w;
    ss = wave_sum(ss);
    const float rstd = rsqrtf(ss * (1.f / 1024.f) + 1e-6f);
#pragma unroll
    for (int i = 0; i < 4; ++i) {
      const int k4 = lane + 64 * i;
      const float4 g = gpre[i];
      const float4 sh = shp[i];
      const float4 sc = scp[i];
      float h0 = v[i].x * rstd * g.x * (1.f + sc.x) + sh.x;
      float h1 = v[i].y * rstd * g.y * (1.f + sc.y) + sh.y;
      float h2 = v[i].z * rstd * g.z * (1.f + sc.z) + sh.z;
      float h3 = v[i].w * rstd * g.w * (1.f + sc.w) + sh.w;
      u32x2 pk;
      pk.x = pack2(h0, h1);
      pk.y = pack2(h2, h3);
      *(u32x2*)(p.hbuf + (size_t)R * 1024 + k4 * 4) = pk;
    }
  }
}

__device__ void phase_final(const Params& p) {
  const int tid = ofull();
  const int lane = tid & 63;
  const int gw = blockIdx.x * 8 + (tid >> 6);
  const int nw = gridDim.x * 8;
  float4 fg[4];
#pragma unroll
  for (int i = 0; i < 4; ++i) fg[i] = ((const float4*)p.final_g)[lane + 64 * i];
  for (int R = gw; R < NL; R += nw) {
    const float* src = p.xbuf + (size_t)R * 1024;
    float4 v[4];
#pragma unroll
    for (int i = 0; i < 4; ++i) v[i] = ((const float4*)src)[lane + 64 * i];
    float ss = 0.f;
#pragma unroll
    for (int i = 0; i < 4; ++i) ss += v[i].x * v[i].x + v[i].y * v[i].y + v[i].z * v[i].z + v[i].w * v[i].w;
    ss = wave_sum(ss);
    const float rstd = rsqrtf(ss * (1.f / 1024.f) + 1e-6f);
#pragma unroll
    for (int i = 0; i < 4; ++i) {
      const int k4 = lane + 64 * i;
      const float4 g = fg[i];
      float4 o;
      o.x = v[i].x * rstd * g.x;
      o.y = v[i].y * rstd * g.y;
      o.z = v[i].z * rstd * g.z;
      o.w = v[i].w * rstd * g.w;
      ((float4*)(p.out + (size_t)R * 1024))[k4] = o;
    }
  }
}

constexpr int GS = 72;

__device__ __forceinline__ u32x4 add_bf16x8(u32x4 a, u32x4 b) {
  u32x4 r;
  r.x = pack2(lo_bf(a.x) + lo_bf(b.x), hi_bf(a.x) + hi_bf(b.x));
  r.y = pack2(lo_bf(a.y) + lo_bf(b.y), hi_bf(a.y) + hi_bf(b.y));
  r.z = pack2(lo_bf(a.z) + lo_bf(b.z), hi_bf(a.z) + hi_bf(b.z));
  r.w = pack2(lo_bf(a.w) + lo_bf(b.w), hi_bf(a.w) + hi_bf(b.w));
  return r;
}

template <int AMODE, class Epi>
__device__ void gemm_phase(const bf16_t* __restrict__ A0, const bf16_t* __restrict__ A1,
                           const bf16_t* __restrict__ Bt, int Mtiles, int Ntiles, char* smem, Epi epi) {
  constexpr int PD = (AMODE == 1) ? 1 : 2;
  constexpr int BUF = 2 * 128 * GS;
  bf16_t* S0 = (bf16_t*)smem;
  const int tid = otid(), lane = tid & 63, w = __builtin_amdgcn_readfirstlane(tid >> 6);
  const int wm = w >> 1, wn = w & 1;
  const int r = lane & 31, h = lane >> 5;
  const int lrow = tid >> 3, kc = tid & 7;
  const int total = Mtiles * Ntiles;
  const int woff = lrow * GS + kc * 8;
  const int aro = (wm * 64 + r) * GS + h * 8;
  const int bro = 128 * GS + (wn * 64 + r) * GS + h * 8;
  const bool swz = ((gridDim.x & 7) == 0) && ((Mtiles & 7) == 0);
  const int xcd = blockIdx.x & 7;
  const int Mx = Mtiles >> 3;
  const int lstart = swz ? (int)(blockIdx.x >> 3) * 2 + vbid() : vblk();
  const int lstep = swz ? (int)(gridDim.x >> 3) * 2 : nvblk();
  const int lend = swz ? Mx * Ntiles : total;
  for (int L0 = 0; L0 < lend; L0 += lstep) {
    const bool tvalid = L0 + lstart < lend;
    const int L = tvalid ? L0 + lstart : lend - 1;
    int mt, nt;
    if (swz) {
      const int gfull = 8 * Ntiles;
      const int mg = L / gfull, rem = L - mg * gfull;
      const int gs = min(8, Mx - mg * 8);
      nt = rem / gs;
      mt = xcd * Mx + mg * 8 + (rem - nt * gs);
    } else {
      mt = L / Ntiles;
      nt = L - mt * Ntiles;
    }
    const int m0 = mt * 128, n0 = nt * 128;
    const size_t aoff = (size_t)(m0 + lrow) * 1024 + kc * 8;
    const bf16_t* ap = A0 + aoff;
    const bf16_t* ap1 = (AMODE == 1) ? (A1 + aoff) : A0;
    const bf16_t* bp = Bt + (size_t)(n0 + lrow) * 1024 + kc * 8;
    u32x4 ra[PD][4], ra1[PD][4], rb[PD][4];
#define G_LOAD(S, KT)                                                                              \
    {                                                                                              \
      _Pragma("unroll") for (int i = 0; i < 4; ++i) {                                              \
        ra[S][i] = *(const u32x4*)(ap + (size_t)i * 32 * 1024 + (KT) * 64);                        \
        if (AMODE == 1) ra1[S][i] = *(const u32x4*)(ap1 + (size_t)i * 32 * 1024 + (KT) * 64);     \
        rb[S][i] = *(const u32x4*)(bp + (size_t)i * 32 * 1024 + (KT) * 64);                        \
      }                                                                                            \
    }
#define L_WRITE(S, BUFI)                                                                           \
    {                                                                                              \
      bf16_t* dstA = S0 + (BUFI) * BUF + woff;                                                     \
      _Pragma("unroll") for (int i = 0; i < 4; ++i) {                                              \
        u32x4 av = ra[S][i];                                                                       \
        if (AMODE == 1) av = add_bf16x8(av, ra1[S][i]);                                            \
        *(u32x4*)(dstA + 32 * i * GS) = av;                                                        \
        *(u32x4*)(dstA + 128 * GS + 32 * i * GS) = rb[S][i];                                       \
      }                                                                                            \
    }
    G_LOAD(0, 0);
    L_WRITE(0, 0);
#pragma unroll
    for (int s = 0; s < PD; ++s) G_LOAD(s, 1 + s);
    f32x16 acc[2][2];
#pragma unroll
    for (int mi = 0; mi < 2; ++mi)
#pragma unroll
      for (int ni = 0; ni < 2; ++ni) acc[mi][ni] = zero16();
#pragma unroll 1
    for (int kt0 = 0; kt0 < 16; kt0 += 2) {
#pragma unroll
      for (int u = 0; u < 2; ++u) {
        const int kt = kt0 + u;
        constexpr int dummy = 0; (void)dummy;
        const int s = (PD == 2) ? u : 0;
        __syncthreads();
        L_WRITE(s, (u ^ 1));
        {
          const int ktl = (kt + 1 + PD < 16) ? (kt + 1 + PD) : 15;
          G_LOAD(s, ktl);
        }
        const bf16_t* Aw = S0 + u * BUF + aro;
        const bf16_t* Bw = S0 + u * BUF + bro;
#pragma unroll
        for (int ks = 0; ks < 4; ++ks) {
          bf16x8 a0 = *(const bf16x8*)(Aw + ks * 16);
          bf16x8 a1 = *(const bf16x8*)(Aw + 32 * GS + ks * 16);
          bf16x8 b0 = *(const bf16x8*)(Bw + ks * 16);
          bf16x8 b1 = *(const bf16x8*)(Bw + 32 * GS + ks * 16);
          acc[0][0] = __builtin_amdgcn_mfma_f32_32x32x16_bf16(a0, b0, acc[0][0], 0, 0, 0);
          acc[0][1] = __builtin_amdgcn_mfma_f32_32x32x16_bf16(a0, b1, acc[0][1], 0, 0, 0);
          acc[1][0] = __builtin_amdgcn_mfma_f32_32x32x16_bf16(a1, b0, acc[1][0], 0, 0, 0);
          acc[1][1] = __builtin_amdgcn_mfma_f32_32x32x16_bf16(a1, b1, acc[1][1], 0, 0, 0);
        }
      }
    }
#undef G_LOAD
#undef L_WRITE
    if (tvalid) epi(acc, m0 + wm * 64, n0 + wn * 64, lane);
  }
}

template <class Epi>
__device__ void gemm_phase_big(const bf16_t* __restrict__ A0, const bf16_t* __restrict__ Bt, int Mtiles  ,
                               int Ntiles, char* smem, Epi epi) {
  bf16_t* As = (bf16_t*)smem;
  bf16_t* Bs = As + 256 * GS;
  const int tid = otid(), lane = tid & 63, w = __builtin_amdgcn_readfirstlane(tid >> 6);
  const int wm = w >> 1, wn = w & 1;
  const int r = lane & 31, h = lane >> 5;
  const int lrow = tid >> 3, kc = tid & 7;
  const bool swz = ((gridDim.x & 7) == 0) && ((Mtiles & 7) == 0);
  const int xcd = blockIdx.x & 7;
  const int Mx = Mtiles >> 3;
  const int lstart = swz ? (int)(blockIdx.x >> 3) * 2 + vbid() : vblk();
  const int lstep = swz ? (int)(gridDim.x >> 3) * 2 : nvblk();
  const int lend = swz ? Mx * Ntiles : Mtiles * Ntiles;
  for (int L0 = 0; L0 < lend; L0 += lstep) {
    const bool tvalid = L0 + lstart < lend;
    const int L = tvalid ? L0 + lstart : lend - 1;
    int mt, nt;
    if (swz) {
      const int gfull = 8 * Ntiles;
      const int mg = L / gfull, rem = L - mg * gfull;
      const int gs = min(8, Mx - mg * 8);
      nt = rem / gs;
      mt = xcd * Mx + mg * 8 + (rem - nt * gs);
    } else {
      mt = L / Ntiles;
      nt = L - mt * Ntiles;
    }
    const int m0 = mt * 256, n0 = nt * 128;
    const bf16_t* ap = A0 + (size_t)(m0 + lrow) * 1024 + kc * 8;
    const bf16_t* bp = Bt + (size_t)(n0 + lrow) * 1024 + kc * 8;
    u32x4 ra[8], rb[4];
#pragma unroll
    for (int i = 0; i < 8; ++i) ra[i] = *(const u32x4*)(ap + (size_t)i * 32 * 1024);
#pragma unroll
    for (int i = 0; i < 4; ++i) rb[i] = *(const u32x4*)(bp + (size_t)i * 32 * 1024);
    f32x16 acc[2][2][2];
#pragma unroll
    for (int hf = 0; hf < 2; ++hf)
#pragma unroll
      for (int mi = 0; mi < 2; ++mi)
#pragma unroll
        for (int ni = 0; ni < 2; ++ni) acc[hf][mi][ni] = zero16();
#pragma unroll 1
    for (int kt = 0; kt < 16; ++kt) {
      __syncthreads();
#pragma unroll
      for (int i = 0; i < 8; ++i) *(u32x4*)(As + (lrow + 32 * i) * GS + kc * 8) = ra[i];
#pragma unroll
      for (int i = 0; i < 4; ++i) *(u32x4*)(Bs + (lrow + 32 * i) * GS + kc * 8) = rb[i];
      __syncthreads();
      {
        const int k0 = ((kt + 1 < 16) ? (kt + 1) : 15) * 64;
#pragma unroll
        for (int i = 0; i < 8; ++i) ra[i] = *(const u32x4*)(ap + (size_t)i * 32 * 1024 + k0);
#pragma unroll
        for (int i = 0; i < 4; ++i) rb[i] = *(const u32x4*)(bp + (size_t)i * 32 * 1024 + k0);
      }
      const bf16_t* Aw = As + (wm * 128 + r) * GS + h * 8;
      const bf16_t* Bw = Bs + (wn * 64 + r) * GS + h * 8;
#pragma unroll
      for (int ks = 0; ks < 4; ++ks) {
        bf16x8 b0 = *(const bf16x8*)(Bw + ks * 16);
        bf16x8 b1 = *(const bf16x8*)(Bw + 32 * GS + ks * 16);
#pragma unroll
        for (int hf = 0; hf < 2; ++hf) {
          bf16x8 a0 = *(const bf16x8*)(Aw + (hf * 64) * GS + ks * 16);
          bf16x8 a1 = *(const bf16x8*)(Aw + (hf * 64 + 32) * GS + ks * 16);
          acc[hf][0][0] = __builtin_amdgcn_mfma_f32_32x32x16_bf16(a0, b0, acc[hf][0][0], 0, 0, 0);
          acc[hf][0][1] = __builtin_amdgcn_mfma_f32_32x32x16_bf16(a0, b1, acc[hf][0][1], 0, 0, 0);
          acc[hf][1][0] = __builtin_amdgcn_mfma_f32_32x32x16_bf16(a1, b0, acc[hf][1][0], 0, 0, 0);
          acc[hf][1][1] = __builtin_amdgcn_mfma_f32_32x32x16_bf16(a1, b1, acc[hf][1][1], 0, 0, 0);
        }
      }
    }
    if (tvalid) {
      epi(acc[0], m0 + wm * 128, n0 + wn * 64, lane);
      epi(acc[1], m0 + wm * 128 + 64, n0 + wn * 64, lane);
    }
  }
}


struct EpiEvenIn {
  EvenBufs e;
  __device__ void operator()(f32x16 (&acc)[2][2], int rb, int cb, int lane) const {
    const int r = lane & 31, h = lane >> 5;
    if (cb < 1536 || cb >= 2304) {
      bf16_t* dst;
      int c0;
      int mode;
      if (cb < 512) { dst = e.ug; c0 = cb; mode = 0; }
      else if (cb < 1024) { dst = e.vg; c0 = cb - 512; mode = 0; }
      else if (cb < 1536) { dst = e.gas; c0 = cb - 1024; mode = 1; }
      else { dst = e.gbs; c0 = cb - 2304; mode = 1; }
#pragma unroll
      for (int mi = 0; mi < 2; ++mi)
#pragma unroll
        for (int ni = 0; ni < 2; ++ni)
#pragma unroll
          for (int reg = 0; reg < 16; ++reg) {
            const int row = rb + mi * 32 + (reg & 3) + 8 * (reg >> 2) + 4 * h;
            const int col = c0 + ni * 32 + r;
            float v = acc[mi][ni][reg];
            v = (mode == 0) ? gelu_f(v) : silu_f(v);
            dst[(size_t)row * 512 + col] = f2bf(v);
          }
    } else if (cb < 2176) {
      const bool isq = cb < 2048;
      bf16_t* dst = isq ? e.qb : e.kb;
      const int c0 = isq ? (cb - 1536) : (cb - 2048);
      const int ld = isq ? 512 : 128;
      const float scale = isq ? 0.125f : 1.f;
      const bool latent = rb < NL;
      const float inv_freq = exp2f(-(float)(r & 15) * 0.8304820237218406f);
#pragma unroll
      for (int mi = 0; mi < 2; ++mi)
#pragma unroll
        for (int reg = 0; reg < 16; ++reg) {
          const int row = rb + mi * 32 + (reg & 3) + 8 * (reg >> 2) + 4 * h;
          float x1 = acc[mi][0][reg], x2 = acc[mi][1][reg];
          float o1 = x1, o2 = x2;
          if (latent) {
            const int t = row & (SEQL - 1);
            const float pos = (float)((r < 16) ? (t >> 6) : (t & 63));
            const float ang = pos * inv_freq;
            const float cs = __cosf(ang), sn = __sinf(ang);
            o1 = x1 * cs - x2 * sn;
            o2 = x2 * cs + x1 * sn;
          }
          dst[(size_t)row * ld + c0 + r] = f2bf(o1 * scale);
          dst[(size_t)row * ld + c0 + 32 + r] = f2bf(o2 * scale);
        }
    } else {
      const int kvh = (cb - 2176) >> 6;
      const bool latent = rb < NL;
#pragma unroll
      for (int mi = 0; mi < 2; ++mi)
#pragma unroll
        for (int ni = 0; ni < 2; ++ni)
#pragma unroll
          for (int q4 = 0; q4 < 4; ++q4) {
            const int row = rb + mi * 32 + 8 * q4 + 4 * h;
            const int d = ni * 32 + r;
            u32x2 pk;
            pk.x = pack2(acc[mi][ni][q4 * 4 + 0], acc[mi][ni][q4 * 4 + 1]);
            pk.y = pack2(acc[mi][ni][q4 * 4 + 2], acc[mi][ni][q4 * 4 + 3]);
            if (latent) {
              const int b = row >> 12, t = row & (SEQL - 1);
              *(u32x2*)(e.vtl + ((size_t)((b * 2 + kvh) * 64 + d)) * SEQL + t) = pk;
            } else {
              const int rr = row - NL;
              const int b = rr >> 8, t = rr & (LCTX - 1);
              *(u32x2*)(e.vtc + ((size_t)((b * 2 + kvh) * 64 + d)) * LCTX + t) = pk;
            }
          }
    }
  }
};

struct EpiOddIn {
  OddBufs o;
  __device__ void operator()(f32x16 (&acc)[2][2], int rb, int cb, int lane) const {
    const int r = lane & 31, h = lane >> 5;
    const bool isg = cb >= 1024;
    bf16_t* dst = isg ? o.sg : o.xr;
    const int c0 = isg ? cb - 1024 : cb;
#pragma unroll
    for (int mi = 0; mi < 2; ++mi)
#pragma unroll
      for (int ni = 0; ni < 2; ++ni)
#pragma unroll
        for (int reg = 0; reg < 16; ++reg) {
          const int row = rb + mi * 32 + (reg & 3) + 8 * (reg >> 2) + 4 * h;
          const int col = c0 + ni * 32 + r;
          float v = acc[mi][ni][reg];
          if (isg) v = silu_f(v);
          dst[(size_t)row * 1024 + col] = f2bf(v);
        }
  }
};

struct EpiOut {
  float* xbuf;
  const float* xin_lat;
  const float* xin_ctx;
  const float* mods_l;
  __device__ void operator()(f32x16 (&acc)[2][2], int rb, int cb, int lane) const {
    const int r = lane & 31, h = lane >> 5;
    const int bidx = (rb < NL) ? (rb >> 12) : 8;
    const float* gate = mods_l + (size_t)bidx * 3072 + 2048;
    const float* xin = (rb < NL) ? xin_lat : xin_ctx;
    const int rsub = (rb < NL) ? 0 : NL;
#pragma unroll
    for (int ni = 0; ni < 2; ++ni) {
      const int col = cb + ni * 32 + r;
      const float gv = gate[col];
#pragma unroll
      for (int mi = 0; mi < 2; ++mi)
#pragma unroll
        for (int reg = 0; reg < 16; ++reg) {
          const int row = rb + mi * 32 + (reg & 3) + 8 * (reg >> 2) + 4 * h;
          xbuf[(size_t)row * 1024 + col] = xin[(size_t)(row - rsub) * 1024 + col] + gv * acc[mi][ni][reg];
        }
    }
  }
};


namespace pg8 {
#define PG8_LAS __attribute__((address_space(3)))
typedef float f32x4 __attribute__((ext_vector_type(4)));
constexpr int BM = 256, BK = 64, HALF = 128, HTB = HALF * BK * 2, STAGE_BYTES = 8 * HTB, NXCD = 8, WGM = 8;
__device__ __forceinline__ int lds_byte(int r, int c) { const int st = (r >> 4) * 2 + (c >> 5), rr = r & 15, cc = c & 31, ob = rr * 64 + cc * 2; return st * 1024 + (ob ^ (((ob >> 9) & 1) << 5)); }
__device__ __forceinline__ void stage_rc(int b, int& R, int& C) { const int st = b / 1024, sb = b % 1024, swz = sb ^ (((sb >> 9) & 1) << 5); R = (st >> 1) * 16 + swz / 64; C = (st & 1) * 32 + (swz % 64) / 2; }
__device__ __forceinline__ int perm32(int rho) { const int n = rho >> 4, i = rho & 15; return 8 * (i >> 2) + 4 * n + (i & 3); }
struct Unit { int pm, pn, ko; };
struct Gemm { const bf16_t* A; const bf16_t* Bt; int M, N, K; };
struct StaticOrder {
    int nM, nN, nwg, G, c;
    __device__ void init(int M, int N, int G_, int c_) { nM = M / BM; nN = N / BM; nwg = nM * nN; G = G_; c = c_; }
    __device__ bool next(int i, Unit& u) const {
        const long L = (long)i * G + c; if (L >= nwg) return false;
        int wgid = (int)L; { const int q = nwg / NXCD, r = nwg % NXCD, xcd = wgid % NXCD, off = wgid / NXCD; wgid = (xcd < r ? xcd * (q + 1) : r * (q + 1) + (xcd - r) * q) + off; }
        const int nig = WGM * nN, gid = wgid / nig, fm = gid * WGM, gsz = (nM - fm) < WGM ? (nM - fm) : WGM;
        u.pm = fm + ((wgid % nig) % gsz); u.pn = (wgid % nig) / gsz; u.ko = 0; return true;
    }
    __device__ __forceinline__ void a_ready(const Unit&) const {}
    __device__ __forceinline__ void done(const Unit&) const {}
};
struct CtxSplitOrder {
    int G, c;
    __device__ void init(int G_, int c_) { G = G_; c = c_; }
    __device__ bool next(int i, Unit& u) const {
        const int L = i * G + c; if (L >= 128) return false;
        const int unit = L >> 2; u.pm = (NL / 256) + (unit >> 2); u.pn = unit & 3; u.ko = (L & 3) * 256; return true;
    }
};
struct OutOrder {
    StaticOrder so; CtxSplitOrder cs; int mode;
    __device__ bool next(int i, Unit& u) const { return mode ? cs.next(i, u) : so.next(i, u); }
    __device__ __forceinline__ void a_ready(const Unit&) const {}
    __device__ __forceinline__ void done(const Unit&) const {}
};
template <class Epi, class Sched>
__device__ __forceinline__ void gemm_phase(PG8_LAS unsigned char* lds, const Gemm g, const Sched& S, const Epi& E) {
    const int tid = ofull(), wid = __builtin_amdgcn_readfirstlane(tid >> 6), lane = tid & 63, wr = wid >> 2, wc = wid & 3, fr = lane & 15, fq = lane >> 4;
    const int K = g.K, nt = K / BK;
    unsigned voffA[2], voffB[2];
#pragma unroll
    for (int i = 0; i < 2; ++i) { int R, C; stage_rc(tid * 16 + i * 8192, R, C); const int Rb = Epi::PERM ? ((R & ~31) + perm32(R & 31)) : R;
        voffA[i] = (unsigned)(R * 1024 + C) * 2u; voffB[i] = (unsigned)(Rb * 1024 + C) * 2u; }
    const size_t kstep = (size_t)(BK * 2);
    const size_t hstep = (size_t)HALF * 1024 * 2;
    const size_t tstep = 2 * hstep;
    const unsigned ldsw = (unsigned)wid * 1024u;
    const int aoff = lds_byte(wr * 64 + fr, fq * 8), boff = lds_byte(wc * 32 + fr, fq * 8);
#define PG8_SA(b, h) (((b) * 2 + (h)) * HTB)
#define PG8_SB(b, h) ((4 + (b) * 2 + (h)) * HTB)
#define PG8_STAGE(bufoff, gbase, voff) do { _Pragma("unroll") for (int _i = 0; _i < 2; ++_i) \
        __builtin_amdgcn_global_load_lds((const unsigned*)((const char*)(gbase) + (voff)[_i]), (PG8_LAS unsigned*)(lds + (bufoff) + ldsw + _i * 8192), 16, 0, 0); } while (0)
#define PG8_LDA(dst, b, h) do { _Pragma("unroll") for (int m = 0; m < 4; ++m) _Pragma("unroll") for (int k = 0; k < 2; ++k) dst[m][k] = *(const PG8_LAS bf16x8*)(lds + PG8_SA(b, h) + aoff + m * 2048 + k * 1024); } while (0)
#define PG8_LDB(dst, b, h) do { _Pragma("unroll") for (int n = 0; n < 2; ++n) _Pragma("unroll") for (int k = 0; k < 2; ++k) dst[n][k] = *(const PG8_LAS bf16x8*)(lds + PG8_SB(b, h) + boff + n * 2048 + k * 1024); } while (0)
#define PG8_MMA(ai, bj, At, Bt) do { __builtin_amdgcn_s_setprio(1); _Pragma("unroll") for (int m = 0; m < 4; ++m) _Pragma("unroll") for (int n = 0; n < 2; ++n) _Pragma("unroll") for (int k = 0; k < 2; ++k) \
        acc[ai][bj][m][n] = __builtin_amdgcn_mfma_f32_16x16x32_bf16(Bt[n][k], At[m][k], acc[ai][bj][m][n], 0, 0, 0); __builtin_amdgcn_s_setprio(0); } while (0)
#define PG8_WAIT_V(n) asm volatile("s_waitcnt vmcnt(" #n ")" ::: "memory")
#define PG8_WAIT_L(n) asm volatile("s_waitcnt lgkmcnt(" #n ")" ::: "memory")
#define PG8_BAR __builtin_amdgcn_s_barrier()
#define PG8_SCHED __builtin_amdgcn_sched_barrier(0)
    Unit cur, nxt; int ui = 0;
    if (!S.next(0, cur)) return;
    f32x4 acc[2][2][4][2];
#pragma unroll
    for (int a = 0; a < 2; ++a)
#pragma unroll
        for (int b = 0; b < 2; ++b)
#pragma unroll
            for (int m = 0; m < 4; ++m)
#pragma unroll
                for (int n = 0; n < 2; ++n) acc[a][b][m][n] = (f32x4){0.f, 0.f, 0.f, 0.f};
    bf16x8 At[4][2], B0[2][2], B1[2][2];
    const char* cA = (const char*)g.A + (size_t)cur.pm * tstep + (size_t)cur.ko * 2; const char* cB = (const char*)g.Bt + (size_t)cur.pn * tstep + (size_t)cur.ko * 2;
    S.a_ready(cur);
    PG8_STAGE(PG8_SB(0, 0), cB, voffB); PG8_STAGE(PG8_SA(0, 0), cA, voffA); PG8_STAGE(PG8_SB(0, 1), cB + hstep, voffB); PG8_STAGE(PG8_SA(0, 1), cA + hstep, voffA);
    if (wr == 1) PG8_BAR;
    PG8_WAIT_V(4); PG8_BAR;
    PG8_STAGE(PG8_SB(1, 0), cB + kstep, voffB); PG8_STAGE(PG8_SA(1, 0), cA + kstep, voffA); PG8_STAGE(PG8_SB(1, 1), cB + hstep + kstep, voffB);
    PG8_WAIT_V(6); PG8_BAR;
    for (;;) {
        const bool has_next = S.next(ui + 1, nxt);
        const char* nA = has_next ? (const char*)g.A + (size_t)nxt.pm * tstep + (size_t)nxt.ko * 2 : cA; const char* nB = has_next ? (const char*)g.Bt + (size_t)nxt.pn * tstep + (size_t)nxt.ko * 2 : cB;
        for (int t = 0; t < nt; t += 2) {
            const bool last = (t == nt - 2);
            const char* a1 = cA + (size_t)(t + 1) * kstep;
            const char* a2 = last ? nA : cA + (size_t)(t + 2) * kstep; const char* b2 = last ? nB : cB + (size_t)(t + 2) * kstep;
            const char* a3 = a2 + kstep; const char* b3 = b2 + kstep;
            if (last && has_next) S.a_ready(nxt);
            PG8_LDB(B0, 0, 0); PG8_SCHED; PG8_LDA(At, 0, 0); PG8_STAGE(PG8_SA(1, 1), a1 + hstep, voffA);
            PG8_WAIT_L(8); PG8_BAR; PG8_WAIT_L(0); PG8_MMA(0, 0, At, B0); PG8_BAR; PG8_SCHED;
            PG8_LDB(B1, 0, 1); PG8_STAGE(PG8_SB(0, 0), b2, voffB);
            PG8_BAR; PG8_WAIT_L(0); PG8_MMA(0, 1, At, B1); PG8_BAR;
            PG8_LDA(At, 0, 1); PG8_STAGE(PG8_SA(0, 0), a2, voffA);
            PG8_BAR; PG8_WAIT_L(0); PG8_MMA(1, 0, At, B0); PG8_BAR; PG8_SCHED;
            PG8_STAGE(PG8_SB(0, 1), b2 + hstep, voffB);
            PG8_WAIT_V(6); PG8_BAR; PG8_MMA(1, 1, At, B1); PG8_BAR;
            PG8_LDB(B0, 1, 0); PG8_SCHED; PG8_LDA(At, 1, 0); PG8_STAGE(PG8_SA(0, 1), a2 + hstep, voffA);
            PG8_WAIT_L(8); PG8_BAR; PG8_WAIT_L(0); PG8_MMA(0, 0, At, B0); PG8_BAR; PG8_SCHED;
            PG8_LDB(B1, 1, 1); PG8_STAGE(PG8_SB(1, 0), b3, voffB);
            PG8_BAR; PG8_WAIT_L(0); PG8_MMA(0, 1, At, B1); PG8_BAR;
            PG8_LDA(At, 1, 1); PG8_STAGE(PG8_SA(1, 0), a3, voffA);
            PG8_BAR; PG8_WAIT_L(0); PG8_MMA(1, 0, At, B0); PG8_BAR; PG8_SCHED;
            PG8_STAGE(PG8_SB(1, 1), b3 + hstep, voffB);
            PG8_WAIT_V(6); PG8_BAR; PG8_MMA(1, 1, At, B1); PG8_BAR;
        }
        if constexpr (!Epi::AFTER_DRAIN) { E(acc, cur, wr, wc, fr, fq); S.done(cur); }
        if (!has_next) break;
#pragma unroll
        for (int a = 0; a < 2; ++a)
#pragma unroll
            for (int b = 0; b < 2; ++b)
#pragma unroll
                for (int m = 0; m < 4; ++m)
#pragma unroll
                    for (int n = 0; n < 2; ++n) acc[a][b][m][n] = (f32x4){0.f, 0.f, 0.f, 0.f};
        cur = nxt; cA = nA; cB = nB; ++ui;
    }
    PG8_WAIT_V(0);
    if (wr == 0) PG8_BAR;
    PG8_BAR;
    if constexpr (Epi::AFTER_DRAIN) { E.fused(acc, cur, wr, wc, fr, fq, lds, wid, lane); S.done(cur); }
#undef PG8_SA
#undef PG8_SB
#undef PG8_STAGE
#undef PG8_LDA
#undef PG8_LDB
#undef PG8_MMA
#undef PG8_WAIT_V
#undef PG8_WAIT_L
#undef PG8_BAR
#undef PG8_SCHED
}
}


struct PEpiOddIn {
  static constexpr bool PERM = true, AFTER_DRAIN = false;
  OddBufs o;
  __device__ __forceinline__ void operator()(const pg8::f32x4 (&acc)[2][2][4][2], const pg8::Unit& u, int wr, int wc, int fr, int fq) const {
    const bool isg = u.pn >= 4;
    bf16_t* dst = isg ? o.sg : o.xr;
    const int colt = (u.pn & 3) * 256 + wc * 32 + 8 * fq;
    const int row0 = u.pm * 256 + wr * 64 + fr;
#pragma unroll
    for (int ai = 0; ai < 2; ++ai)
#pragma unroll
      for (int m = 0; m < 4; ++m) {
        bf16_t* rowp = dst + (size_t)(row0 + ai * 128 + m * 16) * 1024 + colt;
#pragma unroll
        for (int bj = 0; bj < 2; ++bj) {
          pg8::f32x4 v0 = acc[ai][bj][m][0], v1 = acc[ai][bj][m][1];
          if (isg) {
            const f32x2p a0 = silu_pk((f32x2p){v0[0], v0[1]}), a1 = silu_pk((f32x2p){v0[2], v0[3]});
            const f32x2p b0 = silu_pk((f32x2p){v1[0], v1[1]}), b1 = silu_pk((f32x2p){v1[2], v1[3]});
            v0[0] = a0.x; v0[1] = a0.y; v0[2] = a1.x; v0[3] = a1.y;
            v1[0] = b0.x; v1[1] = b0.y; v1[2] = b1.x; v1[3] = b1.y;
          }
          u32x4 pk;
          pk.x = pack2(v0[0], v0[1]); pk.y = pack2(v0[2], v0[3]);
          pk.z = pack2(v1[0], v1[1]); pk.w = pack2(v1[2], v1[3]);
          *(u32x4*)(rowp + bj * 128) = pk;
        }
      }
  }
};

struct PEpiOut {
  static constexpr bool PERM = false, AFTER_DRAIN = false;
  float* xbuf;
  const float* xin_lat;
  const float* xin_ctx;
  const float* mods_l;
  float* part;
  int split;
  __device__ __forceinline__ void operator()(const pg8::f32x4 (&acc)[2][2][4][2], const pg8::Unit& u, int wr, int wc, int fr, int fq) const {
    if (split) {
      float* pb = part + ((size_t)(u.ko >> 8) * NC + (size_t)(u.pm * 256 - NL + wr * 64 + fr)) * 1024 + u.pn * 256 + wc * 32 + 4 * fq;
#pragma unroll
      for (int ai = 0; ai < 2; ++ai)
#pragma unroll
        for (int m = 0; m < 4; ++m)
#pragma unroll
          for (int bj = 0; bj < 2; ++bj)
#pragma unroll
            for (int n = 0; n < 2; ++n) *(pg8::f32x4*)(pb + (size_t)(ai * 128 + m * 16) * 1024 + bj * 128 + n * 16) = acc[ai][bj][m][n];
      return;
    }
    const bool lat = u.pm < (NL / 256);
    const int bidx = lat ? (u.pm >> 4) : 8;
    const float* gate = mods_l + (size_t)bidx * 3072 + 2048;
    const float* xin = lat ? xin_lat : xin_ctx;
    const int rsub = lat ? 0 : NL;
    const int row0 = u.pm * 256 + wr * 64 + fr, col0 = u.pn * 256 + wc * 32 + 4 * fq;
    pg8::f32x4 gv[2][2];
#pragma unroll
    for (int bj = 0; bj < 2; ++bj)
#pragma unroll
      for (int n = 0; n < 2; ++n) gv[bj][n] = *(const pg8::f32x4*)(gate + col0 + bj * 128 + n * 16);
#pragma unroll
    for (int ai = 0; ai < 2; ++ai)
#pragma unroll
      for (int m = 0; m < 4; ++m) {
        const int row = row0 + ai * 128 + m * 16;
        const float* xr = xin + (size_t)(row - rsub) * 1024 + col0;
        float* xo = xbuf + (size_t)row * 1024 + col0;
#pragma unroll
        for (int bj = 0; bj < 2; ++bj)
#pragma unroll
          for (int n = 0; n < 2; ++n) {
            const pg8::f32x4 xv = *(const pg8::f32x4*)(xr + bj * 128 + n * 16);
            *(pg8::f32x4*)(xo + bj * 128 + n * 16) = xv + gv[bj][n] * acc[ai][bj][m][n];
          }
      }
  }
};

struct PEpiEvenIn {
  static constexpr bool PERM = true, AFTER_DRAIN = false;
  EvenBufs e;
  __device__ __forceinline__ void operator()(const pg8::f32x4 (&acc)[2][2][4][2], const pg8::Unit& u, int wr, int wc, int fr, int fq) const {
    const int row0 = u.pm * 256 + wr * 64 + fr;
    const bool latent = u.pm < (NL / 256);
    const int cw = wc * 32 + 8 * fq;
#pragma unroll
    for (int bj = 0; bj < 2; ++bj) {
      const int cbase = u.pn * 256 + bj * 128;
      if (cbase < 1536 || cbase >= 2304) {
        bf16_t* dst;
        int c0, mode;
        if (cbase < 512) { dst = e.ug; c0 = cbase; mode = 0; }
        else if (cbase < 1024) { dst = e.vg; c0 = cbase - 512; mode = 0; }
        else if (cbase < 1536) { dst = e.gas; c0 = cbase - 1024; mode = 1; }
        else { dst = e.gbs; c0 = cbase - 2304; mode = 1; }
#pragma unroll
        for (int ai = 0; ai < 2; ++ai)
#pragma unroll
          for (int m = 0; m < 4; ++m) {
            const int row = row0 + ai * 128 + m * 16;
            pg8::f32x4 v0 = acc[ai][bj][m][0], v1 = acc[ai][bj][m][1];
            {
              f32x2p a0 = {v0[0], v0[1]}, a1 = {v0[2], v0[3]}, b0 = {v1[0], v1[1]}, b1 = {v1[2], v1[3]};
              if (mode) { a0 = silu_pk(a0); a1 = silu_pk(a1); b0 = silu_pk(b0); b1 = silu_pk(b1); }
              else { a0 = gelu_pk(a0); a1 = gelu_pk(a1); b0 = gelu_pk(b0); b1 = gelu_pk(b1); }
              v0[0] = a0.x; v0[1] = a0.y; v0[2] = a1.x; v0[3] = a1.y;
              v1[0] = b0.x; v1[1] = b0.y; v1[2] = b1.x; v1[3] = b1.y;
            }
            u32x4 pk;
            pk.x = pack2(v0[0], v0[1]); pk.y = pack2(v0[2], v0[3]);
            pk.z = pack2(v1[0], v1[1]); pk.w = pack2(v1[2], v1[3]);
            *(u32x4*)(dst + (size_t)row * 512 + c0 + cw) = pk;
          }
      } else if (cbase < 2176) {
        const bool isq = cbase < 2048;
        bf16_t* dst = isq ? e.qb : e.kb;
        const int ld = isq ? 512 : 128;
        const int hb = (isq ? cbase - 1536 : cbase - 2048) + (cw & 64);
        const float scale = isq ? (0.125f * 1.4426950408889634f) : 1.f;
        const int i4 = ((cw & 63) >> 3) * 4;
        const bool rowaxis = i4 < 16;
        float invf[4];
#pragma unroll
        for (int q = 0; q < 4; ++q) invf[q] = exp2f(-(float)((i4 + q) & 15) * 0.8304820237218406f);
#pragma unroll
        for (int ai = 0; ai < 2; ++ai)
#pragma unroll
          for (int m = 0; m < 4; ++m) {
            const int row = row0 + ai * 128 + m * 16;
            const pg8::f32x4 x1 = acc[ai][bj][m][0], x2 = acc[ai][bj][m][1];
            float o1[4], o2[4];
            const int t = row & (SEQL - 1);
            const float pos = (float)(rowaxis ? (t >> 6) : (t & 63));
#pragma unroll
            for (int q = 0; q < 4; ++q) {
              float a = x1[q], bq = x2[q];
              if (latent) {
                const float ang = pos * invf[q];
                const float cs = __cosf(ang), sn = __sinf(ang);
                a = x1[q] * cs - x2[q] * sn;
                bq = x2[q] * cs + x1[q] * sn;
              }
              o1[q] = a * scale;
              o2[q] = bq * scale;
            }
            u32x2 p1, p2;
            p1.x = pack2(o1[0], o1[1]); p1.y = pack2(o1[2], o1[3]);
            p2.x = pack2(o2[0], o2[1]); p2.y = pack2(o2[2], o2[3]);
            bf16_t* rp = dst + (size_t)row * ld + hb + i4;
            *(u32x2*)(rp) = p1;
            *(u32x2*)(rp + 32) = p2;
          }
      } else {
        const int kvh = cw >> 6, dd0 = cw & 63;
#pragma unroll
        for (int ai = 0; ai < 2; ++ai)
#pragma unroll
          for (int m = 0; m < 4; ++m) {
            const int row = row0 + ai * 128 + m * 16;
            bf16_t* base;
            int ldt;
            if (latent) {
              const int b = row >> 12, t = row & (SEQL - 1);
              base = e.vtl + ((size_t)((b * 2 + kvh) * 64 + dd0)) * SEQL + t;
              ldt = SEQL;
            } else {
              const int rr = row - NL;
              const int b = rr >> 8, t = rr & (LCTX - 1);
              base = e.vtc + ((size_t)((b * 2 + kvh) * 64 + dd0)) * LCTX + t;
              ldt = LCTX;
            }
#pragma unroll
            for (int n = 0; n < 2; ++n)
#pragma unroll
              for (int q = 0; q < 4; ++q) base[(size_t)(4 * n + q) * ldt] = f2bf(acc[ai][bj][m][n][q]);
          }
      }
    }
  }
};
constexpr int AS = 72;

__device__ void attn_item(const Params& p, const EvenBufs& e, int item, char* smem, int ei) {
  bf16_t* Ks = (bf16_t*)smem;
  bf16_t* Vs = Ks + 64 * AS;
  const int tid = otid(), lane = tid & 63, w = __builtin_amdgcn_readfirstlane(tid >> 6);
  const int r = lane & 31, h = lane >> 5;
  int b, hq, start, R0;
  bool isctx;
  if (item < 2048) {
    b = item >> 8;
    hq = (item >> 5) & 7;
    const int qblk = item & 31;
    start = qblk * 128;
    R0 = b * SEQL + start;
    isctx = false;
  } else {
    const int it = item - 2048;
    b = it >> 4;
    hq = (it >> 1) & 7;
    start = (it & 1) * 128;
    R0 = NL + b * LCTX + start;
    isctx = true;
  }
  const int kvh = hq >> 2;
  const int qrow = R0 + w * 32 + r;
  bf16x8 qf[4];
#pragma unroll
  for (int s = 0; s < 4; ++s) qf[s] = *(const bf16x8*)(e.qb + (size_t)qrow * 512 + hq * 64 + s * 16 + h * 8);
  float m = p.b_sink[ei * 8 + hq] * 1.4426950408889634f, l = 1.f;
  u32x2 gpre[2][4];
#pragma unroll
  for (int dt = 0; dt < 2; ++dt)
#pragma unroll
    for (int q4 = 0; q4 < 4; ++q4) gpre[dt][q4] = *(const u32x2*)(e.gbs + (size_t)qrow * 512 + hq * 64 + dt * 32 + 8 * q4 + 4 * h);
  f32x16 o[2];
  o[0] = zero16();
  o[1] = zero16();
  const int nblk = isctx ? 4 : 10;
  auto kb_desc = [&](int kb, const bf16_t*& kp, const bf16_t*& vp, int& vstride, int& kpos0, bool& local) -> bool {
    if (kb < 4) {
      kp = e.kb + (size_t)(NL + b * LCTX + kb * 64) * 128 + kvh * 64;
      vp = e.vtc + (size_t)((b * 2 + kvh) * 64) * LCTX + kb * 64;
      vstride = LCTX; kpos0 = 0; local = false;
      return true;
    }
    kpos0 = start - 128 + (kb - 4) * 64;
    local = true;
    if (kpos0 < 0 || kpos0 >= SEQL) return false;
    kp = e.kb + (size_t)(b * SEQL + kpos0) * 128 + kvh * 64;
    vp = e.vtl + (size_t)((b * 2 + kvh) * 64) * SEQL + kpos0;
    vstride = SEQL;
    return true;
  };
  const int lr0 = tid >> 3, lc0 = tid & 7;
  u32x4 pk0, pk1, pv0, pv1;
  {
    const bf16_t *kp, *vp; int vs, kp0; bool lc;
    kb_desc(0, kp, vp, vs, kp0, lc);
    pk0 = *(const u32x4*)(kp + (size_t)lr0 * 128 + lc0 * 8);
    pk1 = *(const u32x4*)(kp + (size_t)(lr0 + 32) * 128 + lc0 * 8);
    pv0 = *(const u32x4*)(vp + (size_t)lr0 * vs + lc0 * 8);
    pv1 = *(const u32x4*)(vp + (size_t)(lr0 + 32) * vs + lc0 * 8);
  }
  for (int kb = 0; kb < nblk; ++kb) {
    int kpos0 = 0;
    bool local = false;
    bool valid;
    {
      const bf16_t *kp, *vp; int vs;
      valid = kb_desc(kb, kp, vp, vs, kpos0, local);
    }
    __syncthreads();
    if (valid) {
      *(u32x4*)(Ks + lr0 * AS + lc0 * 8) = pk0;
      *(u32x4*)(Ks + (lr0 + 32) * AS + lc0 * 8) = pk1;
      *(u32x4*)(Vs + lr0 * AS + lc0 * 8) = pv0;
      *(u32x4*)(Vs + (lr0 + 32) * AS + lc0 * 8) = pv1;
    }
    __syncthreads();
    if (kb + 1 < nblk) {
      const bf16_t *kp = nullptr, *vp = nullptr; int vs = 0, kp0; bool lc;
      if (kb_desc(kb + 1, kp, vp, vs, kp0, lc)) {
        pk0 = *(const u32x4*)(kp + (size_t)lr0 * 128 + lc0 * 8);
        pk1 = *(const u32x4*)(kp + (size_t)(lr0 + 32) * 128 + lc0 * 8);
        pv0 = *(const u32x4*)(vp + (size_t)lr0 * vs + lc0 * 8);
        pv1 = *(const u32x4*)(vp + (size_t)(lr0 + 32) * vs + lc0 * 8);
      }
    }
    if (!valid) continue;
    if (local) {
      const int qmin = start + w * 32;
      if (kpos0 > qmin + 31 + 128 || kpos0 + 63 < qmin - 128) continue;
    }
    f32x16 s[2];
#pragma unroll
    for (int kt = 0; kt < 2; ++kt) {
      s[kt] = zero16();
#pragma unroll
      for (int ks = 0; ks < 4; ++ks) {
        bf16x8 a = *(const bf16x8*)(Ks + (kt * 32 + r) * AS + ks * 16 + h * 8);
        s[kt] = __builtin_amdgcn_mfma_f32_32x32x16_bf16(a, qf[ks], s[kt], 0, 0, 0);
      }
    }
    if (local) {
      const int qmin = start + w * 32;
      const bool interior = (kpos0 >= qmin + 31 - 128) && (kpos0 + 63 <= qmin + 128);
      if (!interior) {
        const int dqp = (start + w * 32 + r) - kpos0 - 4 * h + 128;
#pragma unroll
        for (int kt = 0; kt < 2; ++kt)
#pragma unroll
          for (int reg = 0; reg < 16; ++reg) {
            const int d = dqp - (kt * 32 + (reg & 3) + 8 * (reg >> 2));
            if ((unsigned)d > 256u) s[kt][reg] = -1e30f;
          }
      }
    }
    float mx = m;
#pragma unroll
    for (int kt = 0; kt < 2; ++kt)
#pragma unroll
      for (int reg = 0; reg < 16; reg += 2) mx = fmaxf(fmaxf(mx, s[kt][reg]), s[kt][reg + 1]);
    mx = fmaxf(mx, __shfl_xor(mx, 32));
    const bool grew = __any(mx > m) != 0;
    float rs = 0.f;
#pragma unroll
    for (int kt = 0; kt < 2; ++kt)
#pragma unroll
      for (int reg = 0; reg < 16; ++reg) {
        const float pv = __builtin_amdgcn_exp2f(s[kt][reg] - mx);
        rs += pv;
        s[kt][reg] = pv;
      }
    rs += __shfl_xor(rs, 32);
    if (grew) {
      const float alpha = __builtin_amdgcn_exp2f(m - mx);
      m = mx;
      l = l * alpha + rs;
#pragma unroll
      for (int dt = 0; dt < 2; ++dt)
#pragma unroll
        for (int reg = 0; reg < 16; ++reg) o[dt][reg] *= alpha;
    } else {
      l += rs;
    }
#pragma unroll
    for (int kt = 0; kt < 2; ++kt)
#pragma unroll
      for (int sp = 0; sp < 2; ++sp) {
        union { bf16x8 v; uint32_t u[4]; } pf;
#pragma unroll
        for (int j = 0; j < 4; ++j) pf.u[j] = pack2(s[kt][8 * sp + 2 * j], s[kt][8 * sp + 2 * j + 1]);
#pragma unroll
        for (int dt = 0; dt < 2; ++dt) {
          const bf16_t* vp = Vs + (dt * 32 + r) * AS + kt * 32 + sp * 16 + 4 * h;
          union { bf16x8 v; u32x2 u[2]; } af;
          af.u[0] = *(const u32x2*)(vp);
          af.u[1] = *(const u32x2*)(vp + 8);
          o[dt] = __builtin_amdgcn_mfma_f32_32x32x16_bf16(af.v, pf.v, o[dt], 0, 0, 0);
        }
      }
  }
  const float inv = 1.f / l;
  bf16_t* ymix = p.hbuf;
#pragma unroll
  for (int dt = 0; dt < 2; ++dt)
#pragma unroll
    for (int q4 = 0; q4 < 4; ++q4) {
      const int d0 = dt * 32 + 8 * q4 + 4 * h;
      const u32x2 g = gpre[dt][q4];
      u32x2 pk;
      pk.x = pack2(o[dt][q4 * 4 + 0] * inv * lo_bf(g.x), o[dt][q4 * 4 + 1] * inv * hi_bf(g.x));
      pk.y = pack2(o[dt][q4 * 4 + 2] * inv * lo_bf(g.y), o[dt][q4 * 4 + 3] * inv * hi_bf(g.y));
      *(u32x2*)(ymix + (size_t)qrow * 1024 + 512 + hq * 64 + d0) = pk;
    }
}

constexpr int MS = 136;

__device__ void gmlp_item(const Params& p, const EvenBufs& e, int item, char* smem, int ei) {
  bf16_t* Ws = (bf16_t*)smem;
  bf16_t* VT = Ws + 128 * MS;
  const int tid = otid(), lane = tid & 63, w = __builtin_amdgcn_readfirstlane(tid >> 6);
  const int r = lane & 31, h = lane >> 5;
  const int wm = w >> 1, wn = w & 1;
  const int rt = item >> 2, g = item & 3;
  const int R0 = rt * 128;
  u32x4 wreg[8], vreg[2][4];
  {
    const bf16_t* wsrc = p.wsb + (size_t)(ei * 4 + g) * 128 * 128;
#pragma unroll
    for (int i = 0; i < 8; ++i) {
      const int idx = tid + 256 * i;
      wreg[i] = *(const u32x4*)(wsrc + (idx >> 4) * 128 + (idx & 15) * 8);
    }
#pragma unroll
    for (int hp = 0; hp < 2; ++hp) {
      const bf16_t* vsrc = e.vg + (size_t)(R0 + hp * 64 + (tid >> 2)) * 512 + g * 128 + (tid & 3) * 32;
#pragma unroll
      for (int i = 0; i < 4; ++i) vreg[hp][i] = *(const u32x4*)(vsrc + i * 8);
    }
  }
  __syncthreads();
#pragma unroll
  for (int i = 0; i < 8; ++i) {
    const int idx = tid + 256 * i;
    *(u32x4*)(Ws + (idx >> 4) * MS + (idx & 15) * 8) = wreg[i];
  }
#pragma unroll
  for (int hp = 0; hp < 2; ++hp) {
    const int q = hp * 64 + (tid >> 2), qt = tid & 3;
    float xv[32];
#pragma unroll
    for (int i = 0; i < 4; ++i) {
      const u32x4 u = vreg[hp][i];
      xv[i * 8 + 0] = lo_bf(u.x); xv[i * 8 + 1] = hi_bf(u.x);
      xv[i * 8 + 2] = lo_bf(u.y); xv[i * 8 + 3] = hi_bf(u.y);
      xv[i * 8 + 4] = lo_bf(u.z); xv[i * 8 + 5] = hi_bf(u.z);
      xv[i * 8 + 6] = lo_bf(u.w); xv[i * 8 + 7] = hi_bf(u.w);
    }
    float sm = 0.f;
#pragma unroll
    for (int j = 0; j < 32; ++j) sm += xv[j];
    sm += __shfl_xor(sm, 1);
    sm += __shfl_xor(sm, 2);
    const float mean = sm * (1.f / 128.f);
    float sq = 0.f;
#pragma unroll
    for (int j = 0; j < 32; ++j) { float dlt = xv[j] - mean; sq += dlt * dlt; }
    sq += __shfl_xor(sq, 1);
    sq += __shfl_xor(sq, 2);
    const float rstd = rsqrtf(sq * (1.f / 128.f) + 1e-6f);
    bf16_t* vdst = VT + (qt * 32) * MS + (q ^ (16 * qt));
#pragma unroll
    for (int j = 0; j < 32; ++j) vdst[j * MS] = f2bf((xv[j] - mean) * rstd);
  }
  __syncthreads();
  u32x2 upre[2][2][4], gapre[2][2][4];
#pragma unroll
  for (int mi = 0; mi < 2; ++mi)
#pragma unroll
    for (int ni = 0; ni < 2; ++ni)
#pragma unroll
      for (int q4 = 0; q4 < 4; ++q4) {
        const size_t off = (size_t)(R0 + wm * 64 + mi * 32 + r) * 512 + g * 128 + wn * 64 + ni * 32 + 8 * q4 + 4 * h;
        upre[mi][ni][q4] = *(const u32x2*)(e.ug + off);
        gapre[mi][ni][q4] = *(const u32x2*)(e.gas + off);
      }
  float4 lgpre[2][4], lbpre[2][4];
  float bspre[2], wspre[2];
#pragma unroll
  for (int ni = 0; ni < 2; ++ni)
#pragma unroll
    for (int q4 = 0; q4 < 4; ++q4) {
      const int d0p = wn * 64 + ni * 32 + 8 * q4 + 4 * h;
      lgpre[ni][q4] = *(const float4*)(p.a_ln_g + ei * 512 + g * 128 + d0p);
      lbpre[ni][q4] = *(const float4*)(p.a_ln_b + ei * 512 + g * 128 + d0p);
    }
#pragma unroll
  for (int mi = 0; mi < 2; ++mi) {
    bspre[mi] = p.a_b_s[(ei * 4 + g) * 128 + wm * 64 + mi * 32 + r];
    wspre[mi] = p.wsum[(ei * 4 + g) * 128 + wm * 64 + mi * 32 + r];
  }
  f32x16 acc[2][2];
#pragma unroll
  for (int ni = 0; ni < 2; ++ni)
#pragma unroll
    for (int mi = 0; mi < 2; ++mi) acc[ni][mi] = zero16();
  const bf16_t* Aw = Ws + (wm * 64 + r) * MS + h * 8;
  const bf16_t* Bw = VT + (wn * 64 + r) * MS;
  const int sw0 = 16 * ((wn * 2) & 3), sw1 = 16 * ((wn * 2 + 1) & 3);
#pragma unroll
  for (int ks = 0; ks < 8; ++ks) {
    bf16x8 a0 = *(const bf16x8*)(Aw + ks * 16);
    bf16x8 a1 = *(const bf16x8*)(Aw + 32 * MS + ks * 16);
    bf16x8 b0 = *(const bf16x8*)(Bw + ((ks * 16 + h * 8) ^ sw0));
    bf16x8 b1 = *(const bf16x8*)(Bw + 32 * MS + ((ks * 16 + h * 8) ^ sw1));
    acc[0][0] = __builtin_amdgcn_mfma_f32_32x32x16_bf16(b0, a0, acc[0][0], 0, 0, 0);
    acc[0][1] = __builtin_amdgcn_mfma_f32_32x32x16_bf16(b0, a1, acc[0][1], 0, 0, 0);
    acc[1][0] = __builtin_amdgcn_mfma_f32_32x32x16_bf16(b1, a0, acc[1][0], 0, 0, 0);
    acc[1][1] = __builtin_amdgcn_mfma_f32_32x32x16_bf16(b1, a1, acc[1][1], 0, 0, 0);
  }
  bf16_t* ymix = p.hbuf;
  const float* bs = p.a_b_s + (ei * 4 + g) * 128;
  const float* wsm = p.wsum + (ei * 4 + g) * 128;
  const float* lgp = p.a_ln_g + ei * 512 + g * 128;
  const float* lbp = p.a_ln_b + ei * 512 + g * 128;
#pragma unroll
  for (int mi = 0; mi < 2; ++mi) {
    const int prow = wm * 64 + mi * 32 + r;
    const float bsv = bspre[mi], wsv = wspre[mi];
    const size_t row = (size_t)(R0 + prow);
#pragma unroll
    for (int ni = 0; ni < 2; ++ni)
#pragma unroll
      for (int q4 = 0; q4 < 4; ++q4) {
        const int d0 = wn * 64 + ni * 32 + 8 * q4 + 4 * h;
        const float4 lg = lgpre[ni][q4];
        const float4 lb = lbpre[ni][q4];
        const u32x2 uu = upre[mi][ni][q4];
        const u32x2 gg = gapre[mi][ni][q4];
        const float s0 = lg.x * acc[ni][mi][q4 * 4 + 0] + (lb.x * wsv + bsv);
        const float s1 = lg.y * acc[ni][mi][q4 * 4 + 1] + (lb.y * wsv + bsv);
        const float s2 = lg.z * acc[ni][mi][q4 * 4 + 2] + (lb.z * wsv + bsv);
        const float s3 = lg.w * acc[ni][mi][q4 * 4 + 3] + (lb.w * wsv + bsv);
        u32x2 pk;
        pk.x = pack2(lo_bf(uu.x) * s0 * lo_bf(gg.x), hi_bf(uu.x) * s1 * hi_bf(gg.x));
        pk.y = pack2(lo_bf(uu.y) * s2 * lo_bf(gg.y), hi_bf(uu.y) * s3 * hi_bf(gg.y));
        *(u32x2*)(ymix + row * 1024 + g * 128 + d0) = pk;
      }
  }
}

__device__ void phase_even_mix(const Params& p, char* smem, int ei) {
  const EvenBufs e = even_bufs(p);
  const int n_attn = 2048 + 128, n_gmlp = 1088;
  for (int item = vblk(); item < n_attn + n_gmlp; item += nvblk()) {
    if (item < n_attn) attn_item(p, e, item, smem, ei);
    else gmlp_item(p, e, item - n_attn, smem, ei);
  }
}

__device__ void phase_conv(const Params& p, int oi) {
  const OddBufs ob = odd_bufs(p);
  const bf16_t* xr = ob.xr;
  bf16_t* zb = ob.sg + (size_t)NR * 1024;
  const int tid = ofull();
  const int total = (NR / 8) * 128;
  const int chb = ((blockIdx.x * NTHREADS + tid) & 127) * 8;
    float cw[4][8], cbias[8];
#pragma unroll
    for (int j = 0; j < 4; ++j) {
      const float4 w0 = *(const float4*)(p.c_conv_w + ((size_t)oi * 4 + j) * 1024 + chb);
      const float4 w1 = *(const float4*)(p.c_conv_w + ((size_t)oi * 4 + j) * 1024 + chb + 4);
      cw[j][0] = w0.x; cw[j][1] = w0.y; cw[j][2] = w0.z; cw[j][3] = w0.w;
      cw[j][4] = w1.x; cw[j][5] = w1.y; cw[j][6] = w1.z; cw[j][7] = w1.w;
    }
    {
      const float4 b0 = *(const float4*)(p.c_conv_b + oi * 1024 + chb);
      const float4 b1 = *(const float4*)(p.c_conv_b + oi * 1024 + chb + 4);
      cbias[0] = b0.x; cbias[1] = b0.y; cbias[2] = b0.z; cbias[3] = b0.w;
      cbias[4] = b1.x; cbias[5] = b1.y; cbias[6] = b1.z; cbias[7] = b1.w;
    }
  auto load_rows = [&](int id, u32x4 (&raw)[11]) {
    const int R0 = (id >> 7) * 8;
    int t0, Ls;
    if (R0 < NL) { t0 = R0 & (SEQL - 1); Ls = SEQL; } else { t0 = (R0 - NL) & (LCTX - 1); Ls = LCTX; }
#pragma unroll
    for (int jj = 0; jj < 11; ++jj) {
      const int t = t0 - 2 + jj;
      raw[jj] = (u32x4){0u, 0u, 0u, 0u};
      if (t >= 0 && t < Ls) raw[jj] = *(const u32x4*)(xr + (size_t)(R0 - 2 + jj) * 1024 + chb);
    }
  };
  const int id0 = blockIdx.x * NTHREADS + tid, idstep = gridDim.x * NTHREADS;
  u32x4 cur[11];
  if (id0 < total) load_rows(id0, cur);
  for (int id = id0; id < total; id += idstep) {
    const int R0 = (id >> 7) * 8;
    u32x4 nxt[11];
    const bool more = id + idstep < total;
    if (more) load_rows(id + idstep, nxt);
    float xw[11][8];
#pragma unroll
    for (int jj = 0; jj < 11; ++jj) {
      const u32x4 u = cur[jj];
      xw[jj][0] = lo_bf(u.x); xw[jj][1] = hi_bf(u.x);
      xw[jj][2] = lo_bf(u.y); xw[jj][3] = hi_bf(u.y);
      xw[jj][4] = lo_bf(u.z); xw[jj][5] = hi_bf(u.z);
      xw[jj][6] = lo_bf(u.w); xw[jj][7] = hi_bf(u.w);
    }
#pragma unroll
    for (int i = 0; i < 8; ++i) {
      float z[8];
#pragma unroll
      for (int e2 = 0; e2 < 8; ++e2) {
        float a = cbias[e2];
#pragma unroll
        for (int j = 0; j < 4; ++j) a += cw[j][e2] * xw[i + j][e2];
        z[e2] = a;
      }
      u32x4 pk;
      pk.x = pack2(z[0], z[1]); pk.y = pack2(z[2], z[3]);
      pk.z = pack2(z[4], z[5]); pk.w = pack2(z[6], z[7]);
      *(u32x4*)(zb + (size_t)(R0 + i) * 1024 + chb) = pk;
    }
    if (more) {
#pragma unroll
      for (int jj = 0; jj < 11; ++jj) cur[jj] = nxt[jj];
    }
  }
}

constexpr int ZS = 264;

template <int DIR>
__device__ void rglru_item(const Params& p, const OddBufs& ob, int item, char* smem, int oi, bool need_ctx) {
  bf16_t* Zs = (bf16_t*)smem;
  float* segA = (float*)(Zs + 128 * ZS);
  float* segB = segA + 256;
  float* carry = segB + 256;
  constexpr int LT = 132;
  float* La = (float*)Zs;
  float* Gz = La + 32 * LT;
  const int tid = otid(), lane = tid & 63, w = __builtin_amdgcn_readfirstlane(tid >> 6);
  const int r = lane & 31, h = lane >> 5;
  const int wm = w >> 1, wn = w & 1;
  const int b = item >> 6, cs = item & 31;
  constexpr int dir = DIR;
  const int hd = cs >> 3, j0 = (cs & 7) * 32, c0 = cs * 32;
  bf16_t* sout = p.hbuf;
  const bf16_t* zb = ob.sg + (size_t)NR * 1024;
  __syncthreads();
  if (tid < 32) carry[tid] = 0.f;
  bf16x8 bfr[16];
  {
    const size_t mo = ((size_t)((oi * 2 + dir) * 4 + hd)) * 65536 + (size_t)(j0 + r) * 256 + h * 8;
    const bf16_t* wsrc = (wn ? p.wgi : p.wga) + mo;
#pragma unroll
    for (int ks = 0; ks < 16; ++ks) bfr[ks] = *(const bf16x8*)(wsrc + ks * 16);
  }
  const int gch = (oi * 2 + dir) * 1024 + c0 + r;
  const float gbias = wn ? p.c_b_i[gch] : p.c_b_a[gch];
  const float spl = log1pf(__expf(-p.c_lam[gch]));
  const int sc_c = tid & 31, sc_sg = tid >> 5;
  const int lrow = tid >> 5, kc = tid & 31;

  u32x4 zt[4];
  {
    const int Rs0 = NL + b * LCTX;
    const int ti0 = dir ? 1 : 0;
    const bf16_t* src = zb + (size_t)(Rs0 + ti0 * 128 + lrow) * 1024 + hd * 256 + kc * 8;
#pragma unroll
    for (int i = 0; i < 4; ++i) zt[i] = *(const u32x4*)(src + (size_t)i * 8 * 1024);
  }
  const int sbase = DIR ? (7 - sc_sg) * 16 : sc_sg * 16;
  const unsigned voff = (unsigned)(sbase * 1024 + c0 + sc_c);
  for (int step = 0; step < 34; ++step) {
    int Rs, ti;
    bool wr;
    if (step < 2) { Rs = NL + b * LCTX; ti = dir ? 1 - step : step; wr = need_ctx; }
    else { Rs = b * SEQL; ti = dir ? 31 - (step - 2) : (step - 2); wr = true; }
    const int t0 = ti * 128;
    __syncthreads();
    {
      const bf16_t* src2 = zb + (size_t)(Rs + t0 + lrow + 32) * 1024 + hd * 256 + kc * 8;
      u32x4 z2[12];
#pragma unroll
      for (int i = 0; i < 12; ++i) z2[i] = *(const u32x4*)(src2 + (size_t)i * 8 * 1024);
#pragma unroll
      for (int i = 0; i < 4; ++i) *(u32x4*)(Zs + (lrow + 8 * i) * ZS + kc * 8) = zt[i];
#pragma unroll
      for (int i = 0; i < 12; ++i) *(u32x4*)(Zs + (lrow + 32 + 8 * i) * ZS + kc * 8) = z2[i];
    }
    const bf16_t* sgp = ob.sg + (size_t)(Rs + t0) * 1024;
    bf16_t sgv[16];
    const bool later = (step < 2) ? (step == 1) : (DIR ? (ti <= 15) : (ti >= 16));
    const bf16_t* sip = sout + (size_t)(Rs + t0) * 1024;
    bf16_t prv[16];
    if (wr) {
#pragma unroll
      for (int i = 0; i < 16; ++i) sgv[i] = sgp[voff + (DIR ? 15 - i : i) * 1024];
      if (later) {
#pragma unroll
        for (int i = 0; i < 16; ++i) prv[i] = sip[voff + (DIR ? 15 - i : i) * 1024];
      }
    }
    __syncthreads();
    f32x16 acc[2];
    acc[0] = zero16();
    acc[1] = zero16();
    {
      const bf16_t* Aw = Zs + (wm * 64 + r) * ZS + h * 8;
#pragma unroll
      for (int ks = 0; ks < 16; ++ks) {
        bf16x8 a0 = *(const bf16x8*)(Aw + ks * 16);
        bf16x8 a1 = *(const bf16x8*)(Aw + 32 * ZS + ks * 16);
        acc[0] = __builtin_amdgcn_mfma_f32_32x32x16_bf16(a0, bfr[ks], acc[0], 0, 0, 0);
        acc[1] = __builtin_amdgcn_mfma_f32_32x32x16_bf16(a1, bfr[ks], acc[1], 0, 0, 0);
      }
    }
    if (wn == 0) {
#pragma unroll
      for (int mi = 0; mi < 2; ++mi)
#pragma unroll
        for (int reg = 0; reg < 16; ++reg) acc[mi][reg] = -8.f * spl * sigmoid_f(acc[mi][reg] + gbias);
    } else {
#pragma unroll
      for (int mi = 0; mi < 2; ++mi) {
        float zv[16];
#pragma unroll
        for (int reg = 0; reg < 16; ++reg) {
          const int row = wm * 64 + mi * 32 + (reg & 3) + 8 * (reg >> 2) + 4 * h;
          zv[reg] = bf2f(Zs[row * ZS + j0 + r]);
        }
#pragma unroll
        for (int reg = 0; reg < 16; ++reg) acc[mi][reg] = zv[reg] * sigmoid_f(acc[mi][reg] + gbias);
        asm volatile("" ::: "memory");
      }
    }
    __syncthreads();
    {
      float* dstb = (wn ? Gz : La) + r * LT + wm * 64 + 4 * h;
#pragma unroll
      for (int mi = 0; mi < 2; ++mi)
#pragma unroll
        for (int q4 = 0; q4 < 4; ++q4) {
          pg8::f32x4 v4 = {acc[mi][q4 * 4 + 0], acc[mi][q4 * 4 + 1], acc[mi][q4 * 4 + 2], acc[mi][q4 * 4 + 3]};
          *(pg8::f32x4*)(dstb + mi * 32 + 8 * q4) = v4;
        }
    }
    __syncthreads();
    if (step + 1 < 34) {
      const int ns = step + 1;
      int nRs, nti;
      if (ns < 2) { nRs = NL + b * LCTX; nti = dir ? 1 - ns : ns; }
      else { nRs = b * SEQL; nti = dir ? 31 - (ns - 2) : (ns - 2); }
      const bf16_t* src = zb + (size_t)(nRs + nti * 128 + lrow) * 1024 + hd * 256 + kc * 8;
#pragma unroll
      for (int i = 0; i < 4; ++i) zt[i] = *(const u32x4*)(src + (size_t)i * 8 * 1024);
    }
    bf16_t* sop = sout + (size_t)(Rs + t0) * 1024;
    float* Lap = La + sc_c * LT + sbase;
    float* Gzp = Gz + sc_c * LT + sbase;
    {
      pg8::f32x4 va[4], vg[4];
#pragma unroll
      for (int k = 0; k < 4; ++k) { va[k] = *(const pg8::f32x4*)(Lap + 4 * k); vg[k] = *(const pg8::f32x4*)(Gzp + 4 * k); }
      float A = 1.f, Bv = 0.f;
#pragma unroll
      for (int i = 0; i < 16; ++i) {
        const int ro = DIR ? 15 - i : i;
        const float la = va[ro >> 2][ro & 3];
        const float a = __expf(la);
        const float mult = __builtin_amdgcn_sqrtf(fmaf(-a, a, 1.f));
        const float bx = mult * vg[ro >> 2][ro & 3];
        va[ro >> 2][ro & 3] = a;
        vg[ro >> 2][ro & 3] = bx;
        Bv = a * Bv + bx;
        A *= a;
      }
#pragma unroll
      for (int k = 0; k < 4; ++k) { *(pg8::f32x4*)(Lap + 4 * k) = va[k]; *(pg8::f32x4*)(Gzp + 4 * k) = vg[k]; }
      segA[sc_sg * 32 + sc_c] = A;
      segB[sc_sg * 32 + sc_c] = Bv;
    }
    __syncthreads();
    {
      float hh = carry[(step & 1) * 32 + sc_c];
      {
        float sa[7], sbv[7];
#pragma unroll
        for (int s2 = 0; s2 < 7; ++s2) { sa[s2] = segA[s2 * 32 + sc_c]; sbv[s2] = segB[s2 * 32 + sc_c]; }
#pragma unroll
        for (int s2 = 0; s2 < 7; ++s2) hh = (s2 < sc_sg) ? (sa[s2] * hh + sbv[s2]) : hh;
      }
      pg8::f32x4 va[4], vg[4];
#pragma unroll
      for (int k = 0; k < 4; ++k) { va[k] = *(const pg8::f32x4*)(Lap + 4 * k); vg[k] = *(const pg8::f32x4*)(Gzp + 4 * k); }
#pragma unroll
      for (int i = 0; i < 16; ++i) {
        const int ro = (DIR ? 15 - i : i);
        hh = va[ro >> 2][ro & 3] * hh + vg[ro >> 2][ro & 3];
        if (wr) {
          float ov = hh * bf2f(sgv[i]);
          if (later) ov += bf2f(prv[i]);
          sop[voff + ro * 1024] = f2bf(ov);
        }
      }
      if (sc_sg == 7) carry[((step + 1) & 1) * 32 + sc_c] = hh;
    }
  }
}

__device__ void phase_rglru(const Params& p, char* smem, int oi, bool need_ctx) {
  const OddBufs ob = odd_bufs(p);
  const int vb = vbid();
  for (int P0 = blockIdx.x; P0 < 256; P0 += gridDim.x) {
    const int xcd = P0 & 7, slot = P0 >> 3;
    const int grp = xcd * 4 + (slot >> 3), j = slot & 7;
    const int item = ((grp >> 2) << 6) | ((grp & 3) << 3) | j;
    if (vb) rglru_item<1>(p, ob, item, smem, oi, need_ctx);
    else rglru_item<0>(p, ob, item, smem, oi, need_ctx);
  }
}

#define XB_TMO      128
#define XB_XCNT(j)  (256  + 64 * (j))
#define XB_XSUB(j)  (1280 + 64 * (j))
#define XB_XGEN(j)  (2304 + 64 * (j))
#define XB_TOP      3328
#define XB_TOPGEN   3392
#define XCD_BAR_WORDS 3456
#define XB_SPIN_CAP (1u << 18)
#define LAS __attribute__((address_space(3)))

__device__ __forceinline__ unsigned xb_ld(unsigned* p)              { return __hip_atomic_load(p, __ATOMIC_RELAXED, __HIP_MEMORY_SCOPE_AGENT); }
__device__ __forceinline__ unsigned xb_add(unsigned* p, unsigned v) { return __hip_atomic_fetch_add(p, v, __ATOMIC_RELAXED, __HIP_MEMORY_SCOPE_AGENT); }
__device__ __forceinline__ unsigned xb_xcc_id() { return (unsigned)__builtin_amdgcn_s_getreg((3 << 11) | 20) & 0xFu; }
#define XB_SPIN(cond, bar) do { unsigned _sp = 0; while (cond) { __builtin_amdgcn_s_sleep(1); \
    if ((++_sp & 255u) == 0u) { if (xb_ld(&(bar)[XB_TMO])) break; if (_sp > XB_SPIN_CAP) { atomicAdd(&(bar)[XB_TMO], 1u); break; } } } } while (0)

struct XcdBarrier {
    unsigned* bar; unsigned x;
    volatile LAS unsigned* st;
};

__device__ __forceinline__ XcdBarrier xcd_barrier_post(unsigned* bar, volatile LAS unsigned* st) {
    XcdBarrier b; b.bar = bar; b.x = xb_xcc_id(); b.st = st;
    if (threadIdx.x == 0) (void)xb_add(&bar[XB_XCNT(b.x)], 1u);
    return b;
}
__device__ __forceinline__ void xcd_barrier_complete(unsigned* bar, unsigned x, unsigned& nloc, unsigned& nx) {
    const unsigned G = gridDim.x * gridDim.y * gridDim.z;
    unsigned sum, cnt, mine, sp = 0u;
    for (;;) {
        sum = 0u; cnt = 0u; mine = 0u;
#pragma unroll
        for (unsigned j = 0; j < 16; ++j) { const unsigned c = xb_ld(&bar[XB_XCNT(j)]); sum += c; cnt += (c > 0u) ? 1u : 0u; mine = (j == x) ? c : mine; }
        if (sum == G) break;
        __builtin_amdgcn_s_sleep(1);
        if ((++sp & 255u) == 0u) { if (xb_ld(&bar[XB_TMO])) break; if (sp > XB_SPIN_CAP) { atomicAdd(&bar[XB_TMO], 1u); break; } }
    }
    nloc = mine > 0u ? mine : 1u; nx = cnt > 0u ? cnt : 1u;
}

__device__ __forceinline__ void xcd_barrier(const XcdBarrier& b) {
    asm volatile("s_waitcnt vmcnt(0)" ::: "memory");
    __syncthreads();
    if (threadIdx.x == 0) {
        unsigned* bar = b.bar;
        __builtin_amdgcn_s_waitcnt(0);
        unsigned nloc = b.st[0], nx = b.st[1];
        if (nloc == 0u) { xcd_barrier_complete(bar, b.x, nloc, nx); b.st[0] = nloc; b.st[1] = nx; }
        const unsigned old = xb_add(&bar[XB_XSUB(b.x)], 1u);
        const unsigned gen = old / nloc;
        if (old + 1u == (gen + 1u) * nloc) {
            __builtin_amdgcn_fence(__ATOMIC_RELEASE, "agent");
            asm volatile("s_waitcnt vmcnt(0)" ::: "memory");
            const unsigned og = xb_add(&bar[XB_TOP], 1u);
            const unsigned tg = og / nx;
            if (og + 1u == (tg + 1u) * nx) xb_add(&bar[XB_TOPGEN], 1u);
            else XB_SPIN(xb_ld(&bar[XB_TOPGEN]) == tg, bar);
            __builtin_amdgcn_fence(__ATOMIC_ACQUIRE, "agent");
            xb_add(&bar[XB_XGEN(b.x)], 1u);
            asm volatile("s_waitcnt vmcnt(0)" ::: "memory");
        } else {
            XB_SPIN(xb_ld(&bar[XB_XGEN(b.x)]) == gen, bar);
            __builtin_amdgcn_fence(__ATOMIC_ACQUIRE, "agent");
            asm volatile("s_waitcnt vmcnt(0)" ::: "memory");
        }
    }
    __syncthreads();
}


#define LAUNDER(f) q.f = p.f + z
__device__ __forceinline__ void launder(Params& q, const Params& p) {
  long z;
  asm volatile("s_mov_b64 %0, 0" : "=s"(z));
  LAUNDER(x); LAUNDER(c); LAUNDER(ctx); LAUNDER(c_ctx); LAUNDER(norm_g); LAUNDER(w_mod); LAUNDER(b_mod);
  LAUNDER(ab_w_in); LAUNDER(a_ln_g); LAUNDER(a_ln_b); LAUNDER(a_w_s); LAUNDER(a_b_s); LAUNDER(b_sink);
  LAUNDER(ab_w_out); LAUNDER(c_w_in); LAUNDER(c_conv_w); LAUNDER(c_conv_b); LAUNDER(c_w_a); LAUNDER(c_b_a);
  LAUNDER(c_w_i); LAUNDER(c_b_i); LAUNDER(c_lam); LAUNDER(c_w_out); LAUNDER(final_g); LAUNDER(out);
  LAUNDER(xbuf); LAUNDER(mods); LAUNDER(hbuf); LAUNDER(ebuf); LAUNDER(wt_in_e); LAUNDER(wt_out_e);
  LAUNDER(wt_in_o); LAUNDER(wt_out_o); LAUNDER(wga); LAUNDER(wgi); LAUNDER(wsb); LAUNDER(wsum); LAUNDER(part);
}

constexpr int NPHASES = 20;

__device__ void run_phase(const Params& p0, int ph, char* smem, char* dsm) {
  if (ph == 0) { Params p; launder(p, p0); phase0(p, smem); return; }
  if (ph == 19) { Params p; launder(p, p0); phase_final(p); return; }
  int layer, sub;
  if (ph < 5) { layer = 0; sub = ph - 1; }
  else if (ph < 10) { layer = 1; sub = ph - 5; }
  else if (ph < 14) { layer = 2; sub = ph - 10; }
  else { layer = 3; sub = ph - 14; }
  const int idx = layer >> 1;
  const bool even = (layer & 1) == 0;
  const bool need_ctx = layer < 3;
  if (sub == 0) { Params p; launder(p, p0); phase_prep(p, layer); if (layer == 0) phase0_transposes(p, smem); return; }
  if (even) {
    if (sub == 1) {
      Params p; launder(p, p0);
      EpiEvenIn epi; epi.e = even_bufs(p);
      (void)epi;
      PEpiEvenIn pe; pe.e = even_bufs(p);
      pg8::Gemm g; g.A = p.hbuf; g.Bt = p.wt_in_e + (size_t)idx * 2816 * 1024; g.M = NR; g.N = 2816; g.K = 1024;
      pg8::StaticOrder so; so.init(g.M, g.N, (int)gridDim.x, (int)blockIdx.x);
      pg8::gemm_phase((PG8_LAS unsigned char*)dsm, g, so, pe);
    } else if (sub == 2) {
      Params p; launder(p, p0);
      phase_even_mix(p, smem, idx);
    } else {
      Params p; launder(p, p0);
      EpiOut epi; epi.xbuf = p.xbuf; epi.mods_l = p.mods + (size_t)layer * 9 * 3072;
      epi.xin_lat = (layer == 0) ? p.x : p.xbuf;
      epi.xin_ctx = (layer == 0) ? p.ctx : p.xbuf + (size_t)NL * 1024;
      PEpiOut pe; pe.xbuf = epi.xbuf; pe.xin_lat = epi.xin_lat; pe.xin_ctx = epi.xin_ctx; pe.mods_l = epi.mods_l;
      pe.part = p.part;
      pg8::OutOrder oo;
#pragma unroll 1
      for (int pass = 0; pass < 2; ++pass) {
        pg8::Gemm g; g.A = p.hbuf; g.Bt = p.wt_out_e + (size_t)idx * 1024 * 1024; g.M = pass ? NR : NL; g.N = 1024; g.K = pass ? 256 : 1024;
        oo.so.init(NL, 1024, (int)gridDim.x, (int)blockIdx.x); oo.cs.init((int)gridDim.x, (int)blockIdx.x); oo.mode = pass;
        pe.split = pass;
        pg8::gemm_phase((PG8_LAS unsigned char*)dsm, g, oo, pe);
      }
    }
  } else {
    if (sub == 1) {
      Params p; launder(p, p0);
      EpiOddIn epi; epi.o = odd_bufs(p);
      (void)epi;
      PEpiOddIn pe; pe.o = odd_bufs(p);
      pg8::Gemm g; g.A = p.hbuf; g.Bt = p.wt_in_o + (size_t)idx * 2048 * 1024; g.M = NR; g.N = 2048; g.K = 1024;
      pg8::StaticOrder so; so.init(g.M, g.N, (int)gridDim.x, (int)blockIdx.x);
      pg8::gemm_phase((PG8_LAS unsigned char*)dsm, g, so, pe);
    } else if (sub == 2) {
      Params p; launder(p, p0);
      phase_conv(p, idx);
    } else if (sub == 3) {
      Params p; launder(p, p0);
      phase_rglru(p, smem, idx, need_ctx);
    } else {
      Params p; launder(p, p0);
      EpiOut epi; epi.xbuf = p.xbuf; epi.mods_l = p.mods + (size_t)layer * 9 * 3072;
      epi.xin_lat = (layer == 0) ? p.x : p.xbuf;
      epi.xin_ctx = (layer == 0) ? p.ctx : p.xbuf + (size_t)NL * 1024;
      PEpiOut pe; pe.xbuf = epi.xbuf; pe.xin_lat = epi.xin_lat; pe.xin_ctx = epi.xin_ctx; pe.mods_l = epi.mods_l;
      pe.part = p.part;
      pg8::OutOrder oo;
      const int npass = need_ctx ? 2 : 1;
#pragma unroll 1
      for (int pass = 0; pass < npass; ++pass) {
        pg8::Gemm g; g.A = p.hbuf; g.Bt = p.wt_out_o + (size_t)idx * 1024 * 1024; g.M = pass ? NR : NL; g.N = 1024; g.K = pass ? 256 : 1024;
        oo.so.init(NL, 1024, (int)gridDim.x, (int)blockIdx.x); oo.cs.init((int)gridDim.x, (int)blockIdx.x); oo.mode = pass;
        pe.split = pass;
        pg8::gemm_phase((PG8_LAS unsigned char*)dsm, g, oo, pe);
      }
    }
  }
}

__global__ void __launch_bounds__(NTHREADS, 2) mega_kernel(Params p, int ph_lo, int ph_hi, int use_bar) {
  extern __shared__ __attribute__((aligned(16))) char dsm[];
  uint4* xbw = (uint4*)(dsm + 2 * VSMEM);
  if (threadIdx.x == 0) *xbw = make_uint4(0u, 0u, 0u, 0u);
  __syncthreads();
  if (use_bar == 1) (void)xcd_barrier_post(p.bar, (volatile LAS unsigned*)xbw);
  char* smem = dsm + (threadIdx.x >> 8) * VSMEM;
  for (int ph = ph_lo; ph < ph_hi; ++ph) {
    run_phase(p, ph, smem, dsm);
    if (ph + 1 < ph_hi) {
      if (use_bar == 1) {
        XcdBarrier xb;
        xb.bar = p.bar; xb.x = xb_xcc_id(); xb.st = (volatile LAS unsigned*)xbw;
        xcd_barrier(xb);
      } else if (use_bar == 2) cg::this_grid().sync();
    }
  }
}

extern "C" void kernel_launch(void* const* d_in, const int* in_sizes, int n_in, void* d_out, int out_size,
                              void* d_ws, size_t ws_size, hipStream_t stream) {
  static int grid_blocks = 0;
  if (!grid_blocks) {
    int dev = 0, cus = 0, per_cu = 0;
    hipGetDevice(&dev);
    hipDeviceGetAttribute(&cus, hipDeviceAttributeMultiprocessorCount, dev);
    hipFuncSetAttribute((const void*)mega_kernel, hipFuncAttributeMaxDynamicSharedMemorySize, DSM_BYTES);
    hipOccupancyMaxActiveBlocksPerMultiprocessor(&per_cu, mega_kernel, NTHREADS, DSM_BYTES);
    if (per_cu < 1) per_cu = 1;
    if (per_cu > 1) per_cu = 1;
    grid_blocks = cus * per_cu;
  }
  Params p{};
  const float** fp = (const float**)&p;
  for (int i = 0; i < 24; ++i) fp[i] = (const float*)d_in[i];
  p.out = (float*)d_out;
  char* ws = (char*)d_ws;
  size_t off = 0;
  auto take = [&](size_t bytes) { char* q = ws + off; off += (bytes + 255) & ~(size_t)255; return q; };
  p.xbuf = (float*)take((size_t)NR * 1024 * 4);
  p.mods = (float*)take((size_t)4 * 9 * 3072 * 4);
  p.hbuf = (bf16_t*)take((size_t)NR * 1024 * 2);
  p.ebuf = (bf16_t*)take((size_t)NR * 3072 * 2);
  p.wt_in_e = (bf16_t*)take((size_t)2 * 2816 * 1024 * 2);
  p.wt_out_e = (bf16_t*)take((size_t)2 * 1024 * 1024 * 2);
  p.wt_in_o = (bf16_t*)take((size_t)2 * 2048 * 1024 * 2);
  p.wt_out_o = (bf16_t*)take((size_t)2 * 1024 * 1024 * 2);
  p.wga = (bf16_t*)take((size_t)16 * 65536 * 2);
  p.wgi = (bf16_t*)take((size_t)16 * 65536 * 2);
  p.wsb = (bf16_t*)take((size_t)8 * 16384 * 2);
  p.wsum = (float*)take((size_t)8 * 128 * 4);
  p.part = (float*)take((size_t)4 * NC * 1024 * 4);
  p.bar = (unsigned*)take((size_t)XCD_BAR_WORDS * 4);
  if (off > ws_size) fprintf(stderr, "workspace too small: need %zu have %zu\n", off, ws_size);
#if COOP
  hipMemsetAsync(p.bar, 0, (size_t)XCD_BAR_WORDS * 4, stream);
  int lo = 0, hi = NPHASES, ub = 1;
  void* args[] = {&p, &lo, &hi, &ub};
  hipError_t e = hipLaunchCooperativeKernel((void*)mega_kernel, dim3(grid_blocks), dim3(NTHREADS), args, DSM_BYTES, stream);
  if (e != hipSuccess) fprintf(stderr, "cooperative launch failed: %s (grid %d)\n", hipGetErrorString(e), grid_blocks);
#else
  for (int ph = 0; ph < NPHASES; ++ph) mega_kernel<<<grid_blocks, NTHREADS, DSM_BYTES, stream>>>(p, ph, ph + 1, 0);
#endif
}
```

```cpp
#include <hip/hip_runtime.h>
#include <hip/hip_cooperative_groups.h>
#include <stdint.h>
#include <stdio.h>
namespace cg = cooperative_groups;

#ifndef COOP
#define COOP 1
#endif

typedef unsigned short bf16_t;
typedef __attribute__((ext_vector_type(8))) short bf16x8;
typedef __attribute__((ext_vector_type(16))) float f32x16;
typedef __attribute__((ext_vector_type(4))) unsigned int u32x4;
typedef __attribute__((ext_vector_type(2))) unsigned int u32x2;

constexpr int DM = 1024;
constexpr int NBATCH = 8;
constexpr int SEQL = 4096;
constexpr int LCTX = 256;
constexpr int NL = NBATCH * SEQL;
constexpr int NC = NBATCH * LCTX;
constexpr int NR = NL + NC;
constexpr int VSMEM = 72 * 1024;
constexpr int NTHREADS = 512;
constexpr int VTH = 256;
constexpr int DSM_BYTES = 2 * VSMEM + 256;

struct Params {
  const float *x, *c, *ctx, *c_ctx, *norm_g, *w_mod, *b_mod, *ab_w_in, *a_ln_g, *a_ln_b, *a_w_s, *a_b_s,
      *b_sink, *ab_w_out, *c_w_in, *c_conv_w, *c_conv_b, *c_w_a, *c_b_a, *c_w_i, *c_b_i, *c_lam, *c_w_out,
      *final_g;
  float* out;
  float* xbuf;
  float* mods;
  bf16_t* hbuf;
  bf16_t* ebuf;
  bf16_t *wt_in_e, *wt_out_e, *wt_in_o, *wt_out_o, *wga, *wgi;
  bf16_t* wsb;
  float* wsum;
  float* part;
  unsigned* bar;
};

typedef __bf16 hwbf16x2 __attribute__((ext_vector_type(2)));
typedef float f32x2v __attribute__((ext_vector_type(2)));
__device__ __forceinline__ uint32_t pack2(float a, float b) {
  f32x2v v = {a, b};
  hwbf16x2 r = __builtin_convertvector(v, hwbf16x2);
  return __builtin_bit_cast(uint32_t, r);
}
__device__ __forceinline__ bf16_t f2bf(float f) { return (bf16_t)(pack2(f, f) & 0xffffu); }
__device__ __forceinline__ float bf2f(bf16_t b) { return __uint_as_float(((uint32_t)b) << 16); }
__device__ __forceinline__ float lo_bf(uint32_t u) { return __uint_as_float(u << 16); }
__device__ __forceinline__ float hi_bf(uint32_t u) { return __uint_as_float(u & 0xffff0000u); }
__device__ __forceinline__ float frcp(float x) { return __builtin_amdgcn_rcpf(x); }
__device__ __forceinline__ float silu_f(float x) { return x * frcp(1.f + __expf(-x)); }
__device__ __forceinline__ float sigmoid_f(float x) { return frcp(1.f + __expf(-x)); }
__device__ __forceinline__ float gelu_f(float x) {
  float y = 0.7978845608028654f * (x + 0.044715f * x * x * x);
  float t = 1.f - 2.f * frcp(1.f + __expf(2.f * y));
  return 0.5f * x * (1.f + t);
}
typedef float f32x2p __attribute__((ext_vector_type(2)));
__device__ __forceinline__ f32x2p silu_pk(f32x2p x) {
  const f32x2p t = x * (-1.4426950408889634f);
  f32x2p e; e.x = __builtin_amdgcn_exp2f(t.x); e.y = __builtin_amdgcn_exp2f(t.y);
  const f32x2p d = e + 1.0f;
  f32x2p r; r.x = __builtin_amdgcn_rcpf(d.x); r.y = __builtin_amdgcn_rcpf(d.y);
  return x * r;
}
__device__ __forceinline__ f32x2p gelu_pk(f32x2p x) {
  const f32x2p x2 = x * x;
  const f32x2p pz = x2 * (0.044715f * 2.3022082003f) + 2.3022082003f;
  const f32x2p u = x * pz;
  f32x2p e; e.x = __builtin_amdgcn_exp2f(u.x); e.y = __builtin_amdgcn_exp2f(u.y);
  const f32x2p d = e + 1.0f;
  f32x2p r; r.x = __builtin_amdgcn_rcpf(d.x); r.y = __builtin_amdgcn_rcpf(d.y);
  return x - x * r;
}
__device__ __forceinline__ f32x16 zero16() {
  f32x16 z;
#pragma unroll
  for (int i = 0; i < 16; ++i) z[i] = 0.f;
  return z;
}
__device__ __forceinline__ float wave_sum(float v) {
#pragma unroll
  for (int o = 32; o > 0; o >>= 1) v += __shfl_xor(v, o);
  return v;
}

__device__ __forceinline__ int ofull() {
  int t = threadIdx.x;
  asm volatile("" : "+v"(t));
  return t;
}
__device__ __forceinline__ int otid() { return ofull() & (VTH - 1); }
__device__ __forceinline__ int vbid() { return __builtin_amdgcn_readfirstlane(ofull() >> 8); }
__device__ __forceinline__ int vblk() { return (int)blockIdx.x * 2 + vbid(); }
__device__ __forceinline__ int nvblk() { return (int)gridDim.x * 2; }

struct EvenBufs {
  bf16_t *ug, *vg, *gas, *qb, *gbs, *kb, *vtl, *vtc;
};
__device__ __forceinline__ EvenBufs even_bufs(const Params& p) {
  EvenBufs e;
  e.ug = p.ebuf;
  e.vg = e.ug + (size_t)NR * 512;
  e.gas = e.vg + (size_t)NR * 512;
  e.qb = e.gas + (size_t)NR * 512;
  e.gbs = e.qb + (size_t)NR * 512;
  e.kb = e.gbs + (size_t)NR * 512;
  e.vtl = e.kb + (size_t)NR * 128;
  e.vtc = e.vtl + (size_t)NBATCH * 128 * SEQL;
  return e;
}
struct OddBufs {
  bf16_t *xr, *sg, *sb;
};
__device__ __forceinline__ OddBufs odd_bufs(const Params& p) {
  OddBufs o;
  o.xr = p.ebuf;
  o.sg = o.xr + (size_t)NR * 1024;
  o.sb = o.xr;
  return o;
}

struct TrDesc { const float* src; bf16_t* dst; int K, N, k0, n0; bool qk; };
__device__ __forceinline__ TrDesc transpose_desc(const Params& p, int item) {
  TrDesc d;
  int local;
  if (item < 1408) { d.src = p.ab_w_in; d.dst = p.wt_in_e; d.K = 1024; d.N = 2816; local = item; }
  else if (item < 1920) { d.src = p.ab_w_out; d.dst = p.wt_out_e; d.K = 1024; d.N = 1024; local = item - 1408; }
  else if (item < 2944) { d.src = p.c_w_in; d.dst = p.wt_in_o; d.K = 1024; d.N = 2048; local = item - 1920; }
  else if (item < 3456) { d.src = p.c_w_out; d.dst = p.wt_out_o; d.K = 1024; d.N = 1024; local = item - 2944; }
  else if (item < 3712) { d.src = p.c_w_a; d.dst = p.wga; d.K = 256; d.N = 256; local = item - 3456; }
  else { d.src = p.c_w_i; d.dst = p.wgi; d.K = 256; d.N = 256; local = item - 3712; }
  const int ntn = d.N / 64;
  const int tpb = (d.K / 64) * ntn;
  const int bi = local / tpb;
  const int rem = local % tpb;
  d.k0 = (rem / ntn) * 64; d.n0 = (rem % ntn) * 64;
  d.src += (size_t)bi * d.K * d.N;
  d.dst += (size_t)bi * d.K * d.N;
  d.qk = (item < 1408) && d.n0 >= 1536 && d.n0 < 2176;
  return d;
}
__device__ __forceinline__ void transpose_load(const TrDesc& d, int tid, float (&v)[16]) {
#pragma unroll
  for (int i = 0; i < 16; ++i) {
    const int rr = i * 4 + (tid >> 6), cc = tid & 63;
    v[i] = d.src[(size_t)(d.k0 + rr) * d.N + d.n0 + cc];
  }
}
__device__ void transpose_items(const Params& p, int item0, int istep, int iend, char* smem) {
  float* tile = (float*)smem;
  const int tid = otid();
  float cur[16];
  if (item0 < iend) { const TrDesc d0 = transpose_desc(p, item0); transpose_load(d0, tid, cur); }
  for (int item = item0; item < iend; item += istep) {
    const bool more = item + istep < iend;
    float nxt[16];
    if (more) { const TrDesc dn = transpose_desc(p, item + istep); transpose_load(dn, tid, nxt); }
    const TrDesc d = transpose_desc(p, item);
    __syncthreads();
#pragma unroll
    for (int i = 0; i < 16; ++i) tile[(i * 4 + (tid >> 6)) * 65 + (tid & 63)] = cur[i];
    __syncthreads();
#pragma unroll
    for (int i = 0; i < 16; ++i) {
      const int n = i * 4 + (tid >> 6), k = tid & 63;
      const int ns = d.qk ? (((n >> 3) << 2) + (n & 3) + (((n >> 2) & 1) << 5)) : n;
      d.dst[(size_t)(d.n0 + n) * d.K + d.k0 + k] = f2bf(tile[k * 65 + ns]);
    }
    if (more) {
#pragma unroll
      for (int i = 0; i < 16; ++i) cur[i] = nxt[i];
    }
  }
}

__device__ void mods_item(const Params& p, int item, char* smem) {
  float* sc = (float*)smem;
  float* red = sc + 9 * 1024;
  const int tid = otid();
  const int l = item / 96, n0 = (item % 96) * 32;
  __syncthreads();
  {
    float cv[36];
#pragma unroll
    for (int it = 0; it < 36; ++it) {
      const int j = it >> 2, k = tid + 256 * (it & 3);
      cv[it] = (j < 8) ? p.c[j * 1024 + k] : p.c_ctx[k];
    }
#pragma unroll
    for (int it = 0; it < 36; ++it) sc[tid + 256 * it] = silu_f(cv[it]);
  }
  __syncthreads();
  const int col = tid & 31, kg = tid >> 5;
  float acc[9];
#pragma unroll
  for (int j = 0; j < 9; ++j) acc[j] = 0.f;
  const float* w = p.w_mod + ((size_t)l * 1024 + kg * 128) * 3072 + n0 + col;
#pragma unroll 64
  for (int k = 0; k < 128; ++k) {
    float wv = w[(size_t)k * 3072];
#pragma unroll
    for (int j = 0; j < 9; ++j) acc[j] += sc[j * 1024 + kg * 128 + k] * wv;
  }
#pragma unroll
  for (int j = 0; j < 9; ++j) red[(kg * 9 + j) * 32 + col] = acc[j];
  __syncthreads();
  for (int i = tid; i < 9 * 32; i += VTH) {
    int j = i >> 5, cc = i & 31;
    float s = 0.f;
#pragma unroll
    for (int g = 0; g < 8; ++g) s += red[(g * 9 + j) * 32 + cc];
    p.mods[((size_t)l * 9 + j) * 3072 + n0 + cc] = s + p.b_mod[l * 3072 + n0 + cc];
  }
}

__device__ void phase0(const Params& p, char* smem) {
  for (int row = blockIdx.x * NTHREADS + ofull(); row < 8 * 128; row += gridDim.x * NTHREADS) {
    const float4* src = (const float4*)(p.a_w_s + (size_t)row * 128);
    float sm = 0.f;
#pragma unroll 8
    for (int i = 0; i < 32; ++i) {
      const float4 v = src[i];
      sm += (v.x + v.y) + (v.z + v.w);
      u32x2 pk;
      pk.x = pack2(v.x, v.y);
      pk.y = pack2(v.z, v.w);
      *(u32x2*)(p.wsb + (size_t)row * 128 + i * 4) = pk;
    }
    p.wsum[row] = sm;
  }
  for (int item = vblk(); item < 384; item += nvblk()) mods_item(p, item, smem);
}
__device__ void phase0_transposes(const Params& p, char* smem) {
  transpose_items(p, vblk(), nvblk(), 3968, smem);
}

__device__ void phase_prep(const Params& p, int layer) {
  const int tid = ofull();
  const int lane = tid & 63;
  const int gw = blockIdx.x * 8 + (tid >> 6);
  const int nw = gridDim.x * 8;
  const float* ng = p.norm_g + layer * 1024;
  float4 gpre[4];
#pragma unroll
  for (int i = 0; i < 4; ++i) gpre[i] = ((const float4*)ng)[lane + 64 * i];
  for (int R = gw; R < NR; R += nw) {
    const float* src;
    if (layer == 0) src = (R < NL) ? p.x + (size_t)R * 1024 : p.ctx + (size_t)(R - NL) * 1024;
    else if (layer == 1 && R >= NL) src = p.ctx + (size_t)(R - NL) * 1024;
    else src = p.xbuf + (size_t)R * 1024;
    const int bidx = (R < NL) ? (R >> 12) : 8;
    const float* md = p.mods + ((size_t)layer * 9 + bidx) * 3072;
    float4 v[4], shp[4], scp[4];
#pragma unroll
    for (int i = 0; i < 4; ++i) v[i] = ((const float4*)src)[lane + 64 * i];
#pragma unroll
    for (int i = 0; i < 4; ++i) {
      shp[i] = ((const float4*)md)[lane + 64 * i];
      scp[i] = ((const float4*)(md + 1024))[lane + 64 * i];
    }
    if (layer >= 1 && R >= NL) {
      const float* gp = p.mods + ((size_t)(layer - 1) * 9 + 8) * 3072 + 2048;
      const float* pp = p.part + (size_t)(R - NL) * 1024;
#pragma unroll
      for (int i = 0; i < 4; ++i) {
        const int k4 = lane + 64 * i;
        const float4 g = ((const float4*)gp)[k4];
        const float4 a0 = ((const float4*)pp)[k4];
        const float4 a1 = ((const float4*)(pp + (size_t)NC * 1024))[k4];
        const float4 a2 = ((const float4*)(pp + (size_t)2 * NC * 1024))[k4];
        const float4 a3 = ((const float4*)(pp + (size_t)3 * NC * 1024))[k4];
        v[i].x += g.x * ((a0.x + a1.x) + (a2.x + a3.x));
        v[i].y += g.y * ((a0.y + a1.y) + (a2.y + a3.y));
        v[i].z += g.z * ((a0.z + a1.z) + (a2.z + a3.z));
        v[i].w += g.w * ((a0.w + a1.w) + (a2.w + a3.w));
        ((float4*)(p.xbuf + (size_t)R * 1024))[k4] = v[i];
      }
    }
    float ss = 0.f;
#pragma unroll
    for (int i = 0; i < 4; ++i) ss += v[i].x * v[i].x + v[i].y * v[i].y + v[i].z * v[i].z + v[i].w * v[i].w;
    ss = wave_sum(ss);
    const float rstd = rsqrtf(ss * (1.f / 1024.f) + 1e-6f);
#pragma unroll
    for (int i = 0; i < 4; ++i) {
      const int k4 = lane + 64 * i;
      const float4 g = gpre[i];
      const float4 sh = shp[i];
      const float4 sc = scp[i];
      float h0 = v[i].x * rstd * g.x * (1.f + sc.x) + sh.x;
      float h1 = v[i].y * rstd * g.y * (1.f + sc.y) + sh.y;
      float h2 = v[i].z * rstd * g.z * (1.f + sc.z) + sh.z;
      float h3 = v[i].w * rstd * g.w * (1.f + sc.w) + sh.w;
      u32x2 pk;
      pk.x = pack2(h0, h1);
      pk.y = pack2(h2, h3);
      *(u32x2*)(p.hbuf + (size_t)R * 1024 + k4 * 4) = pk;
    }
  }
}

__device__ void phase_final(const Params& p) {
  const int tid = ofull();
  const int lane = tid & 63;
  const int gw = blockIdx.x * 8 + (tid >> 6);
  const int nw = gridDim.x * 8;
  float4 fg[4];
#pragma unroll
  for (int i = 0; i < 4; ++i) fg[i] = ((const float4*)p.final_g)[lane + 64 * i];
  for (int R = gw; R < NL; R += nw) {
    const float* src = p.xbuf + (size_t)R * 1024;
    float4 v[4];
#pragma unroll
    for (int i = 0; i < 4; ++i) v[i] = ((const float4*)src)[lane + 64 * i];
    float ss = 0.f;
#pragma unroll
    for (int i = 0; i < 4; ++i) ss += v[i].x * v[i].x + v[i].y * v[i].y + v[i].z * v[i].z + v[i].w * v[i].w;
    ss = wave_sum(ss);
    const float rstd = rsqrtf(ss * (1.f / 1024.f) + 1e-6f);
#pragma unroll
    for (int i = 0; i < 4; ++i) {
      const int k4 = lane + 64 * i;
      const float4 g = fg[i];
      float4 o;
      o.x = v[i].x * rstd * g.x;
      o.y = v[i].y * rstd * g.y;
      o.z = v[i].z * rstd * g.z;
      o.w = v[i].w * rstd * g.w;
      ((float4*)(p.out + (size_t)R * 1024))[k4] = o;
    }
  }
}

constexpr int GS = 72;

__device__ __forceinline__ u32x4 add_bf16x8(u32x4 a, u32x4 b) {
  u32x4 r;
  r.x = pack2(lo_bf(a.x) + lo_bf(b.x), hi_bf(a.x) + hi_bf(b.x));
  r.y = pack2(lo_bf(a.y) + lo_bf(b.y), hi_bf(a.y) + hi_bf(b.y));
  r.z = pack2(lo_bf(a.z) + lo_bf(b.z), hi_bf(a.z) + hi_bf(b.z));
  r.w = pack2(lo_bf(a.w) + lo_bf(b.w), hi_bf(a.w) + hi_bf(b.w));
  return r;
}

template <int AMODE, class Epi>
__device__ void gemm_phase(const bf16_t* __restrict__ A0, const bf16_t* __restrict__ A1,
                           const bf16_t* __restrict__ Bt, int Mtiles, int Ntiles, char* smem, Epi epi) {
  constexpr int PD = (AMODE == 1) ? 1 : 2;
  constexpr int BUF = 2 * 128 * GS;
  bf16_t* S0 = (bf16_t*)smem;
  const int tid = otid(), lane = tid & 63, w = __builtin_amdgcn_readfirstlane(tid >> 6);
  const int wm = w >> 1, wn = w & 1;
  const int r = lane & 31, h = lane >> 5;
  const int lrow = tid >> 3, kc = tid & 7;
  const int total = Mtiles * Ntiles;
  const int woff = lrow * GS + kc * 8;
  const int aro = (wm * 64 + r) * GS + h * 8;
  const int bro = 128 * GS + (wn * 64 + r) * GS + h * 8;
  const bool swz = ((gridDim.x & 7) == 0) && ((Mtiles & 7) == 0);
  const int xcd = blockIdx.x & 7;
  const int Mx = Mtiles >> 3;
  const int lstart = swz ? (int)(blockIdx.x >> 3) * 2 + vbid() : vblk();
  const int lstep = swz ? (int)(gridDim.x >> 3) * 2 : nvblk();
  const int lend = swz ? Mx * Ntiles : total;
  for (int L0 = 0; L0 < lend; L0 += lstep) {
    const bool tvalid = L0 + lstart < lend;
    const int L = tvalid ? L0 + lstart : lend - 1;
    int mt, nt;
    if (swz) {
      const int gfull = 8 * Ntiles;
      const int mg = L / gfull, rem = L - mg * gfull;
      const int gs = min(8, Mx - mg * 8);
      nt = rem / gs;
      mt = xcd * Mx + mg * 8 + (rem - nt * gs);
    } else {
      mt = L / Ntiles;
      nt = L - mt * Ntiles;
    }
    const int m0 = mt * 128, n0 = nt * 128;
    const size_t aoff = (size_t)(m0 + lrow) * 1024 + kc * 8;
    const bf16_t* ap = A0 + aoff;
    const bf16_t* ap1 = (AMODE == 1) ? (A1 + aoff) : A0;
    const bf16_t* bp = Bt + (size_t)(n0 + lrow) * 1024 + kc * 8;
    u32x4 ra[PD][4], ra1[PD][4], rb[PD][4];
#define G_LOAD(S, KT)                                                                              \
    {                                                                                              \
      _Pragma("unroll") for (int i = 0; i < 4; ++i) {                                              \
        ra[S][i] = *(const u32x4*)(ap + (size_t)i * 32 * 1024 + (KT) * 64);                        \
        if (AMODE == 1) ra1[S][i] = *(const u32x4*)(ap1 + (size_t)i * 32 * 1024 + (KT) * 64);     \
        rb[S][i] = *(const u32x4*)(bp + (size_t)i * 32 * 1024 + (KT) * 64);                        \
      }                                                                                            \
    }
#define L_WRITE(S, BUFI)                                                                           \
    {                                                                                              \
      bf16_t* dstA = S0 + (BUFI) * BUF + woff;                                                     \
      _Pragma("unroll") for (int i = 0; i < 4; ++i) {                                              \
        u32x4 av = ra[S][i];                                                                       \
        if (AMODE == 1) av = add_bf16x8(av, ra1[S][i]);                                            \
        *(u32x4*)(dstA + 32 * i * GS) = av;                                                        \
        *(u32x4*)(dstA + 128 * GS + 32 * i * GS) = rb[S][i];                                       \
      }                                                                                            \
    }
    G_LOAD(0, 0);
    L_WRITE(0, 0);
#pragma unroll
    for (int s = 0; s < PD; ++s) G_LOAD(s, 1 + s);
    f32x16 acc[2][2];
#pragma unroll
    for (int mi = 0; mi < 2; ++mi)
#pragma unroll
      for (int ni = 0; ni < 2; ++ni) acc[mi][ni] = zero16();
#pragma unroll 1
    for (int kt0 = 0; kt0 < 16; kt0 += 2) {
#pragma unroll
      for (int u = 0; u < 2; ++u) {
        const int kt = kt0 + u;
        constexpr int dummy = 0; (void)dummy;
        const int s = (PD == 2) ? u : 0;
        __syncthreads();
        L_WRITE(s, (u ^ 1));
        {
          const int ktl = (kt + 1 + PD < 16) ? (kt + 1 + PD) : 15;
          G_LOAD(s, ktl);
        }
        const bf16_t* Aw = S0 + u * BUF + aro;
        const bf16_t* Bw = S0 + u * BUF + bro;
#pragma unroll
        for (int ks = 0; ks < 4; ++ks) {
          bf16x8 a0 = *(const bf16x8*)(Aw + ks * 16);
          bf16x8 a1 = *(const bf16x8*)(Aw + 32 * GS + ks * 16);
          bf16x8 b0 = *(const bf16x8*)(Bw + ks * 16);
          bf16x8 b1 = *(const bf16x8*)(Bw + 32 * GS + ks * 16);
          acc[0][0] = __builtin_amdgcn_mfma_f32_32x32x16_bf16(a0, b0, acc[0][0], 0, 0, 0);
          acc[0][1] = __builtin_amdgcn_mfma_f32_32x32x16_bf16(a0, b1, acc[0][1], 0, 0, 0);
          acc[1][0] = __builtin_amdgcn_mfma_f32_32x32x16_bf16(a1, b0, acc[1][0], 0, 0, 0);
          acc[1][1] = __builtin_amdgcn_mfma_f32_32x32x16_bf16(a1, b1, acc[1][1], 0, 0, 0);
        }
      }
    }
#undef G_LOAD
#undef L_WRITE
    if (tvalid) epi(acc, m0 + wm * 64, n0 + wn * 64, lane);
  }
}

template <class Epi>
__device__ void gemm_phase_big(const bf16_t* __restrict__ A0, const bf16_t* __restrict__ Bt, int Mtiles  ,
                               int Ntiles, char* smem, Epi epi) {
  bf16_t* As = (bf16_t*)smem;
  bf16_t* Bs = As + 256 * GS;
  const int tid = otid(), lane = tid & 63, w = __builtin_amdgcn_readfirstlane(tid >> 6);
  const int wm = w >> 1, wn = w & 1;
  const int r = lane & 31, h = lane >> 5;
  const int lrow = tid >> 3, kc = tid & 7;
  const bool swz = ((gridDim.x & 7) == 0) && ((Mtiles & 7) == 0);
  const int xcd = blockIdx.x & 7;
  const int Mx = Mtiles >> 3;
  const int lstart = swz ? (int)(blockIdx.x >> 3) * 2 + vbid() : vblk();
  const int lstep = swz ? (int)(gridDim.x >> 3) * 2 : nvblk();
  const int lend = swz ? Mx * Ntiles : Mtiles * Ntiles;
  for (int L0 = 0; L0 < lend; L0 += lstep) {
    const bool tvalid = L0 + lstart < lend;
    const int L = tvalid ? L0 + lstart : lend - 1;
    int mt, nt;
    if (swz) {
      const int gfull = 8 * Ntiles;
      const int mg = L / gfull, rem = L - mg * gfull;
      const int gs = min(8, Mx - mg * 8);
      nt = rem / gs;
      mt = xcd * Mx + mg * 8 + (rem - nt * gs);
    } else {
      mt = L / Ntiles;
      nt = L - mt * Ntiles;
    }
    const int m0 = mt * 256, n0 = nt * 128;
    const bf16_t* ap = A0 + (size_t)(m0 + lrow) * 1024 + kc * 8;
    const bf16_t* bp = Bt + (size_t)(n0 + lrow) * 1024 + kc * 8;
    u32x4 ra[8], rb[4];
#pragma unroll
    for (int i = 0; i < 8; ++i) ra[i] = *(const u32x4*)(ap + (size_t)i * 32 * 1024);
#pragma unroll
    for (int i = 0; i < 4; ++i) rb[i] = *(const u32x4*)(bp + (size_t)i * 32 * 1024);
    f32x16 acc[2][2][2];
#pragma unroll
    for (int hf = 0; hf < 2; ++hf)
#pragma unroll
      for (int mi = 0; mi < 2; ++mi)
#pragma unroll
        for (int ni = 0; ni < 2; ++ni) acc[hf][mi][ni] = zero16();
#pragma unroll 1
    for (int kt = 0; kt < 16; ++kt) {
      __syncthreads();
#pragma unroll
      for (int i = 0; i < 8; ++i) *(u32x4*)(As + (lrow + 32 * i) * GS + kc * 8) = ra[i];
#pragma unroll
      for (int i = 0; i < 4; ++i) *(u32x4*)(Bs + (lrow + 32 * i) * GS + kc * 8) = rb[i];
      __syncthreads();
      {
        const int k0 = ((kt + 1 < 16) ? (kt + 1) : 15) * 64;
#pragma unroll
        for (int i = 0; i < 8; ++i) ra[i] = *(const u32x4*)(ap + (size_t)i * 32 * 1024 + k0);
#pragma unroll
        for (int i = 0; i < 4; ++i) rb[i] = *(const u32x4*)(bp + (size_t)i * 32 * 1024 + k0);
      }
      const bf16_t* Aw = As + (wm * 128 + r) * GS + h * 8;
      const bf16_t* Bw = Bs + (wn * 64 + r) * GS + h * 8;
#pragma unroll
      for (int ks = 0; ks < 4; ++ks) {
        bf16x8 b0 = *(const bf16x8*)(Bw + ks * 16);
        bf16x8 b1 = *(const bf16x8*)(Bw + 32 * GS + ks * 16);
#pragma unroll
        for (int hf = 0; hf < 2; ++hf) {
          bf16x8 a0 = *(const bf16x8*)(Aw + (hf * 64) * GS + ks * 16);
          bf16x8 a1 = *(const bf16x8*)(Aw + (hf * 64 + 32) * GS + ks * 16);
          acc[hf][0][0] = __builtin_amdgcn_mfma_f32_32x32x16_bf16(a0, b0, acc[hf][0][0], 0, 0, 0);
          acc[hf][0][1] = __builtin_amdgcn_mfma_f32_32x32x16_bf16(a0, b1, acc[hf][0][1], 0, 0, 0);
          acc[hf][1][0] = __builtin_amdgcn_mfma_f32_32x32x16_bf16(a1, b0, acc[hf][1][0], 0, 0, 0);
          acc[hf][1][1] = __builtin_amdgcn_mfma_f32_32x32x16_bf16(a1, b1, acc[hf][1][1], 0, 0, 0);
        }
      }
    }
    if (tvalid) {
      epi(acc[0], m0 + wm * 128, n0 + wn * 64, lane);
      epi(acc[1], m0 + wm * 128 + 64, n0 + wn * 64, lane);
    }
  }
}


struct EpiEvenIn {
  EvenBufs e;
  __device__ void operator()(f32x16 (&acc)[2][2], int rb, int cb, int lane) const {
    const int r = lane & 31, h = lane >> 5;
    if (cb < 1536 || cb >= 2304) {
      bf16_t* dst;
      int c0;
      int mode;
      if (cb < 512) { dst = e.ug; c0 = cb; mode = 0; }
      else if (cb < 1024) { dst = e.vg; c0 = cb - 512; mode = 0; }
      else if (cb < 1536) { dst = e.gas; c0 = cb - 1024; mode = 1; }
      else { dst = e.gbs; c0 = cb - 2304; mode = 1; }
#pragma unroll
      for (int mi = 0; mi < 2; ++mi)
#pragma unroll
        for (int ni = 0; ni < 2; ++ni)
#pragma unroll
          for (int reg = 0; reg < 16; ++reg) {
            const int row = rb + mi * 32 + (reg & 3) + 8 * (reg >> 2) + 4 * h;
            const int col = c0 + ni * 32 + r;
            float v = acc[mi][ni][reg];
            v = (mode == 0) ? gelu_f(v) : silu_f(v);
            dst[(size_t)row * 512 + col] = f2bf(v);
          }
    } else if (cb < 2176) {
      const bool isq = cb < 2048;
      bf16_t* dst = isq ? e.qb : e.kb;
      const int c0 = isq ? (cb - 1536) : (cb - 2048);
      const int ld = isq ? 512 : 128;
      const float scale = isq ? 0.125f : 1.f;
      const bool latent = rb < NL;
      const float inv_freq = exp2f(-(float)(r & 15) * 0.8304820237218406f);
#pragma unroll
      for (int mi = 0; mi < 2; ++mi)
#pragma unroll
        for (int reg = 0; reg < 16; ++reg) {
          const int row = rb + mi * 32 + (reg & 3) + 8 * (reg >> 2) + 4 * h;
          float x1 = acc[mi][0][reg], x2 = acc[mi][1][reg];
          float o1 = x1, o2 = x2;
          if (latent) {
            const int t = row & (SEQL - 1);
            const float pos = (float)((r < 16) ? (t >> 6) : (t & 63));
            const float ang = pos * inv_freq;
            const float cs = __cosf(ang), sn = __sinf(ang);
            o1 = x1 * cs - x2 * sn;
            o2 = x2 * cs + x1 * sn;
          }
          dst[(size_t)row * ld + c0 + r] = f2bf(o1 * scale);
          dst[(size_t)row * ld + c0 + 32 + r] = f2bf(o2 * scale);
        }
    } else {
      const int kvh = (cb - 2176) >> 6;
      const bool latent = rb < NL;
#pragma unroll
      for (int mi = 0; mi < 2; ++mi)
#pragma unroll
        for (int ni = 0; ni < 2; ++ni)
#pragma unroll
          for (int q4 = 0; q4 < 4; ++q4) {
            const int row = rb + mi * 32 + 8 * q4 + 4 * h;
            const int d = ni * 32 + r;
            u32x2 pk;
            pk.x = pack2(acc[mi][ni][q4 * 4 + 0], acc[mi][ni][q4 * 4 + 1]);
            pk.y = pack2(acc[mi][ni][q4 * 4 + 2], acc[mi][ni][q4 * 4 + 3]);
            if (latent) {
              const int b = row >> 12, t = row & (SEQL - 1);
              *(u32x2*)(e.vtl + ((size_t)((b * 2 + kvh) * 64 + d)) * SEQL + t) = pk;
            } else {
              const int rr = row - NL;
              const int b = rr >> 8, t = rr & (LCTX - 1);
              *(u32x2*)(e.vtc + ((size_t)((b * 2 + kvh) * 64 + d)) * LCTX + t) = pk;
            }
          }
    }
  }
};

struct EpiOddIn {
  OddBufs o;
  __device__ void operator()(f32x16 (&acc)[2][2], int rb, int cb, int lane) const {
    const int r = lane & 31, h = lane >> 5;
    const bool isg = cb >= 1024;
    bf16_t* dst = isg ? o.sg : o.xr;
    const int c0 = isg ? cb - 1024 : cb;
#pragma unroll
    for (int mi = 0; mi < 2; ++mi)
#pragma unroll
      for (int ni = 0; ni < 2; ++ni)
#pragma unroll
        for (int reg = 0; reg < 16; ++reg) {
          const int row = rb + mi * 32 + (reg & 3) + 8 * (reg >> 2) + 4 * h;
          const int col = c0 + ni * 32 + r;
          float v = acc[mi][ni][reg];
          if (isg) v = silu_f(v);
          dst[(size_t)row * 1024 + col] = f2bf(v);
        }
  }
};

struct EpiOut {
  float* xbuf;
  const float* xin_lat;
  const float* xin_ctx;
  const float* mods_l;
  __device__ void operator()(f32x16 (&acc)[2][2], int rb, int cb, int lane) const {
    const int r = lane & 31, h = lane >> 5;
    const int bidx = (rb < NL) ? (rb >> 12) : 8;
    const float* gate = mods_l + (size_t)bidx * 3072 + 2048;
    const float* xin = (rb < NL) ? xin_lat : xin_ctx;
    const int rsub = (rb < NL) ? 0 : NL;
#pragma unroll
    for (int ni = 0; ni < 2; ++ni) {
      const int col = cb + ni * 32 + r;
      const float gv = gate[col];
#pragma unroll
      for (int mi = 0; mi < 2; ++mi)
#pragma unroll
        for (int reg = 0; reg < 16; ++reg) {
          const int row = rb + mi * 32 + (reg & 3) + 8 * (reg >> 2) + 4 * h;
          xbuf[(size_t)row * 1024 + col] = xin[(size_t)(row - rsub) * 1024 + col] + gv * acc[mi][ni][reg];
        }
    }
  }
};


namespace pg8 {
#define PG8_LAS __attribute__((address_space(3)))
typedef float f32x4 __attribute__((ext_vector_type(4)));
constexpr int BM = 256, BK = 64, HALF = 128, HTB = HALF * BK * 2, STAGE_BYTES = 8 * HTB, NXCD = 8, WGM = 8;
__device__ __forceinline__ int lds_byte(int r, int c) { const int st = (r >> 4) * 2 + (c >> 5), rr = r & 15, cc = c & 31, ob = rr * 64 + cc * 2; return st * 1024 + (ob ^ (((ob >> 9) & 1) << 5)); }
__device__ __forceinline__ void stage_rc(int b, int& R, int& C) { const int st = b / 1024, sb = b % 1024, swz = sb ^ (((sb >> 9) & 1) << 5); R = (st >> 1) * 16 + swz / 64; C = (st & 1) * 32 + (swz % 64) / 2; }
__device__ __forceinline__ int perm32(int rho) { const int n = rho >> 4, i = rho & 15; return 8 * (i >> 2) + 4 * n + (i & 3); }
struct Unit { int pm, pn, ko; };
struct Gemm { const bf16_t* A; const bf16_t* Bt; int M, N, K; };
struct StaticOrder {
    int nM, nN, nwg, G, c;
    __device__ void init(int M, int N, int G_, int c_) { nM = M / BM; nN = N / BM; nwg = nM * nN; G = G_; c = c_; }
    __device__ bool next(int i, Unit& u) const {
        const long L = (long)i * G + c; if (L >= nwg) return false;
        int wgid = (int)L; { const int q = nwg / NXCD, r = nwg % NXCD, xcd = wgid % NXCD, off = wgid / NXCD; wgid = (xcd < r ? xcd * (q + 1) : r * (q + 1) + (xcd - r) * q) + off; }
        const int nig = WGM * nN, gid = wgid / nig, fm = gid * WGM, gsz = (nM - fm) < WGM ? (nM - fm) : WGM;
        u.pm = fm + ((wgid % nig) % gsz); u.pn = (wgid % nig) / gsz; u.ko = 0; return true;
    }
    __device__ __forceinline__ void a_ready(const Unit&) const {}
    __device__ __forceinline__ void done(const Unit&) const {}
};
struct CtxSplitOrder {
    int G, c;
    __device__ void init(int G_, int c_) { G = G_; c = c_; }
    __device__ bool next(int i, Unit& u) const {
        const int L = i * G + c; if (L >= 128) return false;
        const int unit = L >> 2; u.pm = (NL / 256) + (unit >> 2); u.pn = unit & 3; u.ko = (L & 3) * 256; return true;
    }
};
struct OutOrder {
    StaticOrder so; CtxSplitOrder cs; int mode;
    __device__ bool next(int i, Unit& u) const { return mode ? cs.next(i, u) : so.next(i, u); }
    __device__ __forceinline__ void a_ready(const Unit&) const {}
    __device__ __forceinline__ void done(const Unit&) const {}
};
template <class Epi, class Sched>
__device__ __forceinline__ void gemm_phase(PG8_LAS unsigned char* lds, const Gemm g, const Sched& S, const Epi& E) {
    const int tid = ofull(), wid = __builtin_amdgcn_readfirstlane(tid >> 6), lane = tid & 63, wr = wid >> 2, wc = wid & 3, fr = lane & 15, fq = lane >> 4;
    const int K = g.K, nt = K / BK;
    unsigned voffA[2], voffB[2];
#pragma unroll
    for (int i = 0; i < 2; ++i) { int R, C; stage_rc(tid * 16 + i * 8192, R, C); const int Rb = Epi::PERM ? ((R & ~31) + perm32(R & 31)) : R;
        voffA[i] = (unsigned)(R * 1024 + C) * 2u; voffB[i] = (unsigned)(Rb * 1024 + C) * 2u; }
    const size_t kstep = (size_t)(BK * 2);
    const size_t hstep = (size_t)HALF * 1024 * 2;
    const size_t tstep = 2 * hstep;
    const unsigned ldsw = (unsigned)wid * 1024u;
    const int aoff = lds_byte(wr * 64 + fr, fq * 8), boff = lds_byte(wc * 32 + fr, fq * 8);
#define PG8_SA(b, h) (((b) * 2 + (h)) * HTB)
#define PG8_SB(b, h) ((4 + (b) * 2 + (h)) * HTB)
#define PG8_STAGE(bufoff, gbase, voff) do { _Pragma("unroll") for (int _i = 0; _i < 2; ++_i) \
        __builtin_amdgcn_global_load_lds((const unsigned*)((const char*)(gbase) + (voff)[_i]), (PG8_LAS unsigned*)(lds + (bufoff) + ldsw + _i * 8192), 16, 0, 0); } while (0)
#define PG8_LDA(dst, b, h) do { _Pragma("unroll") for (int m = 0; m < 4; ++m) _Pragma("unroll") for (int k = 0; k < 2; ++k) dst[m][k] = *(const PG8_LAS bf16x8*)(lds + PG8_SA(b, h) + aoff + m * 2048 + k * 1024); } while (0)
#define PG8_LDB(dst, b, h) do { _Pragma("unroll") for (int n = 0; n < 2; ++n) _Pragma("unroll") for (int k = 0; k < 2; ++k) dst[n][k] = *(const PG8_LAS bf16x8*)(lds + PG8_SB(b, h) + boff + n * 2048 + k * 1024); } while (0)
#define PG8_MMA(ai, bj, At, Bt) do { __builtin_amdgcn_s_setprio(1); _Pragma("unroll") for (int m = 0; m < 4; ++m) _Pragma("unroll") for (int n = 0; n < 2; ++n) _Pragma("unroll") for (int k = 0; k < 2; ++k) \
        acc[ai][bj][m][n] = __builtin_amdgcn_mfma_f32_16x16x32_bf16(Bt[n][k], At[m][k], acc[ai][bj][m][n], 0, 0, 0); __builtin_amdgcn_s_setprio(0); } while (0)
#define PG8_WAIT_V(n) asm volatile("s_waitcnt vmcnt(" #n ")" ::: "memory")
#define PG8_WAIT_L(n) asm volatile("s_waitcnt lgkmcnt(" #n ")" ::: "memory")
#define PG8_BAR __builtin_amdgcn_s_barrier()
#define PG8_SCHED __builtin_amdgcn_sched_barrier(0)
    Unit cur, nxt; int ui = 0;
    if (!S.next(0, cur)) return;
    f32x4 acc[2][2][4][2];
#pragma unroll
    for (int a = 0; a < 2; ++a)
#pragma unroll
        for (int b = 0; b < 2; ++b)
#pragma unroll
            for (int m = 0; m < 4; ++m)
#pragma unroll
                for (int n = 0; n < 2; ++n) acc[a][b][m][n] = (f32x4){0.f, 0.f, 0.f, 0.f};
    bf16x8 At[4][2], B0[2][2], B1[2][2];
    const char* cA = (const char*)g.A + (size_t)cur.pm * tstep + (size_t)cur.ko * 2; const char* cB = (const char*)g.Bt + (size_t)cur.pn * tstep + (size_t)cur.ko * 2;
    S.a_ready(cur);
    PG8_STAGE(PG8_SB(0, 0), cB, voffB); PG8_STAGE(PG8_SA(0, 0), cA, voffA); PG8_STAGE(PG8_SB(0, 1), cB + hstep, voffB); PG8_STAGE(PG8_SA(0, 1), cA + hstep, voffA);
    if (wr == 1) PG8_BAR;
    PG8_WAIT_V(4); PG8_BAR;
    PG8_STAGE(PG8_SB(1, 0), cB + kstep, voffB); PG8_STAGE(PG8_SA(1, 0), cA + kstep, voffA); PG8_STAGE(PG8_SB(1, 1), cB + hstep + kstep, voffB);
    PG8_WAIT_V(6); PG8_BAR;
    for (;;) {
        const bool has_next = S.next(ui + 1, nxt);
        const char* nA = has_next ? (const char*)g.A + (size_t)nxt.pm * tstep + (size_t)nxt.ko * 2 : cA; const char* nB = has_next ? (const char*)g.Bt + (size_t)nxt.pn * tstep + (size_t)nxt.ko * 2 : cB;
        for (int t = 0; t < nt; t += 2) {
            const bool last = (t == nt - 2);
            const char* a1 = cA + (size_t)(t + 1) * kstep;
            const char* a2 = last ? nA : cA + (size_t)(t + 2) * kstep; const char* b2 = last ? nB : cB + (size_t)(t + 2) * kstep;
            const char* a3 = a2 + kstep; const char* b3 = b2 + kstep;
            if (last && has_next) S.a_ready(nxt);
            PG8_LDB(B0, 0, 0); PG8_SCHED; PG8_LDA(At, 0, 0); PG8_STAGE(PG8_SA(1, 1), a1 + hstep, voffA);
            PG8_WAIT_L(8); PG8_BAR; PG8_WAIT_L(0); PG8_MMA(0, 0, At, B0); PG8_BAR; PG8_SCHED;
            PG8_LDB(B1, 0, 1); PG8_STAGE(PG8_SB(0, 0), b2, voffB);
            PG8_BAR; PG8_WAIT_L(0); PG8_MMA(0, 1, At, B1); PG8_BAR;
            PG8_LDA(At, 0, 1); PG8_STAGE(PG8_SA(0, 0), a2, voffA);
            PG8_BAR; PG8_WAIT_L(0); PG8_MMA(1, 0, At, B0); PG8_BAR; PG8_SCHED;
            PG8_STAGE(PG8_SB(0, 1), b2 + hstep, voffB);
            PG8_WAIT_V(6); PG8_BAR; PG8_MMA(1, 1, At, B1); PG8_BAR;
            PG8_LDB(B0, 1, 0); PG8_SCHED; PG8_LDA(At, 1, 0); PG8_STAGE(PG8_SA(0, 1), a2 + hstep, voffA);
            PG8_WAIT_L(8); PG8_BAR; PG8_WAIT_L(0); PG8_MMA(0, 0, At, B0); PG8_BAR; PG8_SCHED;
            PG8_LDB(B1, 1, 1); PG8_STAGE(PG8_SB(1, 0), b3, voffB);
            PG8_BAR; PG8_WAIT_L(0); PG8_MMA(0, 1, At, B1); PG8_BAR;
            PG8_LDA(At, 1, 1); PG8_STAGE(PG8_SA(1, 0), a3, voffA);
            PG8_BAR; PG8_WAIT_L(0); PG8_MMA(1, 0, At, B0); PG8_BAR; PG8_SCHED;
            PG8_STAGE(PG8_SB(1, 1), b3 + hstep, voffB);
            PG8_WAIT_V(6); PG8_BAR; PG8_MMA(1, 1, At, B1); PG8_BAR;
        }
        if constexpr (!Epi::AFTER_DRAIN) { E(acc, cur, wr, wc, fr, fq); S.done(cur); }
        if (!has_next) break;
#pragma unroll
        for (int a = 0; a < 2; ++a)
#pragma unroll
            for (int b = 0; b < 2; ++b)
#pragma unroll
                for (int m = 0; m < 4; ++m)
#pragma unroll
                    for (int n = 0; n < 2; ++n) acc[a][b][m][n] = (f32x4){0.f, 0.f, 0.f, 0.f};
        cur = nxt; cA = nA; cB = nB; ++ui;
    }
    PG8_WAIT_V(0);
    if (wr == 0) PG8_BAR;
    PG8_BAR;
    if constexpr (Epi::AFTER_DRAIN) { E.fused(acc, cur, wr, wc, fr, fq, lds, wid, lane); S.done(cur); }
#undef PG8_SA
#undef PG8_SB
#undef PG8_STAGE
#undef PG8_LDA
#undef PG8_LDB
#undef PG8_MMA
#undef PG8_WAIT_V
#undef PG8_WAIT_L
#undef PG8_BAR
#undef PG8_SCHED
}
}


struct PEpiOddIn {
  static constexpr bool PERM = true, AFTER_DRAIN = false;
  OddBufs o;
  __device__ __forceinline__ void operator()(const pg8::f32x4 (&acc)[2][2][4][2], const pg8::Unit& u, int wr, int wc, int fr, int fq) const {
    const bool isg = u.pn >= 4;
    bf16_t* dst = isg ? o.sg : o.xr;
    const int colt = (u.pn & 3) * 256 + wc * 32 + 8 * fq;
    const int row0 = u.pm * 256 + wr * 64 + fr;
#pragma unroll
    for (int ai = 0; ai < 2; ++ai)
#pragma unroll
      for (int m = 0; m < 4; ++m) {
        bf16_t* rowp = dst + (size_t)(row0 + ai * 128 + m * 16) * 1024 + colt;
#pragma unroll
        for (int bj = 0; bj < 2; ++bj) {
          pg8::f32x4 v0 = acc[ai][bj][m][0], v1 = acc[ai][bj][m][1];
          if (isg) {
            const f32x2p a0 = silu_pk((f32x2p){v0[0], v0[1]}), a1 = silu_pk((f32x2p){v0[2], v0[3]});
            const f32x2p b0 = silu_pk((f32x2p){v1[0], v1[1]}), b1 = silu_pk((f32x2p){v1[2], v1[3]});
            v0[0] = a0.x; v0[1] = a0.y; v0[2] = a1.x; v0[3] = a1.y;
            v1[0] = b0.x; v1[1] = b0.y; v1[2] = b1.x; v1[3] = b1.y;
          }
          u32x4 pk;
          pk.x = pack2(v0[0], v0[1]); pk.y = pack2(v0[2], v0[3]);
          pk.z = pack2(v1[0], v1[1]); pk.w = pack2(v1[2], v1[3]);
          *(u32x4*)(rowp + bj * 128) = pk;
        }
      }
  }
};

struct PEpiOut {
  static constexpr bool PERM = false, AFTER_DRAIN = false;
  float* xbuf;
  const float* xin_lat;
  const float* xin_ctx;
  const float* mods_l;
  float* part;
  int split;
  __device__ __forceinline__ void operator()(const pg8::f32x4 (&acc)[2][2][4][2], const pg8::Unit& u, int wr, int wc, int fr, int fq) const {
    if (split) {
      float* pb = part + ((size_t)(u.ko >> 8) * NC + (size_t)(u.pm * 256 - NL + wr * 64 + fr)) * 1024 + u.pn * 256 + wc * 32 + 4 * fq;
#pragma unroll
      for (int ai = 0; ai < 2; ++ai)
#pragma unroll
        for (int m = 0; m < 4; ++m)
#pragma unroll
          for (int bj = 0; bj < 2; ++bj)
#pragma unroll
            for (int n = 0; n < 2; ++n) *(pg8::f32x4*)(pb + (size_t)(ai * 128 + m * 16) * 1024 + bj * 128 + n * 16) = acc[ai][bj][m][n];
      return;
    }
    const bool lat = u.pm < (NL / 256);
    const int bidx = lat ? (u.pm >> 4) : 8;
    const float* gate = mods_l + (size_t)bidx * 3072 + 2048;
    const float* xin = lat ? xin_lat : xin_ctx;
    const int rsub = lat ? 0 : NL;
    const int row0 = u.pm * 256 + wr * 64 + fr, col0 = u.pn * 256 + wc * 32 + 4 * fq;
    pg8::f32x4 gv[2][2];
#pragma unroll
    for (int bj = 0; bj < 2; ++bj)
#pragma unroll
      for (int n = 0; n < 2; ++n) gv[bj][n] = *(const pg8::f32x4*)(gate + col0 + bj * 128 + n * 16);
#pragma unroll
    for (int ai = 0; ai < 2; ++ai)
#pragma unroll
      for (int m = 0; m < 4; ++m) {
        const int row = row0 + ai * 128 + m * 16;
        const float* xr = xin + (size_t)(row - rsub) * 1024 + col0;
        float* xo = xbuf + (size_t)row * 1024 + col0;
#pragma unroll
        for (int bj = 0; bj < 2; ++bj)
#pragma unroll
          for (int n = 0; n < 2; ++n) {
            const pg8::f32x4 xv = *(const pg8::f32x4*)(xr + bj * 128 + n * 16);
            *(pg8::f32x4*)(xo + bj * 128 + n * 16) = xv + gv[bj][n] * acc[ai][bj][m][n];
          }
      }
  }
};

struct PEpiEvenIn {
  static constexpr bool PERM = true, AFTER_DRAIN = false;
  EvenBufs e;
  __device__ __forceinline__ void operator()(const pg8::f32x4 (&acc)[2][2][4][2], const pg8::Unit& u, int wr, int wc, int fr, int fq) const {
    const int row0 = u.pm * 256 + wr * 64 + fr;
    const bool latent = u.pm < (NL / 256);
    const int cw = wc * 32 + 8 * fq;
#pragma unroll
    for (int bj = 0; bj < 2; ++bj) {
      const int cbase = u.pn * 256 + bj * 128;
      if (cbase < 1536 || cbase >= 2304) {
        bf16_t* dst;
        int c0, mode;
        if (cbase < 512) { dst = e.ug; c0 = cbase; mode = 0; }
        else if (cbase < 1024) { dst = e.vg; c0 = cbase - 512; mode = 0; }
        else if (cbase < 1536) { dst = e.gas; c0 = cbase - 1024; mode = 1; }
        else { dst = e.gbs; c0 = cbase - 2304; mode = 1; }
#pragma unroll
        for (int ai = 0; ai < 2; ++ai)
#pragma unroll
          for (int m = 0; m < 4; ++m) {
            const int row = row0 + ai * 128 + m * 16;
            pg8::f32x4 v0 = acc[ai][bj][m][0], v1 = acc[ai][bj][m][1];
            {
              f32x2p a0 = {v0[0], v0[1]}, a1 = {v0[2], v0[3]}, b0 = {v1[0], v1[1]}, b1 = {v1[2], v1[3]};
              if (mode) { a0 = silu_pk(a0); a1 = silu_pk(a1); b0 = silu_pk(b0); b1 = silu_pk(b1); }
              else { a0 = gelu_pk(a0); a1 = gelu_pk(a1); b0 = gelu_pk(b0); b1 = gelu_pk(b1); }
              v0[0] = a0.x; v0[1] = a0.y; v0[2] = a1.x; v0[3] = a1.y;
              v1[0] = b0.x; v1[1] = b0.y; v1[2] = b1.x; v1[3] = b1.y;
            }
            u32x4 pk;
            pk.x = pack2(v0[0], v0[1]); pk.y = pack2(v0[2], v0[3]);
            pk.z = pack2(v1[0], v1[1]); pk.w = pack2(v1[2], v1[3]);
            *(u32x4*)(dst + (size_t)row * 512 + c0 + cw) = pk;
          }
      } else if (cbase < 2176) {
        const bool isq = cbase < 2048;
        bf16_t* dst = isq ? e.qb : e.kb;
        const int ld = isq ? 512 : 128;
        const int hb = (isq ? cbase - 1536 : cbase - 2048) + (cw & 64);
        const float scale = isq ? (0.125f * 1.4426950408889634f) : 1.f;
        const int i4 = ((cw & 63) >> 3) * 4;
        const bool rowaxis = i4 < 16;
        float invf[4];
#pragma unroll
        for (int q = 0; q < 4; ++q) invf[q] = exp2f(-(float)((i4 + q) & 15) * 0.8304820237218406f);
#pragma unroll
        for (int ai = 0; ai < 2; ++ai)
#pragma unroll
          for (int m = 0; m < 4; ++m) {
            const int row = row0 + ai * 128 + m * 16;
            const pg8::f32x4 x1 = acc[ai][bj][m][0], x2 = acc[ai][bj][m][1];
            float o1[4], o2[4];
            const int t = row & (SEQL - 1);
            const float pos = (float)(rowaxis ? (t >> 6) : (t & 63));
#pragma unroll
            for (int q = 0; q < 4; ++q) {
              float a = x1[q], bq = x2[q];
              if (latent) {
                const float ang = pos * invf[q];
                const float cs = __cosf(ang), sn = __sinf(ang);
                a = x1[q] * cs - x2[q] * sn;
                bq = x2[q] * cs + x1[q] * sn;
              }
              o1[q] = a * scale;
              o2[q] = bq * scale;
            }
            u32x2 p1, p2;
            p1.x = pack2(o1[0], o1[1]); p1.y = pack2(o1[2], o1[3]);
            p2.x = pack2(o2[0], o2[1]); p2.y = pack2(o2[2], o2[3]);
            bf16_t* rp = dst + (size_t)row * ld + hb + i4;
            *(u32x2*)(rp) = p1;
            *(u32x2*)(rp + 32) = p2;
          }
      } else {
        const int kvh = cw >> 6, dd0 = cw & 63;
#pragma unroll
        for (int ai = 0; ai < 2; ++ai)
#pragma unroll
          for (int m = 0; m < 4; ++m) {
            const int row = row0 + ai * 128 + m * 16;
            bf16_t* base;
            int ldt;
            if (latent) {
              const int b = row >> 12, t = row & (SEQL - 1);
              base = e.vtl + ((size_t)((b * 2 + kvh) * 64 + dd0)) * SEQL + t;
              ldt = SEQL;
            } else {
              const int rr = row - NL;
              const int b = rr >> 8, t = rr & (LCTX - 1);
              base = e.vtc + ((size_t)((b * 2 + kvh) * 64 + dd0)) * LCTX + t;
              ldt = LCTX;
            }
#pragma unroll
            for (int n = 0; n < 2; ++n)
#pragma unroll
              for (int q = 0; q < 4; ++q) base[(size_t)(4 * n + q) * ldt] = f2bf(acc[ai][bj][m][n][q]);
          }
      }
    }
  }
};
constexpr int AS = 72;

struct AGeom { int b, hq, start, R0; bool isctx; };
__device__ __forceinline__ AGeom attn_geom(int item) {
  AGeom g;
  if (item < 2048) {
    g.b = item >> 8; g.hq = (item >> 5) & 7; g.start = (item & 31) * 128; g.R0 = g.b * SEQL + g.start; g.isctx = false;
  } else {
    const int it = item - 2048;
    g.b = it >> 4; g.hq = (it >> 1) & 7; g.start = (it & 1) * 128; g.R0 = NL + g.b * LCTX + g.start; g.isctx = true;
  }
  return g;
}
struct APre { bf16x8 qf[4]; u32x4 pk0, pk1, pv0, pv1; u32x2 gpre[2][4]; };
__device__ __forceinline__ void attn_preload(const EvenBufs& e, int item, int tid, bf16x8 (&qf)[4], u32x4& pk0, u32x4& pk1,
                                             u32x4& pv0, u32x4& pv1, u32x2 (&gpre)[2][4]) {
  const AGeom g = attn_geom(item);
  const int lane = tid & 63, w = tid >> 6, r = lane & 31, h = lane >> 5;
  const int kvh = g.hq >> 2;
  const int qrow = g.R0 + w * 32 + r;
#pragma unroll
  for (int s = 0; s < 4; ++s) qf[s] = *(const bf16x8*)(e.qb + (size_t)qrow * 512 + g.hq * 64 + s * 16 + h * 8);
  const int lr0 = tid >> 3, lc0 = tid & 7;
  const bf16_t* kp = e.kb + (size_t)(NL + g.b * LCTX) * 128 + kvh * 64;
  const bf16_t* vp = e.vtc + (size_t)((g.b * 2 + kvh) * 64) * LCTX;
  pk0 = *(const u32x4*)(kp + (size_t)lr0 * 128 + lc0 * 8);
  pk1 = *(const u32x4*)(kp + (size_t)(lr0 + 32) * 128 + lc0 * 8);
  pv0 = *(const u32x4*)(vp + (size_t)lr0 * LCTX + lc0 * 8);
  pv1 = *(const u32x4*)(vp + (size_t)(lr0 + 32) * LCTX + lc0 * 8);
#pragma unroll
  for (int dt = 0; dt < 2; ++dt)
#pragma unroll
    for (int q4 = 0; q4 < 4; ++q4) gpre[dt][q4] = *(const u32x2*)(e.gbs + (size_t)qrow * 512 + g.hq * 64 + dt * 32 + 8 * q4 + 4 * h);
}

__device__ void attn_item(const Params& p, const EvenBufs& e, int item, int next_item, char* smem, int ei, bf16x8 (&qf)[4],
                          u32x4& pk0, u32x4& pk1, u32x4& pv0, u32x4& pv1, u32x2 (&gpre)[2][4]) {
  bf16_t* Ks = (bf16_t*)smem;
  bf16_t* Vs = Ks + 64 * AS;
  const int tid = otid(), lane = tid & 63, w = __builtin_amdgcn_readfirstlane(tid >> 6);
  const int r = lane & 31, h = lane >> 5;
  const AGeom geo = attn_geom(item);
  const int b = geo.b, hq = geo.hq, start = geo.start, R0 = geo.R0;
  const bool isctx = geo.isctx;
  const int kvh = hq >> 2;
  const int qrow = R0 + w * 32 + r;
  float m = p.b_sink[ei * 8 + hq] * 1.4426950408889634f, l = 1.f;
  bf16x8 qfn[4];
  u32x2 gpn[2][4];
  f32x16 o[2];
  o[0] = zero16();
  o[1] = zero16();
  const int nblk = isctx ? 4 : 10;
  auto kb_desc = [&](int kb, const bf16_t*& kp, const bf16_t*& vp, int& vstride, int& kpos0, bool& local) -> bool {
    if (kb < 4) {
      kp = e.kb + (size_t)(NL + b * LCTX + kb * 64) * 128 + kvh * 64;
      vp = e.vtc + (size_t)((b * 2 + kvh) * 64) * LCTX + kb * 64;
      vstride = LCTX; kpos0 = 0; local = false;
      return true;
    }
    kpos0 = start - 128 + (kb - 4) * 64;
    local = true;
    if (kpos0 < 0 || kpos0 >= SEQL) return false;
    kp = e.kb + (size_t)(b * SEQL + kpos0) * 128 + kvh * 64;
    vp = e.vtl + (size_t)((b * 2 + kvh) * 64) * SEQL + kpos0;
    vstride = SEQL;
    return true;
  };
  const int lr0 = tid >> 3, lc0 = tid & 7;
  for (int kb = 0; kb < nblk; ++kb) {
    int kpos0 = 0;
    bool local = false;
    bool valid;
    {
      const bf16_t *kp, *vp; int vs;
      valid = kb_desc(kb, kp, vp, vs, kpos0, local);
    }
    __syncthreads();
    if (valid) {
      *(u32x4*)(Ks + lr0 * AS + lc0 * 8) = pk0;
      *(u32x4*)(Ks + (lr0 + 32) * AS + lc0 * 8) = pk1;
      *(u32x4*)(Vs + lr0 * AS + lc0 * 8) = pv0;
      *(u32x4*)(Vs + (lr0 + 32) * AS + lc0 * 8) = pv1;
    }
    __syncthreads();
    if (kb + 1 < nblk) {
      const bf16_t *kp = nullptr, *vp = nullptr; int vs = 0, kp0; bool lc;
      if (kb_desc(kb + 1, kp, vp, vs, kp0, lc)) {
        pk0 = *(const u32x4*)(kp + (size_t)lr0 * 128 + lc0 * 8);
        pk1 = *(const u32x4*)(kp + (size_t)(lr0 + 32) * 128 + lc0 * 8);
        pv0 = *(const u32x4*)(vp + (size_t)lr0 * vs + lc0 * 8);
        pv1 = *(const u32x4*)(vp + (size_t)(lr0 + 32) * vs + lc0 * 8);
      }
    }
    else if (next_item >= 0) attn_preload(e, next_item, tid, qfn, pk0, pk1, pv0, pv1, gpn);
    if (!valid) continue;
    if (local) {
      const int qmin = start + w * 32;
      if (kpos0 > qmin + 31 + 128 || kpos0 + 63 < qmin - 128) continue;
    }
    f32x16 s[2];
#pragma unroll
    for (int kt = 0; kt < 2; ++kt) {
      s[kt] = zero16();
#pragma unroll
      for (int ks = 0; ks < 4; ++ks) {
        bf16x8 a = *(const bf16x8*)(Ks + (kt * 32 + r) * AS + ks * 16 + h * 8);
        s[kt] = __builtin_amdgcn_mfma_f32_32x32x16_bf16(a, qf[ks], s[kt], 0, 0, 0);
      }
    }
    if (local) {
      const int qmin = start + w * 32;
      const bool interior = (kpos0 >= qmin + 31 - 128) && (kpos0 + 63 <= qmin + 128);
      if (!interior) {
        const int dqp = (start + w * 32 + r) - kpos0 - 4 * h + 128;
#pragma unroll
        for (int kt = 0; kt < 2; ++kt)
#pragma unroll
          for (int reg = 0; reg < 16; ++reg) {
            const int d = dqp - (kt * 32 + (reg & 3) + 8 * (reg >> 2));
            if ((unsigned)d > 256u) s[kt][reg] = -1e30f;
          }
      }
    }
    float mx = m;
#pragma unroll
    for (int kt = 0; kt < 2; ++kt)
#pragma unroll
      for (int reg = 0; reg < 16; reg += 2) mx = fmaxf(fmaxf(mx, s[kt][reg]), s[kt][reg + 1]);
    mx = fmaxf(mx, __shfl_xor(mx, 32));
    const bool grew = __any(mx > m) != 0;
    float rs = 0.f;
#pragma unroll
    for (int kt = 0; kt < 2; ++kt)
#pragma unroll
      for (int reg = 0; reg < 16; ++reg) {
        const float pv = __builtin_amdgcn_exp2f(s[kt][reg] - mx);
        rs += pv;
        s[kt][reg] = pv;
      }
    rs += __shfl_xor(rs, 32);
    if (grew) {
      const float alpha = __builtin_amdgcn_exp2f(m - mx);
      m = mx;
      l = l * alpha + rs;
#pragma unroll
      for (int dt = 0; dt < 2; ++dt)
#pragma unroll
        for (int reg = 0; reg < 16; ++reg) o[dt][reg] *= alpha;
    } else {
      l += rs;
    }
#pragma unroll
    for (int kt = 0; kt < 2; ++kt)
#pragma unroll
      for (int sp = 0; sp < 2; ++sp) {
        union { bf16x8 v; uint32_t u[4]; } pf;
#pragma unroll
        for (int j = 0; j < 4; ++j) pf.u[j] = pack2(s[kt][8 * sp + 2 * j], s[kt][8 * sp + 2 * j + 1]);
#pragma unroll
        for (int dt = 0; dt < 2; ++dt) {
          const bf16_t* vp = Vs + (dt * 32 + r) * AS + kt * 32 + sp * 16 + 4 * h;
          union { bf16x8 v; u32x2 u[2]; } af;
          af.u[0] = *(const u32x2*)(vp);
          af.u[1] = *(const u32x2*)(vp + 8);
          o[dt] = __builtin_amdgcn_mfma_f32_32x32x16_bf16(af.v, pf.v, o[dt], 0, 0, 0);
        }
      }
  }
  const float inv = 1.f / l;
  bf16_t* ymix = p.hbuf;
#pragma unroll
  for (int dt = 0; dt < 2; ++dt)
#pragma unroll
    for (int q4 = 0; q4 < 4; ++q4) {
      const int d0 = dt * 32 + 8 * q4 + 4 * h;
      const u32x2 g = gpre[dt][q4];
      u32x2 pk;
      pk.x = pack2(o[dt][q4 * 4 + 0] * inv * lo_bf(g.x), o[dt][q4 * 4 + 1] * inv * hi_bf(g.x));
      pk.y = pack2(o[dt][q4 * 4 + 2] * inv * lo_bf(g.y), o[dt][q4 * 4 + 3] * inv * hi_bf(g.y));
      *(u32x2*)(ymix + (size_t)qrow * 1024 + 512 + hq * 64 + d0) = pk;
    }
  if (next_item >= 0) {
#pragma unroll
    for (int s2 = 0; s2 < 4; ++s2) qf[s2] = qfn[s2];
#pragma unroll
    for (int dt = 0; dt < 2; ++dt)
#pragma unroll
      for (int q4 = 0; q4 < 4; ++q4) gpre[dt][q4] = gpn[dt][q4];
  }
}

constexpr int MS = 136;

__device__ void gmlp_item(const Params& p, const EvenBufs& e, int item, char* smem, int ei) {
  bf16_t* Ws = (bf16_t*)smem;
  bf16_t* VT = Ws + 128 * MS;
  const int tid = otid(), lane = tid & 63, w = __builtin_amdgcn_readfirstlane(tid >> 6);
  const int r = lane & 31, h = lane >> 5;
  const int wm = w >> 1, wn = w & 1;
  const int rt = item >> 2, g = item & 3;
  const int R0 = rt * 128;
  u32x4 wreg[8], vreg[2][4];
  {
    const bf16_t* wsrc = p.wsb + (size_t)(ei * 4 + g) * 128 * 128;
#pragma unroll
    for (int i = 0; i < 8; ++i) {
      const int idx = tid + 256 * i;
      wreg[i] = *(const u32x4*)(wsrc + (idx >> 4) * 128 + (idx & 15) * 8);
    }
#pragma unroll
    for (int hp = 0; hp < 2; ++hp) {
      const bf16_t* vsrc = e.vg + (size_t)(R0 + hp * 64 + (tid >> 2)) * 512 + g * 128 + (tid & 3) * 32;
#pragma unroll
      for (int i = 0; i < 4; ++i) vreg[hp][i] = *(const u32x4*)(vsrc + i * 8);
    }
  }
  __syncthreads();
#pragma unroll
  for (int i = 0; i < 8; ++i) {
    const int idx = tid + 256 * i;
    *(u32x4*)(Ws + (idx >> 4) * MS + (idx & 15) * 8) = wreg[i];
  }
#pragma unroll
  for (int hp = 0; hp < 2; ++hp) {
    const int q = hp * 64 + (tid >> 2), qt = tid & 3;
    float xv[32];
#pragma unroll
    for (int i = 0; i < 4; ++i) {
      const u32x4 u = vreg[hp][i];
      xv[i * 8 + 0] = lo_bf(u.x); xv[i * 8 + 1] = hi_bf(u.x);
      xv[i * 8 + 2] = lo_bf(u.y); xv[i * 8 + 3] = hi_bf(u.y);
      xv[i * 8 + 4] = lo_bf(u.z); xv[i * 8 + 5] = hi_bf(u.z);
      xv[i * 8 + 6] = lo_bf(u.w); xv[i * 8 + 7] = hi_bf(u.w);
    }
    float sm = 0.f;
#pragma unroll
    for (int j = 0; j < 32; ++j) sm += xv[j];
    sm += __shfl_xor(sm, 1);
    sm += __shfl_xor(sm, 2);
    const float mean = sm * (1.f / 128.f);
    float sq = 0.f;
#pragma unroll
    for (int j = 0; j < 32; ++j) { float dlt = xv[j] - mean; sq += dlt * dlt; }
    sq += __shfl_xor(sq, 1);
    sq += __shfl_xor(sq, 2);
    const float rstd = rsqrtf(sq * (1.f / 128.f) + 1e-6f);
    bf16_t* vdst = VT + (qt * 32) * MS + (q ^ (16 * qt));
#pragma unroll
    for (int j = 0; j < 32; ++j) vdst[j * MS] = f2bf((xv[j] - mean) * rstd);
  }
  __syncthreads();
  u32x2 upre[2][2][4], gapre[2][2][4];
#pragma unroll
  for (int mi = 0; mi < 2; ++mi)
#pragma unroll
    for (int ni = 0; ni < 2; ++ni)
#pragma unroll
      for (int q4 = 0; q4 < 4; ++q4) {
        const size_t off = (size_t)(R0 + wm * 64 + mi * 32 + r) * 512 + g * 128 + wn * 64 + ni * 32 + 8 * q4 + 4 * h;
        upre[mi][ni][q4] = *(const u32x2*)(e.ug + off);
        gapre[mi][ni][q4] = *(const u32x2*)(e.gas + off);
      }
  float4 lgpre[2][4], lbpre[2][4];
  float bspre[2], wspre[2];
#pragma unroll
  for (int ni = 0; ni < 2; ++ni)
#pragma unroll
    for (int q4 = 0; q4 < 4; ++q4) {
      const int d0p = wn * 64 + ni * 32 + 8 * q4 + 4 * h;
      lgpre[ni][q4] = *(const float4*)(p.a_ln_g + ei * 512 + g * 128 + d0p);
      lbpre[ni][q4] = *(const float4*)(p.a_ln_b + ei * 512 + g * 128 + d0p);
    }
#pragma unroll
  for (int mi = 0; mi < 2; ++mi) {
    bspre[mi] = p.a_b_s[(ei * 4 + g) * 128 + wm * 64 + mi * 32 + r];
    wspre[mi] = p.wsum[(ei * 4 + g) * 128 + wm * 64 + mi * 32 + r];
  }
  f32x16 acc[2][2];
#pragma unroll
  for (int ni = 0; ni < 2; ++ni)
#pragma unroll
    for (int mi = 0; mi < 2; ++mi) acc[ni][mi] = zero16();
  const bf16_t* Aw = Ws + (wm * 64 + r) * MS + h * 8;
  const bf16_t* Bw = VT + (wn * 64 + r) * MS;
  const int sw0 = 16 * ((wn * 2) & 3), sw1 = 16 * ((wn * 2 + 1) & 3);
#pragma unroll
  for (int ks = 0; ks < 8; ++ks) {
    bf16x8 a0 = *(const bf16x8*)(Aw + ks * 16);
    bf16x8 a1 = *(const bf16x8*)(Aw + 32 * MS + ks * 16);
    bf16x8 b0 = *(const bf16x8*)(Bw + ((ks * 16 + h * 8) ^ sw0));
    bf16x8 b1 = *(const bf16x8*)(Bw + 32 * MS + ((ks * 16 + h * 8) ^ sw1));
    acc[0][0] = __builtin_amdgcn_mfma_f32_32x32x16_bf16(b0, a0, acc[0][0], 0, 0, 0);
    acc[0][1] = __builtin_amdgcn_mfma_f32_32x32x16_bf16(b0, a1, acc[0][1], 0, 0, 0);
    acc[1][0] = __builtin_amdgcn_mfma_f32_32x32x16_bf16(b1, a0, acc[1][0], 0, 0, 0);
    acc[1][1] = __builtin_amdgcn_mfma_f32_32x32x16_bf16(b1, a1, acc[1][1], 0, 0, 0);
  }
  bf16_t* ymix = p.hbuf;
  const float* bs = p.a_b_s + (ei * 4 + g) * 128;
  const float* wsm = p.wsum + (ei * 4 + g) * 128;
  const float* lgp = p.a_ln_g + ei * 512 + g * 128;
  const float* lbp = p.a_ln_b + ei * 512 + g * 128;
#pragma unroll
  for (int mi = 0; mi < 2; ++mi) {
    const int prow = wm * 64 + mi * 32 + r;
    const float bsv = bspre[mi], wsv = wspre[mi];
    const size_t row = (size_t)(R0 + prow);
#pragma unroll
    for (int ni = 0; ni < 2; ++ni)
#pragma unroll
      for (int q4 = 0; q4 < 4; ++q4) {
        const int d0 = wn * 64 + ni * 32 + 8 * q4 + 4 * h;
        const float4 lg = lgpre[ni][q4];
        const float4 lb = lbpre[ni][q4];
        const u32x2 uu = upre[mi][ni][q4];
        const u32x2 gg = gapre[mi][ni][q4];
        const float s0 = lg.x * acc[ni][mi][q4 * 4 + 0] + (lb.x * wsv + bsv);
        const float s1 = lg.y * acc[ni][mi][q4 * 4 + 1] + (lb.y * wsv + bsv);
        const float s2 = lg.z * acc[ni][mi][q4 * 4 + 2] + (lb.z * wsv + bsv);
        const float s3 = lg.w * acc[ni][mi][q4 * 4 + 3] + (lb.w * wsv + bsv);
        u32x2 pk;
        pk.x = pack2(lo_bf(uu.x) * s0 * lo_bf(gg.x), hi_bf(uu.x) * s1 * hi_bf(gg.x));
        pk.y = pack2(lo_bf(uu.y) * s2 * lo_bf(gg.y), hi_bf(uu.y) * s3 * hi_bf(gg.y));
        *(u32x2*)(ymix + row * 1024 + g * 128 + d0) = pk;
      }
  }
}

__device__ void phase_even_mix(const Params& p, char* smem, int ei) {
  const EvenBufs e = even_bufs(p);
  const int n_attn = 2048 + 128, n_gmlp = 1088;
  const int step = nvblk();
  int item = vblk();
  if (item < n_attn) {
    bf16x8 qf[4];
    u32x4 pk0, pk1, pv0, pv1;
    u32x2 gpre[2][4];
    attn_preload(e, item, otid(), qf, pk0, pk1, pv0, pv1, gpre);
    while (item < n_attn) {
      const int nxt = item + step;
      attn_item(p, e, item, nxt < n_attn ? nxt : -1, smem, ei, qf, pk0, pk1, pv0, pv1, gpre);
      item = nxt;
    }
  }
  for (; item < n_attn + n_gmlp; item += step) gmlp_item(p, e, item - n_attn, smem, ei);
}

__device__ void phase_conv(const Params& p, int oi) {
  const OddBufs ob = odd_bufs(p);
  const bf16_t* xr = ob.xr;
  bf16_t* zb = ob.sg + (size_t)NR * 1024;
  const int tid = ofull();
  const int total = (NR / 8) * 128;
  const int chb = ((blockIdx.x * NTHREADS + tid) & 127) * 8;
    float cw[4][8], cbias[8];
#pragma unroll
    for (int j = 0; j < 4; ++j) {
      const float4 w0 = *(const float4*)(p.c_conv_w + ((size_t)oi * 4 + j) * 1024 + chb);
      const float4 w1 = *(const float4*)(p.c_conv_w + ((size_t)oi * 4 + j) * 1024 + chb + 4);
      cw[j][0] = w0.x; cw[j][1] = w0.y; cw[j][2] = w0.z; cw[j][3] = w0.w;
      cw[j][4] = w1.x; cw[j][5] = w1.y; cw[j][6] = w1.z; cw[j][7] = w1.w;
    }
    {
      const float4 b0 = *(const float4*)(p.c_conv_b + oi * 1024 + chb);
      const float4 b1 = *(const float4*)(p.c_conv_b + oi * 1024 + chb + 4);
      cbias[0] = b0.x; cbias[1] = b0.y; cbias[2] = b0.z; cbias[3] = b0.w;
      cbias[4] = b1.x; cbias[5] = b1.y; cbias[6] = b1.z; cbias[7] = b1.w;
    }
  auto load_rows = [&](int id, u32x4 (&raw)[11]) {
    const int R0 = (id >> 7) * 8;
    int t0, Ls;
    if (R0 < NL) { t0 = R0 & (SEQL - 1); Ls = SEQL; } else { t0 = (R0 - NL) & (LCTX - 1); Ls = LCTX; }
#pragma unroll
    for (int jj = 0; jj < 11; ++jj) {
      const int t = t0 - 2 + jj;
      raw[jj] = (u32x4){0u, 0u, 0u, 0u};
      if (t >= 0 && t < Ls) raw[jj] = *(const u32x4*)(xr + (size_t)(R0 - 2 + jj) * 1024 + chb);
    }
  };
  const int id0 = blockIdx.x * NTHREADS + tid, idstep = gridDim.x * NTHREADS;
  u32x4 cur[11];
  if (id0 < total) load_rows(id0, cur);
  for (int id = id0; id < total; id += idstep) {
    const int R0 = (id >> 7) * 8;
    u32x4 nxt[11];
    const bool more = id + idstep < total;
    if (more) load_rows(id + idstep, nxt);
    float xw[11][8];
#pragma unroll
    for (int jj = 0; jj < 11; ++jj) {
      const u32x4 u = cur[jj];
      xw[jj][0] = lo_bf(u.x); xw[jj][1] = hi_bf(u.x);
      xw[jj][2] = lo_bf(u.y); xw[jj][3] = hi_bf(u.y);
      xw[jj][4] = lo_bf(u.z); xw[jj][5] = hi_bf(u.z);
      xw[jj][6] = lo_bf(u.w); xw[jj][7] = hi_bf(u.w);
    }
#pragma unroll
    for (int i = 0; i < 8; ++i) {
      float z[8];
#pragma unroll
      for (int e2 = 0; e2 < 8; ++e2) {
        float a = cbias[e2];
#pragma unroll
        for (int j = 0; j < 4; ++j) a += cw[j][e2] * xw[i + j][e2];
        z[e2] = a;
      }
      u32x4 pk;
      pk.x = pack2(z[0], z[1]); pk.y = pack2(z[2], z[3]);
      pk.z = pack2(z[4], z[5]); pk.w = pack2(z[6], z[7]);
      *(u32x4*)(zb + (size_t)(R0 + i) * 1024 + chb) = pk;
    }
    if (more) {
#pragma unroll
      for (int jj = 0; jj < 11; ++jj) cur[jj] = nxt[jj];
    }
  }
}

constexpr int ZS = 264;

template <int DIR>
__device__ void rglru_item(const Params& p, const OddBufs& ob, int item, char* smem, int oi, bool need_ctx) {
  bf16_t* Zs = (bf16_t*)smem;
  float* segA = (float*)(Zs + 128 * ZS);
  float* segB = segA + 256;
  float* carry = segB + 256;
  constexpr int LT = 132;
  float* La = (float*)Zs;
  float* Gz = La + 32 * LT;
  const int tid = otid(), lane = tid & 63, w = __builtin_amdgcn_readfirstlane(tid >> 6);
  const int r = lane & 31, h = lane >> 5;
  const int wm = w >> 1, wn = w & 1;
  const int b = item >> 6, cs = item & 31;
  constexpr int dir = DIR;
  const int hd = cs >> 3, j0 = (cs & 7) * 32, c0 = cs * 32;
  bf16_t* sout = p.hbuf;
  const bf16_t* zb = ob.sg + (size_t)NR * 1024;
  __syncthreads();
  if (tid < 32) carry[tid] = 0.f;
  bf16x8 bfr[16];
  {
    const size_t mo = ((size_t)((oi * 2 + dir) * 4 + hd)) * 65536 + (size_t)(j0 + r) * 256 + h * 8;
    const bf16_t* wsrc = (wn ? p.wgi : p.wga) + mo;
#pragma unroll
    for (int ks = 0; ks < 16; ++ks) bfr[ks] = *(const bf16x8*)(wsrc + ks * 16);
  }
  const int gch = (oi * 2 + dir) * 1024 + c0 + r;
  const float gbias = wn ? p.c_b_i[gch] : p.c_b_a[gch];
  const float spl = log1pf(__expf(-p.c_lam[gch]));
  const int sc_c = tid & 31, sc_sg = tid >> 5;
  const int lrow = tid >> 5, kc = tid & 31;

  u32x4 zt[4];
  {
    const int Rs0 = NL + b * LCTX;
    const int ti0 = dir ? 1 : 0;
    const bf16_t* src = zb + (size_t)(Rs0 + ti0 * 128 + lrow) * 1024 + hd * 256 + kc * 8;
#pragma unroll
    for (int i = 0; i < 4; ++i) zt[i] = *(const u32x4*)(src + (size_t)i * 8 * 1024);
  }
  const int sbase = DIR ? (7 - sc_sg) * 16 : sc_sg * 16;
  const unsigned voff = (unsigned)(sbase * 1024 + c0 + sc_c);
  for (int step = 0; step < 34; ++step) {
    int Rs, ti;
    bool wr;
    if (step < 2) { Rs = NL + b * LCTX; ti = dir ? 1 - step : step; wr = need_ctx; }
    else { Rs = b * SEQL; ti = dir ? 31 - (step - 2) : (step - 2); wr = true; }
    const int t0 = ti * 128;
    __syncthreads();
    {
      const bf16_t* src2 = zb + (size_t)(Rs + t0 + lrow + 32) * 1024 + hd * 256 + kc * 8;
      u32x4 z2[12];
#pragma unroll
      for (int i = 0; i < 12; ++i) z2[i] = *(const u32x4*)(src2 + (size_t)i * 8 * 1024);
#pragma unroll
      for (int i = 0; i < 4; ++i) *(u32x4*)(Zs + (lrow + 8 * i) * ZS + kc * 8) = zt[i];
#pragma unroll
      for (int i = 0; i < 12; ++i) *(u32x4*)(Zs + (lrow + 32 + 8 * i) * ZS + kc * 8) = z2[i];
    }
    const bf16_t* sgp = ob.sg + (size_t)(Rs + t0) * 1024;
    bf16_t sgv[16];
    const bool later = (step < 2) ? (step == 1) : (DIR ? (ti <= 15) : (ti >= 16));
    const bf16_t* sip = sout + (size_t)(Rs + t0) * 1024;
    bf16_t prv[16];
    if (wr) {
#pragma unroll
      for (int i = 0; i < 16; ++i) sgv[i] = sgp[voff + (DIR ? 15 - i : i) * 1024];
      if (later) {
#pragma unroll
        for (int i = 0; i < 16; ++i) prv[i] = sip[voff + (DIR ? 15 - i : i) * 1024];
      }
    }
    __syncthreads();
    f32x16 acc[2];
    acc[0] = zero16();
    acc[1] = zero16();
    {
      const bf16_t* Aw = Zs + (wm * 64 + r) * ZS + h * 8;
#pragma unroll
      for (int ks = 0; ks < 16; ++ks) {
        bf16x8 a0 = *(const bf16x8*)(Aw + ks * 16);
        bf16x8 a1 = *(const bf16x8*)(Aw + 32 * ZS + ks * 16);
        acc[0] = __builtin_amdgcn_mfma_f32_32x32x16_bf16(a0, bfr[ks], acc[0], 0, 0, 0);
        acc[1] = __builtin_amdgcn_mfma_f32_32x32x16_bf16(a1, bfr[ks], acc[1], 0, 0, 0);
      }
    }
    if (wn == 0) {
#pragma unroll
      for (int mi = 0; mi < 2; ++mi)
#pragma unroll
        for (int reg = 0; reg < 16; ++reg) acc[mi][reg] = -8.f * spl * sigmoid_f(acc[mi][reg] + gbias);
    } else {
#pragma unroll
      for (int mi = 0; mi < 2; ++mi) {
        float zv[16];
#pragma unroll
        for (int reg = 0; reg < 16; ++reg) {
          const int row = wm * 64 + mi * 32 + (reg & 3) + 8 * (reg >> 2) + 4 * h;
          zv[reg] = bf2f(Zs[row * ZS + j0 + r]);
        }
#pragma unroll
        for (int reg = 0; reg < 16; ++reg) acc[mi][reg] = zv[reg] * sigmoid_f(acc[mi][reg] + gbias);
        asm volatile("" ::: "memory");
      }
    }
    __syncthreads();
    {
      float* dstb = (wn ? Gz : La) + r * LT + wm * 64 + 4 * h;
#pragma unroll
      for (int mi = 0; mi < 2; ++mi)
#pragma unroll
        for (int q4 = 0; q4 < 4; ++q4) {
          pg8::f32x4 v4 = {acc[mi][q4 * 4 + 0], acc[mi][q4 * 4 + 1], acc[mi][q4 * 4 + 2], acc[mi][q4 * 4 + 3]};
          *(pg8::f32x4*)(dstb + mi * 32 + 8 * q4) = v4;
        }
    }
    __syncthreads();
    if (step + 1 < 34) {
      const int ns = step + 1;
      int nRs, nti;
      if (ns < 2) { nRs = NL + b * LCTX; nti = dir ? 1 - ns : ns; }
      else { nRs = b * SEQL; nti = dir ? 31 - (ns - 2) : (ns - 2); }
      const bf16_t* src = zb + (size_t)(nRs + nti * 128 + lrow) * 1024 + hd * 256 + kc * 8;
#pragma unroll
      for (int i = 0; i < 4; ++i) zt[i] = *(const u32x4*)(src + (size_t)i * 8 * 1024);
    }
    bf16_t* sop = sout + (size_t)(Rs + t0) * 1024;
    float* Lap = La + sc_c * LT + sbase;
    float* Gzp = Gz + sc_c * LT + sbase;
    {
      pg8::f32x4 va[4], vg[4];
#pragma unroll
      for (int k = 0; k < 4; ++k) { va[k] = *(const pg8::f32x4*)(Lap + 4 * k); vg[k] = *(const pg8::f32x4*)(Gzp + 4 * k); }
      float A = 1.f, Bv = 0.f;
#pragma unroll
      for (int i = 0; i < 16; ++i) {
        const int ro = DIR ? 15 - i : i;
        const float la = va[ro >> 2][ro & 3];
        const float a = __expf(la);
        const float mult = __builtin_amdgcn_sqrtf(fmaf(-a, a, 1.f));
        const float bx = mult * vg[ro >> 2][ro & 3];
        va[ro >> 2][ro & 3] = a;
        vg[ro >> 2][ro & 3] = bx;
        Bv = a * Bv + bx;
        A *= a;
      }
#pragma unroll
      for (int k = 0; k < 4; ++k) { *(pg8::f32x4*)(Lap + 4 * k) = va[k]; *(pg8::f32x4*)(Gzp + 4 * k) = vg[k]; }
      segA[sc_sg * 32 + sc_c] = A;
      segB[sc_sg * 32 + sc_c] = Bv;
    }
    __syncthreads();
    {
      float hh = carry[(step & 1) * 32 + sc_c];
      {
        float sa[7], sbv[7];
#pragma unroll
        for (int s2 = 0; s2 < 7; ++s2) { sa[s2] = segA[s2 * 32 + sc_c]; sbv[s2] = segB[s2 * 32 + sc_c]; }
#pragma unroll
        for (int s2 = 0; s2 < 7; ++s2) hh = (s2 < sc_sg) ? (sa[s2] * hh + sbv[s2]) : hh;
      }
      pg8::f32x4 va[4], vg[4];
#pragma unroll
      for (int k = 0; k < 4; ++k) { va[k] = *(const pg8::f32x4*)(Lap + 4 * k); vg[k] = *(const pg8::f32x4*)(Gzp + 4 * k); }
#pragma unroll
      for (int i = 0; i < 16; ++i) {
        const int ro = (DIR ? 15 - i : i);
        hh = va[ro >> 2][ro & 3] * hh + vg[ro >> 2][ro & 3];
        if (wr) {
          float ov = hh * bf2f(sgv[i]);
          if (later) ov += bf2f(prv[i]);
          sop[voff + ro * 1024] = f2bf(ov);
        }
      }
      if (sc_sg == 7) carry[((step + 1) & 1) * 32 + sc_c] = hh;
    }
  }
}

__device__ void phase_rglru(const Params& p, char* smem, int oi, bool need_ctx) {
  const OddBufs ob = odd_bufs(p);
  const int vb = vbid();
  for (int P0 = blockIdx.x; P0 < 256; P0 += gridDim.x) {
    const int xcd = P0 & 7, slot = P0 >> 3;
    const int grp = xcd * 4 + (slot >> 3), j = slot & 7;
    const int item = ((grp >> 2) << 6) | ((grp & 3) << 3) | j;
    if (vb) rglru_item<1>(p, ob, item, smem, oi, need_ctx);
    else rglru_item<0>(p, ob, item, smem, oi, need_ctx);
  }
}

#define XB_TMO      128
#define XB_XCNT(j)  (256  + 64 * (j))
#define XB_XSUB(j)  (1280 + 64 * (j))
#define XB_XGEN(j)  (2304 + 64 * (j))
#define XB_TOP      3328
#define XB_TOPGEN   3392
#define XCD_BAR_WORDS 3456
#define XB_SPIN_CAP (1u << 18)
#define LAS __attribute__((address_space(3)))

__device__ __forceinline__ unsigned xb_ld(unsigned* p)              { return __hip_atomic_load(p, __ATOMIC_RELAXED, __HIP_MEMORY_SCOPE_AGENT); }
__device__ __forceinline__ unsigned xb_add(unsigned* p, unsigned v) { return __hip_atomic_fetch_add(p, v, __ATOMIC_RELAXED, __HIP_MEMORY_SCOPE_AGENT); }
__device__ __forceinline__ unsigned xb_xcc_id() { return (unsigned)__builtin_amdgcn_s_getreg((3 << 11) | 20) & 0xFu; }
#define XB_SPIN(cond, bar) do { unsigned _sp = 0; while (cond) { __builtin_amdgcn_s_sleep(1); \
    if ((++_sp & 255u) == 0u) { if (xb_ld(&(bar)[XB_TMO])) break; if (_sp > XB_SPIN_CAP) { atomicAdd(&(bar)[XB_TMO], 1u); break; } } } } while (0)

struct XcdBarrier {
    unsigned* bar; unsigned x;
    volatile LAS unsigned* st;
};

__device__ __forceinline__ XcdBarrier xcd_barrier_post(unsigned* bar, volatile LAS unsigned* st) {
    XcdBarrier b; b.bar = bar; b.x = xb_xcc_id(); b.st = st;
    if (threadIdx.x == 0) (void)xb_add(&bar[XB_XCNT(b.x)], 1u);
    return b;
}
__device__ __forceinline__ void xcd_barrier_complete(unsigned* bar, unsigned x, unsigned& nloc, unsigned& nx) {
    const unsigned G = gridDim.x * gridDim.y * gridDim.z;
    unsigned sum, cnt, mine, sp = 0u;
    for (;;) {
        sum = 0u; cnt = 0u; mine = 0u;
#pragma unroll
        for (unsigned j = 0; j < 16; ++j) { const unsigned c = xb_ld(&bar[XB_XCNT(j)]); sum += c; cnt += (c > 0u) ? 1u : 0u; mine = (j == x) ? c : mine; }
        if (sum == G) break;
        __builtin_amdgcn_s_sleep(1);
        if ((++sp & 255u) == 0u) { if (xb_ld(&bar[XB_TMO])) break; if (sp > XB_SPIN_CAP) { atomicAdd(&bar[XB_TMO], 1u); break; } }
    }
    nloc = mine > 0u ? mine : 1u; nx = cnt > 0u ? cnt : 1u;
}

__device__ __forceinline__ void xcd_barrier(const XcdBarrier& b) {
    asm volatile("s_waitcnt vmcnt(0)" ::: "memory");
    __syncthreads();
    if (threadIdx.x == 0) {
        unsigned* bar = b.bar;
        __builtin_amdgcn_s_waitcnt(0);
        unsigned nloc = b.st[0], nx = b.st[1];
        if (nloc == 0u) { xcd_barrier_complete(bar, b.x, nloc, nx); b.st[0] = nloc; b.st[1] = nx; }
        const unsigned old = xb_add(&bar[XB_XSUB(b.x)], 1u);
        const unsigned gen = old / nloc;
        if (old + 1u == (gen + 1u) * nloc) {
            __builtin_amdgcn_fence(__ATOMIC_RELEASE, "agent");
            asm volatile("s_waitcnt vmcnt(0)" ::: "memory");
            const unsigned og = xb_add(&bar[XB_TOP], 1u);
            const unsigned tg = og / nx;
            if (og + 1u == (tg + 1u) * nx) xb_add(&bar[XB_TOPGEN], 1u);
            else XB_SPIN(xb_ld(&bar[XB_TOPGEN]) == tg, bar);
            __builtin_amdgcn_fence(__ATOMIC_ACQUIRE, "agent");
            xb_add(&bar[XB_XGEN(b.x)], 1u);
            asm volatile("s_waitcnt vmcnt(0)" ::: "memory");
        } else {
            XB_SPIN(xb_ld(&bar[XB_XGEN(b.x)]) == gen, bar);
            __builtin_amdgcn_fence(__ATOMIC_ACQUIRE, "agent");
            asm volatile("s_waitcnt vmcnt(0)" ::: "memory");
        }
    }
    __syncthreads();
}


#define LAUNDER(f) q.f = p.f + z
__device__ __forceinline__ void launder(Params& q, const Params& p) {
  long z;
  asm volatile("s_mov_b64 %0, 0" : "=s"(z));
  LAUNDER(x); LAUNDER(c); LAUNDER(ctx); LAUNDER(c_ctx); LAUNDER(norm_g); LAUNDER(w_mod); LAUNDER(b_mod);
  LAUNDER(ab_w_in); LAUNDER(a_ln_g); LAUNDER(a_ln_b); LAUNDER(a_w_s); LAUNDER(a_b_s); LAUNDER(b_sink);
  LAUNDER(ab_w_out); LAUNDER(c_w_in); LAUNDER(c_conv_w); LAUNDER(c_conv_b); LAUNDER(c_w_a); LAUNDER(c_b_a);
  LAUNDER(c_w_i); LAUNDER(c_b_i); LAUNDER(c_lam); LAUNDER(c_w_out); LAUNDER(final_g); LAUNDER(out);
  LAUNDER(xbuf); LAUNDER(mods); LAUNDER(hbuf); LAUNDER(ebuf); LAUNDER(wt_in_e); LAUNDER(wt_out_e);
  LAUNDER(wt_in_o); LAUNDER(wt_out_o); LAUNDER(wga); LAUNDER(wgi); LAUNDER(wsb); LAUNDER(wsum); LAUNDER(part);
}

constexpr int NPHASES = 20;

__device__ void run_phase(const Params& p0, int ph, char* smem, char* dsm) {
  if (ph == 0) { Params p; launder(p, p0); phase0(p, smem); return; }
  if (ph == 19) { Params p; launder(p, p0); phase_final(p); return; }
  int layer, sub;
  if (ph < 5) { layer = 0; sub = ph - 1; }
  else if (ph < 10) { layer = 1; sub = ph - 5; }
  else if (ph < 14) { layer = 2; sub = ph - 10; }
  else { layer = 3; sub = ph - 14; }
  const int idx = layer >> 1;
  const bool even = (layer & 1) == 0;
  const bool need_ctx = layer < 3;
  if (sub == 0) { Params p; launder(p, p0); phase_prep(p, layer); if (layer == 0) phase0_transposes(p, smem); return; }
  if (even) {
    if (sub == 1) {
      Params p; launder(p, p0);
      EpiEvenIn epi; epi.e = even_bufs(p);
      (void)epi;
      PEpiEvenIn pe; pe.e = even_bufs(p);
      pg8::Gemm g; g.A = p.hbuf; g.Bt = p.wt_in_e + (size_t)idx * 2816 * 1024; g.M = NR; g.N = 2816; g.K = 1024;
      pg8::StaticOrder so; so.init(g.M, g.N, (int)gridDim.x, (int)blockIdx.x);
      pg8::gemm_phase((PG8_LAS unsigned char*)dsm, g, so, pe);
    } else if (sub == 2) {
      Params p; launder(p, p0);
      phase_even_mix(p, smem, idx);
    } else {
      Params p; launder(p, p0);
      EpiOut epi; epi.xbuf = p.xbuf; epi.mods_l = p.mods + (size_t)layer * 9 * 3072;
      epi.xin_lat = (layer == 0) ? p.x : p.xbuf;
      epi.xin_ctx = (layer == 0) ? p.ctx : p.xbuf + (size_t)NL * 1024;
      PEpiOut pe; pe.xbuf = epi.xbuf; pe.xin_lat = epi.xin_lat; pe.xin_ctx = epi.xin_ctx; pe.mods_l = epi.mods_l;
      pe.part = p.part;
      pg8::OutOrder oo;
#pragma unroll 1
      for (int pass = 0; pass < 2; ++pass) {
        pg8::Gemm g; g.A = p.hbuf; g.Bt = p.wt_out_e + (size_t)idx * 1024 * 1024; g.M = pass ? NR : NL; g.N = 1024; g.K = pass ? 256 : 1024;
        oo.so.init(NL, 1024, (int)gridDim.x, (int)blockIdx.x); oo.cs.init((int)gridDim.x, (int)blockIdx.x); oo.mode = pass;
        pe.split = pass;
        pg8::gemm_phase((PG8_LAS unsigned char*)dsm, g, oo, pe);
      }
    }
  } else {
    if (sub == 1) {
      Params p; launder(p, p0);
      EpiOddIn epi; epi.o = odd_bufs(p);
      (void)epi;
      PEpiOddIn pe; pe.o = odd_bufs(p);
      pg8::Gemm g; g.A = p.hbuf; g.Bt = p.wt_in_o + (size_t)idx * 2048 * 1024; g.M = NR; g.N = 2048; g.K = 1024;
      pg8::StaticOrder so; so.init(g.M, g.N, (int)gridDim.x, (int)blockIdx.x);
      pg8::gemm_phase((PG8_LAS unsigned char*)dsm, g, so, pe);
    } else if (sub == 2) {
      Params p; launder(p, p0);
      phase_conv(p, idx);
    } else if (sub == 3) {
      Params p; launder(p, p0);
      phase_rglru(p, smem, idx, need_ctx);
    } else {
      Params p; launder(p, p0);
      EpiOut epi; epi.xbuf = p.xbuf; epi.mods_l = p.mods + (size_t)layer * 9 * 3072;
      epi.xin_lat = (layer == 0) ? p.x : p.xbuf;
      epi.xin_ctx = (layer == 0) ? p.ctx : p.xbuf + (size_t)NL * 1024;
      PEpiOut pe; pe.xbuf = epi.xbuf; pe.xin_lat = epi.xin_lat; pe.xin_ctx = epi.xin_ctx; pe.mods_l = epi.mods_l;
      pe.part = p.part;
      pg8::OutOrder oo;
      const int npass = need_ctx ? 2 : 1;
#pragma unroll 1
      for (int pass = 0; pass < npass; ++pass) {
        pg8::Gemm g; g.A = p.hbuf; g.Bt = p.wt_out_o + (size_t)idx * 1024 * 1024; g.M = pass ? NR : NL; g.N = 1024; g.K = pass ? 256 : 1024;
        oo.so.init(NL, 1024, (int)gridDim.x, (int)blockIdx.x); oo.cs.init((int)gridDim.x, (int)blockIdx.x); oo.mode = pass;
        pe.split = pass;
        pg8::gemm_phase((PG8_LAS unsigned char*)dsm, g, oo, pe);
      }
    }
  }
}

__global__ void __launch_bounds__(NTHREADS, 2) mega_kernel(Params p, int ph_lo, int ph_hi, int use_bar) {
  extern __shared__ __attribute__((aligned(16))) char dsm[];
  uint4* xbw = (uint4*)(dsm + 2 * VSMEM);
  if (threadIdx.x == 0) *xbw = make_uint4(0u, 0u, 0u, 0u);
  __syncthreads();
  if (use_bar == 1) (void)xcd_barrier_post(p.bar, (volatile LAS unsigned*)xbw);
  char* smem = dsm + (threadIdx.x >> 8) * VSMEM;
  for (int ph = ph_lo; ph < ph_hi; ++ph) {
    run_phase(p, ph, smem, dsm);
    if (ph + 1 < ph_hi) {
      if (use_bar == 1) {
        XcdBarrier xb;
        xb.bar = p.bar; xb.x = xb_xcc_id(); xb.st = (volatile LAS unsigned*)xbw;
        xcd_barrier(xb);
      } else if (use_bar == 2) cg::this_grid().sync();
    }
  }
}

extern "C" void kernel_launch(void* const* d_in, const int* in_sizes, int n_in, void* d_out, int out_size,
                              void* d_ws, size_t ws_size, hipStream_t stream) {
  static int grid_blocks = 0;
  if (!grid_blocks) {
    int dev = 0, cus = 0, per_cu = 0;
    hipGetDevice(&dev);
    hipDeviceGetAttribute(&cus, hipDeviceAttributeMultiprocessorCount, dev);
    hipFuncSetAttribute((const void*)mega_kernel, hipFuncAttributeMaxDynamicSharedMemorySize, DSM_BYTES);
    hipOccupancyMaxActiveBlocksPerMultiprocessor(&per_cu, mega_kernel, NTHREADS, DSM_BYTES);
    if (per_cu < 1) per_cu = 1;
    if (per_cu > 1) per_cu = 1;
    grid_blocks = cus * per_cu;
  }
  Params p{};
  const float** fp = (const float**)&p;
  for (int i = 0; i < 24; ++i) fp[i] = (const float*)d_in[i];
  p.out = (float*)d_out;
  char* ws = (char*)d_ws;
  size_t off = 0;
  auto take = [&](size_t bytes) { char* q = ws + off; off += (bytes + 255) & ~(size_t)255; return q; };
  p.xbuf = (float*)take((size_t)NR * 1024 * 4);
  p.mods = (float*)take((size_t)4 * 9 * 3072 * 4);
  p.hbuf = (bf16_t*)take((size_t)NR * 1024 * 2);
  p.ebuf = (bf16_t*)take((size_t)NR * 3072 * 2);
  p.wt_in_e = (bf16_t*)take((size_t)2 * 2816 * 1024 * 2);
  p.wt_out_e = (bf16_t*)take((size_t)2 * 1024 * 1024 * 2);
  p.wt_in_o = (bf16_t*)take((size_t)2 * 2048 * 1024 * 2);
  p.wt_out_o = (bf16_t*)take((size_t)2 * 1024 * 1024 * 2);
  p.wga = (bf16_t*)take((size_t)16 * 65536 * 2);
  p.wgi = (bf16_t*)take((size_t)16 * 65536 * 2);
  p.wsb = (bf16_t*)take((size_t)8 * 16384 * 2);
  p.wsum = (float*)take((size_t)8 * 128 * 4);
  p.part = (float*)take((size_t)4 * NC * 1024 * 4);
  p.bar = (unsigned*)take((size_t)XCD_BAR_WORDS * 4);
  if (off > ws_size) fprintf(stderr, "workspace too small: need %zu have %zu\n", off, ws_size);
#if COOP
  hipMemsetAsync(p.bar, 0, (size_t)XCD_BAR_WORDS * 4, stream);
  int lo = 0, hi = NPHASES, ub = 1;
  void* args[] = {&p, &lo, &hi, &ub};
  hipError_t e = hipLaunchCooperativeKernel((void*)mega_kernel, dim3(grid_blocks), dim3(NTHREADS), args, DSM_BYTES, stream);
  if (e != hipSuccess) fprintf(stderr, "cooperative launch failed: %s (grid %d)\n", hipGetErrorString(e), grid_blocks);
#else
  for (int ph = 0; ph < NPHASES; ++ph) mega_kernel<<<grid_blocks, NTHREADS, DSM_BYTES, stream>>>(p, ph, ph + 1, 0);
#endif
}
```
